# Optimizing an MI355X kernel written in HIP

```python
import math
import jax
import jax.numpy as jnp
from jax import lax
import numpy as np

D_MODEL = 1024
BATCH = 8
SEQ = 2048
DEPTH = 4

GRID_W = 64
CTX_LEN = 256
N_MIXERS = 3
Q_BLOCK = 128
ROPE_THETA = 10000.0
EPS = 1e-6
NEG_INF = -1e30

MLA_V = 64
MLA_HEADS = D_MODEL // MLA_V
MLA_NOPE = 64
MLA_ROPE = 32
MLA_QK = MLA_NOPE + MLA_ROPE
MLA_Q_LORA = 12 * MLA_V
MLA_KV_LORA = 4 * MLA_V

DIFF_HD = 64
DIFF_HEADS = D_MODEL // (2 * DIFF_HD)
DIFF_WIDTH = DIFF_HEADS * 2 * DIFF_HD

SWA_HD = 64
SWA_HEADS = D_MODEL // SWA_HD
SWA_KV_HEADS = 4
SWA_GROUP = SWA_HEADS // SWA_KV_HEADS
WINDOW = 128

PEER_HEADS = 8
PEER_KEYS = 128
PEER_EXPERTS = PEER_KEYS * PEER_KEYS
PEER_KEY_DIM = 128
PEER_TOPK = 16

kernel_name = 'hybrid_mla_diff_swa_peer_dit'


def rms_norm(t, g):
    tf = t.astype(jnp.float32)
    y = tf * lax.rsqrt(jnp.mean(tf * tf, axis=-1, keepdims=True) + EPS)
    return y.astype(t.dtype) * g


def modulate(t, g, shift, scale):
    return rms_norm(t, g) * (1 + scale) + shift


def rope_1d(t, pos):
    nf = t.shape[-1] // 2
    inv = ROPE_THETA ** (-jnp.arange(nf, dtype=jnp.float32) / nf)
    ang = pos.astype(jnp.float32)[:, None] * inv[None, :]
    shape = (pos.shape[0],) + (1,) * (t.ndim - 3) + (nf,)
    cos = jnp.cos(ang).reshape(shape).astype(t.dtype)
    sin = jnp.sin(ang).reshape(shape).astype(t.dtype)
    t1, t2 = t[..., :nf], t[..., nf:]
    return jnp.concatenate([t1 * cos - t2 * sin, t1 * sin + t2 * cos], axis=-1)


def axial_rope(t, row, col):
    half = t.shape[-1] // 2
    return jnp.concatenate([rope_1d(t[..., :half], row), rope_1d(t[..., half:], col)], axis=-1)


def grid_positions(n_tokens):
    rows = n_tokens // GRID_W
    row = jnp.repeat(jnp.arange(rows, dtype=jnp.int32), GRID_W)
    col = jnp.tile(jnp.arange(GRID_W, dtype=jnp.int32), rows)
    return row, col


def to_blocks(t):
    b, n = t.shape[:2]
    return jnp.moveaxis(t.reshape((b, n // Q_BLOCK, Q_BLOCK) + t.shape[2:]), 1, 0)


def from_blocks(t):
    nb, b, qb = t.shape[:3]
    return jnp.moveaxis(t, 0, 1).reshape((b, nb * qb) + t.shape[3:])


def band_blocks(t):
    b, n = t.shape[:2]
    tb = t.reshape((b, n // Q_BLOCK, Q_BLOCK) + t.shape[2:])
    tp = jnp.pad(tb, [(0, 0), (1, 1)] + [(0, 0)] * (tb.ndim - 2))
    nbhd = jnp.concatenate([tp[:, :-2], tp[:, 1:-1], tp[:, 2:]], axis=2)
    return jnp.moveaxis(nbhd, 1, 0)


def band_mask(n):
    nb = n // Q_BLOCK
    blk = jnp.arange(nb)[:, None, None]
    qpos = blk * Q_BLOCK + jnp.arange(Q_BLOCK)[None, :, None]
    kpos = (blk - 1) * Q_BLOCK + jnp.arange(3 * Q_BLOCK)[None, None, :]
    return (jnp.abs(kpos - qpos) <= WINDOW) & (kpos >= 0) & (kpos < n)


def softmax_attn(q, k, v, scale):
    s = jnp.einsum('bqhd,bkhd->bhqk', q, k).astype(jnp.float32) * scale
    p = jax.nn.softmax(s, axis=-1).astype(v.dtype)
    return jnp.einsum('bhqk,bkhd->bqhd', p, v)


def rope_tail(t, row, col):
    return jnp.concatenate([t[..., :MLA_NOPE], axial_rope(t[..., MLA_NOPE:], row, col)], axis=-1)


def mla_project(h, p, row, col, with_q):
    w_down, g_cq, g_ckv, w_uq, w_ukv, g_q, g_k = p
    b, n, _ = h.shape
    lat = h @ w_down
    cq = lat[..., :MLA_Q_LORA]
    ckv = lat[..., MLA_Q_LORA:MLA_Q_LORA + MLA_KV_LORA]
    k_rope = lat[..., MLA_Q_LORA + MLA_KV_LORA:]
    kv = (rms_norm(ckv, g_ckv) @ w_ukv).reshape(b, n, MLA_HEADS, MLA_NOPE + MLA_V)
    k = jnp.concatenate([kv[..., :MLA_NOPE],
                         jnp.broadcast_to(k_rope[:, :, None, :], (b, n, MLA_HEADS, MLA_ROPE))], axis=-1)
    k = rms_norm(k, g_k)
    v = kv[..., MLA_NOPE:]
    q = None
    if with_q:
        q = rms_norm((rms_norm(cq, g_cq) @ w_uq).reshape(b, n, MLA_HEADS, MLA_QK), g_q)
    if row is not None:
        k = rope_tail(k, row, col)
        q = rope_tail(q, row, col)
    return q, k, v


def mla_mixer(hx, hc, row, col, p, w_o, need_ctx):
    scale = MLA_QK ** -0.5
    b, n = hx.shape[:2]
    qx, kx, vx = mla_project(hx, p, row, col, True)
    qc, kc, vc = mla_project(hc, p, None, None, need_ctx)
    k_all = jnp.concatenate([kx, kc], axis=1)
    v_all = jnp.concatenate([vx, vc], axis=1)
    ox = from_blocks(lax.map(lambda qb: softmax_attn(qb, k_all, v_all, scale), to_blocks(qx)))
    yx = ox.reshape(b, n, -1) @ w_o
    yc = softmax_attn(qc, kc, vc, scale).reshape(b, hc.shape[1], -1) @ w_o if need_ctx else None
    return yx, yc


def diff_attn(q, k, v, lam, scale):
    s = jnp.einsum('bqhmd,bkhmd->bhmqk', q, k).astype(jnp.float32) * scale
    p = jax.nn.softmax(s, axis=-1)
    a = (p[:, :, 0] - lam * p[:, :, 1]).astype(v.dtype)
    return jnp.einsum('bhqk,bkhe->bqhe', a, v)


def diff_mixer(hx, hc, row, col, w_qkv, g_q, g_k, lam_p, g_sub, w_o, lam_init, need_ctx):
    scale = DIFF_HD ** -0.5
    lp = lam_p.astype(jnp.float32)
    lam = jnp.exp(jnp.sum(lp[0] * lp[1])) - jnp.exp(jnp.sum(lp[2] * lp[3])) + lam_init

    def project(h, rope, with_q):
        b, n, _ = h.shape
        qkv = h @ w_qkv
        k = rms_norm(qkv[..., DIFF_WIDTH:2 * DIFF_WIDTH].reshape(b, n, DIFF_HEADS, 2, DIFF_HD), g_k)
        v = qkv[..., 2 * DIFF_WIDTH:].reshape(b, n, DIFF_HEADS, 2 * DIFF_HD)
        q = rms_norm(qkv[..., :DIFF_WIDTH].reshape(b, n, DIFF_HEADS, 2, DIFF_HD), g_q) if with_q else None
        if rope:
            k = axial_rope(k, row, col)
            q = axial_rope(q, row, col)
        return q, k, v

    def finish(o):
        b, n = o.shape[:2]
        return (rms_norm(o, g_sub) * (1.0 - lam_init)).reshape(b, n, -1) @ w_o

    qx, kx, vx = project(hx, True, True)
    qc, kc, vc = project(hc, False, need_ctx)
    k_all = jnp.concatenate([kx, kc], axis=1)
    v_all = jnp.concatenate([vx, vc], axis=1)
    ox = from_blocks(lax.map(lambda qb: diff_attn(qb, k_all, v_all, lam, scale), to_blocks(qx)))
    yx = finish(ox)
    yc = finish(diff_attn(qc, kc, vc, lam, scale)) if need_ctx else None
    return yx, yc


def gqa_sink_attn(q, k, v, sink, scale, mask):
    s = jnp.einsum('bqhgd,bnhd->bhgqn', q, k).astype(jnp.float32) * scale
    if mask is not None:
        s = jnp.where(mask, s, NEG_INF)
    sink_col = jnp.broadcast_to(sink.astype(jnp.float32)[None, :, :, None, None], s.shape[:-1] + (1,))
    p = jax.nn.softmax(jnp.concatenate([s, sink_col], axis=-1), axis=-1)[..., :-1]
    return jnp.einsum('bhgqn,bnhd->bqhgd', p.astype(v.dtype), v)


def swa_mixer(hx, hc, row, col, w_qkv, g_q, g_k, sink, w_o, need_ctx):
    scale = SWA_HD ** -0.5
    qw = SWA_HEADS * SWA_HD
    kw = SWA_KV_HEADS * SWA_HD

    def project(h, rope, with_q):
        b, n, _ = h.shape
        qkv = h @ w_qkv
        k = rms_norm(qkv[..., qw:qw + kw].reshape(b, n, SWA_KV_HEADS, SWA_HD), g_k)
        v = qkv[..., qw + kw:].reshape(b, n, SWA_KV_HEADS, SWA_HD)
        q = rms_norm(qkv[..., :qw].reshape(b, n, SWA_KV_HEADS, SWA_GROUP, SWA_HD), g_q) if with_q else None
        if rope:
            k = axial_rope(k, row, col)
            q = axial_rope(q, row, col)
        return q, k, v

    b, n = hx.shape[:2]
    qx, kx, vx = project(hx, True, True)
    qc, kc, vc = project(hc, False, need_ctx)
    ctx_mask = jnp.ones((Q_BLOCK, hc.shape[1]), dtype=bool)

    def block(args):
        qb, kb, vb, mb = args
        return gqa_sink_attn(qb, jnp.concatenate([kb, kc], axis=1), jnp.concatenate([vb, vc], axis=1),
                             sink, scale, jnp.concatenate([mb, ctx_mask], axis=-1))

    ox = from_blocks(lax.map(block, (to_blocks(qx), band_blocks(kx), band_blocks(vx), band_mask(n))))
    yx = ox.reshape(b, n, -1) @ w_o
    yc = gqa_sink_attn(qc, kc, vc, sink, scale, None).reshape(b, hc.shape[1], -1) @ w_o if need_ctx else None
    return yx, yc


def peer(h, w_q, sub_keys, u_tab, v_tab):
    b, n, d = h.shape
    t = h.reshape(b * n, d)
    q = (t @ w_q).reshape(b * n, PEER_HEADS, 2, PEER_KEY_DIM)
    s = jnp.einsum('thcd,hcnd->thcn', q, sub_keys)
    sv, si = lax.top_k(s, PEER_TOPK)
    cand = (sv[:, :, 0, :, None] + sv[:, :, 1, None, :]).reshape(b * n, PEER_HEADS, PEER_TOPK * PEER_TOPK)
    score, pos = lax.top_k(cand, PEER_TOPK)
    i1 = jnp.take_along_axis(si[:, :, 0], pos // PEER_TOPK, axis=-1)
    i2 = jnp.take_along_axis(si[:, :, 1], pos % PEER_TOPK, axis=-1)
    expert = i1 * PEER_KEYS + i2
    gate = jax.nn.softmax(score.astype(jnp.float32), axis=-1).astype(h.dtype)

    def block(args):
        tb, eb, gb = args
        act = jax.nn.gelu(jnp.einsum('td,thkd->thk', tb, jnp.take(u_tab, eb, axis=0)), approximate=False)
        return jnp.einsum('thk,thkd->td', gb * act, jnp.take(v_tab, eb, axis=0))

    nb = (b * n) // Q_BLOCK
    out = lax.map(block, (t.reshape(nb, Q_BLOCK, d),
                          expert.reshape(nb, Q_BLOCK, PEER_HEADS, PEER_TOPK),
                          gate.reshape(nb, Q_BLOCK, PEER_HEADS, PEER_TOPK)))
    return out.reshape(b, n, d)


def setup_inputs(seed: int = 0) -> dict:
    key = jax.random.key(seed)
    ks = iter(jax.random.split(key, 48))
    n_mla = len(range(0, DEPTH, N_MIXERS))
    n_diff = len(range(1, DEPTH, N_MIXERS))
    n_swa = len(range(2, DEPTH, N_MIXERS))
    D = D_MODEL

    def nrm(shape, std=1.0):
        return jax.random.normal(next(ks), shape, jnp.float32) * std

    def w(shape, fan_in, gain=1.0):
        return nrm(shape, gain * fan_in ** -0.5)

    def g(shape):
        return 1.0 + nrm(shape, 0.02)

    return {
        'x': nrm((BATCH, SEQ, D)),
        'c': nrm((BATCH, D)),
        'ctx': nrm((BATCH, CTX_LEN, D)),
        'c_ctx': nrm((D,)),
        'ada_w': w((DEPTH, D, 6 * D), D, 0.5),
        'ada_b': nrm((DEPTH, 6 * D), 0.02),
        'norm_mix': g((DEPTH, D)),
        'norm_ffn': g((DEPTH, D)),
        'mla_w_down': w((n_mla, D, MLA_Q_LORA + MLA_KV_LORA + MLA_ROPE), D),
        'mla_g_cq': g((n_mla, MLA_Q_LORA)),
        'mla_g_ckv': g((n_mla, MLA_KV_LORA)),
        'mla_w_uq': w((n_mla, MLA_Q_LORA, MLA_HEADS * MLA_QK), MLA_Q_LORA),
        'mla_w_ukv': w((n_mla, MLA_KV_LORA, MLA_HEADS * (MLA_NOPE + MLA_V)), MLA_KV_LORA),
        'mla_g_q': g((n_mla, MLA_QK)),
        'mla_g_k': g((n_mla, MLA_QK)),
        'mla_w_o': w((n_mla, MLA_HEADS * MLA_V, D), MLA_HEADS * MLA_V),
        'diff_w_qkv': w((n_diff, D, 3 * DIFF_WIDTH), D),
        'diff_g_q': g((n_diff, DIFF_HD)),
        'diff_g_k': g((n_diff, DIFF_HD)),
        'diff_lambda': nrm((n_diff, 4, DIFF_HD), 0.1),
        'diff_g_sub': g((n_diff, 2 * DIFF_HD)),
        'diff_w_o': w((n_diff, DIFF_WIDTH, D), DIFF_WIDTH),
        'swa_w_qkv': w((n_swa, D, (SWA_HEADS + 2 * SWA_KV_HEADS) * SWA_HD), D),
        'swa_g_q': g((n_swa, SWA_HD)),
        'swa_g_k': g((n_swa, SWA_HD)),
        'swa_sink': nrm((n_swa, SWA_KV_HEADS, SWA_GROUP), 0.5),
        'swa_w_o': w((n_swa, SWA_HEADS * SWA_HD, D), SWA_HEADS * SWA_HD),
        'peer_w_q': w((DEPTH, D, PEER_HEADS * 2 * PEER_KEY_DIM), D),
        'peer_keys': w((DEPTH, PEER_HEADS, 2, PEER_KEYS, PEER_KEY_DIM), PEER_KEY_DIM),
        'peer_u': w((DEPTH, PEER_EXPERTS, D), D),
        'peer_v': w((DEPTH, PEER_EXPERTS, D), PEER_HEADS),
    }


def reference(x, c, ctx, c_ctx, ada_w, ada_b, norm_mix, norm_ffn,
              mla_w_down, mla_g_cq, mla_g_ckv, mla_w_uq, mla_w_ukv, mla_g_q, mla_g_k, mla_w_o,
              diff_w_qkv, diff_g_q, diff_g_k, diff_lambda, diff_g_sub, diff_w_o,
              swa_w_qkv, swa_g_q, swa_g_k, swa_sink, swa_w_o,
              peer_w_q, peer_keys, peer_u, peer_v):
    n_ctx = ctx.shape[1]
    row, col = grid_positions(x.shape[1])
    silu_c = jax.nn.silu(c)
    silu_cc = jax.nn.silu(c_ctx)
    for i in range(DEPTH):
        last = i == DEPTH - 1
        kind, j = i % N_MIXERS, i // N_MIXERS
        mod_x = jnp.split((silu_c @ ada_w[i] + ada_b[i])[:, None, :], 6, axis=-1)
        mod_c = jnp.split(silu_cc @ ada_w[i] + ada_b[i], 6, axis=-1)
        hx = modulate(x, norm_mix[i], mod_x[0], mod_x[1])
        hc = modulate(ctx, norm_mix[i], mod_c[0], mod_c[1])
        if kind == 0:
            p = (mla_w_down[j], mla_g_cq[j], mla_g_ckv[j], mla_w_uq[j], mla_w_ukv[j], mla_g_q[j], mla_g_k[j])
            yx, yc = mla_mixer(hx, hc, row, col, p, mla_w_o[j], not last)
        elif kind == 1:
            lam_init = 0.8 - 0.6 * math.exp(-0.3 * i)
            yx, yc = diff_mixer(hx, hc, row, col, diff_w_qkv[j], diff_g_q[j], diff_g_k[j], diff_lambda[j],
                                diff_g_sub[j], diff_w_o[j], lam_init, not last)
        else:
            yx, yc = swa_mixer(hx, hc, row, col, swa_w_qkv[j], swa_g_q[j], swa_g_k[j], swa_sink[j],
                               swa_w_o[j], not last)
        x = x + mod_x[2] * yx
        hx = modulate(x, norm_ffn[i], mod_x[3], mod_x[4])
        if last:
            x = x + mod_x[5] * peer(hx, peer_w_q[i], peer_keys[i], peer_u[i], peer_v[i])
        else:
            ctx = ctx + mod_c[2] * yc
            hc = modulate(ctx, norm_ffn[i], mod_c[3], mod_c[4])
            y = peer(jnp.concatenate([hc, hx], axis=1), peer_w_q[i], peer_keys[i], peer_u[i], peer_v[i])
            ctx = ctx + mod_c[5] * y[:, :n_ctx]
            x = x + mod_x[5] * y[:, n_ctx:]
    return x
```

```cpp
#include <hip/hip_runtime.h>
#include <hip/hip_cooperative_groups.h>
#include <cstdio>
#include <cstdint>
namespace cg = cooperative_groups;

#define LAS __attribute__((address_space(3)))
typedef unsigned short bf16_t;
typedef short bf16x8 __attribute__((ext_vector_type(8)));
typedef short v4i16_t __attribute__((ext_vector_type(4)));
typedef float f32x4 __attribute__((ext_vector_type(4)));
typedef float f32x16 __attribute__((ext_vector_type(16)));
typedef unsigned u32x4 __attribute__((ext_vector_type(4)));
typedef unsigned u32x2 __attribute__((ext_vector_type(2)));
typedef float f32x2_t __attribute__((ext_vector_type(2)));
typedef __bf16 bf16x2_t __attribute__((ext_vector_type(2)));

constexpr int D = 1024, NB = 8, SEQ = 2048, NCTX = 256, TPB = SEQ + NCTX  , M = NB * TPB  ;
constexpr int NTHREADS = 512, NWAVES = 8;
constexpr float EPS = 1e-6f;
constexpr float LOG2E = 1.4426950408889634f;
constexpr float LAM_INIT = 0.35550907f;
constexpr size_t MiB = 1u << 20;
constexpr size_t WS_MODP = 1 * MiB, WS_MOD = 8 * MiB, WS_TAB = 9 * MiB, WS_XC = 10 * MiB;
constexpr size_t WS_WDOWN = 18 * MiB, WS_WUQ = 23 * MiB, WS_WUKV = 28 * MiB, WS_MWO = 30 * MiB, WS_DQKV = 34 * MiB, WS_DWO = 40 * MiB;
constexpr size_t WS_SQKV = 42 * MiB, WS_SWO = 45 * MiB, WS_PWQ = 47 * MiB, WS_PKEYS = 63 * MiB, WS_WEFF = 65 * MiB;
constexpr size_t WS_PU = 96 * MiB, WS_PV = 224 * MiB, WS_H = 352 * MiB, WS_O = 388 * MiB, WS_BUF1 = 424 * MiB, WS_BUF2 = 532 * MiB;
constexpr size_t WS_BUF3 = 586 * MiB, WS_BUF4 = 658 * MiB, WS_CQN = 712 * MiB, WS_CKVN = 739 * MiB, WS_SC = 748 * MiB, WS_END = 892 * MiB;
constexpr int LDS_BYTES = 147456;
constexpr int NPHASES = 38;
#ifndef DBG_MASK
#define DBG_MASK 0xff
#endif

struct Params {
  const float *x, *c, *ctx, *c_ctx, *ada_w, *ada_b, *norm_mix, *norm_ffn;
  const float *mla_w_down, *mla_g_cq, *mla_g_ckv, *mla_w_uq, *mla_w_ukv, *mla_g_q, *mla_g_k, *mla_w_o;
  const float *diff_w_qkv, *diff_g_q, *diff_g_k, *diff_lambda, *diff_g_sub, *diff_w_o;
  const float *swa_w_qkv, *swa_g_q, *swa_g_k, *swa_sink, *swa_w_o;
  const float *peer_w_q, *peer_keys, *peer_u, *peer_v;
  float* out; unsigned char* ws;
  int single, phase;
};

__device__ __forceinline__ int opaque_tid() { int t = threadIdx.x; asm volatile("" : "+v"(t)); return t; }
__device__ __forceinline__ unsigned pk2(float lo, float hi) { f32x2_t v = {lo, hi}; bf16x2_t b = __builtin_convertvector(v, bf16x2_t); return __builtin_bit_cast(unsigned, b); }
__device__ __forceinline__ float bf_lo(unsigned u) { return __uint_as_float(u << 16); }
__device__ __forceinline__ float bf_hi(unsigned u) { return __uint_as_float(u & 0xffff0000u); }
__device__ __forceinline__ float wave_sum(float v) {
#pragma unroll
  for (int o = 32; o >= 1; o >>= 1) v += __shfl_xor(v, o);
  return v;
}
__device__ __forceinline__ float dot2bf(unsigned a, unsigned b, float c) { return __builtin_amdgcn_fdot2_f32_bf16(__builtin_bit_cast(bf16x2_t, a), __builtin_bit_cast(bf16x2_t, b), c, false); }
__device__ __forceinline__ int crow(int r, int hi) { return (r & 3) + 8 * (r >> 2) + 4 * hi; }
__device__ __forceinline__ unsigned f2ord(float f) { unsigned u = __float_as_uint(f); return (u & 0x80000000u) ? ~u : (u | 0x80000000u); }
__device__ __forceinline__ float ord2f(unsigned o) { return __uint_as_float((o & 0x80000000u) ? (o & 0x7fffffffu) : ~o); }
__device__ __forceinline__ float* xrow_ptr(float* xl, float* xc, int r) {
  const int b = r / TPB, s = r - b * TPB;
  return (s < SEQ) ? xl + (size_t)(b * SEQ + s) * D : xc + (size_t)(b * NCTX + (s - SEQ)) * D;
}

__device__ __forceinline__ void tr_job(LAS unsigned char* lds, const float* __restrict__ W, bf16_t* __restrict__ Wt, int K, int N, int Npad) {
  LAS float* tile = (LAS float*)lds;
  const int nnb = Npad / 64, nit = (K / 64) * nnb, tid = opaque_tid();
  for (int it = blockIdx.x; it < nit; it += gridDim.x) {
    const int kb = it / nnb, nb = it - kb * nnb, k0 = kb * 64, n0 = nb * 64;
#pragma unroll
    for (int i = 0; i < 2; ++i) {
      const int idx = tid + i * 512, kk = idx >> 4, nc = (idx & 15) * 4;
      f32x4 v = {0.f, 0.f, 0.f, 0.f};
      if (n0 + nc < N) v = *(const f32x4*)(W + (size_t)(k0 + kk) * N + n0 + nc);
      tile[kk * 65 + nc + 0] = v.x; tile[kk * 65 + nc + 1] = v.y; tile[kk * 65 + nc + 2] = v.z; tile[kk * 65 + nc + 3] = v.w;
    }
    __syncthreads();
    {
      const int n = tid >> 3, kc = tid & 7;
      float f[8];
#pragma unroll
      for (int j = 0; j < 8; ++j) f[j] = tile[(kc * 8 + j) * 65 + n];
      u32x4 o = {pk2(f[0], f[1]), pk2(f[2], f[3]), pk2(f[4], f[5]), pk2(f[6], f[7])};
      *(u32x4*)(Wt + (size_t)(n0 + n) * K + k0 + kc * 8) = o;
    }
    __syncthreads();
  }
}
__device__ __forceinline__ void cvt_job(const float* __restrict__ src, bf16_t* __restrict__ dst, size_t n8) {
  for (size_t i = (size_t)blockIdx.x * NTHREADS + threadIdx.x; i < n8; i += (size_t)gridDim.x * NTHREADS) {
    const f32x4 a = ((const f32x4*)src)[2 * i], b = ((const f32x4*)src)[2 * i + 1];
    ((u32x4*)dst)[i] = (u32x4){pk2(a.x, a.y), pk2(a.z, a.w), pk2(b.x, b.y), pk2(b.z, b.w)};
  }
}
__device__ __forceinline__ void copy_job(const float* __restrict__ src, float* __restrict__ dst, size_t n4) {
  for (size_t i = (size_t)blockIdx.x * NTHREADS + threadIdx.x; i < n4; i += (size_t)gridDim.x * NTHREADS) ((f32x4*)dst)[i] = ((const f32x4*)src)[i];
}
__device__ __forceinline__ void ada_job(LAS unsigned char* lds, const Params& p, float* __restrict__ modp) {
  LAS float* s = (LAS float*)lds;
  const int tid = opaque_tid();
  for (int u = blockIdx.x; u < 384; u += gridDim.x) {
    const int l = u / 96, r = u - l * 96, cc = r >> 3, kc = r & 7;
    __syncthreads();
    for (int i = tid; i < 9 * 128; i += NTHREADS) {
      const int bi = i >> 7, k = i & 127;
      const float c = (bi < 8) ? p.c[bi * D + kc * 128 + k] : p.c_ctx[kc * 128 + k];
      s[i] = c / (1.f + __expf(-c));
    }
    __syncthreads();
    float acc[9];
#pragma unroll
    for (int bi = 0; bi < 9; ++bi) acc[bi] = 0.f;
    const float* w = p.ada_w + ((size_t)l * D + kc * 128) * 6144 + cc * 512 + tid;
#pragma unroll 4
    for (int k = 0; k < 128; ++k) {
      const float wv = w[(size_t)k * 6144];
#pragma unroll
      for (int bi = 0; bi < 9; ++bi) acc[bi] += s[bi * 128 + k] * wv;
    }
#pragma unroll
    for (int bi = 0; bi < 9; ++bi) modp[(((size_t)kc * 4 + l) * 9 + bi) * 6144 + cc * 512 + tid] = acc[bi];
  }
}

__device__ __forceinline__ void norm_phase(float* xl, float* xc, const float* __restrict__ g, const float* __restrict__ modl, int which, bf16_t* __restrict__ H, bool skip_ctx) {
  const int tid_ = opaque_tid(); const int lane = tid_ & 63, wid = tid_ >> 6;
  for (int r = blockIdx.x * NWAVES + wid; r < M; r += gridDim.x * NWAVES) {
    const int b = r / TPB, s = r - b * TPB; const bool isctx = s >= SEQ;
    if (skip_ctx && isctx) continue;
    const float* xr = xrow_ptr(xl, xc, r);
    const int bi = isctx ? 8 : b;
    const float* sh = modl + (size_t)(bi * 6 + which) * D; const float* sc = sh + D;
    f32x4 v[4]; float ss = 0.f;
#pragma unroll
    for (int j = 0; j < 4; ++j) { v[j] = ((const f32x4*)xr)[lane + 64 * j]; ss += v[j].x * v[j].x + v[j].y * v[j].y + v[j].z * v[j].z + v[j].w * v[j].w; }
    ss = wave_sum(ss);
    const float rstd = rsqrtf(ss * (1.f / D) + EPS);
#pragma unroll
    for (int j = 0; j < 4; ++j) {
      const int c4 = lane + 64 * j;
      const f32x4 g4 = ((const f32x4*)g)[c4], s4 = ((const f32x4*)sc)[c4], h4 = ((const f32x4*)sh)[c4];
      const f32x4 y = v[j] * rstd * g4 * (1.f + s4) + h4;
      *(u32x2*)(H + (size_t)r * D + c4 * 4) = (u32x2){pk2(y.x, y.y), pk2(y.z, y.w)};
    }
  }
}
__device__ __forceinline__ void latnorm_phase(const bf16_t* __restrict__ LAT, const float* __restrict__ gcq, const float* __restrict__ gckv, bf16_t* __restrict__ CQN, bf16_t* __restrict__ CKVN) {
  const int tid_ = opaque_tid(); const int lane = tid_ & 63, wid = tid_ >> 6;
  for (int r = blockIdx.x * NWAVES + wid; r < M; r += gridDim.x * NWAVES) {
    const bf16_t* lr = LAT + (size_t)r * 1152;
    float q[12], kv[4]; float sq = 0.f, sk = 0.f;
#pragma unroll
    for (int j = 0; j < 3; ++j) { const u32x2 w = *(const u32x2*)(lr + lane * 4 + 256 * j); q[4 * j] = bf_lo(w.x); q[4 * j + 1] = bf_hi(w.x); q[4 * j + 2] = bf_lo(w.y); q[4 * j + 3] = bf_hi(w.y); }
    { const u32x2 w = *(const u32x2*)(lr + 768 + lane * 4); kv[0] = bf_lo(w.x); kv[1] = bf_hi(w.x); kv[2] = bf_lo(w.y); kv[3] = bf_hi(w.y); }
#pragma unroll
    for (int j = 0; j < 12; ++j) sq += q[j] * q[j];
#pragma unroll
    for (int j = 0; j < 4; ++j) sk += kv[j] * kv[j];
    sq = wave_sum(sq); sk = wave_sum(sk);
    const float rq = rsqrtf(sq * (1.f / 768.f) + EPS), rk = rsqrtf(sk * (1.f / 256.f) + EPS);
#pragma unroll
    for (int j = 0; j < 3; ++j) { const int c = lane * 4 + 256 * j; const f32x4 g4 = *(const f32x4*)(gcq + c);
      *(u32x2*)(CQN + (size_t)r * 768 + c) = (u32x2){pk2(q[4 * j] * rq * g4.x, q[4 * j + 1] * rq * g4.y), pk2(q[4 * j + 2] * rq * g4.z, q[4 * j + 3] * rq * g4.w)}; }
    { const int c = lane * 4; const f32x4 g4 = *(const f32x4*)(gckv + c);
      *(u32x2*)(CKVN + (size_t)r * 256 + c) = (u32x2){pk2(kv[0] * rk * g4.x, kv[1] * rk * g4.y), pk2(kv[2] * rk * g4.z, kv[3] * rk * g4.w)}; }
  }
}

constexpr int G_AS = 144;
constexpr int G_ATILE = 256 * G_AS, G_BTILE = 128 * G_AS, G_STAGE = G_ATILE + G_BTILE;
struct EpiBf16 { bf16_t* C; int ldc;
  __device__ __forceinline__ void operator()(int row, int col, f32x4 v) const { *(u32x2*)(C + (size_t)row * ldc + col) = (u32x2){pk2(v.x, v.y), pk2(v.z, v.w)}; } };
struct EpiF32 { float* C; int ldc;
  __device__ __forceinline__ void operator()(int row, int col, f32x4 v) const { *(f32x4*)(C + (size_t)row * ldc + col) = v; } };
struct EpiBf16T { bf16_t* C; int ldc;
  __device__ __forceinline__ void operator()(int row, int col, f32x4 v) const {
    C[(size_t)(col + 0) * ldc + row] = (bf16_t)(pk2(v.x, 0.f) & 0xffffu); C[(size_t)(col + 1) * ldc + row] = (bf16_t)(pk2(v.y, 0.f) & 0xffffu);
    C[(size_t)(col + 2) * ldc + row] = (bf16_t)(pk2(v.z, 0.f) & 0xffffu); C[(size_t)(col + 3) * ldc + row] = (bf16_t)(pk2(v.w, 0.f) & 0xffffu); } };
struct EpiResid { float* xl; float* xc; const float* modl; int which;
  __device__ __forceinline__ void operator()(int row, int col, f32x4 v) const {
    const int b = row / TPB, s = row - b * TPB; const int bi = (s >= SEQ) ? 8 : b;
    float* xp = xrow_ptr(xl, xc, row) + col;
    const f32x4 gt = *(const f32x4*)(modl + (size_t)(bi * 6 + which) * D + col);
    f32x4 xv = *(const f32x4*)xp; xv += gt * v; *(f32x4*)xp = xv; } };

template <class Epi>
__device__ __forceinline__ void gemm_phase(LAS unsigned char* lds, const bf16_t* __restrict__ A, int lda, const bf16_t* __restrict__ Bt, int ldb,
                                           int Mrows, int N, int K, bool skip_ctx_tiles, const Epi epi, int ustart, int ustride) {
  const int tid = opaque_tid(), lane = tid & 63, wid = tid >> 6, wr = wid >> 1, wc = wid & 1, fr = lane & 15, fq = lane >> 4;
  const int nN = N / 128, nU = (Mrows / 256) * nN, nt = K / 64;
  const int lrow = tid >> 3, lkc = tid & 7;
  for (int u = ustart; u < nU; u += ustride) {
    const int pm = u / nN, pn = u - pm * nN;
    if (skip_ctx_tiles && (pm % 9) == 8) continue;
    const bf16_t* Ag = A + (size_t)(pm * 256 + lrow) * lda + lkc * 8;
    const bf16_t* Bg = Bt + (size_t)(pn * 128 + lrow) * ldb + lkc * 8;
    f32x4 acc[4][4];
#pragma unroll
    for (int m = 0; m < 4; ++m)
#pragma unroll
      for (int n = 0; n < 4; ++n) acc[m][n] = (f32x4){0.f, 0.f, 0.f, 0.f};
    u32x4 ra[4], rb[2];
#pragma unroll
    for (int i = 0; i < 4; ++i) ra[i] = *(const u32x4*)(Ag + (size_t)(64 * i) * lda);
#pragma unroll
    for (int i = 0; i < 2; ++i) rb[i] = *(const u32x4*)(Bg + (size_t)(64 * i) * ldb);
    {
      LAS unsigned char* sa = lds + lrow * G_AS + lkc * 16; LAS unsigned char* sb = lds + G_ATILE + lrow * G_AS + lkc * 16;
#pragma unroll
      for (int i = 0; i < 4; ++i) *(LAS u32x4*)(sa + i * 64 * G_AS) = ra[i];
#pragma unroll
      for (int i = 0; i < 2; ++i) *(LAS u32x4*)(sb + i * 64 * G_AS) = rb[i];
    }
    __syncthreads();
    for (int t = 0; t < nt; ++t) {
      const bool more = (t + 1 < nt);
      if (more) {
#pragma unroll
        for (int i = 0; i < 4; ++i) ra[i] = *(const u32x4*)(Ag + (size_t)(64 * i) * lda + (t + 1) * 64);
#pragma unroll
        for (int i = 0; i < 2; ++i) rb[i] = *(const u32x4*)(Bg + (size_t)(64 * i) * ldb + (t + 1) * 64);
      }
      const LAS unsigned char* st = lds + (t & 1) * G_STAGE;
      const LAS unsigned char* pa = st + (wr * 64 + fr) * G_AS + fq * 16;
      const LAS unsigned char* pb = st + G_ATILE + (wc * 64 + fr) * G_AS + fq * 16;
#pragma unroll
      for (int ks = 0; ks < 2; ++ks) {
        bf16x8 af[4], bfr[4];
#pragma unroll
        for (int m = 0; m < 4; ++m) af[m] = *(const LAS bf16x8*)(pa + m * 16 * G_AS + ks * 64);
#pragma unroll
        for (int n = 0; n < 4; ++n) bfr[n] = *(const LAS bf16x8*)(pb + n * 16 * G_AS + ks * 64);
#pragma unroll
        for (int m = 0; m < 4; ++m)
#pragma unroll
          for (int n = 0; n < 4; ++n) acc[m][n] = __builtin_amdgcn_mfma_f32_16x16x32_bf16(bfr[n], af[m], acc[m][n], 0, 0, 0);
      }
      if (more) {
        LAS unsigned char* sa = lds + ((t + 1) & 1) * G_STAGE + lrow * G_AS + lkc * 16; LAS unsigned char* sb = sa + G_ATILE;
#pragma unroll
        for (int i = 0; i < 4; ++i) *(LAS u32x4*)(sa + i * 64 * G_AS) = ra[i];
#pragma unroll
        for (int i = 0; i < 2; ++i) *(LAS u32x4*)(sb + i * 64 * G_AS) = rb[i];
      }
      __syncthreads();
    }
#pragma unroll
    for (int m = 0; m < 4; ++m)
#pragma unroll
      for (int n = 0; n < 4; ++n) epi(pm * 256 + wr * 64 + m * 16 + fr, pn * 128 + wc * 64 + n * 16 + fq * 4, acc[m][n]);
  }
}

#define UNPACK8(W, V, O) do { V[O + 0] = bf_lo(W.x); V[O + 1] = bf_hi(W.x); V[O + 2] = bf_lo(W.y); V[O + 3] = bf_hi(W.y); V[O + 4] = bf_lo(W.z); V[O + 5] = bf_hi(W.z); V[O + 6] = bf_lo(W.w); V[O + 7] = bf_hi(W.w); } while (0)
#define PACK8(V, O, SC) (u32x4){pk2(V[O] * SC, V[O + 1] * SC), pk2(V[O + 2] * SC, V[O + 3] * SC), pk2(V[O + 4] * SC, V[O + 5] * SC), pk2(V[O + 6] * SC, V[O + 7] * SC)}
__device__ __forceinline__ void headnorm96(const bf16_t* srcA, const bf16_t* srcB, bf16_t* dst, const float* __restrict__ g, float outscale, bool rope, int rowpos, int colpos,
                                           const float* __restrict__ tab8, int j) {
  const u32x4 w0 = *(const u32x4*)(srcA + j * 8), w1 = *(const u32x4*)(srcA + 32 + j * 8), w2 = *(const u32x4*)(srcB + j * 8);
  float v[24];
  UNPACK8(w0, v, 0); UNPACK8(w1, v, 8); UNPACK8(w2, v, 16);
  float ss = 0.f;
#pragma unroll
  for (int e = 0; e < 24; ++e) ss += v[e] * v[e];
  ss += __shfl_xor(ss, 1); ss += __shfl_xor(ss, 2);
  const float rstd = rsqrtf(ss * (1.f / 96.f) + EPS);
#pragma unroll
  for (int e = 0; e < 8; ++e) { v[e] *= rstd * g[j * 8 + e]; v[8 + e] *= rstd * g[32 + j * 8 + e]; v[16 + e] *= rstd * g[64 + j * 8 + e]; }
  const int pos = (j < 2) ? rowpos : colpos;
#pragma unroll
  for (int e = 0; e < 8; ++e) {
    const float own = v[16 + e], oth = __shfl_xor(own, 1);
    const f32x2_t cs = *(const f32x2_t*)(tab8 + (pos * 8 + e) * 2);
    const float res = (j & 1) ? (oth * cs.y + own * cs.x) : (own * cs.x - oth * cs.y);
    if (rope) v[16 + e] = res;
  }
  *(u32x4*)(dst + j * 8) = PACK8(v, 0, outscale); *(u32x4*)(dst + 32 + j * 8) = PACK8(v, 8, outscale); *(u32x4*)(dst + 64 + j * 8) = PACK8(v, 16, outscale);
}
__device__ __forceinline__ void headnorm64(bf16_t* q, const float* __restrict__ g, float outscale, bool rope, int rowpos, int colpos, const float* __restrict__ tab16, int j) {
  const u32x4 w0 = *(const u32x4*)(q + j * 8), w1 = *(const u32x4*)(q + 32 + j * 8);
  float v[16];
  UNPACK8(w0, v, 0); UNPACK8(w1, v, 8);
  float ss = 0.f;
#pragma unroll
  for (int e = 0; e < 16; ++e) ss += v[e] * v[e];
  ss += __shfl_xor(ss, 1); ss += __shfl_xor(ss, 2);
  const float rstd = rsqrtf(ss * (1.f / 64.f) + EPS);
#pragma unroll
  for (int e = 0; e < 8; ++e) { v[e] *= rstd * g[j * 8 + e]; v[8 + e] *= rstd * g[32 + j * 8 + e]; }
#pragma unroll
  for (int e = 0; e < 8; ++e) {
    const int i = (j & 1) * 8 + e;
    const float own0 = v[e], oth0 = __shfl_xor(own0, 2), own1 = v[8 + e], oth1 = __shfl_xor(own1, 2);
    const f32x2_t cr = *(const f32x2_t*)(tab16 + (rowpos * 16 + i) * 2), cc = *(const f32x2_t*)(tab16 + (colpos * 16 + i) * 2);
    const float r0 = (j >> 1) ? (oth0 * cr.y + own0 * cr.x) : (own0 * cr.x - oth0 * cr.y);
    const float r1 = (j >> 1) ? (oth1 * cc.y + own1 * cc.x) : (own1 * cc.x - oth1 * cc.y);
    if (rope) { v[e] = r0; v[8 + e] = r1; }
  }
  *(u32x4*)(q + j * 8) = PACK8(v, 0, outscale); *(u32x4*)(q + 32 + j * 8) = PACK8(v, 8, outscale);
}

template <int DQK, int DV, int NS, bool WINDOW>
__device__ __forceinline__ void attn_unit(LAS unsigned char* lds, const bf16_t* __restrict__ Qb, int qsoff, int ldq, const bf16_t* __restrict__ Kb, int ksoff, int ldk,
                                          const bf16_t* __restrict__ Vb, int ldv, int q0, int ta0, int ta1, int tb0, int tb1, bool has_sink, float sink_l2,
                                          bf16_t* __restrict__ Ob, int ldo, float lam, const float* __restrict__ gsub) {
  constexpr int KS = DQK * 2 + 16, KTB = 64 * KS, VS = (DV == 64) ? 192 : 320, VOFF = NS * KTB, VTB = 64 * VS;
  constexpr int KCR = DQK / 8, KCH = 64 * KCR, VCR = DV / 8, VCH = 64 * VCR, NCH = NS * KCH + VCH, NI = (NCH + NTHREADS - 1) / NTHREADS;
  constexpr int OEX = VOFF + VTB, NDB = DV / 32, NKS = DQK / 16;
  const int tid = opaque_tid(), lane = tid & 63, wid = tid >> 6, l31 = lane & 31, hi = lane >> 5;
  const int qsub = (NS == 1) ? wid : (wid & 3), stream = (NS == 1) ? 0 : (wid >> 2);
  const int qrow = q0 + qsub * 32 + l31;
  bf16x8 qf[NKS];
#pragma unroll
  for (int ks = 0; ks < NKS; ++ks) qf[ks] = *(const bf16x8*)(Qb + (size_t)stream * qsoff + (size_t)qrow * ldq + ks * 16 + hi * 8);
  f32x16 o[NDB];
#pragma unroll
  for (int db = 0; db < NDB; ++db)
#pragma unroll
    for (int r = 0; r < 16; ++r) o[db][r] = 0.f;
  float mrun = -1e30f, lrun = 0.f;
  const int n1 = ta1 - ta0, ntl = n1 + (tb1 - tb0);
  u32x4 st[NI];
#define ATT_LOAD(T_) do { const int t__ = (T_); _Pragma("unroll") for (int ii = 0; ii < NI; ++ii) { const int c = tid + ii * NTHREADS; if (c < NCH) { \
      if (c < NS * KCH) { const int s_ = c / KCH, cc = c - s_ * KCH, row = cc / KCR, kc = cc - row * KCR; st[ii] = *(const u32x4*)(Kb + (size_t)s_ * ksoff + (size_t)(t__ * 64 + row) * ldk + kc * 8); } \
      else { const int cc = c - NS * KCH, row = cc / VCR, vc = cc - row * VCR; st[ii] = *(const u32x4*)(Vb + (size_t)(t__ * 64 + row) * ldv + vc * 8); } } } } while (0)
#define ATT_STORE() do { _Pragma("unroll") for (int ii = 0; ii < NI; ++ii) { const int c = tid + ii * NTHREADS; if (c < NCH) { \
      if (c < NS * KCH) { const int s_ = c / KCH, cc = c - s_ * KCH, row = cc / KCR, kc = cc - row * KCR; *(LAS u32x4*)(lds + s_ * KTB + row * KS + kc * 16) = st[ii]; } \
      else { const int cc = c - NS * KCH, row = cc / VCR, vc = cc - row * VCR; *(LAS u32x4*)(lds + VOFF + row * VS + vc * 16) = st[ii]; } } } } while (0)
  ATT_LOAD(n1 > 0 ? ta0 : tb0);
  for (int i = 0; i < ntl; ++i) {
    const int t = (i < n1) ? ta0 + i : tb0 + (i - n1);
    __syncthreads();
    ATT_STORE();
    __syncthreads();
    if (i + 1 < ntl) { const int tn = (i + 1 < n1) ? ta0 + i + 1 : tb0 + (i + 1 - n1); ATT_LOAD(tn); }
    bool active = true, needmask = false;
    if (WINDOW && t < 32) {
      const int qlo = q0 + qsub * 32, qhi = qlo + 31, klo = t * 64, khi = klo + 63;
      active = !(khi < qlo - 128 || klo > qhi + 128);
      needmask = (khi - qlo > 128) || (qhi - klo > 128);
    }
    if (active) {
      f32x16 p0, p1;
#pragma unroll
      for (int r = 0; r < 16; ++r) { p0[r] = 0.f; p1[r] = 0.f; }
      const LAS unsigned char* kl = lds + stream * KTB + l31 * KS + hi * 16;
#pragma unroll
      for (int ks = 0; ks < NKS; ++ks) {
        const bf16x8 k0 = *(const LAS bf16x8*)(kl + ks * 32);
        const bf16x8 k1 = *(const LAS bf16x8*)(kl + 32 * KS + ks * 32);
        p0 = __builtin_amdgcn_mfma_f32_32x32x16_bf16(k0, qf[ks], p0, 0, 0, 0);
        p1 = __builtin_amdgcn_mfma_f32_32x32x16_bf16(k1, qf[ks], p1, 0, 0, 0);
      }
      if (WINDOW && needmask) {
#pragma unroll
        for (int r = 0; r < 16; ++r) {
          const int d0 = t * 64 + crow(r, hi) - qrow, d1 = d0 + 32;
          if (d0 > 128 || d0 < -128) p0[r] = -INFINITY;
          if (d1 > 128 || d1 < -128) p1[r] = -INFINITY;
        }
      }
      float mx = fmaxf(p0[0], p1[0]);
#pragma unroll
      for (int r = 1; r < 16; ++r) mx = fmaxf(mx, fmaxf(p0[r], p1[r]));
      mx = fmaxf(mx, __shfl_xor(mx, 32));
      const float mnew = fmaxf(mrun, mx);
      if (__builtin_amdgcn_ballot_w64(mnew > mrun) != 0ull) {
        const float alpha = __builtin_amdgcn_exp2f(mrun - mnew);
        lrun *= alpha;
#pragma unroll
        for (int db = 0; db < NDB; ++db)
#pragma unroll
          for (int r = 0; r < 16; ++r) o[db][r] *= alpha;
        mrun = mnew;
      }
      float ps = 0.f;
#pragma unroll
      for (int r = 0; r < 16; ++r) { p0[r] = __builtin_amdgcn_exp2f(p0[r] - mrun); p1[r] = __builtin_amdgcn_exp2f(p1[r] - mrun); ps += p0[r] + p1[r]; }
      lrun += ps;
      u32x4 pw[2][2];
#pragma unroll
      for (int s = 0; s < 2; ++s) {
        pw[0][s] = (u32x4){pk2(p0[8 * s], p0[8 * s + 1]), pk2(p0[8 * s + 2], p0[8 * s + 3]), pk2(p0[8 * s + 4], p0[8 * s + 5]), pk2(p0[8 * s + 6], p0[8 * s + 7])};
        pw[1][s] = (u32x4){pk2(p1[8 * s], p1[8 * s + 1]), pk2(p1[8 * s + 2], p1[8 * s + 3]), pk2(p1[8 * s + 4], p1[8 * s + 5]), pk2(p1[8 * s + 6], p1[8 * s + 7])};
      }
      const LAS unsigned char* vl = lds + VOFF + (4 * hi + ((lane & 15) >> 2)) * VS + (16 * ((lane >> 4) & 1) + 4 * (lane & 3)) * 2;
#pragma unroll
      for (int db = 0; db < NDB; ++db)
#pragma unroll
        for (int kb = 0; kb < 2; ++kb)
#pragma unroll
          for (int s = 0; s < 2; ++s) {
            const LAS unsigned char* vp = vl + (kb * 32 + 16 * s) * VS + db * 64;
            const v4i16_t lo = __builtin_amdgcn_ds_read_tr16_b64_v4i16((LAS v4i16_t*)vp);
            const v4i16_t hi4 = __builtin_amdgcn_ds_read_tr16_b64_v4i16((LAS v4i16_t*)(vp + 8 * VS));
            const bf16x8 vf = (bf16x8){lo[0], lo[1], lo[2], lo[3], hi4[0], hi4[1], hi4[2], hi4[3]};
            o[db] = __builtin_amdgcn_mfma_f32_32x32x16_bf16(vf, __builtin_bit_cast(bf16x8, pw[kb][s]), o[db], 0, 0, 0);
          }
    }
  }
#undef ATT_LOAD
#undef ATT_STORE
  float ltot = lrun + __shfl_xor(lrun, 32);
  if (has_sink) ltot += __builtin_amdgcn_exp2f(sink_l2 - mrun);
  const float inv = 1.f / ltot;
  if (NS == 1) {
    bf16_t* op = Ob + (size_t)qrow * ldo + 4 * hi;
#pragma unroll
    for (int db = 0; db < NDB; ++db)
#pragma unroll
      for (int r4 = 0; r4 < 4; ++r4)
        *(u32x2*)(op + db * 32 + 8 * r4) = (u32x2){pk2(o[db][4 * r4] * inv, o[db][4 * r4 + 1] * inv), pk2(o[db][4 * r4 + 2] * inv, o[db][4 * r4 + 3] * inv)};
  } else {
    LAS float* ex = (LAS float*)(lds + OEX) + qsub * (DV * 32);
    if (stream == 1) {
#pragma unroll
      for (int db = 0; db < NDB; ++db)
#pragma unroll
        for (int r = 0; r < 16; ++r) ex[(db * 32 + crow(r, hi)) * 32 + l31] = o[db][r] * inv;
    }
    __syncthreads();
    if (stream == 0) {
      float ss = 0.f;
#pragma unroll
      for (int db = 0; db < NDB; ++db)
#pragma unroll
        for (int r = 0; r < 16; ++r) { const float v = o[db][r] * inv - lam * ex[(db * 32 + crow(r, hi)) * 32 + l31]; o[db][r] = v; ss += v * v; }
      ss += __shfl_xor(ss, 32);
      const float rs = rsqrtf(ss * (1.f / DV) + EPS) * (1.f - LAM_INIT);
      bf16_t* op = Ob + (size_t)qrow * ldo + 4 * hi;
#pragma unroll
      for (int db = 0; db < NDB; ++db)
#pragma unroll
        for (int r4 = 0; r4 < 4; ++r4) {
          const f32x4 g4 = *(const f32x4*)(gsub + db * 32 + 8 * r4 + 4 * hi);
          *(u32x2*)(op + db * 32 + 8 * r4) = (u32x2){pk2(o[db][4 * r4] * rs * g4.x, o[db][4 * r4 + 1] * rs * g4.y), pk2(o[db][4 * r4 + 2] * rs * g4.z, o[db][4 * r4 + 3] * rs * g4.w)};
        }
    }
  }
}

#define TOPK_INSERT(ARR, KEY) do { unsigned k__ = (KEY); _Pragma("unroll") for (int t_ = 0; t_ < 16; ++t_) { const unsigned h__ = max(ARR[t_], k__); k__ = min(ARR[t_], k__); ARR[t_] = h__; } } while (0)
__device__ __forceinline__ void peer_phase(LAS unsigned char* lds, const float* __restrict__ S, const bf16_t* __restrict__ H, const bf16_t* __restrict__ U, const bf16_t* __restrict__ V,
                                           const float* __restrict__ modl, float* xl, float* xc, bool last) {
  const int tid_ = opaque_tid(); const int lane = tid_ & 63, wid = tid_ >> 6;
  LAS unsigned* keysL = (LAS unsigned*)(lds + wid * 9216);
  LAS u32x2* resL = (LAS u32x2*)(lds + wid * 9216 + 4096);
  LAS float* wL = (LAS float*)(lds + wid * 9216 + 8192);
  const int ngroups = last ? (NB * SEQ / 4) : (M / 4);
  for (int g = blockIdx.x * NWAVES + wid; g < ngroups; g += gridDim.x * NWAVES) {
    const int r0 = last ? (g / (SEQ / 4)) * TPB + (g % (SEQ / 4)) * 4 : g * 4;
    const int tok = lane >> 4, hc = lane & 15;
    unsigned top[16];
#pragma unroll
    for (int i = 0; i < 16; ++i) top[i] = 0u;
    const float* sp = S + (size_t)(r0 + tok) * 2048 + hc * 128;
#pragma unroll 2
    for (int j = 0; j < 128; j += 4) {
      const f32x4 v = *(const f32x4*)(sp + j);
      TOPK_INSERT(top, (f2ord(v.x) & ~127u) | (unsigned)(127 - j));
      TOPK_INSERT(top, (f2ord(v.y) & ~127u) | (unsigned)(126 - j));
      TOPK_INSERT(top, (f2ord(v.z) & ~127u) | (unsigned)(125 - j));
      TOPK_INSERT(top, (f2ord(v.w) & ~127u) | (unsigned)(124 - j));
    }
#pragma unroll
    for (int i = 0; i < 16; ++i) keysL[lane * 16 + i] = top[i];
    float v0[16], v1[16];
#pragma unroll
    for (int i = 0; i < 16; ++i) { const unsigned t1 = __shfl_down(top[i], 1); v0[i] = ord2f(top[i] & ~127u); v1[i] = ord2f(t1 & ~127u); }
    unsigned cd[16];
#pragma unroll
    for (int i = 0; i < 16; ++i) cd[i] = 0u;
#pragma unroll
    for (int a = 0; a < 16; ++a)
#pragma unroll
      for (int b = 0; b < 16 / (a + 1); ++b) TOPK_INSERT(cd, (f2ord(v0[a] + v1[b]) & ~255u) | (unsigned)(255 - (a * 16 + b)));
    {
      float e[16]; float sum = 0.f; const float mx = ord2f(cd[0] & ~255u);
#pragma unroll
      for (int k = 0; k < 16; ++k) { e[k] = __expf(ord2f(cd[k] & ~255u) - mx); sum += e[k]; }
      const float inv = 1.f / sum;
      const int lp1 = (lane + 1) & 63;
#pragma unroll
      for (int k = 0; k < 16; ++k) {
        const int pos = 255 - (int)(cd[k] & 255u), a = pos >> 4, b = pos & 15;
        const unsigned i1 = 127u - (keysL[lane * 16 + a] & 127u), i2 = 127u - (keysL[lp1 * 16 + b] & 127u);
        if ((hc & 1) == 0) resL[tok * 128 + (hc >> 1) * 16 + k] = (u32x2){i1 * 128u + i2, __float_as_uint(e[k] * inv)};
      }
    }
    for (int tk = 0; tk < 4; ++tk) {
      const int r = r0 + tk;
      unsigned hq[8];
      { const bf16_t* hrow = H + (size_t)r * D + lane * 16; const u32x4 ha = *(const u32x4*)hrow, hb = *(const u32x4*)(hrow + 8);
        hq[0] = ha.x; hq[1] = ha.y; hq[2] = ha.z; hq[3] = ha.w; hq[4] = hb.x; hq[5] = hb.y; hq[6] = hb.z; hq[7] = hb.w; }
      for (int bt = 0; bt < 16; ++bt) {
        u32x4 ua[8][2];
#pragma unroll
        for (int i = 0; i < 8; ++i) { const unsigned e = resL[tk * 128 + bt * 8 + i].x; const bf16_t* up = U + (size_t)e * D + lane * 16; ua[i][0] = *(const u32x4*)up; ua[i][1] = *(const u32x4*)(up + 8); }
        float d[8];
#pragma unroll
        for (int i = 0; i < 8; ++i) {
          float a = 0.f;
#pragma unroll
          for (int j = 0; j < 4; ++j) a = dot2bf(ua[i][0][j], hq[j], a);
#pragma unroll
          for (int j = 0; j < 4; ++j) a = dot2bf(ua[i][1][j], hq[4 + j], a);
          d[i] = a;
        }
        const bool b5 = (lane & 32) != 0, b4 = (lane & 16) != 0, b3 = (lane & 8) != 0;
        float k4[4], k2[2], k1;
#pragma unroll
        for (int i = 0; i < 4; ++i) { const float keep = b5 ? d[4 + i] : d[i], send = b5 ? d[i] : d[4 + i]; k4[i] = keep + __shfl_xor(send, 32); }
#pragma unroll
        for (int i = 0; i < 2; ++i) { const float keep = b4 ? k4[2 + i] : k4[i], send = b4 ? k4[i] : k4[2 + i]; k2[i] = keep + __shfl_xor(send, 16); }
        { const float keep = b3 ? k2[1] : k2[0], send = b3 ? k2[0] : k2[1]; k1 = keep + __shfl_xor(send, 8); }
        k1 += __shfl_xor(k1, 4); k1 += __shfl_xor(k1, 2); k1 += __shfl_xor(k1, 1);
        const int ei = (lane >> 3) & 7;
        const float gate = __uint_as_float(resL[tk * 128 + bt * 8 + ei].y);
        const float act = 0.5f * k1 * (1.f + erff(k1 * 0.70710678118f));
        if ((lane & 7) == 0) wL[bt * 8 + ei] = act * gate;
      }
      float outv[16];
#pragma unroll
      for (int j = 0; j < 16; ++j) outv[j] = 0.f;
      for (int bt = 0; bt < 16; ++bt) {
        u32x4 va[8][2]; float w[8];
#pragma unroll
        for (int i = 0; i < 8; ++i) { const unsigned e = resL[tk * 128 + bt * 8 + i].x; const bf16_t* vp = V + (size_t)e * D + lane * 16; va[i][0] = *(const u32x4*)vp; va[i][1] = *(const u32x4*)(vp + 8); w[i] = wL[bt * 8 + i]; }
#pragma unroll
        for (int i = 0; i < 8; ++i)
#pragma unroll
          for (int j = 0; j < 4; ++j) {
            outv[2 * j] += w[i] * bf_lo(va[i][0][j]); outv[2 * j + 1] += w[i] * bf_hi(va[i][0][j]);
            outv[8 + 2 * j] += w[i] * bf_lo(va[i][1][j]); outv[8 + 2 * j + 1] += w[i] * bf_hi(va[i][1][j]);
          }
      }
      {
        const int b = r / TPB, s = r - b * TPB; const int bi = (s >= SEQ) ? 8 : b;
        float* xp = xrow_ptr(xl, xc, r) + lane * 16; const float* gt = modl + (size_t)(bi * 6 + 5) * D + lane * 16;
#pragma unroll
        for (int q = 0; q < 4; ++q) {
          f32x4 xv = ((const f32x4*)xp)[q]; const f32x4 gv = ((const f32x4*)gt)[q];
          xv += gv * (f32x4){outv[4 * q], outv[4 * q + 1], outv[4 * q + 2], outv[4 * q + 3]};
          ((f32x4*)xp)[q] = xv;
        }
      }
    }
  }
}

__global__ void __launch_bounds__(NTHREADS, 2) mega(Params p) {
  extern __shared__ __attribute__((aligned(16))) unsigned char lds_raw[];
  LAS unsigned char* lds = (LAS unsigned char*)lds_raw;
  cg::grid_group grid = cg::this_grid();
  const int tid = threadIdx.x;
  unsigned char* ws = p.ws;
  float* modp = (float*)(ws + WS_MODP); float* mod = (float*)(ws + WS_MOD);
  float* tab8 = (float*)(ws + WS_TAB); float* tab16 = tab8 + 64 * 8 * 2; float* lamp = tab16 + 64 * 16 * 2;
  float* xl = p.out; float* xc = (float*)(ws + WS_XC);
  bf16_t* wdown_t = (bf16_t*)(ws + WS_WDOWN); bf16_t* wuq_t = (bf16_t*)(ws + WS_WUQ); bf16_t* wukv_t = (bf16_t*)(ws + WS_WUKV); bf16_t* mwo_t = (bf16_t*)(ws + WS_MWO);
  bf16_t* dqkv_t = (bf16_t*)(ws + WS_DQKV); bf16_t* dwo_t = (bf16_t*)(ws + WS_DWO); bf16_t* sqkv_t = (bf16_t*)(ws + WS_SQKV); bf16_t* swo_t = (bf16_t*)(ws + WS_SWO);
  bf16_t* pwq = (bf16_t*)(ws + WS_PWQ); bf16_t* pkeys = (bf16_t*)(ws + WS_PKEYS); bf16_t* weff_t = (bf16_t*)(ws + WS_WEFF);
  bf16_t* pu = (bf16_t*)(ws + WS_PU); bf16_t* pv = (bf16_t*)(ws + WS_PV);
  bf16_t* Hb = (bf16_t*)(ws + WS_H); bf16_t* Ob = (bf16_t*)(ws + WS_O);
  bf16_t* B1 = (bf16_t*)(ws + WS_BUF1); bf16_t* B2 = (bf16_t*)(ws + WS_BUF2); bf16_t* B3 = (bf16_t*)(ws + WS_BUF3); bf16_t* B4 = (bf16_t*)(ws + WS_BUF4);
  bf16_t* CQN = (bf16_t*)(ws + WS_CQN); bf16_t* CKVN = (bf16_t*)(ws + WS_CKVN); float* SC = (float*)(ws + WS_SC);

  int phc = 0;
#define PH_BEGIN if (p.single || p.phase == phc) {
#define PH_END } ++phc; if (p.single) grid.sync();

  PH_BEGIN
    for (int j = 0; j < 2; ++j) {
      tr_job(lds, p.mla_w_down + (size_t)j * 1024 * 1056, wdown_t + (size_t)j * 1152 * 1024, 1024, 1056, 1152);
      tr_job(lds, p.mla_w_uq + (size_t)j * 768 * 1536, wuq_t + (size_t)j * 1536 * 768, 768, 1536, 1536);
      tr_job(lds, p.mla_w_ukv + (size_t)j * 256 * 2048, wukv_t + (size_t)j * 2048 * 256, 256, 2048, 2048);
      tr_job(lds, p.mla_w_o + (size_t)j * 1024 * 1024, mwo_t + (size_t)j * 1024 * 1024, 1024, 1024, 1024);
    }
    tr_job(lds, p.diff_w_qkv, dqkv_t, 1024, 3072, 3072);
    tr_job(lds, p.diff_w_o, dwo_t, 1024, 1024, 1024);
    tr_job(lds, p.swa_w_qkv, sqkv_t, 1024, 1536, 1536);
    tr_job(lds, p.swa_w_o, swo_t, 1024, 1024, 1024);
    ada_job(lds, p, modp);
    cvt_job(p.peer_w_q, pwq, (size_t)4 * 1024 * 2048 / 8);
    cvt_job(p.peer_keys, pkeys, (size_t)4 * 16 * 128 * 128 / 8);
    cvt_job(p.peer_u, pu, (size_t)4 * 16384 * 1024 / 8);
    cvt_job(p.peer_v, pv, (size_t)4 * 16384 * 1024 / 8);
    copy_job(p.x, xl, (size_t)NB * SEQ * D / 4);
    copy_job(p.ctx, xc, (size_t)NB * NCTX * D / 4);
    if (blockIdx.x == gridDim.x - 1) {
      for (int i = tid; i < 64 * 8; i += NTHREADS) { const int pos = i >> 3, j = i & 7; const float ang = (float)pos * powf(10000.f, -(float)j / 8.f); tab8[2 * i] = cosf(ang); tab8[2 * i + 1] = sinf(ang); }
      for (int i = tid; i < 64 * 16; i += NTHREADS) { const int pos = i >> 4, j = i & 15; const float ang = (float)pos * powf(10000.f, -(float)j / 16.f); tab16[2 * i] = cosf(ang); tab16[2 * i + 1] = sinf(ang); }
      if (tid == 0) { float s01 = 0.f, s23 = 0.f; for (int i = 0; i < 64; ++i) { s01 += p.diff_lambda[i] * p.diff_lambda[64 + i]; s23 += p.diff_lambda[128 + i] * p.diff_lambda[192 + i]; }
        lamp[0] = expf(s01) - expf(s23) + LAM_INIT; }
    }
  PH_END
  PH_BEGIN
    for (int i = blockIdx.x * NTHREADS + tid; i < 4 * 9 * 6144; i += gridDim.x * NTHREADS) {
      const int col = i % 6144, l = i / (9 * 6144); float a = p.ada_b[l * 6144 + col];
#pragma unroll
      for (int kc = 0; kc < 8; ++kc) a += modp[(size_t)kc * (4 * 9 * 6144) + i];
      mod[i] = a;
    }
    for (int U = blockIdx.x; U < 256; U += gridDim.x) {
      const int q = U >> 2, l = q >> 4, hc = q & 15;
      gemm_phase(lds, pwq + (size_t)l * 1024 * 2048 + hc * 128, 2048, pkeys + (size_t)q * 128 * 128, 128, 1024, 128, 128, false,
                 EpiBf16T{weff_t + (size_t)l * 2048 * 1024 + (size_t)hc * 128 * 1024, 1024}, U & 3, 4);
    }
  PH_END

  for (int l = 0; l < 4; ++l) {
    const int kind = l % 3, j = l / 3; const bool last = (l == 3);
    const float* modl = mod + (size_t)l * 9 * 6144;
    PH_BEGIN
      norm_phase(xl, xc, p.norm_mix + l * D, modl, 0, Hb, false);
    PH_END
    if (kind == 0) {
      bf16_t* LAT = B1; bf16_t* QP = B2; bf16_t* KV = B3; bf16_t* KB = B4;
      PH_BEGIN
        gemm_phase(lds, Hb, D, wdown_t + (size_t)j * 1152 * 1024, 1024, M, 1152, 1024, false, EpiBf16{LAT, 1152}, blockIdx.x, gridDim.x);
      PH_END
      PH_BEGIN
        latnorm_phase(LAT, p.mla_g_cq + j * 768, p.mla_g_ckv + j * 256, CQN, CKVN);
      PH_END
      PH_BEGIN
        gemm_phase(lds, CQN, 768, wuq_t + (size_t)j * 1536 * 768, 768, M, 1536, 768, false, EpiBf16{QP, 1536}, blockIdx.x, gridDim.x);
        gemm_phase(lds, CKVN, 256, wukv_t + (size_t)j * 2048 * 256, 256, M, 2048, 256, false, EpiBf16{KV, 2048}, blockIdx.x, gridDim.x);
      PH_END
      PH_BEGIN
        const float qs = 0.10206207261596577f * LOG2E;
        for (int gi = blockIdx.x * NTHREADS + opaque_tid(); gi < M * 32 * 4; gi += gridDim.x * NTHREADS) {
          const int i = gi >> 2, jl = gi & 3, r = i >> 5, it = i & 31, h = it & 15; const int b = r / TPB, s = r - b * TPB; const bool lat = s < SEQ;
          if (it < 16) { bf16_t* q = QP + (size_t)r * 1536 + h * 96; headnorm96(q, q + 64, q, p.mla_g_q + j * 96, qs, lat, s >> 6, s & 63, tab8, jl); }
          else headnorm96(KV + (size_t)r * 2048 + h * 128, LAT + (size_t)r * 1152 + 1024, KB + (size_t)r * 1536 + h * 96, p.mla_g_k + j * 96, 1.f, lat, s >> 6, s & 63, tab8, jl);
        }
      PH_END
      PH_BEGIN
        const int nu = last ? 1024 : 1152;
        for (int u = blockIdx.x; u < nu; u += gridDim.x) {
          int bh, q0, ta0; if (u < 1024) { bh = u >> 3; q0 = (u & 7) * 256; ta0 = 0; } else { bh = u - 1024; q0 = SEQ; ta0 = 32; }
          const int b = bh >> 4, h = bh & 15; const size_t rb = (size_t)b * TPB;
          attn_unit<96, 64, 1, false>(lds, QP + rb * 1536 + h * 96, 0, 1536, KB + rb * 1536 + h * 96, 0, 1536, KV + rb * 2048 + h * 128 + 64, 2048,
                                      q0, ta0, 36, 0, 0, false, 0.f, Ob + rb * D + h * 64, D, 0.f, nullptr);
        }
      PH_END
      PH_BEGIN
        if (DBG_MASK & (1 << l)) gemm_phase(lds, Ob, D, mwo_t + (size_t)j * 1024 * 1024, 1024, M, 1024, 1024, last, EpiResid{xl, xc, modl, 2}, blockIdx.x, gridDim.x);
      PH_END
    } else if (kind == 1) {
      bf16_t* QKV = B1;
      PH_BEGIN
        gemm_phase(lds, Hb, D, dqkv_t, 1024, M, 3072, 1024, false, EpiBf16{QKV, 3072}, blockIdx.x, gridDim.x);
      PH_END
      PH_BEGIN
        const float qs = 0.125f * LOG2E;
        for (int gi = blockIdx.x * NTHREADS + opaque_tid(); gi < M * 32 * 4; gi += gridDim.x * NTHREADS) {
          const int i = gi >> 2, jl = gi & 3, r = i >> 5, it = i & 31; const int b = r / TPB, s = r - b * TPB; const bool lat = s < SEQ;
          bf16_t* q = QKV + (size_t)r * 3072 + it * 64;
          headnorm64(q, (it < 16) ? p.diff_g_q : p.diff_g_k, (it < 16) ? qs : 1.f, lat, s >> 6, s & 63, tab16, jl);
        }
      PH_END
      PH_BEGIN
        const float lam = lamp[0];
        for (int u = blockIdx.x; u < 1152; u += gridDim.x) {
          int bh, q0, ta0; if (u < 1024) { bh = u >> 4; q0 = (u & 15) * 128; ta0 = 0; } else { bh = (u - 1024) >> 1; q0 = SEQ + ((u - 1024) & 1) * 128; ta0 = 32; }
          const int b = bh >> 3, h = bh & 7; const size_t rb = (size_t)b * TPB;
          attn_unit<64, 128, 2, false>(lds, QKV + rb * 3072 + h * 128, 64, 3072, QKV + rb * 3072 + 1024 + h * 128, 64, 3072, QKV + rb * 3072 + 2048 + h * 128, 3072,
                                       q0, ta0, 36, 0, 0, false, 0.f, Ob + rb * D + h * 128, D, lam, p.diff_g_sub);
        }
      PH_END
      PH_BEGIN
        if (DBG_MASK & (1 << l)) gemm_phase(lds, Ob, D, dwo_t, 1024, M, 1024, 1024, last, EpiResid{xl, xc, modl, 2}, blockIdx.x, gridDim.x);
      PH_END
    } else {
      bf16_t* QKV = B1;
      PH_BEGIN
        gemm_phase(lds, Hb, D, sqkv_t, 1024, M, 1536, 1024, false, EpiBf16{QKV, 1536}, blockIdx.x, gridDim.x);
      PH_END
      PH_BEGIN
        const float qs = 0.125f * LOG2E;
        for (int gi = blockIdx.x * NTHREADS + opaque_tid(); gi < M * 20 * 4; gi += gridDim.x * NTHREADS) {
          const int i = gi >> 2, jl = gi & 3, r = i / 20, it = i - r * 20; const int b = r / TPB, s = r - b * TPB; const bool lat = s < SEQ;
          bf16_t* q = QKV + (size_t)r * 1536 + it * 64;
          headnorm64(q, (it < 16) ? p.swa_g_q : p.swa_g_k, (it < 16) ? qs : 1.f, lat, s >> 6, s & 63, tab16, jl);
        }
      PH_END
      PH_BEGIN
        for (int u = blockIdx.x; u < 1152; u += gridDim.x) {
          int bh, q0, ta0, ta1; if (u < 1024) { bh = u >> 3; q0 = (u & 7) * 256; ta0 = max(0, q0 / 64 - 2); ta1 = min(32, q0 / 64 + 6); } else { bh = u - 1024; q0 = SEQ; ta0 = 0; ta1 = 0; }
          const int b = bh >> 4, h = bh & 15, kvh = h >> 2; const size_t rb = (size_t)b * TPB;
          attn_unit<64, 64, 1, true>(lds, QKV + rb * 1536 + h * 64, 0, 1536, QKV + rb * 1536 + 1024 + kvh * 64, 0, 1536, QKV + rb * 1536 + 1280 + kvh * 64, 1536,
                                     q0, ta0, ta1, 32, 36, true, p.swa_sink[h] * LOG2E, Ob + rb * D + h * 64, D, 0.f, nullptr);
        }
      PH_END
      PH_BEGIN
        if (DBG_MASK & (1 << l)) gemm_phase(lds, Ob, D, swo_t, 1024, M, 1024, 1024, last, EpiResid{xl, xc, modl, 2}, blockIdx.x, gridDim.x);
      PH_END
    }
    PH_BEGIN
      norm_phase(xl, xc, p.norm_ffn + l * D, modl, 3, Hb, last);
    PH_END
    PH_BEGIN
      gemm_phase(lds, Hb, D, weff_t + (size_t)l * 2048 * 1024, 1024, M, 2048, 1024, last, EpiF32{SC, 2048}, blockIdx.x, gridDim.x);
    PH_END
    PH_BEGIN
      if (DBG_MASK & (16 << l)) peer_phase(lds, SC, Hb, pu + (size_t)l * 16384 * 1024, pv + (size_t)l * 16384 * 1024, modl, xl, xc, last);
    PH_END
  }
#undef PH_BEGIN
#undef PH_END
}

extern "C" void kernel_launch(void* const* d_in, const int* in_sizes, int n_in, void* d_out, int out_size, void* d_ws, size_t ws_size, hipStream_t stream) {
  static int grid_blocks = 0;
  if (grid_blocks == 0) {
    int dev = 0, cus = 0, per_cu = 0;
    if (n_in != 31 || out_size != NB * SEQ * D || ws_size < WS_END) { fprintf(stderr, "kernel_launch: unexpected shapes (n_in %d out %d ws %zu)\n", n_in, out_size, ws_size); grid_blocks = -1; return; }
    (void)hipGetDevice(&dev);
    (void)hipDeviceGetAttribute(&cus, hipDeviceAttributeMultiprocessorCount, dev);
    (void)hipFuncSetAttribute((const void*)mega, hipFuncAttributeMaxDynamicSharedMemorySize, LDS_BYTES);
    (void)hipOccupancyMaxActiveBlocksPerMultiprocessor(&per_cu, (const void*)mega, NTHREADS, LDS_BYTES);
    if (per_cu < 1) { fprintf(stderr, "kernel_launch: occupancy query says %d blocks/CU\n", per_cu); per_cu = 1; }
    grid_blocks = cus;
  }
  if (grid_blocks < 0) return;
  Params p{};
  const float** f = (const float**)&p;
  for (int i = 0; i < 31; ++i) f[i] = (const float*)d_in[i];
  p.out = (float*)d_out; p.ws = (unsigned char*)d_ws;
#ifdef MULTI_LAUNCH
  for (int ph = 0; ph < NPHASES; ++ph) {
    p.single = 0; p.phase = ph;
    void* args[] = {&p};
    hipError_t e = hipLaunchCooperativeKernel((const void*)mega, dim3(grid_blocks), dim3(NTHREADS), args, LDS_BYTES, stream);
    if (e != hipSuccess) { fprintf(stderr, "launch %d failed: %s\n", ph, hipGetErrorString(e)); break; }
  }
#else
  p.single = 1; p.phase = 0;
  void* args[] = {&p};
  hipError_t e = hipLaunchCooperativeKernel((const void*)mega, dim3(grid_blocks), dim3(NTHREADS), args, LDS_BYTES, stream);
  if (e != hipSuccess) fprintf(stderr, "cooperative launch failed: %s (grid %d)\n", hipGetErrorString(e), grid_blocks);
#endif
}
```

```cpp
#include <hip/hip_runtime.h>
#include <hip/hip_cooperative_groups.h>
#include <cstdio>
#include <cstdint>
namespace cg = cooperative_groups;

#define LAS __attribute__((address_space(3)))
#define GAS __attribute__((address_space(1)))
typedef unsigned short bf16_t;
typedef short bf16x8 __attribute__((ext_vector_type(8)));
typedef short v4i16_t __attribute__((ext_vector_type(4)));
typedef float f32x4 __attribute__((ext_vector_type(4)));
typedef float f32x16 __attribute__((ext_vector_type(16)));
typedef unsigned u32x4 __attribute__((ext_vector_type(4)));
typedef unsigned u32x2 __attribute__((ext_vector_type(2)));
typedef long long2_t __attribute__((ext_vector_type(2)));
typedef float f32x2_t __attribute__((ext_vector_type(2)));
typedef __bf16 bf16x2_t __attribute__((ext_vector_type(2)));

constexpr int D = 1024, NB = 8, SEQ = 2048, NCTX = 256, TPB = SEQ + NCTX  , M = NB * TPB  ;
constexpr int NTHREADS = 512, NWAVES = 8;
constexpr float EPS = 1e-6f;
constexpr float LOG2E = 1.4426950408889634f;
constexpr float LAM_INIT = 0.35550907f;
constexpr float ASC = 8.f, WSC = 64.f, OSC = 64.f;
constexpr size_t MiB = 1u << 20;
constexpr size_t WS_PTRS = 32768;
constexpr size_t WS_MODP = 352 * MiB  , WS_MOD = 8 * MiB, WS_TAB = 9 * MiB, WS_XC = 10 * MiB;
constexpr size_t WS_WDOWN = 18 * MiB, WS_WUQ = 23 * MiB, WS_WUKV = 28 * MiB, WS_MWO = 30 * MiB, WS_DQKV = 34 * MiB, WS_DWO = 40 * MiB;
constexpr size_t WS_SQKV = 42 * MiB, WS_SWO = 45 * MiB, WS_PWQ = 47 * MiB, WS_PKEYS = 63 * MiB, WS_WEFF = 65 * MiB;
constexpr size_t WS_PU = 96 * MiB, WS_PV = 224 * MiB, WS_H = 352 * MiB, WS_O = 388 * MiB, WS_BUF1 = 424 * MiB, WS_BUF2 = 532 * MiB;
constexpr size_t WS_BUF3 = 586 * MiB, WS_BUF4 = 658 * MiB, WS_CQN = 712 * MiB, WS_CKVN = 739 * MiB, WS_SC = 748 * MiB, WS_END = 892 * MiB;
constexpr size_t WS_XL = 896 * MiB, WS_TOTAL = 928 * MiB;
constexpr int LDS_BYTES = 147456;


struct Params {
  const float *x, *c, *ctx, *c_ctx, *ada_w, *ada_b, *norm_mix, *norm_ffn;
  const float *mla_w_down, *mla_g_cq, *mla_g_ckv, *mla_w_uq, *mla_w_ukv, *mla_g_q, *mla_g_k, *mla_w_o;
  const float *diff_w_qkv, *diff_g_q, *diff_g_k, *diff_lambda, *diff_g_sub, *diff_w_o;
  const float *swa_w_qkv, *swa_g_q, *swa_g_k, *swa_sink, *swa_w_o;
  const float *peer_w_q, *peer_keys, *peer_u, *peer_v;
  float* out; unsigned char* ws;
  int single, phase;
};

__device__ __forceinline__ int opaque_tid() { int t = threadIdx.x; asm volatile("" : "+v"(t)); return t; }
__device__ __forceinline__ int otid(int wv) { int w = wv; asm volatile("" : "+s"(w)); unsigned m = ~0u; asm volatile("" : "+s"(m)); const int l = (int)__builtin_amdgcn_mbcnt_hi(m, __builtin_amdgcn_mbcnt_lo(m, 0u)); return (w << 6) | l; }
__device__ __forceinline__ unsigned pk2(float lo, float hi) { f32x2_t v = {lo, hi}; bf16x2_t b = __builtin_convertvector(v, bf16x2_t); return __builtin_bit_cast(unsigned, b); }
__device__ __forceinline__ unsigned pk4_fp8(float a, float b, float c, float d) { int w = 0; w = __builtin_amdgcn_cvt_pk_fp8_f32(a, b, w, false); w = __builtin_amdgcn_cvt_pk_fp8_f32(c, d, w, true); return (unsigned)w; }
__device__ __forceinline__ float bf_lo(unsigned u) { return __uint_as_float(u << 16); }
__device__ __forceinline__ float bf_hi(unsigned u) { return __uint_as_float(u & 0xffff0000u); }
__device__ __forceinline__ float wave_sum(float v) {
#pragma unroll
  for (int o = 32; o >= 1; o >>= 1) v += __shfl_xor(v, o);
  return v;
}
__device__ __forceinline__ float dot2bf(unsigned a, unsigned b, float c) { return __builtin_amdgcn_fdot2_f32_bf16(__builtin_bit_cast(bf16x2_t, a), __builtin_bit_cast(bf16x2_t, b), c, false); }
__device__ __forceinline__ int crow(int r, int hi) { return (r & 3) + 8 * (r >> 2) + 4 * hi; }
__device__ __forceinline__ unsigned f2ord(float f) { unsigned u = __float_as_uint(f); return (u & 0x80000000u) ? ~u : (u | 0x80000000u); }
__device__ __forceinline__ float ord2f(unsigned o) { return __uint_as_float((o & 0x80000000u) ? (o & 0x7fffffffu) : ~o); }
__device__ __forceinline__ bf16_t* xrow_ptr(bf16_t* xl, bf16_t* xc, int r) {
  const int b = r / TPB, s = r - b * TPB;
  return (s < SEQ) ? xl + (size_t)(b * SEQ + s) * D : xc + (size_t)(b * NCTX + (s - SEQ)) * D;
}
__device__ __forceinline__ const float* xsrc_ptr(const float* sl, const float* sc, int r) {
  const int b = r / TPB, s = r - b * TPB;
  return (s < SEQ) ? sl + (size_t)(b * SEQ + s) * D : sc + (size_t)(b * NCTX + (s - SEQ)) * D;
}
template <bool F8>
__device__ __forceinline__ void tr_job(LAS unsigned char* lds, const float* __restrict__ W, void* __restrict__ Wt_, int K, int N, int Npad, int& rot) {
  LAS float* tile = (LAS float*)lds;
  const int nnb = Npad / 64, nit = (K / 64) * nnb, tid = opaque_tid();
  const int vb = ((int)blockIdx.x - rot % (int)gridDim.x + (int)gridDim.x) % (int)gridDim.x;
  rot += (nit + 3) / 4;
  for (int it0 = vb * 4; it0 < nit; it0 += gridDim.x * 4) {
    f32x4 v[4][2];
#pragma unroll
    for (int q = 0; q < 4; ++q) {
      const int it = it0 + q, kb = it / nnb, nb = it - kb * nnb, k0 = kb * 64, n0 = nb * 64;
#pragma unroll
      for (int i = 0; i < 2; ++i) {
        const int idx = tid + i * 512, kk = idx >> 4, nc = (idx & 15) * 4;
        v[q][i] = (f32x4){0.f, 0.f, 0.f, 0.f};
        if (it < nit && n0 + nc < N) v[q][i] = *(const f32x4*)(W + (size_t)(k0 + kk) * N + n0 + nc);
      }
    }
#pragma unroll
    for (int q = 0; q < 4; ++q)
#pragma unroll
      for (int i = 0; i < 2; ++i) {
        const int idx = tid + i * 512, kk = idx >> 4, nc = (idx & 15) * 4; LAS float* t = tile + q * (64 * 65) + kk * 65 + nc;
        t[0] = v[q][i].x; t[1] = v[q][i].y; t[2] = v[q][i].z; t[3] = v[q][i].w;
      }
    __syncthreads();
#pragma unroll
    for (int q = 0; q < 4; ++q) {
      const int it = it0 + q;
      if (it < nit) {
        const int kb = it / nnb, nb = it - kb * nnb, k0 = kb * 64, n0 = nb * 64;
        const int n = tid >> 3, kc = tid & 7;
        float f[8];
#pragma unroll
        for (int j = 0; j < 8; ++j) f[j] = tile[q * (64 * 65) + (kc * 8 + j) * 65 + n];
        if (F8) *(u32x2*)((unsigned char*)Wt_ + (size_t)(n0 + n) * K + k0 + kc * 8) = (u32x2){pk4_fp8(f[0] * WSC, f[1] * WSC, f[2] * WSC, f[3] * WSC), pk4_fp8(f[4] * WSC, f[5] * WSC, f[6] * WSC, f[7] * WSC)};
        else *(u32x4*)((bf16_t*)Wt_ + (size_t)(n0 + n) * K + k0 + kc * 8) = (u32x4){pk2(f[0], f[1]), pk2(f[2], f[3]), pk2(f[4], f[5]), pk2(f[6], f[7])};
      }
    }
    __syncthreads();
  }
}
__device__ __forceinline__ void cvt_job(const float* __restrict__ src, bf16_t* __restrict__ dst, size_t n8) {
  for (size_t i = (size_t)blockIdx.x * NTHREADS + threadIdx.x; i < n8; i += (size_t)gridDim.x * NTHREADS) {
    const f32x4 a = ((const f32x4*)src)[2 * i], b = ((const f32x4*)src)[2 * i + 1];
    ((u32x4*)dst)[i] = (u32x4){pk2(a.x, a.y), pk2(a.z, a.w), pk2(b.x, b.y), pk2(b.z, b.w)};
  }
}
__device__ __forceinline__ unsigned q4pack(f32x4 a, f32x4 b, float sc) {
  const float v[8] = {a.x, a.y, a.z, a.w, b.x, b.y, b.z, b.w}; unsigned w = 0u;
#pragma unroll
  for (int j = 0; j < 8; ++j) { int q = (int)rintf(v[j] * sc); q = min(7, max(-8, q)); w |= ((unsigned)q & 15u) << (4 * j); }
  return w;
}
__device__ __forceinline__ void conv_rows(const float* __restrict__ usrc, const float* __restrict__ vsrc, unsigned char* __restrict__ udst, unsigned char* __restrict__ vdst, float su, float sv, int r0, int r1, int tid) {
  for (int r = r0 + (tid >> 6); r < r1; r += NWAVES) {
    const bool isv = r >= 16384; const int rr = isv ? r - 16384 : r; const int c = (tid & 63);
    const f32x4* sp = (const f32x4*)((isv ? vsrc : usrc) + (size_t)rr * 1024) + c * 4;
    const f32x4 a = sp[0], b = sp[1], cc = sp[2], d = sp[3];
    u32x2 o;
    if (isv) {
      unsigned w0 = 0u, w1 = 0u;
      w0 = __builtin_amdgcn_cvt_scalef32_pk_fp4_f32(w0, a.x * sv, a.y * sv, 1.0f, 0); w0 = __builtin_amdgcn_cvt_scalef32_pk_fp4_f32(w0, a.z * sv, a.w * sv, 1.0f, 1);
      w0 = __builtin_amdgcn_cvt_scalef32_pk_fp4_f32(w0, b.x * sv, b.y * sv, 1.0f, 2); w0 = __builtin_amdgcn_cvt_scalef32_pk_fp4_f32(w0, b.z * sv, b.w * sv, 1.0f, 3);
      w1 = __builtin_amdgcn_cvt_scalef32_pk_fp4_f32(w1, cc.x * sv, cc.y * sv, 1.0f, 0); w1 = __builtin_amdgcn_cvt_scalef32_pk_fp4_f32(w1, cc.z * sv, cc.w * sv, 1.0f, 1);
      w1 = __builtin_amdgcn_cvt_scalef32_pk_fp4_f32(w1, d.x * sv, d.y * sv, 1.0f, 2); w1 = __builtin_amdgcn_cvt_scalef32_pk_fp4_f32(w1, d.z * sv, d.w * sv, 1.0f, 3);
      o = (u32x2){w0, w1};
    } else o = (u32x2){q4pack(a, b, su), q4pack(cc, d, su)};
    *(u32x2*)((isv ? vdst : udst) + (size_t)rr * 512 + c * 8) = o;
  }
}
__device__ __forceinline__ void ada_job(LAS unsigned char* lds, const Params& p, float* __restrict__ modp) {
  LAS float* s = (LAS float*)lds;
  const int tid = opaque_tid();
  for (int u = blockIdx.x; u < 768; u += gridDim.x) {
    const int l = u / 192, r = u - l * 192, cc = r >> 6, kc = r & 63;
    __syncthreads();
    if (tid < 144) { const int bi = tid >> 4, k = tid & 15; const float c = (bi < 8) ? p.c[bi * D + kc * 16 + k] : p.c_ctx[kc * 16 + k]; s[tid] = c / (1.f + __expf(-c)); }
    __syncthreads();
    f32x4 acc[9];
#pragma unroll
    for (int bi = 0; bi < 9; ++bi) acc[bi] = (f32x4){0.f, 0.f, 0.f, 0.f};
    const float* w = p.ada_w + ((size_t)l * D + kc * 16) * 6144 + cc * 2048 + tid * 4;
#pragma unroll
    for (int h = 0; h < 2; ++h) {
      f32x4 wv[8];
#pragma unroll
      for (int k = 0; k < 8; ++k) wv[k] = *(const f32x4*)(w + (size_t)(h * 8 + k) * 6144);
#pragma unroll
      for (int k = 0; k < 8; ++k)
#pragma unroll
        for (int bi = 0; bi < 9; ++bi) acc[bi] += s[bi * 16 + h * 8 + k] * wv[k];
    }
#pragma unroll
    for (int bi = 0; bi < 9; ++bi) *(f32x4*)(modp + (((size_t)kc * 4 + l) * 9 + bi) * 6144 + cc * 2048 + tid * 4) = acc[bi];
  }
}

__device__ __forceinline__ void norm_phase(const float* sl, const float* sc_, bf16_t* xl, bf16_t* xc, bool src_f32, const float* __restrict__ g, const float* __restrict__ modl, int which, unsigned char* __restrict__ H, bool out_f8, bool skip_ctx, int wv) {
  const int tid_ = otid(wv); const int lane = tid_ & 63, wid = tid_ >> 6;
  for (int r = blockIdx.x * NWAVES + wid; r < M; r += gridDim.x * NWAVES) {
    const int b = r / TPB, s = r - b * TPB; const bool isctx = s >= SEQ;
    if (skip_ctx && isctx) continue;
    const int bi = isctx ? 8 : b;
    const float* sh = modl + (size_t)(bi * 6 + which) * D; const float* sc = sh + D;
    f32x4 v[4]; float ss = 0.f;
    if (src_f32) {
      const float* xr = xsrc_ptr(sl, sc_, r);
#pragma unroll
      for (int j = 0; j < 4; ++j) v[j] = ((const f32x4*)xr)[lane + 64 * j];
    } else {
      const bf16_t* xr = xrow_ptr(xl, xc, r);
#pragma unroll
      for (int j = 0; j < 4; ++j) { const u32x2 w = ((const u32x2*)xr)[lane + 64 * j]; v[j] = (f32x4){bf_lo(w.x), bf_hi(w.x), bf_lo(w.y), bf_hi(w.y)}; }
    }
#pragma unroll
    for (int j = 0; j < 4; ++j) ss += v[j].x * v[j].x + v[j].y * v[j].y + v[j].z * v[j].z + v[j].w * v[j].w;
    ss = wave_sum(ss);
    const float rstd = rsqrtf(ss * (1.f / D) + EPS);
#pragma unroll
    for (int j = 0; j < 4; ++j) {
      const int c4 = lane + 64 * j;
      const f32x4 g4 = ((const f32x4*)g)[c4], s4 = ((const f32x4*)sc)[c4], h4 = ((const f32x4*)sh)[c4];
      const f32x4 y = v[j] * rstd * g4 * (1.f + s4) + h4;
      if (out_f8) *(unsigned*)(H + (size_t)r * D + c4 * 4) = pk4_fp8(y.x * ASC, y.y * ASC, y.z * ASC, y.w * ASC);
      else *(u32x2*)((bf16_t*)H + (size_t)r * D + c4 * 4) = (u32x2){pk2(y.x, y.y), pk2(y.z, y.w)};
    }
  }
}
__device__ __forceinline__ void latnorm_phase(const bf16_t* __restrict__ LAT, const float* __restrict__ gcq, const float* __restrict__ gckv, unsigned char* __restrict__ CQN, bf16_t* __restrict__ CKVN, int wv) {
  const int tid_ = otid(wv); const int lane = tid_ & 63, wid = tid_ >> 6;
  for (int r = blockIdx.x * NWAVES + wid; r < M; r += gridDim.x * NWAVES) {
    const bf16_t* lr = LAT + (size_t)r * 1280;
    float q[12], kv[4]; float sq = 0.f, sk = 0.f;
#pragma unroll
    for (int j = 0; j < 3; ++j) { const u32x2 w = *(const u32x2*)(lr + lane * 4 + 256 * j); q[4 * j] = bf_lo(w.x); q[4 * j + 1] = bf_hi(w.x); q[4 * j + 2] = bf_lo(w.y); q[4 * j + 3] = bf_hi(w.y); }
    { const u32x2 w = *(const u32x2*)(lr + 768 + lane * 4); kv[0] = bf_lo(w.x); kv[1] = bf_hi(w.x); kv[2] = bf_lo(w.y); kv[3] = bf_hi(w.y); }
#pragma unroll
    for (int j = 0; j < 12; ++j) sq += q[j] * q[j];
#pragma unroll
    for (int j = 0; j < 4; ++j) sk += kv[j] * kv[j];
    sq = wave_sum(sq); sk = wave_sum(sk);
    const float rq = rsqrtf(sq * (1.f / 768.f) + EPS), rk = rsqrtf(sk * (1.f / 256.f) + EPS);
#pragma unroll
    for (int j = 0; j < 3; ++j) { const int c = lane * 4 + 256 * j; const f32x4 g4 = *(const f32x4*)(gcq + c);
      *(unsigned*)(CQN + (size_t)r * 768 + c) = pk4_fp8(q[4 * j] * rq * g4.x * ASC, q[4 * j + 1] * rq * g4.y * ASC, q[4 * j + 2] * rq * g4.z * ASC, q[4 * j + 3] * rq * g4.w * ASC); }
    { const int c = lane * 4; const f32x4 g4 = *(const f32x4*)(gckv + c);
      *(u32x2*)(CKVN + (size_t)r * 256 + c) = (u32x2){pk2(kv[0] * rk * g4.x, kv[1] * rk * g4.y), pk2(kv[2] * rk * g4.z, kv[3] * rk * g4.w)}; }
  }
}

constexpr int G_AS = 144;
constexpr int G_ATILE = 256 * G_AS, G_BTILE = 128 * G_AS, G_STAGE = G_ATILE + G_BTILE;
struct EpiFp8T { unsigned char* C; int ldc;
  __device__ __forceinline__ void operator()(int row, int col, f32x4 v) const { const unsigned w = pk4_fp8(v.x * WSC, v.y * WSC, v.z * WSC, v.w * WSC);
    C[(size_t)(col + 0) * ldc + row] = (unsigned char)(w & 255u); C[(size_t)(col + 1) * ldc + row] = (unsigned char)((w >> 8) & 255u); C[(size_t)(col + 2) * ldc + row] = (unsigned char)((w >> 16) & 255u); C[(size_t)(col + 3) * ldc + row] = (unsigned char)(w >> 24); } };
struct EpiBf16T { bf16_t* C; int ldc;
  __device__ __forceinline__ void operator()(int row, int col, f32x4 v) const {
    C[(size_t)(col + 0) * ldc + row] = (bf16_t)(pk2(v.x, 0.f) & 0xffffu); C[(size_t)(col + 1) * ldc + row] = (bf16_t)(pk2(v.y, 0.f) & 0xffffu);
    C[(size_t)(col + 2) * ldc + row] = (bf16_t)(pk2(v.z, 0.f) & 0xffffu); C[(size_t)(col + 3) * ldc + row] = (bf16_t)(pk2(v.w, 0.f) & 0xffffu); } };
template <class Epi>
__device__ __forceinline__ void gemm_phase(LAS unsigned char* lds, const bf16_t* __restrict__ A, int lda, const bf16_t* __restrict__ Bt, int ldb,
                                           int Mrows, int N, int K, bool skip_ctx_tiles, const Epi epi, int ustart, int ustride) {
  const int tid = opaque_tid(), lane = tid & 63, wid = tid >> 6, wr = wid >> 1, wc = wid & 1, fr = lane & 15, fq = lane >> 4;
  const int nN = N / 128, nU = (Mrows / 256) * nN, nt = K / 64;
  const int lrow = tid >> 3, lkc = tid & 7;
  for (int u = ustart; u < nU; u += ustride) {
    const int pm = u / nN, pn = u - pm * nN;
    if (skip_ctx_tiles && (pm % 9) == 8) continue;
    const bf16_t* Ag = A + (size_t)(pm * 256 + lrow) * lda + lkc * 8;
    const bf16_t* Bg = Bt + (size_t)(pn * 128 + lrow) * ldb + lkc * 8;
    f32x4 acc[4][4];
#pragma unroll
    for (int m = 0; m < 4; ++m)
#pragma unroll
      for (int n = 0; n < 4; ++n) acc[m][n] = (f32x4){0.f, 0.f, 0.f, 0.f};
    u32x4 ra[4], rb[2];
#pragma unroll
    for (int i = 0; i < 4; ++i) ra[i] = *(const u32x4*)(Ag + (size_t)(64 * i) * lda);
#pragma unroll
    for (int i = 0; i < 2; ++i) rb[i] = *(const u32x4*)(Bg + (size_t)(64 * i) * ldb);
    {
      LAS unsigned char* sa = lds + lrow * G_AS + lkc * 16; LAS unsigned char* sb = lds + G_ATILE + lrow * G_AS + lkc * 16;
#pragma unroll
      for (int i = 0; i < 4; ++i) *(LAS u32x4*)(sa + i * 64 * G_AS) = ra[i];
#pragma unroll
      for (int i = 0; i < 2; ++i) *(LAS u32x4*)(sb + i * 64 * G_AS) = rb[i];
    }
    __syncthreads();
    for (int t = 0; t < nt; ++t) {
      const bool more = (t + 1 < nt);
      if (more) {
#pragma unroll
        for (int i = 0; i < 4; ++i) ra[i] = *(const u32x4*)(Ag + (size_t)(64 * i) * lda + (t + 1) * 64);
#pragma unroll
        for (int i = 0; i < 2; ++i) rb[i] = *(const u32x4*)(Bg + (size_t)(64 * i) * ldb + (t + 1) * 64);
      }
      const LAS unsigned char* st = lds + (t & 1) * G_STAGE;
      const LAS unsigned char* pa = st + (wr * 64 + fr) * G_AS + fq * 16;
      const LAS unsigned char* pb = st + G_ATILE + (wc * 64 + fr) * G_AS + fq * 16;
#pragma unroll
      for (int ks = 0; ks < 2; ++ks) {
        bf16x8 af[4], bfr[4];
#pragma unroll
        for (int m = 0; m < 4; ++m) af[m] = *(const LAS bf16x8*)(pa + m * 16 * G_AS + ks * 64);
#pragma unroll
        for (int n = 0; n < 4; ++n) bfr[n] = *(const LAS bf16x8*)(pb + n * 16 * G_AS + ks * 64);
#pragma unroll
        for (int m = 0; m < 4; ++m)
#pragma unroll
          for (int n = 0; n < 4; ++n) acc[m][n] = __builtin_amdgcn_mfma_f32_16x16x32_bf16(bfr[n], af[m], acc[m][n], 0, 0, 0);
      }
      if (more) {
        LAS unsigned char* sa = lds + ((t + 1) & 1) * G_STAGE + lrow * G_AS + lkc * 16; LAS unsigned char* sb = sa + G_ATILE;
#pragma unroll
        for (int i = 0; i < 4; ++i) *(LAS u32x4*)(sa + i * 64 * G_AS) = ra[i];
#pragma unroll
        for (int i = 0; i < 2; ++i) *(LAS u32x4*)(sb + i * 64 * G_AS) = rb[i];
      }
      __syncthreads();
    }
#pragma unroll
    for (int m = 0; m < 4; ++m)
#pragma unroll
      for (int n = 0; n < 4; ++n) epi(pm * 256 + wr * 64 + m * 16 + fr, pn * 128 + wc * 64 + n * 16 + fq * 4, acc[m][n]);
  }
}

namespace pg8 {
#define PG8_LAS __attribute__((address_space(3)))
typedef unsigned short bf16_t;
typedef short bf16x8 __attribute__((ext_vector_type(8)));
typedef float f32x4 __attribute__((ext_vector_type(4)));
typedef unsigned u32x4 __attribute__((ext_vector_type(4)));
constexpr int BM = 256, BK = 64, HALF = 128, HTB = HALF * BK * 2  , STAGE_BYTES = 8 * HTB, NXCD = 8, WGM = 8;

__host__ __device__ __forceinline__ int lds_byte(int r, int c) { const int st = (r >> 4) * 2 + (c >> 5), rr = r & 15, cc = c & 31, ob = rr * 64 + cc * 2; return st * 1024 + (ob ^ (((ob >> 9) & 1) << 5)); }
__host__ __device__ __forceinline__ void stage_rc(int b, int& R, int& C) { const int st = b / 1024, sb = b % 1024, swz = sb ^ (((sb >> 9) & 1) << 5); R = (st >> 1) * 16 + swz / 64; C = (st & 1) * 32 + (swz % 64) / 2; }
__host__ __device__ __forceinline__ int perm32(int rho) { const int n = rho >> 4, i = rho & 15; return 8 * (i >> 2) + 4 * n + (i & 3); }

struct Unit { int pm, pn; };
struct Gemm { const bf16_t* A; const bf16_t* Bt; int M, N, K; };

struct StaticOrder {
    int nM, nN, nwg, G, c;
    __host__ __device__ void init(int M, int N, int G_, int c_) { nM = M / BM; nN = N / BM; nwg = nM * nN; G = G_; c = c_; }
    __host__ __device__ bool next(int i, Unit& u) const {
        const long L = (long)i * G + c; if (L >= nwg) return false;
        int wgid = (int)L; { const int q = nwg / NXCD, r = nwg % NXCD, xcd = wgid % NXCD, off = wgid / NXCD; wgid = (xcd < r ? xcd * (q + 1) : r * (q + 1) + (xcd - r) * q) + off; }
        const int nig = WGM * nN, gid = wgid / nig, fm = gid * WGM, gsz = (nM - fm) < WGM ? (nM - fm) : WGM;
        u.pm = fm + ((wgid % nig) % gsz); u.pn = (wgid % nig) / gsz; return true;
    }
    __device__ __forceinline__ void a_ready(const Unit&) const {}
    __device__ __forceinline__ void done(const Unit&) const {}
};
struct LatentOrder {
    StaticOrder base; bool skip;
    __host__ __device__ void init(int M_, int N_, int G_, int c_, bool skip_) { skip = skip_; base.init(skip_ ? (M_ / 9) * 8 : M_, N_, G_, c_); }
    __host__ __device__ bool next(int i, Unit& u) const { if (!base.next(i, u)) return false; if (skip) u.pm += u.pm >> 3; return true; }
    __device__ __forceinline__ void a_ready(const Unit&) const {}
    __device__ __forceinline__ void done(const Unit&) const {}
};
struct EpiBf16P { static constexpr bool PERM = true, AFTER_DRAIN = false; bf16_t* O; int ldc; float sc;
  __device__ __forceinline__ void operator()(const f32x4 (&acc)[2][2][4][2], const Unit& u, int wr, int wc, int fr, int fq) const {
    const int row0 = u.pm * BM + wr * 64 + fr, col0 = u.pn * BM + wc * 32 + 8 * fq;
#pragma unroll
    for (int ai = 0; ai < 2; ++ai)
#pragma unroll
      for (int m = 0; m < 4; ++m) { bf16_t* rowp = O + (size_t)(row0 + ai * HALF + m * 16) * ldc + col0;
#pragma unroll
        for (int bj = 0; bj < 2; ++bj) { const f32x4 v0 = acc[ai][bj][m][0] * sc, v1 = acc[ai][bj][m][1] * sc;
          *(u32x4*)(rowp + bj * HALF) = (u32x4){pk2(v0[0], v0[1]), pk2(v0[2], v0[3]), pk2(v1[0], v1[1]), pk2(v1[2], v1[3])}; } }
  } };
struct EpiResidN { static constexpr bool PERM = false, AFTER_DRAIN = false; const float* sl; const float* sc; bool src_f32; bf16_t* xl; bf16_t* xc; const float* modl; int which; bool live; float osc;
  __device__ __forceinline__ void operator()(const f32x4 (&acc)[2][2][4][2], const Unit& u, int wr, int wc, int fr, int fq) const {
    if (!live) return;
    const int row0 = u.pm * BM + wr * 64 + fr, col0 = u.pn * BM + wc * 32 + 4 * fq;
    const int b = (u.pm * BM) / TPB, s0 = u.pm * BM - b * TPB; const int bi = (s0 >= SEQ) ? 8 : b;
    const float* gp = modl + (size_t)(bi * 6 + which) * D + col0;
#pragma unroll
    for (int bj = 0; bj < 2; ++bj)
#pragma unroll
      for (int n = 0; n < 2; ++n) { const f32x4 gt = *(const f32x4*)(gp + bj * HALF + n * 16) * osc;
#pragma unroll
        for (int ai = 0; ai < 2; ++ai)
#pragma unroll
          for (int m = 0; m < 4; ++m) { const int rr = row0 + ai * HALF + m * 16, cc = col0 + bj * HALF + n * 16;
            bf16_t* xp = xrow_ptr(xl, xc, rr) + cc; f32x4 xv;
            if (src_f32) xv = *(const f32x4*)(xsrc_ptr(sl, sc, rr) + cc);
            else { const u32x2 w = *(const u32x2*)xp; xv = (f32x4){bf_lo(w.x), bf_hi(w.x), bf_lo(w.y), bf_hi(w.y)}; }
            xv += gt * acc[ai][bj][m][n]; *(u32x2*)xp = (u32x2){pk2(xv.x, xv.y), pk2(xv.z, xv.w)}; } }
  } };
template <class Epi, class Sched, bool ALIGN_EPI = false, bool SP2 = false, bool FP8 = false>
__device__ __forceinline__ void gemm_phase(PG8_LAS unsigned char* lds, const Gemm g, const Sched& S, const Epi& E, int wv) {
    const int tid = otid(wv), wid = __builtin_amdgcn_readfirstlane(tid >> 6), lane = tid & 63, wr = wid >> 2, wc = wid & 3, fr = lane & 15, fq = lane >> 4;
    const int K = g.K, nt = K / BK;
    unsigned voffA[2], voffB[2];
#pragma unroll
    for (int i = 0; i < 2; ++i) { int R, C; stage_rc(tid * 16 + i * 8192, R, C); const int Rb = Epi::PERM ? ((R & ~31) + perm32(R & 31)) : R;
        voffA[i] = (unsigned)(R * K + C) * 2u; voffB[i] = (unsigned)(Rb * K + C) * 2u; }
    const size_t kstep = (size_t)(BK * 2);
    const size_t hstep = (size_t)HALF * K * 2;
    const size_t tstep = 2 * hstep;
    const unsigned ldsw = (unsigned)wid * 1024u;
    const int aoff = lds_byte(wr * 64 + fr, fq * 8), boff = lds_byte(wc * 32 + fr, fq * 8);
#define PG8_SA(b, h) (((b) * 2 + (h)) * HTB)
#define PG8_SB(b, h) ((4 + (b) * 2 + (h)) * HTB)
#define PG8_STAGE(bufoff, gbase, voff) do { _Pragma("unroll") for (int _i = 0; _i < 2; ++_i) \
        __builtin_amdgcn_global_load_lds((const unsigned*)((const char*)(gbase) + (voff)[_i]), (PG8_LAS unsigned*)(lds + (bufoff) + ldsw + _i * 8192), 16, 0, 0); } while (0)
#define PG8_LDA(dst, b, h) do { _Pragma("unroll") for (int m = 0; m < 4; ++m) _Pragma("unroll") for (int k = 0; k < 2; ++k) dst[m][k] = *(const PG8_LAS bf16x8*)(lds + PG8_SA(b, h) + aoff + m * 2048 + k * 1024); } while (0)
#define PG8_LDB(dst, b, h) do { _Pragma("unroll") for (int n = 0; n < 2; ++n) _Pragma("unroll") for (int k = 0; k < 2; ++k) dst[n][k] = *(const PG8_LAS bf16x8*)(lds + PG8_SB(b, h) + boff + n * 2048 + k * 1024); } while (0)
#define PG8_MMA(ai, bj, At, Bt) do { __builtin_amdgcn_s_setprio(1); _Pragma("unroll") for (int m = 0; m < 4; ++m) _Pragma("unroll") for (int n = 0; n < 2; ++n) _Pragma("unroll") for (int k = 0; k < 2; ++k) { \
        if constexpr (FP8) { const long2_t a2_ = __builtin_bit_cast(long2_t, At[m][k]), b2_ = __builtin_bit_cast(long2_t, Bt[n][k]); \
          acc[ai][bj][m][n] = __builtin_amdgcn_mfma_f32_16x16x32_fp8_fp8(b2_[0], a2_[0], acc[ai][bj][m][n], 0, 0, 0); \
          acc[ai][bj][m][n] = __builtin_amdgcn_mfma_f32_16x16x32_fp8_fp8(b2_[1], a2_[1], acc[ai][bj][m][n], 0, 0, 0); } \
        else acc[ai][bj][m][n] = __builtin_amdgcn_mfma_f32_16x16x32_bf16(Bt[n][k], At[m][k], acc[ai][bj][m][n], 0, 0, 0); } __builtin_amdgcn_s_setprio(0); } while (0)
#define PG8_WAIT_V(n) asm volatile("s_waitcnt vmcnt(" #n ")" ::: "memory")
#define PG8_WAIT_L(n) asm volatile("s_waitcnt lgkmcnt(" #n ")" ::: "memory")
#define PG8_BAR __builtin_amdgcn_s_barrier()
#define PG8_SCHED __builtin_amdgcn_sched_barrier(0)
    Unit cur, nxt; int ui = 0;
    if (!S.next(0, cur)) return;
    f32x4 acc[2][2][4][2];
#pragma unroll
    for (int a = 0; a < 2; ++a)
#pragma unroll
        for (int b = 0; b < 2; ++b)
#pragma unroll
            for (int m = 0; m < 4; ++m)
#pragma unroll
                for (int n = 0; n < 2; ++n) acc[a][b][m][n] = (f32x4){0.f, 0.f, 0.f, 0.f};
    bf16x8 At[4][2], B0[2][2], B1[2][2];
    const char* cA = (const char*)g.A + (size_t)cur.pm * tstep; const char* cB = (const char*)g.Bt + (size_t)cur.pn * tstep;
    S.a_ready(cur);
    if constexpr (SP2) {
        PG8_STAGE(PG8_SB(0, 0), cB, voffB); PG8_STAGE(PG8_SB(0, 1), cB + hstep, voffB); PG8_STAGE(PG8_SA(0, 0), cA, voffA); PG8_STAGE(PG8_SA(0, 1), cA + hstep, voffA);
        if (wr == 1) PG8_BAR;
        PG8_WAIT_V(2); PG8_BAR;
        PG8_STAGE(PG8_SB(1, 0), cB + kstep, voffB); PG8_STAGE(PG8_SA(1, 0), cA + kstep, voffA); PG8_STAGE(PG8_SB(1, 1), cB + hstep + kstep, voffB);
        PG8_WAIT_V(6); PG8_BAR;
    } else {
        PG8_STAGE(PG8_SB(0, 0), cB, voffB); PG8_STAGE(PG8_SA(0, 0), cA, voffA); PG8_STAGE(PG8_SB(0, 1), cB + hstep, voffB); PG8_STAGE(PG8_SA(0, 1), cA + hstep, voffA);
        if (wr == 1) PG8_BAR;
        PG8_WAIT_V(4); PG8_BAR;
        PG8_STAGE(PG8_SB(1, 0), cB + kstep, voffB); PG8_STAGE(PG8_SA(1, 0), cA + kstep, voffA); PG8_STAGE(PG8_SB(1, 1), cB + hstep + kstep, voffB);
        PG8_WAIT_V(6); PG8_BAR;
    }
    for (;;) {
        const bool has_next = S.next(ui + 1, nxt);
        const char* nA = has_next ? (const char*)g.A + (size_t)nxt.pm * tstep : cA; const char* nB = has_next ? (const char*)g.Bt + (size_t)nxt.pn * tstep : cB;
        for (int t = 0; t < nt; t += 2) {
            const bool last = (t == nt - 2);
            const char* a1 = cA + (size_t)(t + 1) * kstep;
            const char* a2 = last ? nA : cA + (size_t)(t + 2) * kstep; const char* b2 = last ? nB : cB + (size_t)(t + 2) * kstep;
            const char* a3 = a2 + kstep; const char* b3 = b2 + kstep;
            if (last && has_next) S.a_ready(nxt);
            if constexpr (SP2) {
            PG8_LDB(B0, 0, 0); PG8_LDB(B1, 0, 1); PG8_SCHED; PG8_LDA(At, 0, 0); PG8_STAGE(PG8_SA(1, 1), a1 + hstep, voffA);
            PG8_WAIT_V(8); PG8_WAIT_L(0); PG8_BAR; PG8_MMA(0, 0, At, B0); PG8_MMA(0, 1, At, B1); PG8_BAR; PG8_SCHED;
            PG8_LDA(At, 0, 1); PG8_STAGE(PG8_SB(0, 0), b2, voffB); PG8_STAGE(PG8_SB(0, 1), b2 + hstep, voffB); PG8_STAGE(PG8_SA(0, 0), a2, voffA);
            PG8_WAIT_V(8); PG8_WAIT_L(0); PG8_BAR; PG8_MMA(1, 0, At, B0); PG8_MMA(1, 1, At, B1); PG8_BAR; PG8_SCHED;
            PG8_LDB(B0, 1, 0); PG8_LDB(B1, 1, 1); PG8_SCHED; PG8_LDA(At, 1, 0); PG8_STAGE(PG8_SA(0, 1), a2 + hstep, voffA);
            PG8_WAIT_V(8); PG8_WAIT_L(0); PG8_BAR; PG8_MMA(0, 0, At, B0); PG8_MMA(0, 1, At, B1); PG8_BAR; PG8_SCHED;
            PG8_LDA(At, 1, 1); PG8_STAGE(PG8_SB(1, 0), b3, voffB); PG8_STAGE(PG8_SB(1, 1), b3 + hstep, voffB); PG8_STAGE(PG8_SA(1, 0), a3, voffA);
            PG8_WAIT_V(8); PG8_WAIT_L(0); PG8_BAR; PG8_MMA(1, 0, At, B0); PG8_MMA(1, 1, At, B1); PG8_BAR; PG8_SCHED;
            } else {
            PG8_LDB(B0, 0, 0); PG8_SCHED; PG8_LDA(At, 0, 0); PG8_STAGE(PG8_SA(1, 1), a1 + hstep, voffA);
            PG8_WAIT_L(8); PG8_BAR; PG8_WAIT_L(0); PG8_MMA(0, 0, At, B0); PG8_BAR; PG8_SCHED;
            PG8_LDB(B1, 0, 1); PG8_STAGE(PG8_SB(0, 0), b2, voffB);
            PG8_BAR; PG8_WAIT_L(0); PG8_MMA(0, 1, At, B1); PG8_BAR;
            PG8_LDA(At, 0, 1); PG8_STAGE(PG8_SA(0, 0), a2, voffA);
            PG8_BAR; PG8_WAIT_L(0); PG8_MMA(1, 0, At, B0); PG8_BAR; PG8_SCHED;
            PG8_STAGE(PG8_SB(0, 1), b2 + hstep, voffB);
            PG8_WAIT_V(6); PG8_BAR; PG8_MMA(1, 1, At, B1); PG8_BAR;
            PG8_LDB(B0, 1, 0); PG8_SCHED; PG8_LDA(At, 1, 0); PG8_STAGE(PG8_SA(0, 1), a2 + hstep, voffA);
            PG8_WAIT_L(8); PG8_BAR; PG8_WAIT_L(0); PG8_MMA(0, 0, At, B0); PG8_BAR; PG8_SCHED;
            PG8_LDB(B1, 1, 1); PG8_STAGE(PG8_SB(1, 0), b3, voffB);
            PG8_BAR; PG8_WAIT_L(0); PG8_MMA(0, 1, At, B1); PG8_BAR;
            PG8_LDA(At, 1, 1); PG8_STAGE(PG8_SA(1, 0), a3, voffA);
            PG8_BAR; PG8_WAIT_L(0); PG8_MMA(1, 0, At, B0); PG8_BAR; PG8_SCHED;
            PG8_STAGE(PG8_SB(1, 1), b3 + hstep, voffB);
            PG8_WAIT_V(6); PG8_BAR; PG8_MMA(1, 1, At, B1); PG8_BAR;
            }
        }
        if constexpr (ALIGN_EPI) { if (wr == 0) PG8_BAR; }
        if constexpr (!Epi::AFTER_DRAIN) { E(acc, cur, wr, wc, fr, fq); S.done(cur); }
        if (!has_next) break;
#pragma unroll
        for (int a = 0; a < 2; ++a)
#pragma unroll
            for (int b = 0; b < 2; ++b)
#pragma unroll
                for (int m = 0; m < 4; ++m)
#pragma unroll
                    for (int n = 0; n < 2; ++n) acc[a][b][m][n] = (f32x4){0.f, 0.f, 0.f, 0.f};
        cur = nxt; cA = nA; cB = nB; ++ui;
        if constexpr (ALIGN_EPI) { if (wr == 1) PG8_BAR; }
    }
    PG8_WAIT_V(0);
    if constexpr (!ALIGN_EPI) { if (wr == 0) PG8_BAR; }
    PG8_BAR;
    if constexpr (Epi::AFTER_DRAIN) { E.fused(acc, cur, wr, wc, fr, fq, lds, wid, lane); S.done(cur); }
#undef PG8_SA
#undef PG8_SB
#undef PG8_STAGE
#undef PG8_LDA
#undef PG8_LDB
#undef PG8_MMA
#undef PG8_WAIT_V
#undef PG8_WAIT_L
#undef PG8_BAR
#undef PG8_SCHED
}
}
#define UNPACK8(W, V, O) do { V[O + 0] = bf_lo(W.x); V[O + 1] = bf_hi(W.x); V[O + 2] = bf_lo(W.y); V[O + 3] = bf_hi(W.y); V[O + 4] = bf_lo(W.z); V[O + 5] = bf_hi(W.z); V[O + 6] = bf_lo(W.w); V[O + 7] = bf_hi(W.w); } while (0)
#define PACK8(V, O, SC) (u32x4){pk2(V[O] * SC, V[O + 1] * SC), pk2(V[O + 2] * SC, V[O + 3] * SC), pk2(V[O + 4] * SC, V[O + 5] * SC), pk2(V[O + 6] * SC, V[O + 7] * SC)}
__device__ __forceinline__ void headnorm96(const bf16_t* srcA, const bf16_t* srcB, bf16_t* dst, const float* __restrict__ g, float outscale, bool rope, int rowpos, int colpos,
                                           const float* __restrict__ tab8, int j) {
  const u32x4 w0 = *(const u32x4*)(srcA + j * 8), w1 = *(const u32x4*)(srcA + 32 + j * 8), w2 = *(const u32x4*)(srcB + j * 8);
  float v[24];
  UNPACK8(w0, v, 0); UNPACK8(w1, v, 8); UNPACK8(w2, v, 16);
  float ss = 0.f;
#pragma unroll
  for (int e = 0; e < 24; ++e) ss += v[e] * v[e];
  ss += __shfl_xor(ss, 1); ss += __shfl_xor(ss, 2);
  const float rstd = rsqrtf(ss * (1.f / 96.f) + EPS);
#pragma unroll
  for (int e = 0; e < 8; ++e) { v[e] *= rstd * g[j * 8 + e]; v[8 + e] *= rstd * g[32 + j * 8 + e]; v[16 + e] *= rstd * g[64 + j * 8 + e]; }
  const int pos = (j < 2) ? rowpos : colpos;
#pragma unroll
  for (int e = 0; e < 8; ++e) {
    const float own = v[16 + e], oth = __shfl_xor(own, 1);
    const f32x2_t cs = *(const f32x2_t*)(tab8 + (pos * 8 + e) * 2);
    const float res = (j & 1) ? (oth * cs.y + own * cs.x) : (own * cs.x - oth * cs.y);
    if (rope) v[16 + e] = res;
  }
  *(u32x4*)(dst + j * 8) = PACK8(v, 0, outscale); *(u32x4*)(dst + 32 + j * 8) = PACK8(v, 8, outscale); *(u32x4*)(dst + 64 + j * 8) = PACK8(v, 16, outscale);
}
__device__ __forceinline__ void headnorm64(const bf16_t* q, bf16_t* qd, const float* __restrict__ g, float outscale, bool rope, int rowpos, int colpos, const float* __restrict__ tab16, int j) {
  const u32x4 w0 = *(const u32x4*)(q + j * 8), w1 = *(const u32x4*)(q + 32 + j * 8);
  float v[16];
  UNPACK8(w0, v, 0); UNPACK8(w1, v, 8);
  float ss = 0.f;
#pragma unroll
  for (int e = 0; e < 16; ++e) ss += v[e] * v[e];
  ss += __shfl_xor(ss, 1); ss += __shfl_xor(ss, 2);
  const float rstd = rsqrtf(ss * (1.f / 64.f) + EPS);
#pragma unroll
  for (int e = 0; e < 8; ++e) { v[e] *= rstd * g[j * 8 + e]; v[8 + e] *= rstd * g[32 + j * 8 + e]; }
#pragma unroll
  for (int e = 0; e < 8; ++e) {
    const int i = (j & 1) * 8 + e;
    const float own0 = v[e], oth0 = __shfl_xor(own0, 2), own1 = v[8 + e], oth1 = __shfl_xor(own1, 2);
    const f32x2_t cr = *(const f32x2_t*)(tab16 + (rowpos * 16 + i) * 2), cc = *(const f32x2_t*)(tab16 + (colpos * 16 + i) * 2);
    const float r0 = (j >> 1) ? (oth0 * cr.y + own0 * cr.x) : (own0 * cr.x - oth0 * cr.y);
    const float r1 = (j >> 1) ? (oth1 * cc.y + own1 * cc.x) : (own1 * cc.x - oth1 * cc.y);
    if (rope) { v[e] = r0; v[8 + e] = r1; }
  }
  *(u32x4*)(qd + j * 8) = PACK8(v, 0, outscale); *(u32x4*)(qd + 32 + j * 8) = PACK8(v, 8, outscale);
}

template <int DQK, int DV, int NS, bool WINDOW>
__device__ __forceinline__ void attn_unit(LAS unsigned char* lds, const bf16_t* __restrict__ Qb, int qsoff, int ldq, const bf16_t* __restrict__ Kb, int ksoff, int ldk,
                                          const bf16_t* __restrict__ Vb, int ldv, int q0, int ta0, int ta1, int tb0, int tb1, bool has_sink, float sink_l2, float kmax,
                                          unsigned char* __restrict__ Ob, int ldo, float lam, const float* __restrict__ gsub, int wv) {
  constexpr int KS = DQK * 2 + 16, KTB = 64 * KS, VS = (DV == 64) ? 192 : 320, VOFF = NS * KTB, VTB = 64 * VS, STG = VOFF + VTB;
  constexpr int KCR = DQK / 8, KCH = 64 * KCR, VCR = DV / 8, VCH = 64 * VCR, NCH = NS * KCH + VCH, NI = (NCH + NTHREADS - 1) / NTHREADS;
  constexpr int NDB = DV / 32, NKS = DQK / 16;
  static_assert(3 * STG <= LDS_BYTES - 16 && (NS == 1 || 4 * DV * 32 * 4 <= 3 * STG), "LDS");
  const int tid = otid(wv), lane = tid & 63, wid = tid >> 6, l31 = lane & 31, hi = lane >> 5;
  const int grp = wid >> 2;
  const int qsub = (NS == 1) ? wid : (wid & 3), stream = (NS == 1) ? 0 : grp;
  const int qrow = q0 + qsub * 32 + l31;
  bf16x8 qf[NKS];
  float qn2 = 0.f;
#pragma unroll
  for (int ks = 0; ks < NKS; ++ks) {
    const u32x4 w = *(const u32x4*)(Qb + (size_t)stream * qsoff + (size_t)qrow * ldq + ks * 16 + hi * 8);
    qf[ks] = __builtin_bit_cast(bf16x8, w);
    const float a0 = bf_lo(w.x), a1 = bf_hi(w.x), a2 = bf_lo(w.y), a3 = bf_hi(w.y), a4 = bf_lo(w.z), a5 = bf_hi(w.z), a6 = bf_lo(w.w), a7 = bf_hi(w.w);
    qn2 += a0 * a0 + a1 * a1 + a2 * a2 + a3 * a3 + a4 * a4 + a5 * a5 + a6 * a6 + a7 * a7;
  }
  qn2 += __shfl_xor(qn2, 32);
  const float negmb = -(sqrtf(qn2) * kmax);
  f32x16 negmv;
  if (DV == 64) {
#pragma unroll
    for (int r = 0; r < 16; ++r) negmv[r] = negmb;
    asm volatile("" : "+v"(negmv));
  }
  f32x16 o[NDB];
#pragma unroll
  for (int db = 0; db < NDB; ++db)
#pragma unroll
    for (int r = 0; r < 16; ++r) o[db][r] = 0.f;
  float lrun = 0.f;
  const int n1 = ta1 - ta0, ntl = n1 + (tb1 - tb0);
  u32x4 st[NI];
  f32x16 p0, p1;
  const LAS unsigned char* klb = lds + stream * KTB + l31 * KS + hi * 16;
  const LAS unsigned char* vlb = lds + VOFF + (4 * hi + ((lane & 15) >> 2)) * VS + (16 * ((lane >> 4) & 1) + 4 * (lane & 3)) * 2;
#define ATT_TILE(i_) (((i_) < n1) ? ta0 + (i_) : tb0 + ((i_) - n1))
#define ATT_LOAD(T_) do { const int t__ = (T_); _Pragma("unroll") for (int ii = 0; ii < NI; ++ii) { const int c = tid + ii * NTHREADS; if (c < NCH) { \
      if (c < NS * KCH) { const int s_ = c / KCH, cc = c - s_ * KCH, row = cc / KCR, kc = cc - row * KCR; st[ii] = *(const u32x4*)(Kb + (size_t)s_ * ksoff + (size_t)(t__ * 64 + row) * ldk + kc * 8); } \
      else { const int cc = c - NS * KCH, row = cc / VCR, vc = cc - row * VCR; st[ii] = *(const u32x4*)(Vb + (size_t)(t__ * 64 + row) * ldv + vc * 8); } } } } while (0)
#define ATT_STORE(BO_) do { LAS unsigned char* sb__ = lds + (BO_); _Pragma("unroll") for (int ii = 0; ii < NI; ++ii) { const int c = tid + ii * NTHREADS; if (c < NCH) { \
      if (c < NS * KCH) { const int s_ = c / KCH, cc = c - s_ * KCH, row = cc / KCR, kc = cc - row * KCR; *(LAS u32x4*)(sb__ + s_ * KTB + row * KS + kc * 16) = st[ii]; } \
      else { const int cc = c - NS * KCH, row = cc / VCR, vc = cc - row * VCR; *(LAS u32x4*)(sb__ + VOFF + row * VS + vc * 16) = st[ii]; } } } } while (0)
#define ATT_FLAGS(T_, ACT_, MSK_) do { ACT_ = true; MSK_ = false; if (WINDOW && (T_) < 32) { const int qlo = q0 + qsub * 32, qhi = qlo + 31, klo = (T_) * 64, khi = klo + 63; \
      ACT_ = !(khi < qlo - 128 || klo > qhi + 128); MSK_ = (khi - qlo > 128) || (qhi - klo > 128); } } while (0)
  constexpr int KB1 = NKS / 2;
  bf16x8 kf[2 * KB1];
#define ATT_QK_READ1(BO_) do { const LAS unsigned char* kl = klb + (BO_); \
      _Pragma("unroll") for (int ks = 0; ks < KB1; ++ks) { kf[2 * ks] = *(const LAS bf16x8*)(kl + ks * 32); kf[2 * ks + 1] = *(const LAS bf16x8*)(kl + 32 * KS + ks * 32); } \
      __builtin_amdgcn_sched_barrier(0); } while (0)
#define ATT_QK_REST(BO_) do { const LAS unsigned char* kl = klb + (BO_); \
      __builtin_amdgcn_sched_barrier(0); \
      if (DV == 64) { p0 = __builtin_amdgcn_mfma_f32_32x32x16_bf16(kf[0], qf[0], negmv, 0, 0, 0); p1 = __builtin_amdgcn_mfma_f32_32x32x16_bf16(kf[1], qf[0], negmv, 0, 0, 0); } \
      else { _Pragma("unroll") for (int r = 0; r < 16; ++r) { p0[r] = negmb; p1[r] = negmb; } p0 = __builtin_amdgcn_mfma_f32_32x32x16_bf16(kf[0], qf[0], p0, 0, 0, 0); p1 = __builtin_amdgcn_mfma_f32_32x32x16_bf16(kf[1], qf[0], p1, 0, 0, 0); } \
      _Pragma("unroll") for (int ks = 1; ks < KB1; ++ks) { p0 = __builtin_amdgcn_mfma_f32_32x32x16_bf16(kf[2 * ks], qf[ks], p0, 0, 0, 0); p1 = __builtin_amdgcn_mfma_f32_32x32x16_bf16(kf[2 * ks + 1], qf[ks], p1, 0, 0, 0); } \
      __builtin_amdgcn_sched_barrier(0); \
      _Pragma("unroll") for (int ks = KB1; ks < NKS; ++ks) { kf[2 * (ks - KB1)] = *(const LAS bf16x8*)(kl + ks * 32); kf[2 * (ks - KB1) + 1] = *(const LAS bf16x8*)(kl + 32 * KS + ks * 32); } \
      __builtin_amdgcn_sched_barrier(0); \
      _Pragma("unroll") for (int ks = KB1; ks < NKS; ++ks) { p0 = __builtin_amdgcn_mfma_f32_32x32x16_bf16(kf[2 * (ks - KB1)], qf[ks], p0, 0, 0, 0); p1 = __builtin_amdgcn_mfma_f32_32x32x16_bf16(kf[2 * (ks - KB1) + 1], qf[ks], p1, 0, 0, 0); } \
      __builtin_amdgcn_sched_barrier(0); } while (0)
#define ATT_VREAD(G_) do { _Pragma("unroll") for (int d2 = 0; d2 < GD; ++d2) _Pragma("unroll") for (int kb = 0; kb < 2; ++kb) _Pragma("unroll") for (int s_ = 0; s_ < 2; ++s_) { \
        const LAS unsigned char* vp = vl + (kb * 32 + 16 * s_) * VS + ((G_) * GD + d2) * 64; \
        vlo[d2 * 4 + kb * 2 + s_] = __builtin_amdgcn_ds_read_tr16_b64_v4i16((LAS v4i16_t*)vp); vhi[d2 * 4 + kb * 2 + s_] = __builtin_amdgcn_ds_read_tr16_b64_v4i16((LAS v4i16_t*)(vp + 8 * VS)); } } while (0)
#define ATT_PVM(G_) do { _Pragma("unroll") for (int d2 = 0; d2 < GD; ++d2) _Pragma("unroll") for (int kb = 0; kb < 2; ++kb) _Pragma("unroll") for (int s_ = 0; s_ < 2; ++s_) { \
        const v4i16_t lo_ = vlo[d2 * 4 + kb * 2 + s_], hi_ = vhi[d2 * 4 + kb * 2 + s_]; \
        const bf16x8 vf = (bf16x8){lo_[0], lo_[1], lo_[2], lo_[3], hi_[0], hi_[1], hi_[2], hi_[3]}; \
        o[(G_) * GD + d2] = __builtin_amdgcn_mfma_f32_32x32x16_bf16(vf, __builtin_bit_cast(bf16x8, pw[kb][s_]), o[(G_) * GD + d2], 0, 0, 0); } } while (0)
#define ATT_SPV(T_, BO_, MSK_) do { const LAS unsigned char* vl = vlb + (BO_); constexpr int GD = (DV == 128) ? 1 : 2; v4i16_t vlo[4 * GD], vhi[4 * GD]; \
      ATT_VREAD(0); __builtin_amdgcn_sched_barrier(0); \
      if (WINDOW && (MSK_)) { _Pragma("unroll") for (int r = 0; r < 16; ++r) { const int d0 = (T_) * 64 + crow(r, hi) - qrow, d1 = d0 + 32; \
          if (d0 > 128 || d0 < -128) p0[r] = -INFINITY; if (d1 > 128 || d1 < -128) p1[r] = -INFINITY; } } \
      _Pragma("unroll") for (int r = 0; r < 16; ++r) { p0[r] = __builtin_amdgcn_exp2f(p0[r]); p1[r] = __builtin_amdgcn_exp2f(p1[r]); } \
      u32x4 pw[2][2]; \
      _Pragma("unroll") for (int s_ = 0; s_ < 2; ++s_) { \
        pw[0][s_] = (u32x4){pk2(p0[8 * s_], p0[8 * s_ + 1]), pk2(p0[8 * s_ + 2], p0[8 * s_ + 3]), pk2(p0[8 * s_ + 4], p0[8 * s_ + 5]), pk2(p0[8 * s_ + 6], p0[8 * s_ + 7])}; \
        pw[1][s_] = (u32x4){pk2(p1[8 * s_], p1[8 * s_ + 1]), pk2(p1[8 * s_ + 2], p1[8 * s_ + 3]), pk2(p1[8 * s_ + 4], p1[8 * s_ + 5]), pk2(p1[8 * s_ + 6], p1[8 * s_ + 7])}; } \
      _Pragma("unroll") for (int kb = 0; kb < 2; ++kb) _Pragma("unroll") for (int s_ = 0; s_ < 2; ++s_) { \
        lrun = dot2bf(pw[kb][s_].x, 0x3f803f80u, lrun); lrun = dot2bf(pw[kb][s_].y, 0x3f803f80u, lrun); lrun = dot2bf(pw[kb][s_].z, 0x3f803f80u, lrun); lrun = dot2bf(pw[kb][s_].w, 0x3f803f80u, lrun); } \
      __builtin_amdgcn_sched_barrier(0); \
      ATT_PVM(0); \
      _Pragma("unroll") for (int g_ = 1; g_ < NDB / GD; ++g_) { __builtin_amdgcn_sched_barrier(0); ATT_VREAD(g_); __builtin_amdgcn_sched_barrier(0); ATT_PVM(g_); } } while (0)
  ATT_LOAD(ATT_TILE(0));
  ATT_STORE(0);
  if (ntl > 1) ATT_LOAD(ATT_TILE(1));
  __syncthreads();
  int bo_prev = 0, bo_cur = 0, bo_next = STG;
  for (int i = 0; i <= ntl; ++i) {
    if (grp == 0) {
      if (i < ntl) {
        const int t = ATT_TILE(i);
        bool act, msk; ATT_FLAGS(t, act, msk);
        if (act) ATT_QK_READ1(bo_cur);
        if (i + 1 < ntl) ATT_STORE(bo_next);
        if (i + 2 < ntl) ATT_LOAD(ATT_TILE(i + 2));
        if (act) { ATT_QK_REST(bo_cur); ATT_SPV(t, bo_cur, msk); }
      }
    } else {
      if (i >= 1) { const int tp = ATT_TILE(i - 1); bool act, msk; ATT_FLAGS(tp, act, msk); if (act) ATT_SPV(tp, bo_prev, msk); }
      if (i < ntl) {
        const int t = ATT_TILE(i);
        bool act, msk; ATT_FLAGS(t, act, msk);
        if (act) ATT_QK_READ1(bo_cur);
        if (i + 1 < ntl) ATT_STORE(bo_next);
        if (i + 2 < ntl) ATT_LOAD(ATT_TILE(i + 2));
        if (act) ATT_QK_REST(bo_cur);
      }
    }
    bo_prev = bo_cur; bo_cur = bo_next; bo_next = (bo_next == 2 * STG) ? 0 : bo_next + STG;
    __syncthreads();
  }
#undef ATT_LOAD
#undef ATT_STORE
#undef ATT_TILE
#undef ATT_FLAGS
#undef ATT_QK_READ1
#undef ATT_QK_REST
#undef ATT_VREAD
#undef ATT_PVM
#undef ATT_SPV
  float ltot = lrun + __shfl_xor(lrun, 32);
  if (has_sink) ltot += __builtin_amdgcn_exp2f(sink_l2 + negmb);
  const float inv = 1.f / ltot;
  if (NS == 1) {
    unsigned char* op = Ob + (size_t)qrow * ldo + 4 * hi; const float is_ = inv * OSC;
#pragma unroll
    for (int db = 0; db < NDB; ++db)
#pragma unroll
      for (int r4 = 0; r4 < 4; ++r4)
        *(unsigned*)(op + db * 32 + 8 * r4) = pk4_fp8(o[db][4 * r4] * is_, o[db][4 * r4 + 1] * is_, o[db][4 * r4 + 2] * is_, o[db][4 * r4 + 3] * is_);
  } else {
    LAS float* ex = (LAS float*)lds + qsub * (DV * 32);
    if (stream == 1) {
#pragma unroll
      for (int db = 0; db < NDB; ++db)
#pragma unroll
        for (int r = 0; r < 16; ++r) ex[(db * 32 + crow(r, hi)) * 32 + l31] = o[db][r] * inv;
    }
    __syncthreads();
    if (stream == 0) {
      float ss = 0.f;
#pragma unroll
      for (int db = 0; db < NDB; ++db)
#pragma unroll
        for (int r = 0; r < 16; ++r) { const float v = o[db][r] * inv - lam * ex[(db * 32 + crow(r, hi)) * 32 + l31]; o[db][r] = v; ss += v * v; }
      ss += __shfl_xor(ss, 32);
      const float rs = rsqrtf(ss * (1.f / DV) + EPS) * (1.f - LAM_INIT);
      unsigned char* op = Ob + (size_t)qrow * ldo + 4 * hi; const float rs_ = rs * OSC;
#pragma unroll
      for (int db = 0; db < NDB; ++db)
#pragma unroll
        for (int r4 = 0; r4 < 4; ++r4) {
          const f32x4 g4 = *(const f32x4*)(gsub + db * 32 + 8 * r4 + 4 * hi);
          *(unsigned*)(op + db * 32 + 8 * r4) = pk4_fp8(o[db][4 * r4] * rs_ * g4.x, o[db][4 * r4 + 1] * rs_ * g4.y, o[db][4 * r4 + 2] * rs_ * g4.z, o[db][4 * r4 + 3] * rs_ * g4.w);
        }
    }
    __syncthreads();
  }
}

#define TOPK_INSERT(ARR, KEY) do { unsigned k__ = (KEY); _Pragma("unroll") for (int t_ = 0; t_ < 16; ++t_) { const unsigned h__ = max(ARR[t_], k__); k__ = min(ARR[t_], k__); ARR[t_] = h__; } } while (0)
__device__ __forceinline__ void peer_phase(LAS unsigned char* lds, const bf16_t* __restrict__ S, const unsigned char* __restrict__ H, const unsigned char* __restrict__ U, const unsigned char* __restrict__ V, float uinv, float vinv,
                                           const float* __restrict__ modl, bf16_t* xl, bf16_t* xc, float* outf, bool last, bool live, unsigned char* Hn, const float* __restrict__ gn, const float* __restrict__ modn, int wv) {
  const int tid_ = otid(wv); const int lane = tid_ & 63, wid = tid_ >> 6;
  LAS unsigned* keysL = (LAS unsigned*)(lds + wid * 9216);
  LAS u32x2* resL = (LAS u32x2*)(lds + wid * 9216 + 4096);
  LAS float* wL = (LAS float*)(lds + wid * 9216 + 8192);
  const int ngroups = last ? (NB * SEQ / 4) : (M / 4);
  for (int g = blockIdx.x * NWAVES + wid; g < ngroups; g += gridDim.x * NWAVES) {
    const int r0 = last ? (g / (SEQ / 4)) * TPB + (g % (SEQ / 4)) * 4 : g * 4;
    const int tok = lane >> 4, hc = lane & 15;
    unsigned top[16];
    const bf16_t* sp = S + (size_t)(r0 + tok) * 2048 + hc * 128;
#define CE_DESC(A_, B_) do { const unsigned h__ = max(A_, B_), l__ = min(A_, B_); A_ = h__; B_ = l__; } while (0)
#pragma unroll 1
    for (int j0 = 0; j0 < 128; j0 += 16) {
      unsigned blk[16];
      { const u32x4 v0 = *(const u32x4*)(sp + j0), v1 = *(const u32x4*)(sp + j0 + 8);
        const unsigned base = (unsigned)(127 - j0);
        blk[0] = (f2ord(bf_lo(v0.x)) & ~127u) | (base - 0u);  blk[1] = (f2ord(bf_hi(v0.x)) & ~127u) | (base - 1u);
        blk[2] = (f2ord(bf_lo(v0.y)) & ~127u) | (base - 2u);  blk[3] = (f2ord(bf_hi(v0.y)) & ~127u) | (base - 3u);
        blk[4] = (f2ord(bf_lo(v0.z)) & ~127u) | (base - 4u);  blk[5] = (f2ord(bf_hi(v0.z)) & ~127u) | (base - 5u);
        blk[6] = (f2ord(bf_lo(v0.w)) & ~127u) | (base - 6u);  blk[7] = (f2ord(bf_hi(v0.w)) & ~127u) | (base - 7u);
        blk[8] = (f2ord(bf_lo(v1.x)) & ~127u) | (base - 8u);  blk[9] = (f2ord(bf_hi(v1.x)) & ~127u) | (base - 9u);
        blk[10] = (f2ord(bf_lo(v1.y)) & ~127u) | (base - 10u); blk[11] = (f2ord(bf_hi(v1.y)) & ~127u) | (base - 11u);
        blk[12] = (f2ord(bf_lo(v1.z)) & ~127u) | (base - 12u); blk[13] = (f2ord(bf_hi(v1.z)) & ~127u) | (base - 13u);
        blk[14] = (f2ord(bf_lo(v1.w)) & ~127u) | (base - 14u); blk[15] = (f2ord(bf_hi(v1.w)) & ~127u) | (base - 15u); }
#pragma unroll
      for (int k = 2; k <= 16; k <<= 1)
#pragma unroll
        for (int j = k >> 1; j > 0; j >>= 1)
#pragma unroll
          for (int i = 0; i < 16; ++i) { const int l = i ^ j; if (l > i) { if ((i & k) == 0) CE_DESC(blk[i], blk[l]); else CE_DESC(blk[l], blk[i]); } }
      if (j0 == 0) {
#pragma unroll
        for (int i = 0; i < 16; ++i) top[i] = blk[i];
      } else {
#pragma unroll
        for (int i = 0; i < 16; ++i) top[i] = max(top[i], blk[15 - i]);
#pragma unroll
        for (int j = 8; j > 0; j >>= 1)
#pragma unroll
          for (int i = 0; i < 16; ++i) { const int l = i ^ j; if (l > i) CE_DESC(top[i], top[l]); }
      }
    }
#undef CE_DESC
#pragma unroll
    for (int i = 0; i < 16; ++i) keysL[lane * 16 + i] = top[i];
    float v0[16], v1[16];
#pragma unroll
    for (int i = 0; i < 16; ++i) { const unsigned t1 = __shfl_down(top[i], 1); v0[i] = ord2f(top[i] & ~127u); v1[i] = ord2f(t1 & ~127u); }
    unsigned cd[16];
#pragma unroll
    for (int i = 0; i < 16; ++i) cd[i] = 0u;
#pragma unroll
    for (int a = 0; a < 16; ++a)
#pragma unroll
      for (int b = 0; b < 16 / (a + 1); ++b) TOPK_INSERT(cd, (f2ord(v0[a] + v1[b]) & ~255u) | (unsigned)(255 - (a * 16 + b)));
    {
      float e[16]; float sum = 0.f; const float mx = ord2f(cd[0] & ~255u);
#pragma unroll
      for (int k = 0; k < 16; ++k) { e[k] = __expf(ord2f(cd[k] & ~255u) - mx); sum += e[k]; }
      const float inv = 1.f / sum;
      const int lp1 = (lane + 1) & 63;
#pragma unroll
      for (int k = 0; k < 16; ++k) {
        const int pos = 255 - (int)(cd[k] & 255u), a = pos >> 4, b = pos & 15;
        const unsigned i1 = 127u - (keysL[lane * 16 + a] & 127u), i2 = 127u - (keysL[lp1 * 16 + b] & 127u);
        if ((hc & 1) == 0) resL[tok * 128 + (hc >> 1) * 16 + k] = (u32x2){i1 * 128u + i2, __float_as_uint(e[k] * inv)};
      }
    }
    for (int tk = 0; tk < 4; ++tk) {
      const int r = r0 + tk;
      float hf[16];
      { const bf16_t* hrow = (const bf16_t*)H + (size_t)r * D + lane * 16; const u32x4 ha = *(const u32x4*)hrow, hb = *(const u32x4*)(hrow + 8);
        hf[0] = bf_lo(ha.x); hf[1] = bf_hi(ha.x); hf[2] = bf_lo(ha.y); hf[3] = bf_hi(ha.y); hf[4] = bf_lo(ha.z); hf[5] = bf_hi(ha.z); hf[6] = bf_lo(ha.w); hf[7] = bf_hi(ha.w);
        hf[8] = bf_lo(hb.x); hf[9] = bf_hi(hb.x); hf[10] = bf_lo(hb.y); hf[11] = bf_hi(hb.y); hf[12] = bf_lo(hb.z); hf[13] = bf_hi(hb.z); hf[14] = bf_lo(hb.w); hf[15] = bf_hi(hb.w); }
      unsigned hq1a = 0u, hq1b = 0u, hq2a = 0u, hq2b = 0u; float hstep;
      { float ss = 0.f;
#pragma unroll
        for (int j = 0; j < 16; ++j) ss += hf[j] * hf[j];
        ss = wave_sum(ss);
        hstep = 0.5f * sqrtf(ss * (1.f / D) + 1e-20f); const float rs = 1.f / hstep;
#pragma unroll
        for (int j = 0; j < 16; ++j) {
          const float t = hf[j] * rs; int q1 = (int)rintf(t); q1 = min(7, max(-8, q1));
          int q2 = (int)rintf((t - (float)q1) * 16.f); q2 = min(7, max(-8, q2));
          if (j < 8) { hq1a |= ((unsigned)q1 & 15u) << (4 * j); hq2a |= ((unsigned)q2 & 15u) << (4 * j); }
          else { hq1b |= ((unsigned)q1 & 15u) << (4 * (j - 8)); hq2b |= ((unsigned)q2 & 15u) << (4 * (j - 8)); }
        } }
      const float uscale = uinv * hstep * (1.f / 16.f);
      f32x2_t o2[8];
#pragma unroll
      for (int j = 0; j < 8; ++j) o2[j] = (f32x2_t){0.f, 0.f};
      const bool b5 = (lane & 32) != 0, b4 = (lane & 16) != 0, b3 = (lane & 8) != 0, b2 = (lane & 4) != 0;
      const int ei = (lane >> 2) & 15;
      u32x2 ua[16], va[16], ub[16], vb[16];
#define PEER_LOAD(UU, VV, BT) do { _Pragma("unroll") for (int i = 0; i < 16; ++i) { const unsigned e_ = resL[tk * 128 + (BT) * 16 + i].x; \
        UU[i] = *(const u32x2*)(U + (size_t)e_ * 512 + lane * 8); VV[i] = *(const u32x2*)(V + (size_t)e_ * 512 + lane * 8); } } while (0)
#define PEER_PROC(UU, VV, BT) do { float d[16]; \
        _Pragma("unroll") for (int i = 0; i < 16; ++i) { const int w0 = (int)UU[i].x, w1 = (int)UU[i].y; \
          const int i1 = __builtin_amdgcn_sdot8(w1, (int)hq1b, __builtin_amdgcn_sdot8(w0, (int)hq1a, 0, false), false); \
          const int i2 = __builtin_amdgcn_sdot8(w1, (int)hq2b, __builtin_amdgcn_sdot8(w0, (int)hq2a, 0, false), false); \
          d[i] = (float)(i1 * 16 + i2); } \
        float k8[8], k4[4], k2[2], k1; \
        _Pragma("unroll") for (int i = 0; i < 8; ++i) { const auto r_ = __builtin_amdgcn_permlane32_swap(__float_as_uint(d[i]), __float_as_uint(d[8 + i]), false, false); k8[i] = __uint_as_float(r_[0]) + __uint_as_float(r_[1]); } \
        _Pragma("unroll") for (int i = 0; i < 4; ++i) { const auto r_ = __builtin_amdgcn_permlane16_swap(__float_as_uint(k8[i]), __float_as_uint(k8[4 + i]), false, false); k4[i] = __uint_as_float(r_[0]) + __uint_as_float(r_[1]); } \
        _Pragma("unroll") for (int i = 0; i < 2; ++i) { \
          const float sa = k4[i] + __int_as_float(__builtin_amdgcn_update_dpp(0, __float_as_int(k4[i]), 0x128, 0xf, 0xf, false)); \
          const float sb = k4[2 + i] + __int_as_float(__builtin_amdgcn_update_dpp(0, __float_as_int(k4[2 + i]), 0x128, 0xf, 0xf, false)); \
          k2[i] = b3 ? sb : sa; } \
        { const float keep = b2 ? k2[1] : k2[0], send = b2 ? k2[0] : k2[1]; k1 = keep + __shfl_xor(send, 4); } \
        k1 += __shfl_xor(k1, 2); k1 += __shfl_xor(k1, 1); \
        const float tot = k1 * uscale; \
        const float gate = __uint_as_float(resL[tk * 128 + (BT) * 16 + ei].y); \
        const float wact = 0.5f * tot * (1.f + erff(tot * 0.70710678118f)) * gate * vinv; \
        _Pragma("unroll") for (int i = 0; i < 16; ++i) { const float wi = __int_as_float(__builtin_amdgcn_readlane(__float_as_int(wact), 4 * i)); const f32x2_t w2 = {wi, wi}; const unsigned w0 = VV[i].x, w1 = VV[i].y; \
          o2[0] = __builtin_elementwise_fma(__builtin_amdgcn_cvt_scalef32_pk_f32_fp4(w0, 1.0f, 0), w2, o2[0]); o2[1] = __builtin_elementwise_fma(__builtin_amdgcn_cvt_scalef32_pk_f32_fp4(w0, 1.0f, 1), w2, o2[1]); \
          o2[2] = __builtin_elementwise_fma(__builtin_amdgcn_cvt_scalef32_pk_f32_fp4(w0, 1.0f, 2), w2, o2[2]); o2[3] = __builtin_elementwise_fma(__builtin_amdgcn_cvt_scalef32_pk_f32_fp4(w0, 1.0f, 3), w2, o2[3]); \
          o2[4] = __builtin_elementwise_fma(__builtin_amdgcn_cvt_scalef32_pk_f32_fp4(w1, 1.0f, 0), w2, o2[4]); o2[5] = __builtin_elementwise_fma(__builtin_amdgcn_cvt_scalef32_pk_f32_fp4(w1, 1.0f, 1), w2, o2[5]); \
          o2[6] = __builtin_elementwise_fma(__builtin_amdgcn_cvt_scalef32_pk_f32_fp4(w1, 1.0f, 2), w2, o2[6]); o2[7] = __builtin_elementwise_fma(__builtin_amdgcn_cvt_scalef32_pk_f32_fp4(w1, 1.0f, 3), w2, o2[7]); } } while (0)
      PEER_LOAD(ua, va, 0);
      for (int bt = 0; bt < 8; bt += 2) {
        PEER_LOAD(ub, vb, bt + 1);
        PEER_PROC(ua, va, bt);
        if (bt + 2 < 8) PEER_LOAD(ua, va, bt + 2);
        PEER_PROC(ub, vb, bt + 1);
      }
#undef PEER_LOAD
#undef PEER_PROC
      if (live) {
        const int b = r / TPB, s = r - b * TPB; const int bi = (s >= SEQ) ? 8 : b;
        bf16_t* xp = xrow_ptr(xl, xc, r) + lane * 16; const float* gt = modl + (size_t)(bi * 6 + 5) * D + lane * 16;
        f32x4 xn[4]; float ss = 0.f;
        { const u32x4 xa = *(const u32x4*)xp, xb = *(const u32x4*)(xp + 8);
          xn[0] = (f32x4){bf_lo(xa.x), bf_hi(xa.x), bf_lo(xa.y), bf_hi(xa.y)}; xn[1] = (f32x4){bf_lo(xa.z), bf_hi(xa.z), bf_lo(xa.w), bf_hi(xa.w)};
          xn[2] = (f32x4){bf_lo(xb.x), bf_hi(xb.x), bf_lo(xb.y), bf_hi(xb.y)}; xn[3] = (f32x4){bf_lo(xb.z), bf_hi(xb.z), bf_lo(xb.w), bf_hi(xb.w)}; }
#pragma unroll
        for (int q = 0; q < 4; ++q) {
          const f32x4 gv = ((const f32x4*)gt)[q];
          xn[q] += gv * (f32x4){o2[2 * q].x, o2[2 * q].y, o2[2 * q + 1].x, o2[2 * q + 1].y};
          ss += xn[q].x * xn[q].x + xn[q].y * xn[q].y + xn[q].z * xn[q].z + xn[q].w * xn[q].w;
        }
        if (last) {
          float* op = outf + (size_t)(b * SEQ + s) * D + lane * 16;
#pragma unroll
          for (int q = 0; q < 4; ++q) ((f32x4*)op)[q] = xn[q];
        } else {
          *(u32x4*)xp = (u32x4){pk2(xn[0].x, xn[0].y), pk2(xn[0].z, xn[0].w), pk2(xn[1].x, xn[1].y), pk2(xn[1].z, xn[1].w)};
          *(u32x4*)(xp + 8) = (u32x4){pk2(xn[2].x, xn[2].y), pk2(xn[2].z, xn[2].w), pk2(xn[3].x, xn[3].y), pk2(xn[3].z, xn[3].w)};
        }
        if (Hn != nullptr) {
          ss = wave_sum(ss);
          const float rstd = rsqrtf(ss * (1.f / D) + EPS);
          const float* sh = modn + (size_t)(bi * 6) * D + lane * 16; const float* sc = sh + D; const float* gg = gn + lane * 16;
          u32x4 h0;
#pragma unroll
          for (int q = 0; q < 4; ++q) {
            const f32x4 g4 = ((const f32x4*)gg)[q], s4 = ((const f32x4*)sc)[q], h4 = ((const f32x4*)sh)[q];
            const f32x4 y = (xn[q] * rstd * g4 * (1.f + s4) + h4) * ASC;
            h0[q] = pk4_fp8(y.x, y.y, y.z, y.w);
          }
          *(u32x4*)(Hn + (size_t)r * D + lane * 16) = h0;
        }
      }
    }
  }
}

#define XB_TMO      128
#define XB_XCNT(j)  (256  + 64 * (j))
#define XB_XSUB(j)  (1280 + 64 * (j))
#define XB_XGEN(j)  (2304 + 64 * (j))
#define XB_TOP      3328
#define XB_TOPGEN   3392
#define XCD_BAR_WORDS 3456
#define XB_SPIN_CAP (1u << 20)
__device__ __forceinline__ unsigned xb_ld(unsigned* p)              { return __hip_atomic_load(p, __ATOMIC_RELAXED, __HIP_MEMORY_SCOPE_AGENT); }
__device__ __forceinline__ unsigned xb_add(unsigned* p, unsigned v) { return __hip_atomic_fetch_add(p, v, __ATOMIC_RELAXED, __HIP_MEMORY_SCOPE_AGENT); }
__device__ __forceinline__ unsigned xb_xcc_id() { return (unsigned)__builtin_amdgcn_s_getreg((3 << 11) | 20) & 0xFu; }
#define XB_SPIN(cond, bar) do { unsigned _sp = 0; while (cond) { __builtin_amdgcn_s_sleep(1); \
    if ((++_sp & 255u) == 0u) { if (xb_ld(&(bar)[XB_TMO])) break; if (_sp > XB_SPIN_CAP) { atomicAdd(&(bar)[XB_TMO], 1u); break; } } } } while (0)
struct XcdBarrier { unsigned* bar; unsigned x; volatile LAS unsigned* st; };
__device__ __forceinline__ XcdBarrier xcd_barrier_post(unsigned* bar, volatile LAS unsigned* st) {
    XcdBarrier b; b.bar = bar; b.x = xb_xcc_id(); b.st = st;
    if (threadIdx.x == 0) (void)xb_add(&bar[XB_XCNT(b.x)], 1u);
    return b;
}
__device__ __forceinline__ void xcd_barrier_complete(unsigned* bar, unsigned x, unsigned& nloc, unsigned& nx) {
    const unsigned G = gridDim.x * gridDim.y * gridDim.z;
    unsigned sum, cnt, mine, sp = 0u;
    for (;;) {
        sum = 0u; cnt = 0u; mine = 0u;
#pragma unroll
        for (unsigned j = 0; j < 16; ++j) { const unsigned c = xb_ld(&bar[XB_XCNT(j)]); sum += c; cnt += (c > 0u) ? 1u : 0u; mine = (j == x) ? c : mine; }
        if (sum == G) break;
        __builtin_amdgcn_s_sleep(1);
        if ((++sp & 255u) == 0u) { if (xb_ld(&bar[XB_TMO])) break; if (sp > XB_SPIN_CAP) { atomicAdd(&bar[XB_TMO], 1u); break; } }
    }
    nloc = mine > 0u ? mine : 1u; nx = cnt > 0u ? cnt : 1u;
}
__device__ __forceinline__ void xcd_barrier(const XcdBarrier& b, int wv) {
    asm volatile("s_waitcnt vmcnt(0)" ::: "memory");
    __syncthreads();
    if (otid(wv) == 0) {
        unsigned* bar = b.bar;
        __builtin_amdgcn_s_waitcnt(0);
        unsigned nloc = b.st[0], nx = b.st[1];
        if (nloc == 0u) { xcd_barrier_complete(bar, b.x, nloc, nx); b.st[0] = nloc; b.st[1] = nx; }
        const unsigned old = xb_add(&bar[XB_XSUB(b.x)], 1u);
        const unsigned gen = old / nloc;
        if (old + 1u == (gen + 1u) * nloc) {
            __builtin_amdgcn_fence(__ATOMIC_RELEASE, "agent");
            asm volatile("s_waitcnt vmcnt(0)" ::: "memory");
            const unsigned og = xb_add(&bar[XB_TOP], 1u);
            const unsigned tg = og / nx;
            if (og + 1u == (tg + 1u) * nx) xb_add(&bar[XB_TOPGEN], 1u);
            else XB_SPIN(xb_ld(&bar[XB_TOPGEN]) == tg, bar);
            __builtin_amdgcn_fence(__ATOMIC_ACQUIRE, "agent");
            xb_add(&bar[XB_XGEN(b.x)], 1u);
            asm volatile("s_waitcnt vmcnt(0)" ::: "memory");
        } else {
            XB_SPIN(xb_ld(&bar[XB_XGEN(b.x)]) == gen, bar);
            __builtin_amdgcn_fence(__ATOMIC_ACQUIRE, "agent");
            asm volatile("s_waitcnt vmcnt(0)" ::: "memory");
        }
    }
    __syncthreads();
}

enum { ST_NORM = 0, ST_GEMM_BF16, ST_GEMM_F32, ST_GEMM_RESID, ST_LATNORM, ST_HN_MLA, ST_HN_DS, ST_ATTN_MLA, ST_ATTN_D, ST_ATTN_S, ST_PEER };
#define SV(t, v) ((t) | ((v) << 4))
#define SR(t, v) ((t) | ((v) << 4) | 0x80)
__device__ const unsigned char STEPS[3][24] = {
  {SV(ST_NORM, 0), SV(ST_GEMM_BF16, 0), SV(ST_LATNORM, 0), SV(ST_GEMM_BF16, 1), SV(ST_GEMM_BF16, 2), SV(ST_HN_MLA, 0), SV(ST_ATTN_MLA, 0), SV(ST_GEMM_RESID, 0), SV(ST_NORM, 1), SV(ST_GEMM_F32, 0), SV(ST_PEER, 0), 0xFF},
  {SV(ST_NORM, 0), SV(ST_GEMM_BF16, 0), SV(ST_HN_DS, 0), SV(ST_ATTN_D, 0), SV(ST_GEMM_RESID, 0), SV(ST_NORM, 1), SV(ST_GEMM_F32, 0), SV(ST_PEER, 0), 0xFF},
  {SV(ST_NORM, 0), SV(ST_GEMM_BF16, 0), SV(ST_HN_DS, 0), SV(ST_ATTN_S, 0), SV(ST_GEMM_RESID, 0), SV(ST_NORM, 1), SV(ST_GEMM_F32, 0), SV(ST_PEER, 0), 0xFF}};
__global__ void __launch_bounds__(NTHREADS, 2) mega(Params p) {
  extern __shared__ __attribute__((aligned(16))) unsigned char lds_raw[];
  LAS unsigned char* lds = (LAS unsigned char*)lds_raw;
  cg::grid_group grid = cg::this_grid();
  const int tid = threadIdx.x;
  const int wv_s = __builtin_amdgcn_readfirstlane(tid >> 6);
  unsigned char* ws = p.ws;
  float* modp = (float*)(ws + WS_MODP); float* mod = (float*)(ws + WS_MOD);
  float* tab8 = (float*)(ws + WS_TAB); float* tab16 = tab8 + 64 * 8 * 2; float* lamp = tab16 + 64 * 16 * 2;
  bf16_t* xl = (bf16_t*)(ws + WS_XL); bf16_t* xc = (bf16_t*)(ws + WS_XC);
  bf16_t* wdown_t = (bf16_t*)(ws + WS_WDOWN); bf16_t* wuq_t = (bf16_t*)(ws + WS_WUQ); bf16_t* wukv_t = (bf16_t*)(ws + WS_WUKV); bf16_t* mwo_t = (bf16_t*)(ws + WS_MWO);
  bf16_t* dqkv_t = (bf16_t*)(ws + WS_DQKV); bf16_t* dwo_t = (bf16_t*)(ws + WS_DWO); bf16_t* sqkv_t = (bf16_t*)(ws + WS_SQKV); bf16_t* swo_t = (bf16_t*)(ws + WS_SWO);
  bf16_t* pwq = (bf16_t*)(ws + WS_PWQ); bf16_t* pkeys = (bf16_t*)(ws + WS_PKEYS); bf16_t* weff_t = (bf16_t*)(ws + WS_WEFF);
  unsigned char* pu = ws + WS_PU; unsigned char* pv = ws + WS_PV;
  bf16_t* Hb = (bf16_t*)(ws + WS_H); bf16_t* Ob = (bf16_t*)(ws + WS_O);
  bf16_t* B1 = (bf16_t*)(ws + WS_BUF1); bf16_t* B2 = (bf16_t*)(ws + WS_BUF2); bf16_t* B3 = (bf16_t*)(ws + WS_BUF3); bf16_t* B4 = (bf16_t*)(ws + WS_BUF4);
  bf16_t* CQN = (bf16_t*)(ws + WS_CQN); bf16_t* CKVN = (bf16_t*)(ws + WS_CKVN); float* SC = (float*)(ws + WS_SC);

  volatile LAS unsigned* xb_st = (volatile LAS unsigned*)(lds + LDS_BYTES - 16);
  if (tid < 4) xb_st[tid] = 0u;
  __syncthreads();
  (void)xcd_barrier_post((unsigned*)ws, xb_st);
  int phc = 0;
#define PH_BEGIN {
#define PH_END } ++phc; if (phc == 1) grid.sync(); else { XcdBarrier xb_; xb_.bar = (unsigned*)p.ws; xb_.x = xb_xcc_id(); xb_.st = (volatile LAS unsigned*)(lds + LDS_BYTES - 16); xcd_barrier(xb_, wv_s); }

  PH_BEGIN
    int rot = 0;
    for (int j = 0; j < 2; ++j) {
      tr_job<true>(lds, p.mla_w_down + (size_t)j * 1024 * 1056, (unsigned char*)wdown_t + (size_t)j * 1280 * 1024, 1024, 1056, 1280, rot);
      tr_job<true>(lds, p.mla_w_uq + (size_t)j * 768 * 1536, (unsigned char*)wuq_t + (size_t)j * 1536 * 768, 768, 1536, 1536, rot);
      tr_job<false>(lds, p.mla_w_ukv + (size_t)j * 256 * 2048, wukv_t + (size_t)j * 2048 * 256, 256, 2048, 2048, rot);
      tr_job<true>(lds, p.mla_w_o + (size_t)j * 1024 * 1024, (unsigned char*)mwo_t + (size_t)j * 1024 * 1024, 1024, 1024, 1024, rot);
    }
    tr_job<true>(lds, p.diff_w_qkv, dqkv_t, 1024, 3072, 3072, rot);
    tr_job<true>(lds, p.diff_w_o, dwo_t, 1024, 1024, 1024, rot);
    tr_job<true>(lds, p.swa_w_qkv, sqkv_t, 1024, 1536, 1536, rot);
    tr_job<true>(lds, p.swa_w_o, swo_t, 1024, 1024, 1024, rot);
    ada_job(lds, p, modp);
    cvt_job(p.peer_w_q, pwq, (size_t)4 * 1024 * 2048 / 8);
    cvt_job(p.peer_keys, pkeys, (size_t)4 * 16 * 128 * 128 / 8);
    {
      const int wv = tid >> 6, ln = tid & 63, l = wv >> 1; const float* t = ((wv & 1) ? p.peer_v : p.peer_u) + (size_t)l * 16384 * 1024;
      float ss = 0.f;
#pragma unroll
      for (int q = 0; q < 8; ++q) { const f32x4 v = ((const f32x4*)t)[ln + 64 * q]; ss += v.x * v.x + v.y * v.y + v.z * v.z + v.w * v.w; }
      ss = wave_sum(ss);
      const float rms = sqrtf(ss * (1.f / 2048.f));
      if (blockIdx.x == 0 && ln == 0) lamp[4 + wv] = (wv & 1) ? rms * 0.5f : rms * 0.34f;
    }
    if (blockIdx.x == 0 && tid == 0) {
      const float** t = (const float**)(ws + WS_PTRS);
      t[0] = p.x; t[1] = p.c; t[2] = p.ctx; t[3] = p.c_ctx; t[4] = p.ada_w; t[5] = p.ada_b; t[6] = p.norm_mix; t[7] = p.norm_ffn;
      t[8] = p.mla_w_down; t[9] = p.mla_g_cq; t[10] = p.mla_g_ckv; t[11] = p.mla_w_uq; t[12] = p.mla_w_ukv; t[13] = p.mla_g_q; t[14] = p.mla_g_k; t[15] = p.mla_w_o;
      t[16] = p.diff_w_qkv; t[17] = p.diff_g_q; t[18] = p.diff_g_k; t[19] = p.diff_lambda; t[20] = p.diff_g_sub; t[21] = p.diff_w_o;
      t[22] = p.swa_w_qkv; t[23] = p.swa_g_q; t[24] = p.swa_g_k; t[25] = p.swa_sink; t[26] = p.swa_w_o; t[27] = p.peer_w_q; t[28] = p.peer_keys; t[29] = p.peer_u; t[30] = p.peer_v;
    }
    if (blockIdx.x == gridDim.x - 1) {
      for (int i = tid; i < 64 * 8; i += NTHREADS) { const int pos = i >> 3, j = i & 7; const float ang = (float)pos * powf(10000.f, -(float)j / 8.f); tab8[2 * i] = cosf(ang); tab8[2 * i + 1] = sinf(ang); }
      for (int i = tid; i < 64 * 16; i += NTHREADS) { const int pos = i >> 4, j = i & 15; const float ang = (float)pos * powf(10000.f, -(float)j / 16.f); tab16[2 * i] = cosf(ang); tab16[2 * i + 1] = sinf(ang); }
      if (tid >= 64 && tid < 68) {
        const int q = tid - 64; const float* g = (q < 2) ? p.mla_g_k + q * 96 : (q == 2) ? p.diff_g_k : p.swa_g_k; const int n = (q < 2) ? 96 : 64;
        float mx = 0.f; for (int i = 0; i < n; ++i) mx = fmaxf(mx, fabsf(g[i]));
        lamp[12 + q] = sqrtf((float)n) * mx * 1.002f;
      }
      if (tid == 0) { float s01 = 0.f, s23 = 0.f; for (int i = 0; i < 64; ++i) { s01 += p.diff_lambda[i] * p.diff_lambda[64 + i]; s23 += p.diff_lambda[128 + i] * p.diff_lambda[192 + i]; }
        lamp[0] = expf(s01) - expf(s23) + LAM_INIT; }
    }
  PH_END
  PH_BEGIN
    for (int i = blockIdx.x * NTHREADS + tid; i < 4 * 9 * 6144; i += gridDim.x * NTHREADS) {
      const int col = i % 6144, l = i / (9 * 6144); float a = p.ada_b[l * 6144 + col];
#pragma unroll
      for (int kc = 0; kc < 64; ++kc) a += modp[(size_t)kc * (4 * 9 * 6144) + i];
      mod[i] = a;
    }
    for (int U = blockIdx.x; U < 256; U += gridDim.x) {
      const int q = U >> 2, l = q >> 4, hc = q & 15;
      gemm_phase(lds, pwq + (size_t)l * 1024 * 2048 + hc * 128, 2048, pkeys + (size_t)q * 128 * 128, 128, 1024, 128, 128, false,
                 EpiBf16T{weff_t + (size_t)l * 2048 * 1024 + (size_t)hc * 128 * 1024, 1024}, U & 3, 4);
    }
  PH_END

  for (int l = 0; l < 4; ++l) {
    int kind = l % 3; asm volatile("" : "+s"(kind));
    const bool last = (l == 3);
    for (int ss = 0; STEPS[kind][ss] != 0xFF; ++ss) {
      unsigned long long w_ = (unsigned long long)p.ws; asm volatile("" : "+s"(w_));
      unsigned char* w = (unsigned char*)(GAS unsigned char*)w_;
      const unsigned long long* tab = (const unsigned long long*)(w + WS_PTRS);
#define IN_(i) ((const float*)(GAS const float*)tab[i])
      bf16_t* xl = (bf16_t*)(w + WS_XL); bf16_t* xc = (bf16_t*)(w + WS_XC);
      const float* modl = (const float*)(w + WS_MOD) + (size_t)l * 9 * 6144;
      const float* tab8 = (const float*)(w + WS_TAB); const float* tab16 = tab8 + 64 * 8 * 2; const float* lamp = tab16 + 64 * 16 * 2;
      unsigned char* Hb = w + WS_H; unsigned char* Ob = w + WS_O; float* SC = (float*)(w + WS_SC);
      unsigned char* H8 = w + WS_O + 18 * MiB;
      bf16_t* LAT = (bf16_t*)(w + WS_BUF1); bf16_t* QP = (bf16_t*)(w + WS_BUF2); bf16_t* KV = (bf16_t*)(w + WS_BUF3); bf16_t* KB = (bf16_t*)(w + WS_BUF4); bf16_t* QKV = LAT;
      unsigned char* CQN = w + WS_CQN; bf16_t* CKVN = (bf16_t*)(w + WS_CKVN);
      bf16_t* QN = (bf16_t*)(w + WS_SC);
      const int ent = STEPS[kind][ss]; const int ty = ent & 15, var = (ent >> 4) & 7; const bool live = (ent & 0x80) == 0 || (p.phase == 777);
      int lo_ = l; asm volatile("" : "+s"(lo_)); const int j = (lo_ >= 3) ? 1 : 0;
      bool sync = true;
      if (ty == ST_NORM) {
        const bool first = (var == 0);
        if (first && l > 0) sync = false;
        else norm_phase(IN_(0), IN_(2), xl, xc, first && l == 0, (first ? IN_(6) : IN_(7)) + l * D, modl, first ? 0 : 3, first ? H8 : Hb, first, last && !first, wv_s);
      } else if (ty == ST_GEMM_BF16) {
        const void* A = H8; const void* Bt; bf16_t* O; int N, K = 1024;
        if (kind == 0) {
          if (var == 0) { Bt = w + WS_WDOWN + (size_t)j * 1280 * 1024; N = 1280; O = LAT; }
          else if (var == 1) { A = CQN; Bt = w + WS_WUQ + (size_t)j * 1536 * 768; N = 1536; K = 768; O = QP; sync = false; }
          else { A = CKVN; Bt = (const bf16_t*)(w + WS_WUKV) + (size_t)j * 2048 * 256; N = 2048; K = 256; O = KV; }
        } else if (kind == 1) { Bt = w + WS_DQKV; N = 3072; O = QKV; }
        else { Bt = w + WS_SQKV; N = 1536; O = QKV; }
        pg8::LatentOrder S; S.init(M, N, gridDim.x, blockIdx.x, last && kind == 0 && var == 1);
        if (kind == 0 && var == 2) pg8::gemm_phase<pg8::EpiBf16P, pg8::LatentOrder, true, true, false>(lds, pg8::Gemm{(const bf16_t*)A, (const bf16_t*)Bt, M, N, K}, S, pg8::EpiBf16P{O, N, 1.f}, wv_s);
        else pg8::gemm_phase<pg8::EpiBf16P, pg8::LatentOrder, true, true, true>(lds, pg8::Gemm{(const bf16_t*)A, (const bf16_t*)Bt, M, N, K / 2}, S, pg8::EpiBf16P{O, N, 1.f / (ASC * WSC)}, wv_s);

        {
          const int nwg_ = (false ? (M / 9) * 8 / 256 : M / 256) * (N / 256), rem_ = nwg_ % (int)gridDim.x;
          if ((rem_ == 0 || (int)blockIdx.x >= rem_) && ((var == 0) ? 0 : -1) >= 0) {
            const int E_ = (rem_ == 0) ? (int)gridDim.x : (int)gridDim.x - rem_, e_ = (rem_ == 0) ? (int)blockIdx.x : (int)blockIdx.x - rem_;
            const int s0_ = (((var == 0) ? 0 : -1) == 0) ? 0 : (((var == 0) ? 0 : -1) == 1) ? 9600 : 21000, s1_ = (((var == 0) ? 0 : -1) == 0) ? 9600 : (((var == 0) ? 0 : -1) == 1) ? 21000 : 32768;
            const int per_ = (s1_ - s0_ + E_ - 1) / E_, a_ = s0_ + e_ * per_, b_ = min(s1_, a_ + per_);
            const float su_ = 1.f / lamp[4 + 2 * l], sv_ = 1.f / lamp[5 + 2 * l];
            conv_rows(IN_(29) + (size_t)l * 16384 * 1024, IN_(30) + (size_t)l * 16384 * 1024, w + WS_PU + (size_t)l * 16384 * 512, w + WS_PV + (size_t)l * 16384 * 512, su_, sv_, a_, b_, otid(wv_s));
          }
        }
      } else if (ty == ST_GEMM_RESID) {
        const unsigned char* Bt = (kind == 0) ? w + WS_MWO + (size_t)j * 1024 * 1024 : (kind == 1) ? w + WS_DWO : w + WS_SWO;
        pg8::LatentOrder S; S.init(M, 1024, gridDim.x, blockIdx.x, last);
        pg8::gemm_phase<pg8::EpiResidN, pg8::LatentOrder, true, true, true>(lds, pg8::Gemm{(const bf16_t*)Ob, (const bf16_t*)Bt, M, 1024, 512}, S, pg8::EpiResidN{IN_(0), IN_(2), l == 0, xl, xc, modl, 2, live, 1.f / (OSC * WSC)}, wv_s);

        {
          const int nwg_ = (last ? (M / 9) * 8 / 256 : M / 256) * (1024 / 256), rem_ = nwg_ % (int)gridDim.x;
          if ((rem_ == 0 || (int)blockIdx.x >= rem_) && 1 >= 0) {
            const int E_ = (rem_ == 0) ? (int)gridDim.x : (int)gridDim.x - rem_, e_ = (rem_ == 0) ? (int)blockIdx.x : (int)blockIdx.x - rem_;
            const int s0_ = (1 == 0) ? 0 : (1 == 1) ? 9600 : 21000, s1_ = (1 == 0) ? 9600 : (1 == 1) ? 21000 : 32768;
            const int per_ = (s1_ - s0_ + E_ - 1) / E_, a_ = s0_ + e_ * per_, b_ = min(s1_, a_ + per_);
            const float su_ = 1.f / lamp[4 + 2 * l], sv_ = 1.f / lamp[5 + 2 * l];
            conv_rows(IN_(29) + (size_t)l * 16384 * 1024, IN_(30) + (size_t)l * 16384 * 1024, w + WS_PU + (size_t)l * 16384 * 512, w + WS_PV + (size_t)l * 16384 * 512, su_, sv_, a_, b_, otid(wv_s));
          }
        }
      } else if (ty == ST_GEMM_F32) {
        pg8::LatentOrder S; S.init(M, 2048, gridDim.x, blockIdx.x, last);
        pg8::gemm_phase<pg8::EpiBf16P, pg8::LatentOrder, true, true, false>(lds, pg8::Gemm{(const bf16_t*)Hb, (const bf16_t*)(w + WS_WEFF) + (size_t)l * 2048 * 1024, M, 2048, 1024}, S, pg8::EpiBf16P{(bf16_t*)SC, 2048, 1.f}, wv_s);

        {
          const int nwg_ = (last ? (M / 9) * 8 / 256 : M / 256) * (2048 / 256), rem_ = nwg_ % (int)gridDim.x;
          if ((rem_ == 0 || (int)blockIdx.x >= rem_) && 2 >= 0) {
            const int E_ = (rem_ == 0) ? (int)gridDim.x : (int)gridDim.x - rem_, e_ = (rem_ == 0) ? (int)blockIdx.x : (int)blockIdx.x - rem_;
            const int s0_ = (2 == 0) ? 0 : (2 == 1) ? 9600 : 21000, s1_ = (2 == 0) ? 9600 : (2 == 1) ? 21000 : 32768;
            const int per_ = (s1_ - s0_ + E_ - 1) / E_, a_ = s0_ + e_ * per_, b_ = min(s1_, a_ + per_);
            const float su_ = 1.f / lamp[4 + 2 * l], sv_ = 1.f / lamp[5 + 2 * l];
            conv_rows(IN_(29) + (size_t)l * 16384 * 1024, IN_(30) + (size_t)l * 16384 * 1024, w + WS_PU + (size_t)l * 16384 * 512, w + WS_PV + (size_t)l * 16384 * 512, su_, sv_, a_, b_, otid(wv_s));
          }
        }
      } else if (ty == ST_LATNORM) {
        latnorm_phase(LAT, IN_(9) + j * 768, IN_(10) + j * 256, CQN, CKVN, wv_s);
      } else if (ty == ST_HN_MLA) {
        const float qs = 0.10206207261596577f * LOG2E;
        for (int gi = blockIdx.x * NTHREADS + otid(wv_s); gi < M * 32 * 4; gi += gridDim.x * NTHREADS) {
          const int i = gi >> 2, jl = gi & 3, r = i >> 5, it = i & 31, h = it & 15; const int b = r / TPB, s = r - b * TPB; const bool lat = s < SEQ;
          if (it < 16) { const bf16_t* q = QP + (size_t)r * 1536 + h * 96; headnorm96(q, q + 64, QN + (size_t)r * 1536 + h * 96, IN_(13) + j * 96, qs, lat, s >> 6, s & 63, tab8, jl); }
          else headnorm96(KV + (size_t)r * 2048 + h * 128, LAT + (size_t)r * 1280 + 1024, KB + (size_t)r * 1536 + h * 96, IN_(14) + j * 96, 1.f, lat, s >> 6, s & 63, tab8, jl);
        }
      } else if (ty == ST_HN_DS) {
        const float qs = 0.125f * LOG2E;
        const int ipr = (kind == 1) ? 32 : 20, pitch = (kind == 1) ? 3072 : 1536, npitch = (kind == 1) ? 2048 : 1280;
        const float* gq = (kind == 1) ? IN_(17) : IN_(23); const float* gk = (kind == 1) ? IN_(18) : IN_(24);
        for (int gi = blockIdx.x * NTHREADS + otid(wv_s); gi < M * ipr * 4; gi += gridDim.x * NTHREADS) {
          const int i = gi >> 2, jl = gi & 3; int r, it; if (kind == 1) { r = i >> 5; it = i & 31; } else { r = i / 20; it = i - r * 20; }
          const int b = r / TPB, s = r - b * TPB; const bool lat = s < SEQ;
          const bf16_t* q = QKV + (size_t)r * pitch + it * 64;
          headnorm64(q, QN + (size_t)r * npitch + it * 64, (it < 16) ? gq : gk, (it < 16) ? qs : 1.f, lat, s >> 6, s & 63, tab16, jl);
        }
      } else if (ty == ST_ATTN_MLA) {
        const int nu = last ? 1024 : 1152;
        for (int u = blockIdx.x; u < nu; u += gridDim.x) {
          int bh, q0, ta0; if (u < 1024) { const int x = u & 7, y = u >> 3; bh = ((y >> 3) << 3) + x; q0 = (y & 7) * 256; ta0 = 0; } else { bh = u - 1024; q0 = SEQ; ta0 = 32; }
          const int b = bh >> 4, h = bh & 15; const size_t rb = (size_t)b * TPB;
          attn_unit<96, 64, 1, false>(lds, QN + rb * 1536 + h * 96, 0, 1536, KB + rb * 1536 + h * 96, 0, 1536, KV + rb * 2048 + h * 128 + 64, 2048,
                                      q0, ta0, 36, 0, 0, false, 0.f, lamp[12 + j], Ob + rb * D + h * 64, D, 0.f, nullptr, wv_s);
        }
      } else if (ty == ST_ATTN_D) {
        const float lam = lamp[0];
        for (int u = blockIdx.x; u < 1152; u += gridDim.x) {
          int bh, q0, ta0; if (u < 1024) { const int x = u & 7, y = u >> 3; bh = ((y >> 4) << 3) + x; q0 = (y & 15) * 128; ta0 = 0; } else { bh = (u - 1024) >> 1; q0 = SEQ + ((u - 1024) & 1) * 128; ta0 = 32; }
          const int b = bh >> 3, h = bh & 7; const size_t rb = (size_t)b * TPB;
          attn_unit<64, 128, 2, false>(lds, QN + rb * 2048 + h * 128, 64, 2048, QN + rb * 2048 + 1024 + h * 128, 64, 2048, QKV + rb * 3072 + 2048 + h * 128, 3072,
                                       q0, ta0, 36, 0, 0, false, 0.f, lamp[14], Ob + rb * D + h * 128, D, lam, IN_(20), wv_s);
        }
      } else if (ty == ST_ATTN_S) {
        for (int u = blockIdx.x; u < 1152; u += gridDim.x) {
          int bh, q0, ta0, ta1; if (u < 1024) { const int x = u & 7, y = u >> 3; bh = ((y >> 3) << 3) + x; q0 = (y & 7) * 256; ta0 = max(0, q0 / 64 - 2); ta1 = min(32, q0 / 64 + 6); } else { bh = u - 1024; q0 = SEQ; ta0 = 0; ta1 = 0; }
          const int b = bh >> 4, h = bh & 15, kvh = h >> 2; const size_t rb = (size_t)b * TPB;
          attn_unit<64, 64, 1, true>(lds, QN + rb * 1280 + h * 64, 0, 1280, QN + rb * 1280 + 1024 + kvh * 64, 0, 1280, QKV + rb * 1536 + 1280 + kvh * 64, 1536,
                                     q0, ta0, ta1, 32, 36, true, IN_(25)[h] * LOG2E, lamp[15], Ob + rb * D + h * 64, D, 0.f, nullptr, wv_s);
        }
      } else {
        peer_phase(lds, (const bf16_t*)SC, Hb, w + WS_PU + (size_t)l * 16384 * 512, w + WS_PV + (size_t)l * 16384 * 512, lamp[4 + 2 * l], lamp[5 + 2 * l], modl, xl, xc, p.out, last, live, last ? nullptr : H8, IN_(6) + (l + 1) * D, modl + 9 * 6144, wv_s);
      }
#undef IN_
      if (sync) { XcdBarrier xb_; xb_.bar = (unsigned*)p.ws; xb_.x = xb_xcc_id(); xb_.st = (volatile LAS unsigned*)(lds + LDS_BYTES - 16); xcd_barrier(xb_, wv_s); }
    }
  }
#undef PH_BEGIN
#undef PH_END
}

extern "C" void kernel_launch(void* const* d_in, const int* in_sizes, int n_in, void* d_out, int out_size, void* d_ws, size_t ws_size, hipStream_t stream) {
  static int grid_blocks = 0;
  if (grid_blocks == 0) {
    int dev = 0, cus = 0, per_cu = 0;
    if (n_in != 31 || out_size != NB * SEQ * D || ws_size < WS_TOTAL) { fprintf(stderr, "kernel_launch: unexpected shapes (n_in %d out %d ws %zu)\n", n_in, out_size, ws_size); grid_blocks = -1; return; }
    (void)hipGetDevice(&dev);
    (void)hipDeviceGetAttribute(&cus, hipDeviceAttributeMultiprocessorCount, dev);
    (void)hipFuncSetAttribute((const void*)mega, hipFuncAttributeMaxDynamicSharedMemorySize, LDS_BYTES);
    (void)hipOccupancyMaxActiveBlocksPerMultiprocessor(&per_cu, (const void*)mega, NTHREADS, LDS_BYTES);
    if (per_cu < 1) { fprintf(stderr, "kernel_launch: occupancy query says %d blocks/CU\n", per_cu); per_cu = 1; }
    grid_blocks = cus;
  }
  if (grid_blocks < 0) return;
  (void)hipMemsetAsync(d_ws, 0, 16384, stream);
  Params p{};
  const float** f = (const float**)&p;
  for (int i = 0; i < 31; ++i) f[i] = (const float*)d_in[i];
  p.out = (float*)d_out; p.ws = (unsigned char*)d_ws;
  p.single = 1; p.phase = 0;
  void* args[] = {&p};
  hipError_t e = hipLaunchCooperativeKernel((const void*)mega, dim3(grid_blocks), dim3(NTHREADS), args, LDS_BYTES, stream);
  if (e != hipSuccess) fprintf(stderr, "cooperative launch failed: %s (grid %d)\n", hipGetErrorString(e), grid_blocks);
}
```

```cpp
#include <hip/hip_runtime.h>
#include <hip/hip_cooperative_groups.h>
#include <cstdio>
#include <cstdint>
namespace cg = cooperative_groups;

#define LAS __attribute__((address_space(3)))
#define GAS __attribute__((address_space(1)))
typedef unsigned short bf16_t;
typedef short bf16x8 __attribute__((ext_vector_type(8)));
typedef short v4i16_t __attribute__((ext_vector_type(4)));
typedef float f32x4 __attribute__((ext_vector_type(4)));
typedef float f32x16 __attribute__((ext_vector_type(16)));
typedef unsigned u32x4 __attribute__((ext_vector_type(4)));
typedef unsigned u32x2 __attribute__((ext_vector_type(2)));
typedef long long2_t __attribute__((ext_vector_type(2)));
typedef float f32x2_t __attribute__((ext_vector_type(2)));
typedef __bf16 bf16x2_t __attribute__((ext_vector_type(2)));

constexpr int D = 1024, NB = 8, SEQ = 2048, NCTX = 256, TPB = SEQ + NCTX  , M = NB * TPB  ;
constexpr int NTHREADS = 512, NWAVES = 8;
constexpr float EPS = 1e-6f;
constexpr float LOG2E = 1.4426950408889634f;
constexpr float LAM_INIT = 0.35550907f;
constexpr float ASC = 8.f, WSC = 64.f, OSC = 64.f;
constexpr size_t MiB = 1u << 20;
constexpr size_t WS_PTRS = 32768;
constexpr size_t WS_MODP = 352 * MiB  , WS_MOD = 8 * MiB, WS_TAB = 9 * MiB, WS_XC = 10 * MiB;
constexpr size_t WS_WDOWN = 18 * MiB, WS_WUQ = 23 * MiB, WS_WUKV = 28 * MiB, WS_MWO = 30 * MiB, WS_DQKV = 34 * MiB, WS_DWO = 40 * MiB;
constexpr size_t WS_SQKV = 42 * MiB, WS_SWO = 45 * MiB, WS_PWQ = 47 * MiB, WS_PKEYS = 63 * MiB, WS_WEFF = 65 * MiB;
constexpr size_t WS_PU = 96 * MiB, WS_PV = 224 * MiB, WS_H = 352 * MiB, WS_O = 388 * MiB, WS_BUF1 = 424 * MiB, WS_BUF2 = 532 * MiB;
constexpr size_t WS_BUF3 = 586 * MiB, WS_BUF4 = 658 * MiB, WS_CQN = 712 * MiB, WS_CKVN = 739 * MiB, WS_SC = 748 * MiB, WS_END = 892 * MiB;
constexpr size_t WS_XL = 896 * MiB, WS_TOTAL = 928 * MiB;
constexpr int LDS_BYTES = 147456;


struct Params {
  const float *x, *c, *ctx, *c_ctx, *ada_w, *ada_b, *norm_mix, *norm_ffn;
  const float *mla_w_down, *mla_g_cq, *mla_g_ckv, *mla_w_uq, *mla_w_ukv, *mla_g_q, *mla_g_k, *mla_w_o;
  const float *diff_w_qkv, *diff_g_q, *diff_g_k, *diff_lambda, *diff_g_sub, *diff_w_o;
  const float *swa_w_qkv, *swa_g_q, *swa_g_k, *swa_sink, *swa_w_o;
  const float *peer_w_q, *peer_keys, *peer_u, *peer_v;
  float* out; unsigned char* ws;
  int single, phase;
};

__device__ __forceinline__ int opaque_tid() { int t = threadIdx.x; asm volatile("" : "+v"(t)); return t; }
__device__ __forceinline__ int otid(int wv) { int w = wv; asm volatile("" : "+s"(w)); unsigned m = ~0u; asm volatile("" : "+s"(m)); const int l = (int)__builtin_amdgcn_mbcnt_hi(m, __builtin_amdgcn_mbcnt_lo(m, 0u)); return (w << 6) | l; }
__device__ __forceinline__ unsigned pk2(float lo, float hi) { f32x2_t v = {lo, hi}; bf16x2_t b = __builtin_convertvector(v, bf16x2_t); return __builtin_bit_cast(unsigned, b); }
__device__ __forceinline__ unsigned pk4_fp8(float a, float b, float c, float d) { int w = 0; w = __builtin_amdgcn_cvt_pk_fp8_f32(a, b, w, false); w = __builtin_amdgcn_cvt_pk_fp8_f32(c, d, w, true); return (unsigned)w; }
__device__ __forceinline__ float bf_lo(unsigned u) { return __uint_as_float(u << 16); }
__device__ __forceinline__ float bf_hi(unsigned u) { return __uint_as_float(u & 0xffff0000u); }
__device__ __forceinline__ float wave_sum(float v) {
#pragma unroll
  for (int o = 32; o >= 1; o >>= 1) v += __shfl_xor(v, o);
  return v;
}
__device__ __forceinline__ float dot2bf(unsigned a, unsigned b, float c) { return __builtin_amdgcn_fdot2_f32_bf16(__builtin_bit_cast(bf16x2_t, a), __builtin_bit_cast(bf16x2_t, b), c, false); }
__device__ __forceinline__ int crow(int r, int hi) { return (r & 3) + 8 * (r >> 2) + 4 * hi; }
__device__ __forceinline__ unsigned f2ord(float f) { unsigned u = __float_as_uint(f); return (u & 0x80000000u) ? ~u : (u | 0x80000000u); }
__device__ __forceinline__ float ord2f(unsigned o) { return __uint_as_float((o & 0x80000000u) ? (o & 0x7fffffffu) : ~o); }
__device__ __forceinline__ bf16_t* xrow_ptr(bf16_t* xl, bf16_t* xc, int r) {
  const int b = r / TPB, s = r - b * TPB;
  return (s < SEQ) ? xl + (size_t)(b * SEQ + s) * D : xc + (size_t)(b * NCTX + (s - SEQ)) * D;
}
__device__ __forceinline__ const float* xsrc_ptr(const float* sl, const float* sc, int r) {
  const int b = r / TPB, s = r - b * TPB;
  return (s < SEQ) ? sl + (size_t)(b * SEQ + s) * D : sc + (size_t)(b * NCTX + (s - SEQ)) * D;
}
template <bool F8>
__device__ __forceinline__ void tr_job(LAS unsigned char* lds, const float* __restrict__ W, void* __restrict__ Wt_, int K, int N, int Npad, int& rot) {
  LAS float* tile = (LAS float*)lds;
  const int nnb = Npad / 64, nit = (K / 64) * nnb, tid = opaque_tid();
  const int vb = ((int)blockIdx.x - rot % (int)gridDim.x + (int)gridDim.x) % (int)gridDim.x;
  rot += (nit + 3) / 4;
  for (int it0 = vb * 4; it0 < nit; it0 += gridDim.x * 4) {
    f32x4 v[4][2];
#pragma unroll
    for (int q = 0; q < 4; ++q) {
      const int it = it0 + q, kb = it / nnb, nb = it - kb * nnb, k0 = kb * 64, n0 = nb * 64;
#pragma unroll
      for (int i = 0; i < 2; ++i) {
        const int idx = tid + i * 512, kk = idx >> 4, nc = (idx & 15) * 4;
        v[q][i] = (f32x4){0.f, 0.f, 0.f, 0.f};
        if (it < nit && n0 + nc < N) v[q][i] = *(const f32x4*)(W + (size_t)(k0 + kk) * N + n0 + nc);
      }
    }
#pragma unroll
    for (int q = 0; q < 4; ++q)
#pragma unroll
      for (int i = 0; i < 2; ++i) {
        const int idx = tid + i * 512, kk = idx >> 4, nc = (idx & 15) * 4; LAS float* t = tile + q * (64 * 65) + kk * 65 + nc;
        t[0] = v[q][i].x; t[1] = v[q][i].y; t[2] = v[q][i].z; t[3] = v[q][i].w;
      }
    __syncthreads();
#pragma unroll
    for (int q = 0; q < 4; ++q) {
      const int it = it0 + q;
      if (it < nit) {
        const int kb = it / nnb, nb = it - kb * nnb, k0 = kb * 64, n0 = nb * 64;
        const int n = tid >> 3, kc = tid & 7;
        float f[8];
#pragma unroll
        for (int j = 0; j < 8; ++j) f[j] = tile[q * (64 * 65) + (kc * 8 + j) * 65 + n];
        if (F8) *(u32x2*)((unsigned char*)Wt_ + (size_t)(n0 + n) * K + k0 + kc * 8) = (u32x2){pk4_fp8(f[0] * WSC, f[1] * WSC, f[2] * WSC, f[3] * WSC), pk4_fp8(f[4] * WSC, f[5] * WSC, f[6] * WSC, f[7] * WSC)};
        else *(u32x4*)((bf16_t*)Wt_ + (size_t)(n0 + n) * K + k0 + kc * 8) = (u32x4){pk2(f[0], f[1]), pk2(f[2], f[3]), pk2(f[4], f[5]), pk2(f[6], f[7])};
      }
    }
    __syncthreads();
  }
}
__device__ __forceinline__ void cvt_job(const float* __restrict__ src, bf16_t* __restrict__ dst, size_t n8) {
  for (size_t i = (size_t)blockIdx.x * NTHREADS + threadIdx.x; i < n8; i += (size_t)gridDim.x * NTHREADS) {
    const f32x4 a = ((const f32x4*)src)[2 * i], b = ((const f32x4*)src)[2 * i + 1];
    ((u32x4*)dst)[i] = (u32x4){pk2(a.x, a.y), pk2(a.z, a.w), pk2(b.x, b.y), pk2(b.z, b.w)};
  }
}
__device__ __forceinline__ unsigned q4pack(f32x4 a, f32x4 b, float sc) {
  const float v[8] = {a.x, a.y, a.z, a.w, b.x, b.y, b.z, b.w}; unsigned w = 0u;
#pragma unroll
  for (int j = 0; j < 8; ++j) { int q = (int)rintf(v[j] * sc); q = min(7, max(-8, q)); w |= ((unsigned)q & 15u) << (4 * j); }
  return w;
}
__device__ __forceinline__ void conv_rows(const float* __restrict__ usrc, const float* __restrict__ vsrc, unsigned char* __restrict__ udst, unsigned char* __restrict__ vdst, float su, float sv, int r0, int r1, int tid) {
  for (int r = r0 + (tid >> 6); r < r1; r += NWAVES) {
    const bool isv = r >= 16384; const int rr = isv ? r - 16384 : r; const int c = (tid & 63);
    const f32x4* sp = (const f32x4*)((isv ? vsrc : usrc) + (size_t)rr * 1024) + c * 4;
    const f32x4 a = sp[0], b = sp[1], cc = sp[2], d = sp[3];
    u32x2 o;
    if (isv) {
      unsigned w0 = 0u, w1 = 0u;
      w0 = __builtin_amdgcn_cvt_scalef32_pk_fp4_f32(w0, a.x * sv, a.y * sv, 1.0f, 0); w0 = __builtin_amdgcn_cvt_scalef32_pk_fp4_f32(w0, a.z * sv, a.w * sv, 1.0f, 1);
      w0 = __builtin_amdgcn_cvt_scalef32_pk_fp4_f32(w0, b.x * sv, b.y * sv, 1.0f, 2); w0 = __builtin_amdgcn_cvt_scalef32_pk_fp4_f32(w0, b.z * sv, b.w * sv, 1.0f, 3);
      w1 = __builtin_amdgcn_cvt_scalef32_pk_fp4_f32(w1, cc.x * sv, cc.y * sv, 1.0f, 0); w1 = __builtin_amdgcn_cvt_scalef32_pk_fp4_f32(w1, cc.z * sv, cc.w * sv, 1.0f, 1);
      w1 = __builtin_amdgcn_cvt_scalef32_pk_fp4_f32(w1, d.x * sv, d.y * sv, 1.0f, 2); w1 = __builtin_amdgcn_cvt_scalef32_pk_fp4_f32(w1, d.z * sv, d.w * sv, 1.0f, 3);
      o = (u32x2){w0, w1};
    } else o = (u32x2){q4pack(a, b, su), q4pack(cc, d, su)};
    *(u32x2*)((isv ? vdst : udst) + (size_t)rr * 512 + c * 8) = o;
  }
}
__device__ __forceinline__ void ada_job(LAS unsigned char* lds, const Params& p, float* __restrict__ modp) {
  LAS float* s = (LAS float*)lds;
  const int tid = opaque_tid();
  for (int u = blockIdx.x; u < 768; u += gridDim.x) {
    const int l = u / 192, r = u - l * 192, cc = r >> 6, kc = r & 63;
    __syncthreads();
    if (tid < 144) { const int bi = tid >> 4, k = tid & 15; const float c = (bi < 8) ? p.c[bi * D + kc * 16 + k] : p.c_ctx[kc * 16 + k]; s[tid] = c / (1.f + __expf(-c)); }
    __syncthreads();
    f32x4 acc[9];
#pragma unroll
    for (int bi = 0; bi < 9; ++bi) acc[bi] = (f32x4){0.f, 0.f, 0.f, 0.f};
    const float* w = p.ada_w + ((size_t)l * D + kc * 16) * 6144 + cc * 2048 + tid * 4;
#pragma unroll
    for (int h = 0; h < 2; ++h) {
      f32x4 wv[8];
#pragma unroll
      for (int k = 0; k < 8; ++k) wv[k] = *(const f32x4*)(w + (size_t)(h * 8 + k) * 6144);
#pragma unroll
      for (int k = 0; k < 8; ++k)
#pragma unroll
        for (int bi = 0; bi < 9; ++bi) acc[bi] += s[bi * 16 + h * 8 + k] * wv[k];
    }
#pragma unroll
    for (int bi = 0; bi < 9; ++bi) *(f32x4*)(modp + (((size_t)kc * 4 + l) * 9 + bi) * 6144 + cc * 2048 + tid * 4) = acc[bi];
  }
}

__device__ __forceinline__ void norm_phase(const float* sl, const float* sc_, bf16_t* xl, bf16_t* xc, bool src_f32, const float* __restrict__ g, const float* __restrict__ modl, int which, unsigned char* __restrict__ H, bool out_f8, bool skip_ctx, int wv) {
  const int tid_ = otid(wv); const int lane = tid_ & 63, wid = tid_ >> 6;
  for (int r = blockIdx.x * NWAVES + wid; r < M; r += gridDim.x * NWAVES) {
    const int b = r / TPB, s = r - b * TPB; const bool isctx = s >= SEQ;
    if (skip_ctx && isctx) continue;
    const int bi = isctx ? 8 : b;
    const float* sh = modl + (size_t)(bi * 6 + which) * D; const float* sc = sh + D;
    f32x4 v[4]; float ss = 0.f;
    if (src_f32) {
      const float* xr = xsrc_ptr(sl, sc_, r);
#pragma unroll
      for (int j = 0; j < 4; ++j) v[j] = ((const f32x4*)xr)[lane + 64 * j];
    } else {
      const bf16_t* xr = xrow_ptr(xl, xc, r);
#pragma unroll
      for (int j = 0; j < 4; ++j) { const u32x2 w = ((const u32x2*)xr)[lane + 64 * j]; v[j] = (f32x4){bf_lo(w.x), bf_hi(w.x), bf_lo(w.y), bf_hi(w.y)}; }
    }
#pragma unroll
    for (int j = 0; j < 4; ++j) ss += v[j].x * v[j].x + v[j].y * v[j].y + v[j].z * v[j].z + v[j].w * v[j].w;
    ss = wave_sum(ss);
    const float rstd = rsqrtf(ss * (1.f / D) + EPS);
#pragma unroll
    for (int j = 0; j < 4; ++j) {
      const int c4 = lane + 64 * j;
      const f32x4 g4 = ((const f32x4*)g)[c4], s4 = ((const f32x4*)sc)[c4], h4 = ((const f32x4*)sh)[c4];
      const f32x4 y = v[j] * rstd * g4 * (1.f + s4) + h4;
      if (out_f8) *(unsigned*)(H + (size_t)r * D + c4 * 4) = pk4_fp8(y.x * ASC, y.y * ASC, y.z * ASC, y.w * ASC);
      else *(u32x2*)((bf16_t*)H + (size_t)r * D + c4 * 4) = (u32x2){pk2(y.x, y.y), pk2(y.z, y.w)};
    }
  }
}
__device__ __forceinline__ void latnorm_phase(const bf16_t* __restrict__ LAT, const float* __restrict__ gcq, const float* __restrict__ gckv, unsigned char* __restrict__ CQN, bf16_t* __restrict__ CKVN, int wv) {
  const int tid_ = otid(wv); const int lane = tid_ & 63, wid = tid_ >> 6;
  for (int r = blockIdx.x * NWAVES + wid; r < M; r += gridDim.x * NWAVES) {
    const bf16_t* lr = LAT + (size_t)r * 1280;
    float q[12], kv[4]; float sq = 0.f, sk = 0.f;
#pragma unroll
    for (int j = 0; j < 3; ++j) { const u32x2 w = *(const u32x2*)(lr + lane * 4 + 256 * j); q[4 * j] = bf_lo(w.x); q[4 * j + 1] = bf_hi(w.x); q[4 * j + 2] = bf_lo(w.y); q[4 * j + 3] = bf_hi(w.y); }
    { const u32x2 w = *(const u32x2*)(lr + 768 + lane * 4); kv[0] = bf_lo(w.x); kv[1] = bf_hi(w.x); kv[2] = bf_lo(w.y); kv[3] = bf_hi(w.y); }
#pragma unroll
    for (int j = 0; j < 12; ++j) sq += q[j] * q[j];
#pragma unroll
    for (int j = 0; j < 4; ++j) sk += kv[j] * kv[j];
    sq = wave_sum(sq); sk = wave_sum(sk);
    const float rq = rsqrtf(sq * (1.f / 768.f) + EPS), rk = rsqrtf(sk * (1.f / 256.f) + EPS);
#pragma unroll
    for (int j = 0; j < 3; ++j) { const int c = lane * 4 + 256 * j; const f32x4 g4 = *(const f32x4*)(gcq + c);
      *(unsigned*)(CQN + (size_t)r * 768 + c) = pk4_fp8(q[4 * j] * rq * g4.x * ASC, q[4 * j + 1] * rq * g4.y * ASC, q[4 * j + 2] * rq * g4.z * ASC, q[4 * j + 3] * rq * g4.w * ASC); }
    { const int c = lane * 4; const f32x4 g4 = *(const f32x4*)(gckv + c);
      *(u32x2*)(CKVN + (size_t)r * 256 + c) = (u32x2){pk2(kv[0] * rk * g4.x, kv[1] * rk * g4.y), pk2(kv[2] * rk * g4.z, kv[3] * rk * g4.w)}; }
  }
}

constexpr int G_AS = 144;
constexpr int G_ATILE = 256 * G_AS, G_BTILE = 128 * G_AS, G_STAGE = G_ATILE + G_BTILE;
struct EpiFp8T { unsigned char* C; int ldc;
  __device__ __forceinline__ void operator()(int row, int col, f32x4 v) const { const unsigned w = pk4_fp8(v.x * WSC, v.y * WSC, v.z * WSC, v.w * WSC);
    C[(size_t)(col + 0) * ldc + row] = (unsigned char)(w & 255u); C[(size_t)(col + 1) * ldc + row] = (unsigned char)((w >> 8) & 255u); C[(size_t)(col + 2) * ldc + row] = (unsigned char)((w >> 16) & 255u); C[(size_t)(col + 3) * ldc + row] = (unsigned char)(w >> 24); } };
struct EpiBf16T { bf16_t* C; int ldc;
  __device__ __forceinline__ void operator()(int row, int col, f32x4 v) const {
    C[(size_t)(col + 0) * ldc + row] = (bf16_t)(pk2(v.x, 0.f) & 0xffffu); C[(size_t)(col + 1) * ldc + row] = (bf16_t)(pk2(v.y, 0.f) & 0xffffu);
    C[(size_t)(col + 2) * ldc + row] = (bf16_t)(pk2(v.z, 0.f) & 0xffffu); C[(size_t)(col + 3) * ldc + row] = (bf16_t)(pk2(v.w, 0.f) & 0xffffu); } };
template <class Epi>
__device__ __forceinline__ void gemm_phase(LAS unsigned char* lds, const bf16_t* __restrict__ A, int lda, const bf16_t* __restrict__ Bt, int ldb,
                                           int Mrows, int N, int K, bool skip_ctx_tiles, const Epi epi, int ustart, int ustride) {
  const int tid = opaque_tid(), lane = tid & 63, wid = tid >> 6, wr = wid >> 1, wc = wid & 1, fr = lane & 15, fq = lane >> 4;
  const int nN = N / 128, nU = (Mrows / 256) * nN, nt = K / 64;
  const int lrow = tid >> 3, lkc = tid & 7;
  for (int u = ustart; u < nU; u += ustride) {
    const int pm = u / nN, pn = u - pm * nN;
    if (skip_ctx_tiles && (pm % 9) == 8) continue;
    const bf16_t* Ag = A + (size_t)(pm * 256 + lrow) * lda + lkc * 8;
    const bf16_t* Bg = Bt + (size_t)(pn * 128 + lrow) * ldb + lkc * 8;
    f32x4 acc[4][4];
#pragma unroll
    for (int m = 0; m < 4; ++m)
#pragma unroll
      for (int n = 0; n < 4; ++n) acc[m][n] = (f32x4){0.f, 0.f, 0.f, 0.f};
    u32x4 ra[4], rb[2];
#pragma unroll
    for (int i = 0; i < 4; ++i) ra[i] = *(const u32x4*)(Ag + (size_t)(64 * i) * lda);
#pragma unroll
    for (int i = 0; i < 2; ++i) rb[i] = *(const u32x4*)(Bg + (size_t)(64 * i) * ldb);
    {
      LAS unsigned char* sa = lds + lrow * G_AS + lkc * 16; LAS unsigned char* sb = lds + G_ATILE + lrow * G_AS + lkc * 16;
#pragma unroll
      for (int i = 0; i < 4; ++i) *(LAS u32x4*)(sa + i * 64 * G_AS) = ra[i];
#pragma unroll
      for (int i = 0; i < 2; ++i) *(LAS u32x4*)(sb + i * 64 * G_AS) = rb[i];
    }
    __syncthreads();
    for (int t = 0; t < nt; ++t) {
      const bool more = (t + 1 < nt);
      if (more) {
#pragma unroll
        for (int i = 0; i < 4; ++i) ra[i] = *(const u32x4*)(Ag + (size_t)(64 * i) * lda + (t + 1) * 64);
#pragma unroll
        for (int i = 0; i < 2; ++i) rb[i] = *(const u32x4*)(Bg + (size_t)(64 * i) * ldb + (t + 1) * 64);
      }
      const LAS unsigned char* st = lds + (t & 1) * G_STAGE;
      const LAS unsigned char* pa = st + (wr * 64 + fr) * G_AS + fq * 16;
      const LAS unsigned char* pb = st + G_ATILE + (wc * 64 + fr) * G_AS + fq * 16;
#pragma unroll
      for (int ks = 0; ks < 2; ++ks) {
        bf16x8 af[4], bfr[4];
#pragma unroll
        for (int m = 0; m < 4; ++m) af[m] = *(const LAS bf16x8*)(pa + m * 16 * G_AS + ks * 64);
#pragma unroll
        for (int n = 0; n < 4; ++n) bfr[n] = *(const LAS bf16x8*)(pb + n * 16 * G_AS + ks * 64);
#pragma unroll
        for (int m = 0; m < 4; ++m)
#pragma unroll
          for (int n = 0; n < 4; ++n) acc[m][n] = __builtin_amdgcn_mfma_f32_16x16x32_bf16(bfr[n], af[m], acc[m][n], 0, 0, 0);
      }
      if (more) {
        LAS unsigned char* sa = lds + ((t + 1) & 1) * G_STAGE + lrow * G_AS + lkc * 16; LAS unsigned char* sb = sa + G_ATILE;
#pragma unroll
        for (int i = 0; i < 4; ++i) *(LAS u32x4*)(sa + i * 64 * G_AS) = ra[i];
#pragma unroll
        for (int i = 0; i < 2; ++i) *(LAS u32x4*)(sb + i * 64 * G_AS) = rb[i];
      }
      __syncthreads();
    }
#pragma unroll
    for (int m = 0; m < 4; ++m)
#pragma unroll
      for (int n = 0; n < 4; ++n) epi(pm * 256 + wr * 64 + m * 16 + fr, pn * 128 + wc * 64 + n * 16 + fq * 4, acc[m][n]);
  }
}

namespace pg8 {
#define PG8_LAS __attribute__((address_space(3)))
typedef unsigned short bf16_t;
typedef short bf16x8 __attribute__((ext_vector_type(8)));
typedef float f32x4 __attribute__((ext_vector_type(4)));
typedef unsigned u32x4 __attribute__((ext_vector_type(4)));
constexpr int BM = 256, BK = 64, HALF = 128, HTB = HALF * BK * 2  , STAGE_BYTES = 8 * HTB, NXCD = 8, WGM = 8;

__host__ __device__ __forceinline__ int lds_byte(int r, int c) { const int st = (r >> 4) * 2 + (c >> 5), rr = r & 15, cc = c & 31, ob = rr * 64 + cc * 2; return st * 1024 + (ob ^ (((ob >> 9) & 1) << 5)); }
__host__ __device__ __forceinline__ void stage_rc(int b, int& R, int& C) { const int st = b / 1024, sb = b % 1024, swz = sb ^ (((sb >> 9) & 1) << 5); R = (st >> 1) * 16 + swz / 64; C = (st & 1) * 32 + (swz % 64) / 2; }
__host__ __device__ __forceinline__ int perm32(int rho) { const int n = rho >> 4, i = rho & 15; return 8 * (i >> 2) + 4 * n + (i & 3); }

struct Unit { int pm, pn; };
struct Gemm { const bf16_t* A; const bf16_t* Bt; int M, N, K; };

struct StaticOrder {
    int nM, nN, nwg, G, c;
    __host__ __device__ void init(int M, int N, int G_, int c_) { nM = M / BM; nN = N / BM; nwg = nM * nN; G = G_; c = c_; }
    __host__ __device__ bool next(int i, Unit& u) const {
        const long L = (long)i * G + c; if (L >= nwg) return false;
        int wgid = (int)L; { const int q = nwg / NXCD, r = nwg % NXCD, xcd = wgid % NXCD, off = wgid / NXCD; wgid = (xcd < r ? xcd * (q + 1) : r * (q + 1) + (xcd - r) * q) + off; }
        const int nig = WGM * nN, gid = wgid / nig, fm = gid * WGM, gsz = (nM - fm) < WGM ? (nM - fm) : WGM;
        u.pm = fm + ((wgid % nig) % gsz); u.pn = (wgid % nig) / gsz; return true;
    }
    __device__ __forceinline__ void a_ready(const Unit&) const {}
    __device__ __forceinline__ void done(const Unit&) const {}
};
struct LatentOrder {
    StaticOrder base; bool skip;
    __host__ __device__ void init(int M_, int N_, int G_, int c_, bool skip_) { skip = skip_; base.init(skip_ ? (M_ / 9) * 8 : M_, N_, G_, c_); }
    __host__ __device__ bool next(int i, Unit& u) const { if (!base.next(i, u)) return false; if (skip) u.pm += u.pm >> 3; return true; }
    __device__ __forceinline__ void a_ready(const Unit&) const {}
    __device__ __forceinline__ void done(const Unit&) const {}
};
struct EpiBf16P { static constexpr bool PERM = true, AFTER_DRAIN = false; bf16_t* O; int ldc; float sc;
  __device__ __forceinline__ void operator()(const f32x4 (&acc)[2][2][4][2], const Unit& u, int wr, int wc, int fr, int fq) const {
    const int row0 = u.pm * BM + wr * 64 + fr, col0 = u.pn * BM + wc * 32 + 8 * fq;
#pragma unroll
    for (int ai = 0; ai < 2; ++ai)
#pragma unroll
      for (int m = 0; m < 4; ++m) { bf16_t* rowp = O + (size_t)(row0 + ai * HALF + m * 16) * ldc + col0;
#pragma unroll
        for (int bj = 0; bj < 2; ++bj) { const f32x4 v0 = acc[ai][bj][m][0] * sc, v1 = acc[ai][bj][m][1] * sc;
          *(u32x4*)(rowp + bj * HALF) = (u32x4){pk2(v0[0], v0[1]), pk2(v0[2], v0[3]), pk2(v1[0], v1[1]), pk2(v1[2], v1[3])}; } }
  } };
struct EpiResidN { static constexpr bool PERM = false, AFTER_DRAIN = false; const float* sl; const float* sc; bool src_f32; bf16_t* xl; bf16_t* xc; const float* modl; int which; bool live; float osc;
  __device__ __forceinline__ void operator()(const f32x4 (&acc)[2][2][4][2], const Unit& u, int wr, int wc, int fr, int fq) const {
    if (!live) return;
    const int row0 = u.pm * BM + wr * 64 + fr, col0 = u.pn * BM + wc * 32 + 4 * fq;
    const int b = (u.pm * BM) / TPB, s0 = u.pm * BM - b * TPB; const int bi = (s0 >= SEQ) ? 8 : b;
    const float* gp = modl + (size_t)(bi * 6 + which) * D + col0;
#pragma unroll
    for (int bj = 0; bj < 2; ++bj)
#pragma unroll
      for (int n = 0; n < 2; ++n) { const f32x4 gt = *(const f32x4*)(gp + bj * HALF + n * 16) * osc;
#pragma unroll
        for (int ai = 0; ai < 2; ++ai)
#pragma unroll
          for (int m = 0; m < 4; ++m) { const int rr = row0 + ai * HALF + m * 16, cc = col0 + bj * HALF + n * 16;
            bf16_t* xp = xrow_ptr(xl, xc, rr) + cc; f32x4 xv;
            if (src_f32) xv = *(const f32x4*)(xsrc_ptr(sl, sc, rr) + cc);
            else { const u32x2 w = *(const u32x2*)xp; xv = (f32x4){bf_lo(w.x), bf_hi(w.x), bf_lo(w.y), bf_hi(w.y)}; }
            xv += gt * acc[ai][bj][m][n]; *(u32x2*)xp = (u32x2){pk2(xv.x, xv.y), pk2(xv.z, xv.w)}; } }
  } };
template <class Epi, class Sched, bool ALIGN_EPI = false, bool SP2 = false, bool FP8 = false>
__device__ __forceinline__ void gemm_phase(PG8_LAS unsigned char* lds, const Gemm g, const Sched& S, const Epi& E, int wv) {
    const int tid = otid(wv), wid = __builtin_amdgcn_readfirstlane(tid >> 6), lane = tid & 63, wr = wid >> 2, wc = wid & 3, fr = lane & 15, fq = lane >> 4;
    const int K = g.K, nt = K / BK;
    unsigned voffA[2], voffB[2];
#pragma unroll
    for (int i = 0; i < 2; ++i) { int R, C; stage_rc(tid * 16 + i * 8192, R, C); const int Rb = Epi::PERM ? ((R & ~31) + perm32(R & 31)) : R;
        voffA[i] = (unsigned)(R * K + C) * 2u; voffB[i] = (unsigned)(Rb * K + C) * 2u; }
    const size_t kstep = (size_t)(BK * 2);
    const size_t hstep = (size_t)HALF * K * 2;
    const size_t tstep = 2 * hstep;
    const unsigned ldsw = (unsigned)wid * 1024u;
    const int aoff = lds_byte(wr * 64 + fr, fq * 8), boff = lds_byte(wc * 32 + fr, fq * 8);
#define PG8_SA(b, h) (((b) * 2 + (h)) * HTB)
#define PG8_SB(b, h) ((4 + (b) * 2 + (h)) * HTB)
#define PG8_STAGE(bufoff, gbase, voff) do { _Pragma("unroll") for (int _i = 0; _i < 2; ++_i) \
        __builtin_amdgcn_global_load_lds((const unsigned*)((const char*)(gbase) + (voff)[_i]), (PG8_LAS unsigned*)(lds + (bufoff) + ldsw + _i * 8192), 16, 0, 0); } while (0)
#define PG8_LDA(dst, b, h) do { _Pragma("unroll") for (int m = 0; m < 4; ++m) _Pragma("unroll") for (int k = 0; k < 2; ++k) dst[m][k] = *(const PG8_LAS bf16x8*)(lds + PG8_SA(b, h) + aoff + m * 2048 + k * 1024); } while (0)
#define PG8_LDB(dst, b, h) do { _Pragma("unroll") for (int n = 0; n < 2; ++n) _Pragma("unroll") for (int k = 0; k < 2; ++k) dst[n][k] = *(const PG8_LAS bf16x8*)(lds + PG8_SB(b, h) + boff + n * 2048 + k * 1024); } while (0)
#define PG8_MMA(ai, bj, At, Bt) do { __builtin_amdgcn_s_setprio(1); _Pragma("unroll") for (int m = 0; m < 4; ++m) _Pragma("unroll") for (int n = 0; n < 2; ++n) _Pragma("unroll") for (int k = 0; k < 2; ++k) { \
        if constexpr (FP8) { const long2_t a2_ = __builtin_bit_cast(long2_t, At[m][k]), b2_ = __builtin_bit_cast(long2_t, Bt[n][k]); \
          acc[ai][bj][m][n] = __builtin_amdgcn_mfma_f32_16x16x32_fp8_fp8(b2_[0], a2_[0], acc[ai][bj][m][n], 0, 0, 0); \
          acc[ai][bj][m][n] = __builtin_amdgcn_mfma_f32_16x16x32_fp8_fp8(b2_[1], a2_[1], acc[ai][bj][m][n], 0, 0, 0); } \
        else acc[ai][bj][m][n] = __builtin_amdgcn_mfma_f32_16x16x32_bf16(Bt[n][k], At[m][k], acc[ai][bj][m][n], 0, 0, 0); } __builtin_amdgcn_s_setprio(0); } while (0)
#define PG8_WAIT_V(n) asm volatile("s_waitcnt vmcnt(" #n ")" ::: "memory")
#define PG8_WAIT_L(n) asm volatile("s_waitcnt lgkmcnt(" #n ")" ::: "memory")
#define PG8_BAR __builtin_amdgcn_s_barrier()
#define PG8_SCHED __builtin_amdgcn_sched_barrier(0)
    Unit cur, nxt; int ui = 0;
    if (!S.next(0, cur)) return;
    f32x4 acc[2][2][4][2];
#pragma unroll
    for (int a = 0; a < 2; ++a)
#pragma unroll
        for (int b = 0; b < 2; ++b)
#pragma unroll
            for (int m = 0; m < 4; ++m)
#pragma unroll
                for (int n = 0; n < 2; ++n) acc[a][b][m][n] = (f32x4){0.f, 0.f, 0.f, 0.f};
    bf16x8 At[4][2], B0[2][2], B1[2][2];
    const char* cA = (const char*)g.A + (size_t)cur.pm * tstep; const char* cB = (const char*)g.Bt + (size_t)cur.pn * tstep;
    S.a_ready(cur);
    if constexpr (SP2) {
        PG8_STAGE(PG8_SB(0, 0), cB, voffB); PG8_STAGE(PG8_SB(0, 1), cB + hstep, voffB); PG8_STAGE(PG8_SA(0, 0), cA, voffA); PG8_STAGE(PG8_SA(0, 1), cA + hstep, voffA);
        if (wr == 1) PG8_BAR;
        PG8_WAIT_V(2); PG8_BAR;
        PG8_STAGE(PG8_SB(1, 0), cB + kstep, voffB); PG8_STAGE(PG8_SA(1, 0), cA + kstep, voffA); PG8_STAGE(PG8_SB(1, 1), cB + hstep + kstep, voffB);
        PG8_WAIT_V(6); PG8_BAR;
    } else {
        PG8_STAGE(PG8_SB(0, 0), cB, voffB); PG8_STAGE(PG8_SA(0, 0), cA, voffA); PG8_STAGE(PG8_SB(0, 1), cB + hstep, voffB); PG8_STAGE(PG8_SA(0, 1), cA + hstep, voffA);
        if (wr == 1) PG8_BAR;
        PG8_WAIT_V(4); PG8_BAR;
        PG8_STAGE(PG8_SB(1, 0), cB + kstep, voffB); PG8_STAGE(PG8_SA(1, 0), cA + kstep, voffA); PG8_STAGE(PG8_SB(1, 1), cB + hstep + kstep, voffB);
        PG8_WAIT_V(6); PG8_BAR;
    }
    for (;;) {
        const bool has_next = S.next(ui + 1, nxt);
        const char* nA = has_next ? (const char*)g.A + (size_t)nxt.pm * tstep : cA; const char* nB = has_next ? (const char*)g.Bt + (size_t)nxt.pn * tstep : cB;
        for (int t = 0; t < nt; t += 2) {
            const bool last = (t == nt - 2);
            const char* a1 = cA + (size_t)(t + 1) * kstep;
            const char* a2 = last ? nA : cA + (size_t)(t + 2) * kstep; const char* b2 = last ? nB : cB + (size_t)(t + 2) * kstep;
            const char* a3 = a2 + kstep; const char* b3 = b2 + kstep;
            if (last && has_next) S.a_ready(nxt);
            if constexpr (SP2) {
            PG8_LDB(B0, 0, 0); PG8_LDB(B1, 0, 1); PG8_SCHED; PG8_LDA(At, 0, 0); PG8_STAGE(PG8_SA(1, 1), a1 + hstep, voffA);
            PG8_WAIT_V(8); PG8_WAIT_L(0); PG8_BAR; PG8_MMA(0, 0, At, B0); PG8_MMA(0, 1, At, B1); PG8_BAR; PG8_SCHED;
            PG8_LDA(At, 0, 1); PG8_STAGE(PG8_SB(0, 0), b2, voffB); PG8_STAGE(PG8_SB(0, 1), b2 + hstep, voffB); PG8_STAGE(PG8_SA(0, 0), a2, voffA);
            PG8_WAIT_V(8); PG8_WAIT_L(0); PG8_BAR; PG8_MMA(1, 0, At, B0); PG8_MMA(1, 1, At, B1); PG8_BAR; PG8_SCHED;
            PG8_LDB(B0, 1, 0); PG8_LDB(B1, 1, 1); PG8_SCHED; PG8_LDA(At, 1, 0); PG8_STAGE(PG8_SA(0, 1), a2 + hstep, voffA);
            PG8_WAIT_V(8); PG8_WAIT_L(0); PG8_BAR; PG8_MMA(0, 0, At, B0); PG8_MMA(0, 1, At, B1); PG8_BAR; PG8_SCHED;
            PG8_LDA(At, 1, 1); PG8_STAGE(PG8_SB(1, 0), b3, voffB); PG8_STAGE(PG8_SB(1, 1), b3 + hstep, voffB); PG8_STAGE(PG8_SA(1, 0), a3, voffA);
            PG8_WAIT_V(8); PG8_WAIT_L(0); PG8_BAR; PG8_MMA(1, 0, At, B0); PG8_MMA(1, 1, At, B1); PG8_BAR; PG8_SCHED;
            } else {
            PG8_LDB(B0, 0, 0); PG8_SCHED; PG8_LDA(At, 0, 0); PG8_STAGE(PG8_SA(1, 1), a1 + hstep, voffA);
            PG8_WAIT_L(8); PG8_BAR; PG8_WAIT_L(0); PG8_MMA(0, 0, At, B0); PG8_BAR; PG8_SCHED;
            PG8_LDB(B1, 0, 1); PG8_STAGE(PG8_SB(0, 0), b2, voffB);
            PG8_BAR; PG8_WAIT_L(0); PG8_MMA(0, 1, At, B1); PG8_BAR;
            PG8_LDA(At, 0, 1); PG8_STAGE(PG8_SA(0, 0), a2, voffA);
            PG8_BAR; PG8_WAIT_L(0); PG8_MMA(1, 0, At, B0); PG8_BAR; PG8_SCHED;
            PG8_STAGE(PG8_SB(0, 1), b2 + hstep, voffB);
            PG8_WAIT_V(6); PG8_BAR; PG8_MMA(1, 1, At, B1); PG8_BAR;
            PG8_LDB(B0, 1, 0); PG8_SCHED; PG8_LDA(At, 1, 0); PG8_STAGE(PG8_SA(0, 1), a2 + hstep, voffA);
            PG8_WAIT_L(8); PG8_BAR; PG8_WAIT_L(0); PG8_MMA(0, 0, At, B0); PG8_BAR; PG8_SCHED;
            PG8_LDB(B1, 1, 1); PG8_STAGE(PG8_SB(1, 0), b3, voffB);
            PG8_BAR; PG8_WAIT_L(0); PG8_MMA(0, 1, At, B1); PG8_BAR;
            PG8_LDA(At, 1, 1); PG8_STAGE(PG8_SA(1, 0), a3, voffA);
            PG8_BAR; PG8_WAIT_L(0); PG8_MMA(1, 0, At, B0); PG8_BAR; PG8_SCHED;
            PG8_STAGE(PG8_SB(1, 1), b3 + hstep, voffB);
            PG8_WAIT_V(6); PG8_BAR; PG8_MMA(1, 1, At, B1); PG8_BAR;
            }
        }
        if constexpr (ALIGN_EPI) { if (wr == 0) PG8_BAR; }
        if constexpr (!Epi::AFTER_DRAIN) { E(acc, cur, wr, wc, fr, fq); S.done(cur); }
        if (!has_next) break;
#pragma unroll
        for (int a = 0; a < 2; ++a)
#pragma unroll
            for (int b = 0; b < 2; ++b)
#pragma unroll
                for (int m = 0; m < 4; ++m)
#pragma unroll
                    for (int n = 0; n < 2; ++n) acc[a][b][m][n] = (f32x4){0.f, 0.f, 0.f, 0.f};
        cur = nxt; cA = nA; cB = nB; ++ui;
        if constexpr (ALIGN_EPI) { if (wr == 1) PG8_BAR; }
    }
    PG8_WAIT_V(0);
    if constexpr (!ALIGN_EPI) { if (wr == 0) PG8_BAR; }
    PG8_BAR;
    if constexpr (Epi::AFTER_DRAIN) { E.fused(acc, cur, wr, wc, fr, fq, lds, wid, lane); S.done(cur); }
#undef PG8_SA
#undef PG8_SB
#undef PG8_STAGE
#undef PG8_LDA
#undef PG8_LDB
#undef PG8_MMA
#undef PG8_WAIT_V
#undef PG8_WAIT_L
#undef PG8_BAR
#undef PG8_SCHED
}
}
#define UNPACK8(W, V, O) do { V[O + 0] = bf_lo(W.x); V[O + 1] = bf_hi(W.x); V[O + 2] = bf_lo(W.y); V[O + 3] = bf_hi(W.y); V[O + 4] = bf_lo(W.z); V[O + 5] = bf_hi(W.z); V[O + 6] = bf_lo(W.w); V[O + 7] = bf_hi(W.w); } while (0)
#define PACK8(V, O, SC) (u32x4){pk2(V[O] * SC, V[O + 1] * SC), pk2(V[O + 2] * SC, V[O + 3] * SC), pk2(V[O + 4] * SC, V[O + 5] * SC), pk2(V[O + 6] * SC, V[O + 7] * SC)}
__device__ __forceinline__ void headnorm96(const bf16_t* srcA, const bf16_t* srcB, bf16_t* dst, const float* __restrict__ g, float outscale, bool rope, int rowpos, int colpos,
                                           const float* __restrict__ tab8, int j) {
  const u32x4 w0 = *(const u32x4*)(srcA + j * 8), w1 = *(const u32x4*)(srcA + 32 + j * 8), w2 = *(const u32x4*)(srcB + j * 8);
  float v[24];
  UNPACK8(w0, v, 0); UNPACK8(w1, v, 8); UNPACK8(w2, v, 16);
  float ss = 0.f;
#pragma unroll
  for (int e = 0; e < 24; ++e) ss += v[e] * v[e];
  ss += __shfl_xor(ss, 1); ss += __shfl_xor(ss, 2);
  const float rstd = rsqrtf(ss * (1.f / 96.f) + EPS);
#pragma unroll
  for (int e = 0; e < 8; ++e) { v[e] *= rstd * g[j * 8 + e]; v[8 + e] *= rstd * g[32 + j * 8 + e]; v[16 + e] *= rstd * g[64 + j * 8 + e]; }
  const int pos = (j < 2) ? rowpos : colpos;
#pragma unroll
  for (int e = 0; e < 8; ++e) {
    const float own = v[16 + e], oth = __shfl_xor(own, 1);
    const f32x2_t cs = *(const f32x2_t*)(tab8 + (pos * 8 + e) * 2);
    const float res = (j & 1) ? (oth * cs.y + own * cs.x) : (own * cs.x - oth * cs.y);
    if (rope) v[16 + e] = res;
  }
  *(u32x4*)(dst + j * 8) = PACK8(v, 0, outscale); *(u32x4*)(dst + 32 + j * 8) = PACK8(v, 8, outscale); *(u32x4*)(dst + 64 + j * 8) = PACK8(v, 16, outscale);
}
__device__ __forceinline__ void headnorm64(const bf16_t* q, bf16_t* qd, const float* __restrict__ g, float outscale, bool rope, int rowpos, int colpos, const float* __restrict__ tab16, int j) {
  const u32x4 w0 = *(const u32x4*)(q + j * 8), w1 = *(const u32x4*)(q + 32 + j * 8);
  float v[16];
  UNPACK8(w0, v, 0); UNPACK8(w1, v, 8);
  float ss = 0.f;
#pragma unroll
  for (int e = 0; e < 16; ++e) ss += v[e] * v[e];
  ss += __shfl_xor(ss, 1); ss += __shfl_xor(ss, 2);
  const float rstd = rsqrtf(ss * (1.f / 64.f) + EPS);
#pragma unroll
  for (int e = 0; e < 8; ++e) { v[e] *= rstd * g[j * 8 + e]; v[8 + e] *= rstd * g[32 + j * 8 + e]; }
#pragma unroll
  for (int e = 0; e < 8; ++e) {
    const int i = (j & 1) * 8 + e;
    const float own0 = v[e], oth0 = __shfl_xor(own0, 2), own1 = v[8 + e], oth1 = __shfl_xor(own1, 2);
    const f32x2_t cr = *(const f32x2_t*)(tab16 + (rowpos * 16 + i) * 2), cc = *(const f32x2_t*)(tab16 + (colpos * 16 + i) * 2);
    const float r0 = (j >> 1) ? (oth0 * cr.y + own0 * cr.x) : (own0 * cr.x - oth0 * cr.y);
    const float r1 = (j >> 1) ? (oth1 * cc.y + own1 * cc.x) : (own1 * cc.x - oth1 * cc.y);
    if (rope) { v[e] = r0; v[8 + e] = r1; }
  }
  *(u32x4*)(qd + j * 8) = PACK8(v, 0, outscale); *(u32x4*)(qd + 32 + j * 8) = PACK8(v, 8, outscale);
}

template <int DQK, int DV, int NS, bool WINDOW>
__device__ __forceinline__ void attn_unit(LAS unsigned char* lds, const bf16_t* __restrict__ Qb, int qsoff, int ldq, const bf16_t* __restrict__ Kb, int ksoff, int ldk,
                                          const bf16_t* __restrict__ Vb, int ldv, int q0, int ta0, int ta1, int tb0, int tb1, bool has_sink, float sink_l2, float kmax,
                                          unsigned char* __restrict__ Ob, int ldo, float lam, const float* __restrict__ gsub, int wv) {
  constexpr int KS = DQK * 2 + 16, KTB = 64 * KS, VS = (DV == 64) ? 192 : 320, VOFF = NS * KTB, VTB = 64 * VS, STG = VOFF + VTB;
  constexpr int KCR = DQK / 8, KCH = 64 * KCR, VCR = DV / 8, VCH = 64 * VCR, NCH = NS * KCH + VCH, NI = (NCH + NTHREADS - 1) / NTHREADS;
  constexpr int NDB = DV / 32, NKS = DQK / 16;
  static_assert(3 * STG <= LDS_BYTES - 16 && (NS == 1 || 4 * DV * 32 * 4 <= 3 * STG), "LDS");
  const int tid = otid(wv), lane = tid & 63, wid = tid >> 6, l31 = lane & 31, hi = lane >> 5;
  const int grp = wid >> 2;
  const int qsub = (NS == 1) ? wid : (wid & 3), stream = (NS == 1) ? 0 : grp;
  const int qrow = q0 + qsub * 32 + l31;
  bf16x8 qf[NKS];
  float qn2 = 0.f;
#pragma unroll
  for (int ks = 0; ks < NKS; ++ks) {
    const u32x4 w = *(const u32x4*)(Qb + (size_t)stream * qsoff + (size_t)qrow * ldq + ks * 16 + hi * 8);
    qf[ks] = __builtin_bit_cast(bf16x8, w);
    const float a0 = bf_lo(w.x), a1 = bf_hi(w.x), a2 = bf_lo(w.y), a3 = bf_hi(w.y), a4 = bf_lo(w.z), a5 = bf_hi(w.z), a6 = bf_lo(w.w), a7 = bf_hi(w.w);
    qn2 += a0 * a0 + a1 * a1 + a2 * a2 + a3 * a3 + a4 * a4 + a5 * a5 + a6 * a6 + a7 * a7;
  }
  qn2 += __shfl_xor(qn2, 32);
  const float negmb = -(sqrtf(qn2) * kmax);
  f32x16 negmv;
  if (DV == 64) {
#pragma unroll
    for (int r = 0; r < 16; ++r) negmv[r] = negmb;
    asm volatile("" : "+v"(negmv));
  }
  f32x16 o[NDB];
#pragma unroll
  for (int db = 0; db < NDB; ++db)
#pragma unroll
    for (int r = 0; r < 16; ++r) o[db][r] = 0.f;
  float lrun = 0.f;
  const int n1 = ta1 - ta0, ntl = n1 + (tb1 - tb0);
  u32x4 st[NI];
  f32x16 p0, p1;
  const LAS unsigned char* klb = lds + stream * KTB + l31 * KS + hi * 16;
  const LAS unsigned char* vlb = lds + VOFF + (4 * hi + ((lane & 15) >> 2)) * VS + (16 * ((lane >> 4) & 1) + 4 * (lane & 3)) * 2;
#define ATT_TILE(i_) (((i_) < n1) ? ta0 + (i_) : tb0 + ((i_) - n1))
#define ATT_LOAD(T_) do { const int t__ = (T_); _Pragma("unroll") for (int ii = 0; ii < NI; ++ii) { const int c = tid + ii * NTHREADS; if (c < NCH) { \
      if (c < NS * KCH) { const int s_ = c / KCH, cc = c - s_ * KCH, row = cc / KCR, kc = cc - row * KCR; st[ii] = *(const u32x4*)(Kb + (size_t)s_ * ksoff + (size_t)(t__ * 64 + row) * ldk + kc * 8); } \
      else { const int cc = c - NS * KCH, row = cc / VCR, vc = cc - row * VCR; st[ii] = *(const u32x4*)(Vb + (size_t)(t__ * 64 + row) * ldv + vc * 8); } } } } while (0)
#define ATT_STORE(BO_) do { LAS unsigned char* sb__ = lds + (BO_); _Pragma("unroll") for (int ii = 0; ii < NI; ++ii) { const int c = tid + ii * NTHREADS; if (c < NCH) { \
      if (c < NS * KCH) { const int s_ = c / KCH, cc = c - s_ * KCH, row = cc / KCR, kc = cc - row * KCR; *(LAS u32x4*)(sb__ + s_ * KTB + row * KS + kc * 16) = st[ii]; } \
      else { const int cc = c - NS * KCH, row = cc / VCR, vc = cc - row * VCR; *(LAS u32x4*)(sb__ + VOFF + row * VS + vc * 16) = st[ii]; } } } } while (0)
#define ATT_FLAGS(T_, ACT_, MSK_) do { ACT_ = true; MSK_ = false; if (WINDOW && (T_) < 32) { const int qlo = q0 + qsub * 32, qhi = qlo + 31, klo = (T_) * 64, khi = klo + 63; \
      ACT_ = !(khi < qlo - 128 || klo > qhi + 128); MSK_ = (khi - qlo > 128) || (qhi - klo > 128); } } while (0)
  constexpr int KB1 = NKS / 2;
  bf16x8 kf[2 * KB1];
#define ATT_QK_READ1(BO_) do { const LAS unsigned char* kl = klb + (BO_); \
      _Pragma("unroll") for (int ks = 0; ks < KB1; ++ks) { kf[2 * ks] = *(const LAS bf16x8*)(kl + ks * 32); kf[2 * ks + 1] = *(const LAS bf16x8*)(kl + 32 * KS + ks * 32); } \
      __builtin_amdgcn_sched_barrier(0); } while (0)
#define ATT_QK_REST(BO_) do { const LAS unsigned char* kl = klb + (BO_); \
      __builtin_amdgcn_sched_barrier(0); \
      if (DV == 64) { p0 = __builtin_amdgcn_mfma_f32_32x32x16_bf16(kf[0], qf[0], negmv, 0, 0, 0); p1 = __builtin_amdgcn_mfma_f32_32x32x16_bf16(kf[1], qf[0], negmv, 0, 0, 0); } \
      else { _Pragma("unroll") for (int r = 0; r < 16; ++r) { p0[r] = negmb; p1[r] = negmb; } p0 = __builtin_amdgcn_mfma_f32_32x32x16_bf16(kf[0], qf[0], p0, 0, 0, 0); p1 = __builtin_amdgcn_mfma_f32_32x32x16_bf16(kf[1], qf[0], p1, 0, 0, 0); } \
      _Pragma("unroll") for (int ks = 1; ks < KB1; ++ks) { p0 = __builtin_amdgcn_mfma_f32_32x32x16_bf16(kf[2 * ks], qf[ks], p0, 0, 0, 0); p1 = __builtin_amdgcn_mfma_f32_32x32x16_bf16(kf[2 * ks + 1], qf[ks], p1, 0, 0, 0); } \
      __builtin_amdgcn_sched_barrier(0); \
      _Pragma("unroll") for (int ks = KB1; ks < NKS; ++ks) { kf[2 * (ks - KB1)] = *(const LAS bf16x8*)(kl + ks * 32); kf[2 * (ks - KB1) + 1] = *(const LAS bf16x8*)(kl + 32 * KS + ks * 32); } \
      __builtin_amdgcn_sched_barrier(0); \
      _Pragma("unroll") for (int ks = KB1; ks < NKS; ++ks) { p0 = __builtin_amdgcn_mfma_f32_32x32x16_bf16(kf[2 * (ks - KB1)], qf[ks], p0, 0, 0, 0); p1 = __builtin_amdgcn_mfma_f32_32x32x16_bf16(kf[2 * (ks - KB1) + 1], qf[ks], p1, 0, 0, 0); } \
      __builtin_amdgcn_sched_barrier(0); } while (0)
#define ATT_VREAD(G_) do { _Pragma("unroll") for (int d2 = 0; d2 < GD; ++d2) _Pragma("unroll") for (int kb = 0; kb < 2; ++kb) _Pragma("unroll") for (int s_ = 0; s_ < 2; ++s_) { \
        const LAS unsigned char* vp = vl + (kb * 32 + 16 * s_) * VS + ((G_) * GD + d2) * 64; \
        vlo[d2 * 4 + kb * 2 + s_] = __builtin_amdgcn_ds_read_tr16_b64_v4i16((LAS v4i16_t*)vp); vhi[d2 * 4 + kb * 2 + s_] = __builtin_amdgcn_ds_read_tr16_b64_v4i16((LAS v4i16_t*)(vp + 8 * VS)); } } while (0)
#define ATT_PVM(G_) do { _Pragma("unroll") for (int d2 = 0; d2 < GD; ++d2) _Pragma("unroll") for (int kb = 0; kb < 2; ++kb) _Pragma("unroll") for (int s_ = 0; s_ < 2; ++s_) { \
        const v4i16_t lo_ = vlo[d2 * 4 + kb * 2 + s_], hi_ = vhi[d2 * 4 + kb * 2 + s_]; \
        const bf16x8 vf = (bf16x8){lo_[0], lo_[1], lo_[2], lo_[3], hi_[0], hi_[1], hi_[2], hi_[3]}; \
        o[(G_) * GD + d2] = __builtin_amdgcn_mfma_f32_32x32x16_bf16(vf, __builtin_bit_cast(bf16x8, pw[kb][s_]), o[(G_) * GD + d2], 0, 0, 0); } } while (0)
#define ATT_SPV(T_, BO_, MSK_) do { const LAS unsigned char* vl = vlb + (BO_); constexpr int GD = (DV == 128) ? 1 : 2; v4i16_t vlo[4 * GD], vhi[4 * GD]; \
      ATT_VREAD(0); __builtin_amdgcn_sched_barrier(0); \
      if (WINDOW && (MSK_)) { _Pragma("unroll") for (int r = 0; r < 16; ++r) { const int d0 = (T_) * 64 + crow(r, hi) - qrow, d1 = d0 + 32; \
          if (d0 > 128 || d0 < -128) p0[r] = -INFINITY; if (d1 > 128 || d1 < -128) p1[r] = -INFINITY; } } \
      _Pragma("unroll") for (int r = 0; r < 16; ++r) { p0[r] = __builtin_amdgcn_exp2f(p0[r]); p1[r] = __builtin_amdgcn_exp2f(p1[r]); } \
      u32x4 pw[2][2]; \
      _Pragma("unroll") for (int s_ = 0; s_ < 2; ++s_) { \
        pw[0][s_] = (u32x4){pk2(p0[8 * s_], p0[8 * s_ + 1]), pk2(p0[8 * s_ + 2], p0[8 * s_ + 3]), pk2(p0[8 * s_ + 4], p0[8 * s_ + 5]), pk2(p0[8 * s_ + 6], p0[8 * s_ + 7])}; \
        pw[1][s_] = (u32x4){pk2(p1[8 * s_], p1[8 * s_ + 1]), pk2(p1[8 * s_ + 2], p1[8 * s_ + 3]), pk2(p1[8 * s_ + 4], p1[8 * s_ + 5]), pk2(p1[8 * s_ + 6], p1[8 * s_ + 7])}; } \
      _Pragma("unroll") for (int kb = 0; kb < 2; ++kb) _Pragma("unroll") for (int s_ = 0; s_ < 2; ++s_) { \
        lrun = dot2bf(pw[kb][s_].x, 0x3f803f80u, lrun); lrun = dot2bf(pw[kb][s_].y, 0x3f803f80u, lrun); lrun = dot2bf(pw[kb][s_].z, 0x3f803f80u, lrun); lrun = dot2bf(pw[kb][s_].w, 0x3f803f80u, lrun); } \
      __builtin_amdgcn_sched_barrier(0); \
      ATT_PVM(0); \
      _Pragma("unroll") for (int g_ = 1; g_ < NDB / GD; ++g_) { __builtin_amdgcn_sched_barrier(0); ATT_VREAD(g_); __builtin_amdgcn_sched_barrier(0); ATT_PVM(g_); } } while (0)
  ATT_LOAD(ATT_TILE(0));
  ATT_STORE(0);
  if (ntl > 1) ATT_LOAD(ATT_TILE(1));
  __syncthreads();
  int bo_prev = 0, bo_cur = 0, bo_next = STG;
  for (int i = 0; i <= ntl; ++i) {
    if (grp == 0) {
      if (i < ntl) {
        const int t = ATT_TILE(i);
        bool act, msk; ATT_FLAGS(t, act, msk);
        if (act) ATT_QK_READ1(bo_cur);
        if (i + 1 < ntl) ATT_STORE(bo_next);
        if (i + 2 < ntl) ATT_LOAD(ATT_TILE(i + 2));
        if (act) { ATT_QK_REST(bo_cur); ATT_SPV(t, bo_cur, msk); }
      }
    } else {
      if (i >= 1) { const int tp = ATT_TILE(i - 1); bool act, msk; ATT_FLAGS(tp, act, msk); if (act) ATT_SPV(tp, bo_prev, msk); }
      if (i < ntl) {
        const int t = ATT_TILE(i);
        bool act, msk; ATT_FLAGS(t, act, msk);
        if (act) ATT_QK_READ1(bo_cur);
        if (i + 1 < ntl) ATT_STORE(bo_next);
        if (i + 2 < ntl) ATT_LOAD(ATT_TILE(i + 2));
        if (act) ATT_QK_REST(bo_cur);
      }
    }
    bo_prev = bo_cur; bo_cur = bo_next; bo_next = (bo_next == 2 * STG) ? 0 : bo_next + STG;
    __syncthreads();
  }
#undef ATT_LOAD
#undef ATT_STORE
#undef ATT_TILE
#undef ATT_FLAGS
#undef ATT_QK_READ1
#undef ATT_QK_REST
#undef ATT_VREAD
#undef ATT_PVM
#undef ATT_SPV
  float ltot = lrun + __shfl_xor(lrun, 32);
  if (has_sink) ltot += __builtin_amdgcn_exp2f(sink_l2 + negmb);
  const float inv = 1.f / ltot;
  if (NS == 1) {
    unsigned char* op = Ob + (size_t)qrow * ldo + 4 * hi; const float is_ = inv * OSC;
#pragma unroll
    for (int db = 0; db < NDB; ++db)
#pragma unroll
      for (int r4 = 0; r4 < 4; ++r4)
        *(unsigned*)(op + db * 32 + 8 * r4) = pk4_fp8(o[db][4 * r4] * is_, o[db][4 * r4 + 1] * is_, o[db][4 * r4 + 2] * is_, o[db][4 * r4 + 3] * is_);
  } else {
    LAS float* ex = (LAS float*)lds + qsub * (DV * 32);
    if (stream == 1) {
#pragma unroll
      for (int db = 0; db < NDB; ++db)
#pragma unroll
        for (int r = 0; r < 16; ++r) ex[(db * 32 + crow(r, hi)) * 32 + l31] = o[db][r] * inv;
    }
    __syncthreads();
    if (stream == 0) {
      float ss = 0.f;
#pragma unroll
      for (int db = 0; db < NDB; ++db)
#pragma unroll
        for (int r = 0; r < 16; ++r) { const float v = o[db][r] * inv - lam * ex[(db * 32 + crow(r, hi)) * 32 + l31]; o[db][r] = v; ss += v * v; }
      ss += __shfl_xor(ss, 32);
      const float rs = rsqrtf(ss * (1.f / DV) + EPS) * (1.f - LAM_INIT);
      unsigned char* op = Ob + (size_t)qrow * ldo + 4 * hi; const float rs_ = rs * OSC;
#pragma unroll
      for (int db = 0; db < NDB; ++db)
#pragma unroll
        for (int r4 = 0; r4 < 4; ++r4) {
          const f32x4 g4 = *(const f32x4*)(gsub + db * 32 + 8 * r4 + 4 * hi);
          *(unsigned*)(op + db * 32 + 8 * r4) = pk4_fp8(o[db][4 * r4] * rs_ * g4.x, o[db][4 * r4 + 1] * rs_ * g4.y, o[db][4 * r4 + 2] * rs_ * g4.z, o[db][4 * r4 + 3] * rs_ * g4.w);
        }
    }
    __syncthreads();
  }
}

template <int DQK, int DV, bool WINDOW>
__device__ __forceinline__ void attn_unit_p(LAS unsigned char* lds, const bf16_t* __restrict__ Qb, int ldq, const bf16_t* __restrict__ Kb, int ldk, const bf16_t* __restrict__ Vb, int ldv,
                                            int q0, int ta0, int ta1, int tb0, int tb1, bool has_sink, float sink_l2, float kmax, unsigned char* __restrict__ Ob, int ldo, int wv) {
  static_assert(DV == 64 && !WINDOW, "pipelined form: DV = 64, no window");
  constexpr int KS = DQK * 2 + 16, KTB = 64 * KS, VS = 192, VOFF = KTB, VTB = 64 * VS, STG = VOFF + VTB;
  constexpr int KCR = DQK / 8, KCH = 64 * KCR, VCR = DV / 8, VCH = 64 * VCR, NCH = KCH + VCH, NI = (NCH + NTHREADS - 1) / NTHREADS;
  constexpr int NKS = DQK / 16, NQK = 2 * NKS, NPV = 8, EG = (NQK >= 12) ? 8 : NQK - 2;
  static_assert(3 * STG <= LDS_BYTES - 16, "LDS");
  const int tid = otid(wv), lane = tid & 63, wid = tid >> 6, l31 = lane & 31, hi = lane >> 5;
  const int qrow = q0 + wid * 32 + l31;
  bf16x8 qf[NKS];
  float qn2 = 0.f;
#pragma unroll
  for (int ks = 0; ks < NKS; ++ks) {
    const u32x4 w = *(const u32x4*)(Qb + (size_t)qrow * ldq + ks * 16 + hi * 8);
    qf[ks] = __builtin_bit_cast(bf16x8, w);
    const float a0 = bf_lo(w.x), a1 = bf_hi(w.x), a2 = bf_lo(w.y), a3 = bf_hi(w.y), a4 = bf_lo(w.z), a5 = bf_hi(w.z), a6 = bf_lo(w.w), a7 = bf_hi(w.w);
    qn2 += a0 * a0 + a1 * a1 + a2 * a2 + a3 * a3 + a4 * a4 + a5 * a5 + a6 * a6 + a7 * a7;
  }
  qn2 += __shfl_xor(qn2, 32);
  const float negmb = -(sqrtf(qn2) * kmax);
  f32x16 negmv;
#pragma unroll
  for (int r = 0; r < 16; ++r) negmv[r] = negmb;
  asm volatile("" : "+v"(negmv));
  f32x16 o[2];
#pragma unroll
  for (int db = 0; db < 2; ++db)
#pragma unroll
    for (int r = 0; r < 16; ++r) o[db][r] = 0.f;
  float lrun = 0.f;
  const int n1 = ta1 - ta0, ntl = n1 + (tb1 - tb0);
  u32x4 st[NI];
  f32x16 pA0, pA1, pB0, pB1;
  bf16x8 kw[3];
  v4i16_t vwl[3], vwh[3];
  u32x4 pw[2][2];
  const LAS unsigned char* klb = lds + l31 * KS + hi * 16;
  const LAS unsigned char* vlb = lds + VOFF + (4 * hi + ((lane & 15) >> 2)) * VS + (16 * ((lane >> 4) & 1) + 4 * (lane & 3)) * 2;
#define ATT_TILE(i_) (((i_) < n1) ? ta0 + (i_) : tb0 + ((i_) - n1))
  unsigned gof[NI], lof[NI];
#pragma unroll
  for (int ii = 0; ii < NI; ++ii) { const int cw = (wv + 8 * ii) * 64, c = cw + lane;
    if (cw < KCH) { const int row = c / KCR, kc = c - row * KCR; gof[ii] = (unsigned)(row * ldk + kc * 8) * 2u; lof[ii] = (unsigned)(row * KS + kc * 16); }
    else { const int cc = c - KCH, row = cc / VCR, vc = cc - row * VCR; gof[ii] = (unsigned)(row * ldv + vc * 8) * 2u; lof[ii] = (unsigned)(VOFF + row * VS + vc * 16); } }
#define ATT_LOAD(T_) do { const int t__ = (T_); _Pragma("unroll") for (int ii = 0; ii < NI; ++ii) { const int cw = (wv + 8 * ii) * 64; if (cw < NCH) { \
      const char* gb__ = (cw < KCH) ? (const char*)Kb + (size_t)t__ * 128 * ldk : (const char*)Vb + (size_t)t__ * 128 * ldv; st[ii] = *(const u32x4*)(gb__ + gof[ii]); } } } while (0)
#define ATT_STORE(BO_) do { _Pragma("unroll") for (int ii = 0; ii < NI; ++ii) { const int cw = (wv + 8 * ii) * 64; if (cw < NCH) *(LAS u32x4*)(lds + (BO_) + lof[ii]) = st[ii]; } } while (0)
#define SB_() __builtin_amdgcn_sched_barrier(0)
#define KRD1(BO_, G_) do { kw[(G_) % 3] = *(const LAS bf16x8*)(klb + (BO_) + ((G_) & 1) * 32 * KS + ((G_) >> 1) * 32); } while (0)
#define VRDG(BO_, G_) do { const LAS unsigned char* vp = vlb + (BO_) + ((((G_) >> 2) & 1) * 32 + 16 * (((G_) >> 1) & 1)) * VS + ((G_) & 1) * 64; \
      vwl[(G_) % 3] = __builtin_amdgcn_ds_read_tr16_b64_v4i16((LAS v4i16_t*)vp); vwh[(G_) % 3] = __builtin_amdgcn_ds_read_tr16_b64_v4i16((LAS v4i16_t*)(vp + 8 * VS)); } while (0)
#define QKM(R0_, R1_, G_) do { const int ks_ = (G_) >> 1; \
      if (((G_) & 1) == 0) R0_ = __builtin_amdgcn_mfma_f32_32x32x16_bf16(kw[(G_) % 3], qf[ks_], (ks_ == 0) ? negmv : R0_, 0, 0, 0); \
      else R1_ = __builtin_amdgcn_mfma_f32_32x32x16_bf16(kw[(G_) % 3], qf[ks_], (ks_ == 0) ? negmv : R1_, 0, 0, 0); } while (0)
#define PVM(G_) do { const int d2_ = (G_) & 1, kb_ = ((G_) >> 2) & 1, s_ = ((G_) >> 1) & 1; \
      const v4i16_t lo_ = vwl[(G_) % 3], hi_ = vwh[(G_) % 3]; const bf16x8 vf = (bf16x8){lo_[0], lo_[1], lo_[2], lo_[3], hi_[0], hi_[1], hi_[2], hi_[3]}; \
      o[d2_] = __builtin_amdgcn_mfma_f32_32x32x16_bf16(vf, __builtin_bit_cast(bf16x8, pw[kb_][s_]), o[d2_], 0, 0, 0); } while (0)
#define PACK1(P_, KB_, C_) do { const int s_ = (C_) >> 2, e_ = (C_) & 3; pw[KB_][s_][e_] = pk2(P_[8 * s_ + 2 * e_], P_[8 * s_ + 2 * e_ + 1]); } while (0)
#define EXPR(P_, LO_, HI_) do { _Pragma("unroll") for (int x_ = (LO_); x_ < (HI_); ++x_) { float e_ = __builtin_amdgcn_exp2f(P_[x_]); asm volatile("" : "+v"(e_)); P_[x_] = e_; } } while (0)
#define SUMR(P_, LO_, HI_) do { _Pragma("unroll") for (int x_ = (LO_); x_ < (HI_); ++x_) lrun += P_[x_]; asm volatile("" : "+v"(lrun)); } while (0)
#define FILL_A(E0_, E1_, G_) do { \
      if ((G_) < EG) EXPR(E1_, ((G_) * 16) / EG, (((G_) + 1) * 16) / EG); \
      if ((G_) >= 1 && (G_) <= EG) SUMR(E1_, (((G_) - 1) * 16) / EG, ((G_) * 16) / EG); \
      if ((G_) < EG) { _Pragma("unroll") for (int c = ((G_) * 8) / EG; c < (((G_) + 1) * 8) / EG; ++c) PACK1(E0_, 0, c); } \
      else { _Pragma("unroll") for (int c = (((G_) - EG) * 8) / (NQK - EG); c < (((G_) - EG + 1) * 8) / (NQK - EG); ++c) PACK1(E1_, 1, c); } } while (0)
#define FILL_B(R0_, G_) do { EXPR(R0_, 2 * (G_), 2 * (G_) + 2); if ((G_) >= 1) SUMR(R0_, 2 * (G_) - 2, 2 * (G_)); if ((G_) == NPV - 1) SUMR(R0_, 14, 16); } while (0)
#define STEP_MID(R0_, R1_, E0_, E1_, BOC_, BOP_) do { \
      _Pragma("unroll") for (int g = 0; g < NQK; ++g) { \
        QKM(R0_, R1_, g); \
        if (g + 2 < NQK) KRD1(BOC_, g + 2); \
        if (g >= NQK - 2) VRDG(BOP_, g - (NQK - 2)); \
        FILL_A(E0_, E1_, g); \
        SB_(); } \
      _Pragma("unroll") for (int g = 0; g < NPV; ++g) { \
        PVM(g); \
        if (g + 2 < NPV) VRDG(BOP_, g + 2); \
        FILL_B(R0_, g); \
        SB_(); } } while (0)
#define STEP_HEAD(R0_, R1_, BOC_) do { \
      _Pragma("unroll") for (int g = 0; g < NQK; ++g) { QKM(R0_, R1_, g); if (g + 2 < NQK) KRD1(BOC_, g + 2); SB_(); } \
      _Pragma("unroll") for (int g = 0; g < NPV; ++g) { FILL_B(R0_, g); } SB_(); } while (0)
#define STEP_TAIL(E0_, E1_, BOP_) do { \
      VRDG(BOP_, 0); VRDG(BOP_, 1); \
      _Pragma("unroll") for (int g = 0; g < NQK; ++g) FILL_A(E0_, E1_, g); SB_(); \
      _Pragma("unroll") for (int g = 0; g < NPV; ++g) { PVM(g); if (g + 2 < NPV) VRDG(BOP_, g + 2); SB_(); } } while (0)
#define STEP_PRE(I_, KR_) do { const int i__ = (I_); \
      if (KR_) { KRD1(bo_cur, 0); KRD1(bo_cur, 1); } \
      if (i__ + 1 < ntl) ATT_STORE(bo_next); \
      if (i__ + 2 < ntl) ATT_LOAD(ATT_TILE(i__ + 2)); \
      SB_(); } while (0)
#define STEP_POST() do { bo_prev = bo_cur; bo_cur = bo_next; bo_next = (bo_next == 2 * STG) ? 0 : bo_next + STG; __syncthreads(); } while (0)
  ATT_LOAD(ATT_TILE(0));
  ATT_STORE(0);
  if (ntl > 1) ATT_LOAD(ATT_TILE(1));
  __syncthreads();
  int bo_prev = 0, bo_cur = 0, bo_next = STG;
  STEP_PRE(0, true); STEP_HEAD(pA0, pA1, bo_cur); STEP_POST();
  int it = 1;
  for (; it + 1 < ntl; it += 2) {
    STEP_PRE(it, true); STEP_MID(pB0, pB1, pA0, pA1, bo_cur, bo_prev); STEP_POST();
    STEP_PRE(it + 1, true); STEP_MID(pA0, pA1, pB0, pB1, bo_cur, bo_prev); STEP_POST();
  }
  if (it < ntl) {
    STEP_PRE(it, true); STEP_MID(pB0, pB1, pA0, pA1, bo_cur, bo_prev); STEP_POST();
    STEP_TAIL(pB0, pB1, bo_prev);
  } else {
    STEP_TAIL(pA0, pA1, bo_prev);
  }
  __syncthreads();
#undef ATT_TILE
#undef ATT_LOAD
#undef ATT_STORE
#undef SB_
#undef KRD1
#undef VRDG
#undef QKM
#undef PVM
#undef PACK1
#undef EXPR
#undef SUMR
#undef FILL_A
#undef FILL_B
#undef STEP_MID
#undef STEP_HEAD
#undef STEP_TAIL
#undef STEP_PRE
#undef STEP_POST
  float ltot = lrun + __shfl_xor(lrun, 32);
  if (has_sink) ltot += __builtin_amdgcn_exp2f(sink_l2 + negmb);
  const float is_ = OSC / ltot;
  unsigned char* op = Ob + (size_t)qrow * ldo + 4 * hi;
#pragma unroll
  for (int db = 0; db < 2; ++db)
#pragma unroll
    for (int r4 = 0; r4 < 4; ++r4)
      *(unsigned*)(op + db * 32 + 8 * r4) = pk4_fp8(o[db][4 * r4] * is_, o[db][4 * r4 + 1] * is_, o[db][4 * r4 + 2] * is_, o[db][4 * r4 + 3] * is_);
}

#define TOPK_INSERT(ARR, KEY) do { unsigned k__ = (KEY); _Pragma("unroll") for (int t_ = 0; t_ < 16; ++t_) { const unsigned h__ = max(ARR[t_], k__); k__ = min(ARR[t_], k__); ARR[t_] = h__; } } while (0)
__device__ __forceinline__ void peer_phase(LAS unsigned char* lds, const bf16_t* __restrict__ S, const unsigned char* __restrict__ H, const unsigned char* __restrict__ U, const unsigned char* __restrict__ V, float uinv, float vinv,
                                           const float* __restrict__ modl, bf16_t* xl, bf16_t* xc, float* outf, bool last, bool live, unsigned char* Hn, const float* __restrict__ gn, const float* __restrict__ modn, int wv) {
  const int tid_ = otid(wv); const int lane = tid_ & 63, wid = tid_ >> 6;
  LAS unsigned* keysL = (LAS unsigned*)(lds + wid * 9216);
  LAS u32x2* resL = (LAS u32x2*)(lds + wid * 9216 + 4096);
  LAS float* wL = (LAS float*)(lds + wid * 9216 + 8192);
  const int ngroups = last ? (NB * SEQ / 4) : (M / 4);
  for (int g = blockIdx.x * NWAVES + wid; g < ngroups; g += gridDim.x * NWAVES) {
    const int r0 = last ? (g / (SEQ / 4)) * TPB + (g % (SEQ / 4)) * 4 : g * 4;
    const int tok = lane >> 4, hc = lane & 15;
    unsigned top[16];
    const bf16_t* sp = S + (size_t)(r0 + tok) * 2048 + hc * 128;
#define CE_DESC(A_, B_) do { const unsigned h__ = max(A_, B_), l__ = min(A_, B_); A_ = h__; B_ = l__; } while (0)
#pragma unroll 1
    for (int j0 = 0; j0 < 128; j0 += 16) {
      unsigned blk[16];
      { const u32x4 v0 = *(const u32x4*)(sp + j0), v1 = *(const u32x4*)(sp + j0 + 8);
        const unsigned base = (unsigned)(127 - j0);
        blk[0] = (f2ord(bf_lo(v0.x)) & ~127u) | (base - 0u);  blk[1] = (f2ord(bf_hi(v0.x)) & ~127u) | (base - 1u);
        blk[2] = (f2ord(bf_lo(v0.y)) & ~127u) | (base - 2u);  blk[3] = (f2ord(bf_hi(v0.y)) & ~127u) | (base - 3u);
        blk[4] = (f2ord(bf_lo(v0.z)) & ~127u) | (base - 4u);  blk[5] = (f2ord(bf_hi(v0.z)) & ~127u) | (base - 5u);
        blk[6] = (f2ord(bf_lo(v0.w)) & ~127u) | (base - 6u);  blk[7] = (f2ord(bf_hi(v0.w)) & ~127u) | (base - 7u);
        blk[8] = (f2ord(bf_lo(v1.x)) & ~127u) | (base - 8u);  blk[9] = (f2ord(bf_hi(v1.x)) & ~127u) | (base - 9u);
        blk[10] = (f2ord(bf_lo(v1.y)) & ~127u) | (base - 10u); blk[11] = (f2ord(bf_hi(v1.y)) & ~127u) | (base - 11u);
        blk[12] = (f2ord(bf_lo(v1.z)) & ~127u) | (base - 12u); blk[13] = (f2ord(bf_hi(v1.z)) & ~127u) | (base - 13u);
        blk[14] = (f2ord(bf_lo(v1.w)) & ~127u) | (base - 14u); blk[15] = (f2ord(bf_hi(v1.w)) & ~127u) | (base - 15u); }
#pragma unroll
      for (int k = 2; k <= 16; k <<= 1)
#pragma unroll
        for (int j = k >> 1; j > 0; j >>= 1)
#pragma unroll
          for (int i = 0; i < 16; ++i) { const int l = i ^ j; if (l > i) { if ((i & k) == 0) CE_DESC(blk[i], blk[l]); else CE_DESC(blk[l], blk[i]); } }
      if (j0 == 0) {
#pragma unroll
        for (int i = 0; i < 16; ++i) top[i] = blk[i];
      } else {
#pragma unroll
        for (int i = 0; i < 16; ++i) top[i] = max(top[i], blk[15 - i]);
#pragma unroll
        for (int j = 8; j > 0; j >>= 1)
#pragma unroll
          for (int i = 0; i < 16; ++i) { const int l = i ^ j; if (l > i) CE_DESC(top[i], top[l]); }
      }
    }
#undef CE_DESC
#pragma unroll
    for (int i = 0; i < 16; ++i) keysL[lane * 16 + i] = top[i];
    float v0[16], v1[16];
#pragma unroll
    for (int i = 0; i < 16; ++i) { const unsigned t1 = __shfl_down(top[i], 1); v0[i] = ord2f(top[i] & ~127u); v1[i] = ord2f(t1 & ~127u); }
    unsigned cd[16];
#pragma unroll
    for (int i = 0; i < 16; ++i) cd[i] = 0u;
#pragma unroll
    for (int a = 0; a < 16; ++a)
#pragma unroll
      for (int b = 0; b < 16 / (a + 1); ++b) TOPK_INSERT(cd, (f2ord(v0[a] + v1[b]) & ~255u) | (unsigned)(255 - (a * 16 + b)));
    {
      float e[16]; float sum = 0.f; const float mx = ord2f(cd[0] & ~255u);
#pragma unroll
      for (int k = 0; k < 16; ++k) { e[k] = __expf(ord2f(cd[k] & ~255u) - mx); sum += e[k]; }
      const float inv = 1.f / sum;
      const int lp1 = (lane + 1) & 63;
#pragma unroll
      for (int k = 0; k < 16; ++k) {
        const int pos = 255 - (int)(cd[k] & 255u), a = pos >> 4, b = pos & 15;
        const unsigned i1 = 127u - (keysL[lane * 16 + a] & 127u), i2 = 127u - (keysL[lp1 * 16 + b] & 127u);
        if ((hc & 1) == 0) resL[tok * 128 + (hc >> 1) * 16 + k] = (u32x2){i1 * 128u + i2, __float_as_uint(e[k] * inv)};
      }
    }
    for (int tk = 0; tk < 4; ++tk) {
      const int r = r0 + tk;
      float hf[16];
      { const bf16_t* hrow = (const bf16_t*)H + (size_t)r * D + lane * 16; const u32x4 ha = *(const u32x4*)hrow, hb = *(const u32x4*)(hrow + 8);
        hf[0] = bf_lo(ha.x); hf[1] = bf_hi(ha.x); hf[2] = bf_lo(ha.y); hf[3] = bf_hi(ha.y); hf[4] = bf_lo(ha.z); hf[5] = bf_hi(ha.z); hf[6] = bf_lo(ha.w); hf[7] = bf_hi(ha.w);
        hf[8] = bf_lo(hb.x); hf[9] = bf_hi(hb.x); hf[10] = bf_lo(hb.y); hf[11] = bf_hi(hb.y); hf[12] = bf_lo(hb.z); hf[13] = bf_hi(hb.z); hf[14] = bf_lo(hb.w); hf[15] = bf_hi(hb.w); }
      unsigned hq1a = 0u, hq1b = 0u, hq2a = 0u, hq2b = 0u; float hstep;
      { float ss = 0.f;
#pragma unroll
        for (int j = 0; j < 16; ++j) ss += hf[j] * hf[j];
        ss = wave_sum(ss);
        hstep = 0.5f * sqrtf(ss * (1.f / D) + 1e-20f); const float rs = 1.f / hstep;
#pragma unroll
        for (int j = 0; j < 16; ++j) {
          const float t = hf[j] * rs; int q1 = (int)rintf(t); q1 = min(7, max(-8, q1));
          int q2 = (int)rintf((t - (float)q1) * 16.f); q2 = min(7, max(-8, q2));
          if (j < 8) { hq1a |= ((unsigned)q1 & 15u) << (4 * j); hq2a |= ((unsigned)q2 & 15u) << (4 * j); }
          else { hq1b |= ((unsigned)q1 & 15u) << (4 * (j - 8)); hq2b |= ((unsigned)q2 & 15u) << (4 * (j - 8)); }
        } }
      const float uscale = uinv * hstep * (1.f / 16.f);
      f32x2_t o2[8];
#pragma unroll
      for (int j = 0; j < 8; ++j) o2[j] = (f32x2_t){0.f, 0.f};
      const bool b5 = (lane & 32) != 0, b4 = (lane & 16) != 0, b3 = (lane & 8) != 0, b2 = (lane & 4) != 0;
      const int ei = (lane >> 2) & 15;
      u32x2 ua[16], va[16], ub[16], vb[16];
#define PEER_LOAD(UU, VV, BT) do { _Pragma("unroll") for (int i = 0; i < 16; ++i) { const unsigned e_ = resL[tk * 128 + (BT) * 16 + i].x; \
        UU[i] = *(const u32x2*)(U + (size_t)e_ * 512 + lane * 8); VV[i] = *(const u32x2*)(V + (size_t)e_ * 512 + lane * 8); } } while (0)
#define PEER_PROC(UU, VV, BT) do { float d[16]; \
        _Pragma("unroll") for (int i = 0; i < 16; ++i) { const int w0 = (int)UU[i].x, w1 = (int)UU[i].y; \
          const int i1 = __builtin_amdgcn_sdot8(w1, (int)hq1b, __builtin_amdgcn_sdot8(w0, (int)hq1a, 0, false), false); \
          const int i2 = __builtin_amdgcn_sdot8(w1, (int)hq2b, __builtin_amdgcn_sdot8(w0, (int)hq2a, 0, false), false); \
          d[i] = (float)(i1 * 16 + i2); } \
        float k8[8], k4[4], k2[2], k1; \
        _Pragma("unroll") for (int i = 0; i < 8; ++i) { const auto r_ = __builtin_amdgcn_permlane32_swap(__float_as_uint(d[i]), __float_as_uint(d[8 + i]), false, false); k8[i] = __uint_as_float(r_[0]) + __uint_as_float(r_[1]); } \
        _Pragma("unroll") for (int i = 0; i < 4; ++i) { const auto r_ = __builtin_amdgcn_permlane16_swap(__float_as_uint(k8[i]), __float_as_uint(k8[4 + i]), false, false); k4[i] = __uint_as_float(r_[0]) + __uint_as_float(r_[1]); } \
        _Pragma("unroll") for (int i = 0; i < 2; ++i) { \
          const float sa = k4[i] + __int_as_float(__builtin_amdgcn_update_dpp(0, __float_as_int(k4[i]), 0x128, 0xf, 0xf, false)); \
          const float sb = k4[2 + i] + __int_as_float(__builtin_amdgcn_update_dpp(0, __float_as_int(k4[2 + i]), 0x128, 0xf, 0xf, false)); \
          k2[i] = b3 ? sb : sa; } \
        { const float keep = b2 ? k2[1] : k2[0], send = b2 ? k2[0] : k2[1]; k1 = keep + __shfl_xor(send, 4); } \
        k1 += __shfl_xor(k1, 2); k1 += __shfl_xor(k1, 1); \
        const float tot = k1 * uscale; \
        const float gate = __uint_as_float(resL[tk * 128 + (BT) * 16 + ei].y); \
        const float wact = 0.5f * tot * (1.f + erff(tot * 0.70710678118f)) * gate * vinv; \
        _Pragma("unroll") for (int i = 0; i < 16; ++i) { const float wi = __int_as_float(__builtin_amdgcn_readlane(__float_as_int(wact), 4 * i)); const f32x2_t w2 = {wi, wi}; const unsigned w0 = VV[i].x, w1 = VV[i].y; \
          o2[0] = __builtin_elementwise_fma(__builtin_amdgcn_cvt_scalef32_pk_f32_fp4(w0, 1.0f, 0), w2, o2[0]); o2[1] = __builtin_elementwise_fma(__builtin_amdgcn_cvt_scalef32_pk_f32_fp4(w0, 1.0f, 1), w2, o2[1]); \
          o2[2] = __builtin_elementwise_fma(__builtin_amdgcn_cvt_scalef32_pk_f32_fp4(w0, 1.0f, 2), w2, o2[2]); o2[3] = __builtin_elementwise_fma(__builtin_amdgcn_cvt_scalef32_pk_f32_fp4(w0, 1.0f, 3), w2, o2[3]); \
          o2[4] = __builtin_elementwise_fma(__builtin_amdgcn_cvt_scalef32_pk_f32_fp4(w1, 1.0f, 0), w2, o2[4]); o2[5] = __builtin_elementwise_fma(__builtin_amdgcn_cvt_scalef32_pk_f32_fp4(w1, 1.0f, 1), w2, o2[5]); \
          o2[6] = __builtin_elementwise_fma(__builtin_amdgcn_cvt_scalef32_pk_f32_fp4(w1, 1.0f, 2), w2, o2[6]); o2[7] = __builtin_elementwise_fma(__builtin_amdgcn_cvt_scalef32_pk_f32_fp4(w1, 1.0f, 3), w2, o2[7]); } } while (0)
      PEER_LOAD(ua, va, 0);
      for (int bt = 0; bt < 8; bt += 2) {
        PEER_LOAD(ub, vb, bt + 1);
        PEER_PROC(ua, va, bt);
        if (bt + 2 < 8) PEER_LOAD(ua, va, bt + 2);
        PEER_PROC(ub, vb, bt + 1);
      }
#undef PEER_LOAD
#undef PEER_PROC
      if (live) {
        const int b = r / TPB, s = r - b * TPB; const int bi = (s >= SEQ) ? 8 : b;
        bf16_t* xp = xrow_ptr(xl, xc, r) + lane * 16; const float* gt = modl + (size_t)(bi * 6 + 5) * D + lane * 16;
        f32x4 xn[4]; float ss = 0.f;
        { const u32x4 xa = *(const u32x4*)xp, xb = *(const u32x4*)(xp + 8);
          xn[0] = (f32x4){bf_lo(xa.x), bf_hi(xa.x), bf_lo(xa.y), bf_hi(xa.y)}; xn[1] = (f32x4){bf_lo(xa.z), bf_hi(xa.z), bf_lo(xa.w), bf_hi(xa.w)};
          xn[2] = (f32x4){bf_lo(xb.x), bf_hi(xb.x), bf_lo(xb.y), bf_hi(xb.y)}; xn[3] = (f32x4){bf_lo(xb.z), bf_hi(xb.z), bf_lo(xb.w), bf_hi(xb.w)}; }
#pragma unroll
        for (int q = 0; q < 4; ++q) {
          const f32x4 gv = ((const f32x4*)gt)[q];
          xn[q] += gv * (f32x4){o2[2 * q].x, o2[2 * q].y, o2[2 * q + 1].x, o2[2 * q + 1].y};
          ss += xn[q].x * xn[q].x + xn[q].y * xn[q].y + xn[q].z * xn[q].z + xn[q].w * xn[q].w;
        }
        if (last) {
          float* op = outf + (size_t)(b * SEQ + s) * D + lane * 16;
#pragma unroll
          for (int q = 0; q < 4; ++q) ((f32x4*)op)[q] = xn[q];
        } else {
          *(u32x4*)xp = (u32x4){pk2(xn[0].x, xn[0].y), pk2(xn[0].z, xn[0].w), pk2(xn[1].x, xn[1].y), pk2(xn[1].z, xn[1].w)};
          *(u32x4*)(xp + 8) = (u32x4){pk2(xn[2].x, xn[2].y), pk2(xn[2].z, xn[2].w), pk2(xn[3].x, xn[3].y), pk2(xn[3].z, xn[3].w)};
        }
        if (Hn != nullptr) {
          ss = wave_sum(ss);
          const float rstd = rsqrtf(ss * (1.f / D) + EPS);
          const float* sh = modn + (size_t)(bi * 6) * D + lane * 16; const float* sc = sh + D; const float* gg = gn + lane * 16;
          u32x4 h0;
#pragma unroll
          for (int q = 0; q < 4; ++q) {
            const f32x4 g4 = ((const f32x4*)gg)[q], s4 = ((const f32x4*)sc)[q], h4 = ((const f32x4*)sh)[q];
            const f32x4 y = (xn[q] * rstd * g4 * (1.f + s4) + h4) * ASC;
            h0[q] = pk4_fp8(y.x, y.y, y.z, y.w);
          }
          *(u32x4*)(Hn + (size_t)r * D + lane * 16) = h0;
        }
      }
    }
  }
}

#define XB_TMO      128
#define XB_XCNT(j)  (256  + 64 * (j))
#define XB_XSUB(j)  (1280 + 64 * (j))
#define XB_XGEN(j)  (2304 + 64 * (j))
#define XB_TOP      3328
#define XB_TOPGEN   3392
#define XCD_BAR_WORDS 3456
#define XB_SPIN_CAP (1u << 20)
__device__ __forceinline__ unsigned xb_ld(unsigned* p)              { return __hip_atomic_load(p, __ATOMIC_RELAXED, __HIP_MEMORY_SCOPE_AGENT); }
__device__ __forceinline__ unsigned xb_add(unsigned* p, unsigned v) { return __hip_atomic_fetch_add(p, v, __ATOMIC_RELAXED, __HIP_MEMORY_SCOPE_AGENT); }
__device__ __forceinline__ unsigned xb_xcc_id() { return (unsigned)__builtin_amdgcn_s_getreg((3 << 11) | 20) & 0xFu; }
#define XB_SPIN(cond, bar) do { unsigned _sp = 0; while (cond) { __builtin_amdgcn_s_sleep(1); \
    if ((++_sp & 255u) == 0u) { if (xb_ld(&(bar)[XB_TMO])) break; if (_sp > XB_SPIN_CAP) { atomicAdd(&(bar)[XB_TMO], 1u); break; } } } } while (0)
struct XcdBarrier { unsigned* bar; unsigned x; volatile LAS unsigned* st; };
__device__ __forceinline__ XcdBarrier xcd_barrier_post(unsigned* bar, volatile LAS unsigned* st) {
    XcdBarrier b; b.bar = bar; b.x = xb_xcc_id(); b.st = st;
    if (threadIdx.x == 0) (void)xb_add(&bar[XB_XCNT(b.x)], 1u);
    return b;
}
__device__ __forceinline__ void xcd_barrier_complete(unsigned* bar, unsigned x, unsigned& nloc, unsigned& nx) {
    const unsigned G = gridDim.x * gridDim.y * gridDim.z;
    unsigned sum, cnt, mine, sp = 0u;
    for (;;) {
        sum = 0u; cnt = 0u; mine = 0u;
#pragma unroll
        for (unsigned j = 0; j < 16; ++j) { const unsigned c = xb_ld(&bar[XB_XCNT(j)]); sum += c; cnt += (c > 0u) ? 1u : 0u; mine = (j == x) ? c : mine; }
        if (sum == G) break;
        __builtin_amdgcn_s_sleep(1);
        if ((++sp & 255u) == 0u) { if (xb_ld(&bar[XB_TMO])) break; if (sp > XB_SPIN_CAP) { atomicAdd(&bar[XB_TMO], 1u); break; } }
    }
    nloc = mine > 0u ? mine : 1u; nx = cnt > 0u ? cnt : 1u;
}
__device__ __forceinline__ void xcd_barrier(const XcdBarrier& b, int wv) {
    asm volatile("s_waitcnt vmcnt(0)" ::: "memory");
    __syncthreads();
    if (otid(wv) == 0) {
        unsigned* bar = b.bar;
        __builtin_amdgcn_s_waitcnt(0);
        unsigned nloc = b.st[0], nx = b.st[1];
        if (nloc == 0u) { xcd_barrier_complete(bar, b.x, nloc, nx); b.st[0] = nloc; b.st[1] = nx; }
        const unsigned old = xb_add(&bar[XB_XSUB(b.x)], 1u);
        const unsigned gen = old / nloc;
        if (old + 1u == (gen + 1u) * nloc) {
            __builtin_amdgcn_fence(__ATOMIC_RELEASE, "agent");
            asm volatile("s_waitcnt vmcnt(0)" ::: "memory");
            const unsigned og = xb_add(&bar[XB_TOP], 1u);
            const unsigned tg = og / nx;
            if (og + 1u == (tg + 1u) * nx) xb_add(&bar[XB_TOPGEN], 1u);
            else XB_SPIN(xb_ld(&bar[XB_TOPGEN]) == tg, bar);
            __builtin_amdgcn_fence(__ATOMIC_ACQUIRE, "agent");
            xb_add(&bar[XB_XGEN(b.x)], 1u);
            asm volatile("s_waitcnt vmcnt(0)" ::: "memory");
        } else {
            XB_SPIN(xb_ld(&bar[XB_XGEN(b.x)]) == gen, bar);
            __builtin_amdgcn_fence(__ATOMIC_ACQUIRE, "agent");
            asm volatile("s_waitcnt vmcnt(0)" ::: "memory");
        }
    }
    __syncthreads();
}

enum { ST_NORM = 0, ST_GEMM_BF16, ST_GEMM_F32, ST_GEMM_RESID, ST_LATNORM, ST_HN_MLA, ST_HN_DS, ST_ATTN_MLA, ST_ATTN_D, ST_ATTN_S, ST_PEER };
#define SV(t, v) ((t) | ((v) << 4))
#define SR(t, v) ((t) | ((v) << 4) | 0x80)
__device__ const unsigned char STEPS[3][24] = {
  {SV(ST_NORM, 0), SV(ST_GEMM_BF16, 0), SV(ST_LATNORM, 0), SV(ST_GEMM_BF16, 1), SV(ST_GEMM_BF16, 2), SV(ST_HN_MLA, 0), SV(ST_ATTN_MLA, 0), SV(ST_GEMM_RESID, 0), SV(ST_NORM, 1), SV(ST_GEMM_F32, 0), SV(ST_PEER, 0), 0xFF},
  {SV(ST_NORM, 0), SV(ST_GEMM_BF16, 0), SV(ST_HN_DS, 0), SV(ST_ATTN_D, 0), SV(ST_GEMM_RESID, 0), SV(ST_NORM, 1), SV(ST_GEMM_F32, 0), SV(ST_PEER, 0), 0xFF},
  {SV(ST_NORM, 0), SV(ST_GEMM_BF16, 0), SV(ST_HN_DS, 0), SV(ST_ATTN_S, 0), SV(ST_GEMM_RESID, 0), SV(ST_NORM, 1), SV(ST_GEMM_F32, 0), SV(ST_PEER, 0), 0xFF}};
__global__ void __launch_bounds__(NTHREADS, 2) mega(Params p) {
  extern __shared__ __attribute__((aligned(16))) unsigned char lds_raw[];
  LAS unsigned char* lds = (LAS unsigned char*)lds_raw;
  cg::grid_group grid = cg::this_grid();
  const int tid = threadIdx.x;
  const int wv_s = __builtin_amdgcn_readfirstlane(tid >> 6);
  unsigned char* ws = p.ws;
  float* modp = (float*)(ws + WS_MODP); float* mod = (float*)(ws + WS_MOD);
  float* tab8 = (float*)(ws + WS_TAB); float* tab16 = tab8 + 64 * 8 * 2; float* lamp = tab16 + 64 * 16 * 2;
  bf16_t* xl = (bf16_t*)(ws + WS_XL); bf16_t* xc = (bf16_t*)(ws + WS_XC);
  bf16_t* wdown_t = (bf16_t*)(ws + WS_WDOWN); bf16_t* wuq_t = (bf16_t*)(ws + WS_WUQ); bf16_t* wukv_t = (bf16_t*)(ws + WS_WUKV); bf16_t* mwo_t = (bf16_t*)(ws + WS_MWO);
  bf16_t* dqkv_t = (bf16_t*)(ws + WS_DQKV); bf16_t* dwo_t = (bf16_t*)(ws + WS_DWO); bf16_t* sqkv_t = (bf16_t*)(ws + WS_SQKV); bf16_t* swo_t = (bf16_t*)(ws + WS_SWO);
  bf16_t* pwq = (bf16_t*)(ws + WS_PWQ); bf16_t* pkeys = (bf16_t*)(ws + WS_PKEYS); bf16_t* weff_t = (bf16_t*)(ws + WS_WEFF);
  unsigned char* pu = ws + WS_PU; unsigned char* pv = ws + WS_PV;
  bf16_t* Hb = (bf16_t*)(ws + WS_H); bf16_t* Ob = (bf16_t*)(ws + WS_O);
  bf16_t* B1 = (bf16_t*)(ws + WS_BUF1); bf16_t* B2 = (bf16_t*)(ws + WS_BUF2); bf16_t* B3 = (bf16_t*)(ws + WS_BUF3); bf16_t* B4 = (bf16_t*)(ws + WS_BUF4);
  bf16_t* CQN = (bf16_t*)(ws + WS_CQN); bf16_t* CKVN = (bf16_t*)(ws + WS_CKVN); float* SC = (float*)(ws + WS_SC);

  volatile LAS unsigned* xb_st = (volatile LAS unsigned*)(lds + LDS_BYTES - 16);
  if (tid < 4) xb_st[tid] = 0u;
  __syncthreads();
  (void)xcd_barrier_post((unsigned*)ws, xb_st);
  int phc = 0;
#define PH_BEGIN {
#define PH_END } ++phc; if (phc == 1) grid.sync(); else { XcdBarrier xb_; xb_.bar = (unsigned*)p.ws; xb_.x = xb_xcc_id(); xb_.st = (volatile LAS unsigned*)(lds + LDS_BYTES - 16); xcd_barrier(xb_, wv_s); }

  PH_BEGIN
    int rot = 0;
    for (int j = 0; j < 2; ++j) {
      tr_job<true>(lds, p.mla_w_down + (size_t)j * 1024 * 1056, (unsigned char*)wdown_t + (size_t)j * 1280 * 1024, 1024, 1056, 1280, rot);
      tr_job<true>(lds, p.mla_w_uq + (size_t)j * 768 * 1536, (unsigned char*)wuq_t + (size_t)j * 1536 * 768, 768, 1536, 1536, rot);
      tr_job<false>(lds, p.mla_w_ukv + (size_t)j * 256 * 2048, wukv_t + (size_t)j * 2048 * 256, 256, 2048, 2048, rot);
      tr_job<true>(lds, p.mla_w_o + (size_t)j * 1024 * 1024, (unsigned char*)mwo_t + (size_t)j * 1024 * 1024, 1024, 1024, 1024, rot);
    }
    tr_job<true>(lds, p.diff_w_qkv, dqkv_t, 1024, 3072, 3072, rot);
    tr_job<true>(lds, p.diff_w_o, dwo_t, 1024, 1024, 1024, rot);
    tr_job<true>(lds, p.swa_w_qkv, sqkv_t, 1024, 1536, 1536, rot);
    tr_job<true>(lds, p.swa_w_o, swo_t, 1024, 1024, 1024, rot);
    ada_job(lds, p, modp);
    cvt_job(p.peer_w_q, pwq, (size_t)4 * 1024 * 2048 / 8);
    cvt_job(p.peer_keys, pkeys, (size_t)4 * 16 * 128 * 128 / 8);
    {
      const int wv = tid >> 6, ln = tid & 63, l = wv >> 1; const float* t = ((wv & 1) ? p.peer_v : p.peer_u) + (size_t)l * 16384 * 1024;
      float ss = 0.f;
#pragma unroll
      for (int q = 0; q < 8; ++q) { const f32x4 v = ((const f32x4*)t)[ln + 64 * q]; ss += v.x * v.x + v.y * v.y + v.z * v.z + v.w * v.w; }
      ss = wave_sum(ss);
      const float rms = sqrtf(ss * (1.f / 2048.f));
      if (blockIdx.x == 0 && ln == 0) lamp[4 + wv] = (wv & 1) ? rms * 0.5f : rms * 0.34f;
    }
    if (blockIdx.x == 0 && tid == 0) {
      const float** t = (const float**)(ws + WS_PTRS);
      t[0] = p.x; t[1] = p.c; t[2] = p.ctx; t[3] = p.c_ctx; t[4] = p.ada_w; t[5] = p.ada_b; t[6] = p.norm_mix; t[7] = p.norm_ffn;
      t[8] = p.mla_w_down; t[9] = p.mla_g_cq; t[10] = p.mla_g_ckv; t[11] = p.mla_w_uq; t[12] = p.mla_w_ukv; t[13] = p.mla_g_q; t[14] = p.mla_g_k; t[15] = p.mla_w_o;
      t[16] = p.diff_w_qkv; t[17] = p.diff_g_q; t[18] = p.diff_g_k; t[19] = p.diff_lambda; t[20] = p.diff_g_sub; t[21] = p.diff_w_o;
      t[22] = p.swa_w_qkv; t[23] = p.swa_g_q; t[24] = p.swa_g_k; t[25] = p.swa_sink; t[26] = p.swa_w_o; t[27] = p.peer_w_q; t[28] = p.peer_keys; t[29] = p.peer_u; t[30] = p.peer_v;
    }
    if (blockIdx.x == gridDim.x - 1) {
      for (int i = tid; i < 64 * 8; i += NTHREADS) { const int pos = i >> 3, j = i & 7; const float ang = (float)pos * powf(10000.f, -(float)j / 8.f); tab8[2 * i] = cosf(ang); tab8[2 * i + 1] = sinf(ang); }
      for (int i = tid; i < 64 * 16; i += NTHREADS) { const int pos = i >> 4, j = i & 15; const float ang = (float)pos * powf(10000.f, -(float)j / 16.f); tab16[2 * i] = cosf(ang); tab16[2 * i + 1] = sinf(ang); }
      if (tid >= 64 && tid < 68) {
        const int q = tid - 64; const float* g = (q < 2) ? p.mla_g_k + q * 96 : (q == 2) ? p.diff_g_k : p.swa_g_k; const int n = (q < 2) ? 96 : 64;
        float mx = 0.f; for (int i = 0; i < n; ++i) mx = fmaxf(mx, fabsf(g[i]));
        lamp[12 + q] = sqrtf((float)n) * mx * 1.002f;
      }
      if (tid == 0) { float s01 = 0.f, s23 = 0.f; for (int i = 0; i < 64; ++i) { s01 += p.diff_lambda[i] * p.diff_lambda[64 + i]; s23 += p.diff_lambda[128 + i] * p.diff_lambda[192 + i]; }
        lamp[0] = expf(s01) - expf(s23) + LAM_INIT; }
    }
  PH_END
  PH_BEGIN
    for (int i = blockIdx.x * NTHREADS + tid; i < 4 * 9 * 6144; i += gridDim.x * NTHREADS) {
      const int col = i % 6144, l = i / (9 * 6144); float a = p.ada_b[l * 6144 + col];
#pragma unroll
      for (int kc = 0; kc < 64; ++kc) a += modp[(size_t)kc * (4 * 9 * 6144) + i];
      mod[i] = a;
    }
    for (int U = blockIdx.x; U < 256; U += gridDim.x) {
      const int q = U >> 2, l = q >> 4, hc = q & 15;
      gemm_phase(lds, pwq + (size_t)l * 1024 * 2048 + hc * 128, 2048, pkeys + (size_t)q * 128 * 128, 128, 1024, 128, 128, false,
                 EpiBf16T{weff_t + (size_t)l * 2048 * 1024 + (size_t)hc * 128 * 1024, 1024}, U & 3, 4);
    }
  PH_END

  for (int l = 0; l < 4; ++l) {
    int kind = l % 3; asm volatile("" : "+s"(kind));
    const bool last = (l == 3);
    for (int ss = 0; STEPS[kind][ss] != 0xFF; ++ss) {
      unsigned long long w_ = (unsigned long long)p.ws; asm volatile("" : "+s"(w_));
      unsigned char* w = (unsigned char*)(GAS unsigned char*)w_;
      const unsigned long long* tab = (const unsigned long long*)(w + WS_PTRS);
#define IN_(i) ((const float*)(GAS const float*)tab[i])
      bf16_t* xl = (bf16_t*)(w + WS_XL); bf16_t* xc = (bf16_t*)(w + WS_XC);
      const float* modl = (const float*)(w + WS_MOD) + (size_t)l * 9 * 6144;
      const float* tab8 = (const float*)(w + WS_TAB); const float* tab16 = tab8 + 64 * 8 * 2; const float* lamp = tab16 + 64 * 16 * 2;
      unsigned char* Hb = w + WS_H; unsigned char* Ob = w + WS_O; float* SC = (float*)(w + WS_SC);
      unsigned char* H8 = w + WS_O + 18 * MiB;
      bf16_t* LAT = (bf16_t*)(w + WS_BUF1); bf16_t* QP = (bf16_t*)(w + WS_BUF2); bf16_t* KV = (bf16_t*)(w + WS_BUF3); bf16_t* KB = (bf16_t*)(w + WS_BUF4); bf16_t* QKV = LAT;
      unsigned char* CQN = w + WS_CQN; bf16_t* CKVN = (bf16_t*)(w + WS_CKVN);
      bf16_t* QN = (bf16_t*)(w + WS_SC);
      const int ent = STEPS[kind][ss]; const int ty = ent & 15, var = (ent >> 4) & 7; const bool live = (ent & 0x80) == 0 || (p.phase == 777);
      int lo_ = l; asm volatile("" : "+s"(lo_)); const int j = (lo_ >= 3) ? 1 : 0;
      bool sync = true;
      if (ty == ST_NORM) {
        const bool first = (var == 0);
        if (first && l > 0) sync = false;
        else norm_phase(IN_(0), IN_(2), xl, xc, first && l == 0, (first ? IN_(6) : IN_(7)) + l * D, modl, first ? 0 : 3, first ? H8 : Hb, first, last && !first, wv_s);
      } else if (ty == ST_GEMM_BF16) {
        const void* A = H8; const void* Bt; bf16_t* O; int N, K = 1024;
        if (kind == 0) {
          if (var == 0) { Bt = w + WS_WDOWN + (size_t)j * 1280 * 1024; N = 1280; O = LAT; }
          else if (var == 1) { A = CQN; Bt = w + WS_WUQ + (size_t)j * 1536 * 768; N = 1536; K = 768; O = QP; sync = false; }
          else { A = CKVN; Bt = (const bf16_t*)(w + WS_WUKV) + (size_t)j * 2048 * 256; N = 2048; K = 256; O = KV; }
        } else if (kind == 1) { Bt = w + WS_DQKV; N = 3072; O = QKV; }
        else { Bt = w + WS_SQKV; N = 1536; O = QKV; }
        pg8::LatentOrder S; S.init(M, N, gridDim.x, blockIdx.x, last && kind == 0 && var == 1);
        if (kind == 0 && var == 2) pg8::gemm_phase<pg8::EpiBf16P, pg8::LatentOrder, true, true, false>(lds, pg8::Gemm{(const bf16_t*)A, (const bf16_t*)Bt, M, N, K}, S, pg8::EpiBf16P{O, N, 1.f}, wv_s);
        else pg8::gemm_phase<pg8::EpiBf16P, pg8::LatentOrder, true, true, true>(lds, pg8::Gemm{(const bf16_t*)A, (const bf16_t*)Bt, M, N, K / 2}, S, pg8::EpiBf16P{O, N, 1.f / (ASC * WSC)}, wv_s);

        {
          const int nwg_ = (false ? (M / 9) * 8 / 256 : M / 256) * (N / 256), rem_ = nwg_ % (int)gridDim.x;
          if ((rem_ == 0 || (int)blockIdx.x >= rem_) && ((var == 0) ? 0 : -1) >= 0) {
            const int E_ = (rem_ == 0) ? (int)gridDim.x : (int)gridDim.x - rem_, e_ = (rem_ == 0) ? (int)blockIdx.x : (int)blockIdx.x - rem_;
            const int s0_ = (((var == 0) ? 0 : -1) == 0) ? 0 : (((var == 0) ? 0 : -1) == 1) ? 9600 : 21000, s1_ = (((var == 0) ? 0 : -1) == 0) ? 9600 : (((var == 0) ? 0 : -1) == 1) ? 21000 : 32768;
            const int per_ = (s1_ - s0_ + E_ - 1) / E_, a_ = s0_ + e_ * per_, b_ = min(s1_, a_ + per_);
            const float su_ = 1.f / lamp[4 + 2 * l], sv_ = 1.f / lamp[5 + 2 * l];
            conv_rows(IN_(29) + (size_t)l * 16384 * 1024, IN_(30) + (size_t)l * 16384 * 1024, w + WS_PU + (size_t)l * 16384 * 512, w + WS_PV + (size_t)l * 16384 * 512, su_, sv_, a_, b_, otid(wv_s));
          }
        }
      } else if (ty == ST_GEMM_RESID) {
        const unsigned char* Bt = (kind == 0) ? w + WS_MWO + (size_t)j * 1024 * 1024 : (kind == 1) ? w + WS_DWO : w + WS_SWO;
        pg8::LatentOrder S; S.init(M, 1024, gridDim.x, blockIdx.x, last);
        pg8::gemm_phase<pg8::EpiResidN, pg8::LatentOrder, true, true, true>(lds, pg8::Gemm{(const bf16_t*)Ob, (const bf16_t*)Bt, M, 1024, 512}, S, pg8::EpiResidN{IN_(0), IN_(2), l == 0, xl, xc, modl, 2, live, 1.f / (OSC * WSC)}, wv_s);

        {
          const int nwg_ = (last ? (M / 9) * 8 / 256 : M / 256) * (1024 / 256), rem_ = nwg_ % (int)gridDim.x;
          if ((rem_ == 0 || (int)blockIdx.x >= rem_) && 1 >= 0) {
            const int E_ = (rem_ == 0) ? (int)gridDim.x : (int)gridDim.x - rem_, e_ = (rem_ == 0) ? (int)blockIdx.x : (int)blockIdx.x - rem_;
            const int s0_ = (1 == 0) ? 0 : (1 == 1) ? 9600 : 21000, s1_ = (1 == 0) ? 9600 : (1 == 1) ? 21000 : 32768;
            const int per_ = (s1_ - s0_ + E_ - 1) / E_, a_ = s0_ + e_ * per_, b_ = min(s1_, a_ + per_);
            const float su_ = 1.f / lamp[4 + 2 * l], sv_ = 1.f / lamp[5 + 2 * l];
            conv_rows(IN_(29) + (size_t)l * 16384 * 1024, IN_(30) + (size_t)l * 16384 * 1024, w + WS_PU + (size_t)l * 16384 * 512, w + WS_PV + (size_t)l * 16384 * 512, su_, sv_, a_, b_, otid(wv_s));
          }
        }
      } else if (ty == ST_GEMM_F32) {
        pg8::LatentOrder S; S.init(M, 2048, gridDim.x, blockIdx.x, last);
        pg8::gemm_phase<pg8::EpiBf16P, pg8::LatentOrder, true, true, false>(lds, pg8::Gemm{(const bf16_t*)Hb, (const bf16_t*)(w + WS_WEFF) + (size_t)l * 2048 * 1024, M, 2048, 1024}, S, pg8::EpiBf16P{(bf16_t*)SC, 2048, 1.f}, wv_s);

        {
          const int nwg_ = (last ? (M / 9) * 8 / 256 : M / 256) * (2048 / 256), rem_ = nwg_ % (int)gridDim.x;
          if ((rem_ == 0 || (int)blockIdx.x >= rem_) && 2 >= 0) {
            const int E_ = (rem_ == 0) ? (int)gridDim.x : (int)gridDim.x - rem_, e_ = (rem_ == 0) ? (int)blockIdx.x : (int)blockIdx.x - rem_;
            const int s0_ = (2 == 0) ? 0 : (2 == 1) ? 9600 : 21000, s1_ = (2 == 0) ? 9600 : (2 == 1) ? 21000 : 32768;
            const int per_ = (s1_ - s0_ + E_ - 1) / E_, a_ = s0_ + e_ * per_, b_ = min(s1_, a_ + per_);
            const float su_ = 1.f / lamp[4 + 2 * l], sv_ = 1.f / lamp[5 + 2 * l];
            conv_rows(IN_(29) + (size_t)l * 16384 * 1024, IN_(30) + (size_t)l * 16384 * 1024, w + WS_PU + (size_t)l * 16384 * 512, w + WS_PV + (size_t)l * 16384 * 512, su_, sv_, a_, b_, otid(wv_s));
          }
        }
      } else if (ty == ST_LATNORM) {
        latnorm_phase(LAT, IN_(9) + j * 768, IN_(10) + j * 256, CQN, CKVN, wv_s);
      } else if (ty == ST_HN_MLA) {
        const float qs = 0.10206207261596577f * LOG2E;
        for (int gi = blockIdx.x * NTHREADS + otid(wv_s); gi < M * 32 * 4; gi += gridDim.x * NTHREADS) {
          const int i = gi >> 2, jl = gi & 3, r = i >> 5, it = i & 31, h = it & 15; const int b = r / TPB, s = r - b * TPB; const bool lat = s < SEQ;
          if (it < 16) { const bf16_t* q = QP + (size_t)r * 1536 + h * 96; headnorm96(q, q + 64, QN + (size_t)r * 1536 + h * 96, IN_(13) + j * 96, qs, lat, s >> 6, s & 63, tab8, jl); }
          else headnorm96(KV + (size_t)r * 2048 + h * 128, LAT + (size_t)r * 1280 + 1024, KB + (size_t)r * 1536 + h * 96, IN_(14) + j * 96, 1.f, lat, s >> 6, s & 63, tab8, jl);
        }
      } else if (ty == ST_HN_DS) {
        const float qs = 0.125f * LOG2E;
        const int ipr = (kind == 1) ? 32 : 20, pitch = (kind == 1) ? 3072 : 1536, npitch = (kind == 1) ? 2048 : 1280;
        const float* gq = (kind == 1) ? IN_(17) : IN_(23); const float* gk = (kind == 1) ? IN_(18) : IN_(24);
        for (int gi = blockIdx.x * NTHREADS + otid(wv_s); gi < M * ipr * 4; gi += gridDim.x * NTHREADS) {
          const int i = gi >> 2, jl = gi & 3; int r, it; if (kind == 1) { r = i >> 5; it = i & 31; } else { r = i / 20; it = i - r * 20; }
          const int b = r / TPB, s = r - b * TPB; const bool lat = s < SEQ;
          const bf16_t* q = QKV + (size_t)r * pitch + it * 64;
          headnorm64(q, QN + (size_t)r * npitch + it * 64, (it < 16) ? gq : gk, (it < 16) ? qs : 1.f, lat, s >> 6, s & 63, tab16, jl);
        }
      } else if (ty == ST_ATTN_MLA) {
        const int nu = last ? 1024 : 1152;
        for (int u = blockIdx.x; u < nu; u += gridDim.x) {
          int bh, q0, ta0; if (u < 1024) { const int x = u & 7, y = u >> 3; bh = ((y >> 3) << 3) + x; q0 = (y & 7) * 256; ta0 = 0; } else { bh = u - 1024; q0 = SEQ; ta0 = 32; }
          const int b = bh >> 4, h = bh & 15; const size_t rb = (size_t)b * TPB;
          attn_unit_p<96, 64, false>(lds, QN + rb * 1536 + h * 96, 1536, KB + rb * 1536 + h * 96, 1536, KV + rb * 2048 + h * 128 + 64, 2048,
                                     q0, ta0, 36, 0, 0, false, 0.f, lamp[12 + j], Ob + rb * D + h * 64, D, wv_s);
        }
      } else if (ty == ST_ATTN_D) {
        const float lam = lamp[0];
        for (int u = blockIdx.x; u < 1152; u += gridDim.x) {
          int bh, q0, ta0; if (u < 1024) { const int x = u & 7, y = u >> 3; bh = ((y >> 4) << 3) + x; q0 = (y & 15) * 128; ta0 = 0; } else { bh = (u - 1024) >> 1; q0 = SEQ + ((u - 1024) & 1) * 128; ta0 = 32; }
          const int b = bh >> 3, h = bh & 7; const size_t rb = (size_t)b * TPB;
          attn_unit<64, 128, 2, false>(lds, QN + rb * 2048 + h * 128, 64, 2048, QN + rb * 2048 + 1024 + h * 128, 64, 2048, QKV + rb * 3072 + 2048 + h * 128, 3072,
                                       q0, ta0, 36, 0, 0, false, 0.f, lamp[14], Ob + rb * D + h * 128, D, lam, IN_(20), wv_s);
        }
      } else if (ty == ST_ATTN_S) {
        for (int u = blockIdx.x; u < 1152; u += gridDim.x) {
          int bh, q0, ta0, ta1; if (u < 1024) { const int x = u & 7, y = u >> 3; bh = ((y >> 3) << 3) + x; q0 = (y & 7) * 256; ta0 = max(0, q0 / 64 - 2); ta1 = min(32, q0 / 64 + 6); } else { bh = u - 1024; q0 = SEQ; ta0 = 0; ta1 = 0; }
          const int b = bh >> 4, h = bh & 15, kvh = h >> 2; const size_t rb = (size_t)b * TPB;
          attn_unit<64, 64, 1, true>(lds, QN + rb * 1280 + h * 64, 0, 1280, QN + rb * 1280 + 1024 + kvh * 64, 0, 1280, QKV + rb * 1536 + 1280 + kvh * 64, 1536,
                                     q0, ta0, ta1, 32, 36, true, IN_(25)[h] * LOG2E, lamp[15], Ob + rb * D + h * 64, D, 0.f, nullptr, wv_s);
        }
      } else {
        peer_phase(lds, (const bf16_t*)SC, Hb, w + WS_PU + (size_t)l * 16384 * 512, w + WS_PV + (size_t)l * 16384 * 512, lamp[4 + 2 * l], lamp[5 + 2 * l], modl, xl, xc, p.out, last, live, last ? nullptr : H8, IN_(6) + (l + 1) * D, modl + 9 * 6144, wv_s);
      }
#undef IN_
      if (sync) { XcdBarrier xb_; xb_.bar = (unsigned*)p.ws; xb_.x = xb_xcc_id(); xb_.st = (volatile LAS unsigned*)(lds + LDS_BYTES - 16); xcd_barrier(xb_, wv_s); }
    }
  }
#undef PH_BEGIN
#undef PH_END
}

extern "C" void kernel_launch(void* const* d_in, const int* in_sizes, int n_in, void* d_out, int out_size, void* d_ws, size_t ws_size, hipStream_t stream) {
  static int grid_blocks = 0;
  if (grid_blocks == 0) {
    int dev = 0, cus = 0, per_cu = 0;
    if (n_in != 31 || out_size != NB * SEQ * D || ws_size < WS_TOTAL) { fprintf(stderr, "kernel_launch: unexpected shapes (n_in %d out %d ws %zu)\n", n_in, out_size, ws_size); grid_blocks = -1; return; }
    (void)hipGetDevice(&dev);
    (void)hipDeviceGetAttribute(&cus, hipDeviceAttributeMultiprocessorCount, dev);
    (void)hipFuncSetAttribute((const void*)mega, hipFuncAttributeMaxDynamicSharedMemorySize, LDS_BYTES);
    (void)hipOccupancyMaxActiveBlocksPerMultiprocessor(&per_cu, (const void*)mega, NTHREADS, LDS_BYTES);
    if (per_cu < 1) { fprintf(stderr, "kernel_launch: occupancy query says %d blocks/CU\n", per_cu); per_cu = 1; }
    grid_blocks = cus;
  }
  if (grid_blocks < 0) return;
  (void)hipMemsetAsync(d_ws, 0, 16384, stream);
  Params p{};
  const float** f = (const float**)&p;
  for (int i = 0; i < 31; ++i) f[i] = (const float*)d_in[i];
  p.out = (float*)d_out; p.ws = (unsigned char*)d_ws;
  p.single = 1; p.phase = 0;
  void* args[] = {&p};
  hipError_t e = hipLaunchCooperativeKernel((const void*)mega, dim3(grid_blocks), dim3(NTHREADS), args, LDS_BYTES, stream);
  if (e != hipSuccess) fprintf(stderr, "cooperative launch failed: %s (grid %d)\n", hipGetErrorString(e), grid_blocks);
}
```

```cpp
#include <hip/hip_runtime.h>
#include <hip/hip_cooperative_groups.h>
#include <cstdio>
#include <cstdint>
namespace cg = cooperative_groups;

#define LAS __attribute__((address_space(3)))
#define GAS __attribute__((address_space(1)))
typedef unsigned short bf16_t;
typedef short bf16x8 __attribute__((ext_vector_type(8)));
typedef short v4i16_t __attribute__((ext_vector_type(4)));
typedef float f32x4 __attribute__((ext_vector_type(4)));
typedef float f32x16 __attribute__((ext_vector_type(16)));
typedef unsigned u32x4 __attribute__((ext_vector_type(4)));
typedef unsigned u32x2 __attribute__((ext_vector_type(2)));
typedef long long2_t __attribute__((ext_vector_type(2)));
typedef float f32x2_t __attribute__((ext_vector_type(2)));
typedef __bf16 bf16x2_t __attribute__((ext_vector_type(2)));

constexpr int D = 1024, NB = 8, SEQ = 2048, NCTX = 256, TPB = SEQ + NCTX  , M = NB * TPB  ;
constexpr int NTHREADS = 512, NWAVES = 8;
constexpr float EPS = 1e-6f;
constexpr float LOG2E = 1.4426950408889634f;
constexpr float LAM_INIT = 0.35550907f;
constexpr float ASC = 8.f, WSC = 64.f, OSC = 64.f;
constexpr size_t MiB = 1u << 20;
constexpr size_t WS_PTRS = 32768;
constexpr size_t WS_MODP = 352 * MiB  , WS_MOD = 8 * MiB, WS_TAB = 9 * MiB, WS_XC = 10 * MiB;
constexpr size_t WS_WDOWN = 18 * MiB, WS_WUQ = 23 * MiB, WS_WUKV = 28 * MiB, WS_MWO = 30 * MiB, WS_DQKV = 34 * MiB, WS_DWO = 40 * MiB;
constexpr size_t WS_SQKV = 42 * MiB, WS_SWO = 45 * MiB, WS_PWQ = 47 * MiB, WS_PKEYS = 63 * MiB, WS_WEFF = 65 * MiB;
constexpr size_t WS_PU = 96 * MiB, WS_PV = 224 * MiB, WS_H = 352 * MiB, WS_O = 388 * MiB, WS_BUF1 = 424 * MiB, WS_BUF2 = 532 * MiB;
constexpr size_t WS_BUF3 = 586 * MiB, WS_BUF4 = 658 * MiB, WS_CQN = 712 * MiB, WS_CKVN = 739 * MiB, WS_SC = 748 * MiB, WS_END = 892 * MiB;
constexpr size_t WS_XL = 896 * MiB, WS_TOTAL = 928 * MiB;
constexpr int LDS_BYTES = 147456;


struct Params {
  const float *x, *c, *ctx, *c_ctx, *ada_w, *ada_b, *norm_mix, *norm_ffn;
  const float *mla_w_down, *mla_g_cq, *mla_g_ckv, *mla_w_uq, *mla_w_ukv, *mla_g_q, *mla_g_k, *mla_w_o;
  const float *diff_w_qkv, *diff_g_q, *diff_g_k, *diff_lambda, *diff_g_sub, *diff_w_o;
  const float *swa_w_qkv, *swa_g_q, *swa_g_k, *swa_sink, *swa_w_o;
  const float *peer_w_q, *peer_keys, *peer_u, *peer_v;
  float* out; unsigned char* ws;
  int single, phase;
};

__device__ __forceinline__ int opaque_tid() { int t = threadIdx.x; asm volatile("" : "+v"(t)); return t; }
__device__ __forceinline__ int otid(int wv) { int w = wv; asm volatile("" : "+s"(w)); unsigned m = ~0u; asm volatile("" : "+s"(m)); const int l = (int)__builtin_amdgcn_mbcnt_hi(m, __builtin_amdgcn_mbcnt_lo(m, 0u)); return (w << 6) | l; }
__device__ __forceinline__ unsigned pk2(float lo, float hi) { f32x2_t v = {lo, hi}; bf16x2_t b = __builtin_convertvector(v, bf16x2_t); return __builtin_bit_cast(unsigned, b); }
__device__ __forceinline__ unsigned pk4_fp8(float a, float b, float c, float d) { int w = 0; w = __builtin_amdgcn_cvt_pk_fp8_f32(a, b, w, false); w = __builtin_amdgcn_cvt_pk_fp8_f32(c, d, w, true); return (unsigned)w; }
__device__ __forceinline__ float bf_lo(unsigned u) { return __uint_as_float(u << 16); }
__device__ __forceinline__ float bf_hi(unsigned u) { return __uint_as_float(u & 0xffff0000u); }
__device__ __forceinline__ float wave_sum(float v) {
#pragma unroll
  for (int o = 32; o >= 1; o >>= 1) v += __shfl_xor(v, o);
  return v;
}
__device__ __forceinline__ float dot2bf(unsigned a, unsigned b, float c) { return __builtin_amdgcn_fdot2_f32_bf16(__builtin_bit_cast(bf16x2_t, a), __builtin_bit_cast(bf16x2_t, b), c, false); }
__device__ __forceinline__ int crow(int r, int hi) { return (r & 3) + 8 * (r >> 2) + 4 * hi; }
__device__ __forceinline__ unsigned f2ord(float f) { unsigned u = __float_as_uint(f); return (u & 0x80000000u) ? ~u : (u | 0x80000000u); }
__device__ __forceinline__ float ord2f(unsigned o) { return __uint_as_float((o & 0x80000000u) ? (o & 0x7fffffffu) : ~o); }
__device__ __forceinline__ bf16_t* xrow_ptr(bf16_t* xl, bf16_t* xc, int r) {
  const int b = r / TPB, s = r - b * TPB;
  return (s < SEQ) ? xl + (size_t)(b * SEQ + s) * D : xc + (size_t)(b * NCTX + (s - SEQ)) * D;
}
__device__ __forceinline__ const float* xsrc_ptr(const float* sl, const float* sc, int r) {
  const int b = r / TPB, s = r - b * TPB;
  return (s < SEQ) ? sl + (size_t)(b * SEQ + s) * D : sc + (size_t)(b * NCTX + (s - SEQ)) * D;
}
template <bool F8>
__device__ __forceinline__ void tr_job(LAS unsigned char* lds, const float* __restrict__ W, void* __restrict__ Wt_, int K, int N, int Npad, int& rot) {
  LAS float* tile = (LAS float*)lds;
  const int nnb = Npad / 64, nit = (K / 64) * nnb, tid = opaque_tid();
  const int vb = ((int)blockIdx.x - rot % (int)gridDim.x + (int)gridDim.x) % (int)gridDim.x;
  rot += (nit + 3) / 4;
  for (int it0 = vb * 4; it0 < nit; it0 += gridDim.x * 4) {
    f32x4 v[4][2];
#pragma unroll
    for (int q = 0; q < 4; ++q) {
      const int it = it0 + q, kb = it / nnb, nb = it - kb * nnb, k0 = kb * 64, n0 = nb * 64;
#pragma unroll
      for (int i = 0; i < 2; ++i) {
        const int idx = tid + i * 512, kk = idx >> 4, nc = (idx & 15) * 4;
        v[q][i] = (f32x4){0.f, 0.f, 0.f, 0.f};
        if (it < nit && n0 + nc < N) v[q][i] = *(const f32x4*)(W + (size_t)(k0 + kk) * N + n0 + nc);
      }
    }
#pragma unroll
    for (int q = 0; q < 4; ++q)
#pragma unroll
      for (int i = 0; i < 2; ++i) {
        const int idx = tid + i * 512, kk = idx >> 4, nc = (idx & 15) * 4; LAS float* t = tile + q * (64 * 65) + kk * 65 + nc;
        t[0] = v[q][i].x; t[1] = v[q][i].y; t[2] = v[q][i].z; t[3] = v[q][i].w;
      }
    __syncthreads();
#pragma unroll
    for (int q = 0; q < 4; ++q) {
      const int it = it0 + q;
      if (it < nit) {
        const int kb = it / nnb, nb = it - kb * nnb, k0 = kb * 64, n0 = nb * 64;
        const int n = tid >> 3, kc = tid & 7;
        float f[8];
#pragma unroll
        for (int j = 0; j < 8; ++j) f[j] = tile[q * (64 * 65) + (kc * 8 + j) * 65 + n];
        if (F8) *(u32x2*)((unsigned char*)Wt_ + (size_t)(n0 + n) * K + k0 + kc * 8) = (u32x2){pk4_fp8(f[0] * WSC, f[1] * WSC, f[2] * WSC, f[3] * WSC), pk4_fp8(f[4] * WSC, f[5] * WSC, f[6] * WSC, f[7] * WSC)};
        else *(u32x4*)((bf16_t*)Wt_ + (size_t)(n0 + n) * K + k0 + kc * 8) = (u32x4){pk2(f[0], f[1]), pk2(f[2], f[3]), pk2(f[4], f[5]), pk2(f[6], f[7])};
      }
    }
    __syncthreads();
  }
}
__device__ __forceinline__ void cvt_job(const float* __restrict__ src, bf16_t* __restrict__ dst, size_t n8) {
  for (size_t i = (size_t)blockIdx.x * NTHREADS + threadIdx.x; i < n8; i += (size_t)gridDim.x * NTHREADS) {
    const f32x4 a = ((const f32x4*)src)[2 * i], b = ((const f32x4*)src)[2 * i + 1];
    ((u32x4*)dst)[i] = (u32x4){pk2(a.x, a.y), pk2(a.z, a.w), pk2(b.x, b.y), pk2(b.z, b.w)};
  }
}
__device__ __forceinline__ unsigned q4pack(f32x4 a, f32x4 b, float sc) {
  const float v[8] = {a.x, a.y, a.z, a.w, b.x, b.y, b.z, b.w}; unsigned w = 0u;
#pragma unroll
  for (int j = 0; j < 8; ++j) { int q = (int)rintf(v[j] * sc); q = min(7, max(-8, q)); w |= ((unsigned)q & 15u) << (4 * j); }
  return w;
}
__device__ __forceinline__ void conv_rows(const float* __restrict__ usrc, const float* __restrict__ vsrc, unsigned char* __restrict__ udst, unsigned char* __restrict__ vdst, float su, float sv, int r0, int r1, int tid) {
  for (int r = r0 + (tid >> 6); r < r1; r += NWAVES) {
    const bool isv = r >= 16384; const int rr = isv ? r - 16384 : r; const int c = (tid & 63);
    const f32x4* sp = (const f32x4*)((isv ? vsrc : usrc) + (size_t)rr * 1024) + c * 4;
    const f32x4 a = sp[0], b = sp[1], cc = sp[2], d = sp[3];
    u32x2 o;
    if (isv) {
      unsigned w0 = 0u, w1 = 0u;
      w0 = __builtin_amdgcn_cvt_scalef32_pk_fp4_f32(w0, a.x * sv, a.y * sv, 1.0f, 0); w0 = __builtin_amdgcn_cvt_scalef32_pk_fp4_f32(w0, a.z * sv, a.w * sv, 1.0f, 1);
      w0 = __builtin_amdgcn_cvt_scalef32_pk_fp4_f32(w0, b.x * sv, b.y * sv, 1.0f, 2); w0 = __builtin_amdgcn_cvt_scalef32_pk_fp4_f32(w0, b.z * sv, b.w * sv, 1.0f, 3);
      w1 = __builtin_amdgcn_cvt_scalef32_pk_fp4_f32(w1, cc.x * sv, cc.y * sv, 1.0f, 0); w1 = __builtin_amdgcn_cvt_scalef32_pk_fp4_f32(w1, cc.z * sv, cc.w * sv, 1.0f, 1);
      w1 = __builtin_amdgcn_cvt_scalef32_pk_fp4_f32(w1, d.x * sv, d.y * sv, 1.0f, 2); w1 = __builtin_amdgcn_cvt_scalef32_pk_fp4_f32(w1, d.z * sv, d.w * sv, 1.0f, 3);
      o = (u32x2){w0, w1};
    } else o = (u32x2){q4pack(a, b, su), q4pack(cc, d, su)};
    *(u32x2*)((isv ? vdst : udst) + (size_t)rr * 512 + c * 8) = o;
  }
}
__device__ __forceinline__ void ada_job(LAS unsigned char* lds, const Params& p, float* __restrict__ modp) {
  LAS float* s = (LAS float*)lds;
  const int tid = opaque_tid();
  for (int u = blockIdx.x; u < 768; u += gridDim.x) {
    const int l = u / 192, r = u - l * 192, cc = r >> 6, kc = r & 63;
    __syncthreads();
    if (tid < 144) { const int bi = tid >> 4, k = tid & 15; const float c = (bi < 8) ? p.c[bi * D + kc * 16 + k] : p.c_ctx[kc * 16 + k]; s[tid] = c / (1.f + __expf(-c)); }
    __syncthreads();
    f32x4 acc[9];
#pragma unroll
    for (int bi = 0; bi < 9; ++bi) acc[bi] = (f32x4){0.f, 0.f, 0.f, 0.f};
    const float* w = p.ada_w + ((size_t)l * D + kc * 16) * 6144 + cc * 2048 + tid * 4;
#pragma unroll
    for (int h = 0; h < 2; ++h) {
      f32x4 wv[8];
#pragma unroll
      for (int k = 0; k < 8; ++k) wv[k] = *(const f32x4*)(w + (size_t)(h * 8 + k) * 6144);
#pragma unroll
      for (int k = 0; k < 8; ++k)
#pragma unroll
        for (int bi = 0; bi < 9; ++bi) acc[bi] += s[bi * 16 + h * 8 + k] * wv[k];
    }
#pragma unroll
    for (int bi = 0; bi < 9; ++bi) *(f32x4*)(modp + (((size_t)kc * 4 + l) * 9 + bi) * 6144 + cc * 2048 + tid * 4) = acc[bi];
  }
}

__device__ __forceinline__ void norm_phase(const float* sl, const float* sc_, bf16_t* xl, bf16_t* xc, bool src_f32, const float* __restrict__ g, const float* __restrict__ modl, int which, unsigned char* __restrict__ H, bool out_f8, bool skip_ctx, int wv) {
  const int tid_ = otid(wv); const int lane = tid_ & 63, wid = tid_ >> 6;
  for (int r = blockIdx.x * NWAVES + wid; r < M; r += gridDim.x * NWAVES) {
    const int b = r / TPB, s = r - b * TPB; const bool isctx = s >= SEQ;
    if (skip_ctx && isctx) continue;
    const int bi = isctx ? 8 : b;
    const float* sh = modl + (size_t)(bi * 6 + which) * D; const float* sc = sh + D;
    f32x4 v[4]; float ss = 0.f;
    if (src_f32) {
      const float* xr = xsrc_ptr(sl, sc_, r);
#pragma unroll
      for (int j = 0; j < 4; ++j) v[j] = ((const f32x4*)xr)[lane + 64 * j];
    } else {
      const bf16_t* xr = xrow_ptr(xl, xc, r);
#pragma unroll
      for (int j = 0; j < 4; ++j) { const u32x2 w = ((const u32x2*)xr)[lane + 64 * j]; v[j] = (f32x4){bf_lo(w.x), bf_hi(w.x), bf_lo(w.y), bf_hi(w.y)}; }
    }
#pragma unroll
    for (int j = 0; j < 4; ++j) ss += v[j].x * v[j].x + v[j].y * v[j].y + v[j].z * v[j].z + v[j].w * v[j].w;
    ss = wave_sum(ss);
    const float rstd = rsqrtf(ss * (1.f / D) + EPS);
#pragma unroll
    for (int j = 0; j < 4; ++j) {
      const int c4 = lane + 64 * j;
      const f32x4 g4 = ((const f32x4*)g)[c4], s4 = ((const f32x4*)sc)[c4], h4 = ((const f32x4*)sh)[c4];
      const f32x4 y = v[j] * rstd * g4 * (1.f + s4) + h4;
      if (out_f8) *(unsigned*)(H + (size_t)r * D + c4 * 4) = pk4_fp8(y.x * ASC, y.y * ASC, y.z * ASC, y.w * ASC);
      else *(u32x2*)((bf16_t*)H + (size_t)r * D + c4 * 4) = (u32x2){pk2(y.x, y.y), pk2(y.z, y.w)};
    }
  }
}
__device__ __forceinline__ void latnorm_phase(const bf16_t* __restrict__ LAT, const float* __restrict__ gcq, const float* __restrict__ gckv, unsigned char* __restrict__ CQN, bf16_t* __restrict__ CKVN, int wv) {
  const int tid_ = otid(wv); const int lane = tid_ & 63, wid = tid_ >> 6;
  for (int r = blockIdx.x * NWAVES + wid; r < M; r += gridDim.x * NWAVES) {
    const bf16_t* lr = LAT + (size_t)r * 1280;
    float q[12], kv[4]; float sq = 0.f, sk = 0.f;
#pragma unroll
    for (int j = 0; j < 3; ++j) { const u32x2 w = *(const u32x2*)(lr + lane * 4 + 256 * j); q[4 * j] = bf_lo(w.x); q[4 * j + 1] = bf_hi(w.x); q[4 * j + 2] = bf_lo(w.y); q[4 * j + 3] = bf_hi(w.y); }
    { const u32x2 w = *(const u32x2*)(lr + 768 + lane * 4); kv[0] = bf_lo(w.x); kv[1] = bf_hi(w.x); kv[2] = bf_lo(w.y); kv[3] = bf_hi(w.y); }
#pragma unroll
    for (int j = 0; j < 12; ++j) sq += q[j] * q[j];
#pragma unroll
    for (int j = 0; j < 4; ++j) sk += kv[j] * kv[j];
    sq = wave_sum(sq); sk = wave_sum(sk);
    const float rq = rsqrtf(sq * (1.f / 768.f) + EPS), rk = rsqrtf(sk * (1.f / 256.f) + EPS);
#pragma unroll
    for (int j = 0; j < 3; ++j) { const int c = lane * 4 + 256 * j; const f32x4 g4 = *(const f32x4*)(gcq + c);
      *(unsigned*)(CQN + (size_t)r * 768 + c) = pk4_fp8(q[4 * j] * rq * g4.x * ASC, q[4 * j + 1] * rq * g4.y * ASC, q[4 * j + 2] * rq * g4.z * ASC, q[4 * j + 3] * rq * g4.w * ASC); }
    { const int c = lane * 4; const f32x4 g4 = *(const f32x4*)(gckv + c);
      *(u32x2*)(CKVN + (size_t)r * 256 + c) = (u32x2){pk2(kv[0] * rk * g4.x, kv[1] * rk * g4.y), pk2(kv[2] * rk * g4.z, kv[3] * rk * g4.w)}; }
  }
}

constexpr int G_AS = 144;
constexpr int G_ATILE = 256 * G_AS, G_BTILE = 128 * G_AS, G_STAGE = G_ATILE + G_BTILE;
struct EpiFp8T { unsigned char* C; int ldc;
  __device__ __forceinline__ void operator()(int row, int col, f32x4 v) const { const unsigned w = pk4_fp8(v.x * WSC, v.y * WSC, v.z * WSC, v.w * WSC);
    C[(size_t)(col + 0) * ldc + row] = (unsigned char)(w & 255u); C[(size_t)(col + 1) * ldc + row] = (unsigned char)((w >> 8) & 255u); C[(size_t)(col + 2) * ldc + row] = (unsigned char)((w >> 16) & 255u); C[(size_t)(col + 3) * ldc + row] = (unsigned char)(w >> 24); } };
struct EpiBf16T { bf16_t* C; int ldc;
  __device__ __forceinline__ void operator()(int row, int col, f32x4 v) const {
    C[(size_t)(col + 0) * ldc + row] = (bf16_t)(pk2(v.x, 0.f) & 0xffffu); C[(size_t)(col + 1) * ldc + row] = (bf16_t)(pk2(v.y, 0.f) & 0xffffu);
    C[(size_t)(col + 2) * ldc + row] = (bf16_t)(pk2(v.z, 0.f) & 0xffffu); C[(size_t)(col + 3) * ldc + row] = (bf16_t)(pk2(v.w, 0.f) & 0xffffu); } };
template <class Epi>
__device__ __forceinline__ void gemm_phase(LAS unsigned char* lds, const bf16_t* __restrict__ A, int lda, const bf16_t* __restrict__ Bt, int ldb,
                                           int Mrows, int N, int K, bool skip_ctx_tiles, const Epi epi, int ustart, int ustride) {
  const int tid = opaque_tid(), lane = tid & 63, wid = tid >> 6, wr = wid >> 1, wc = wid & 1, fr = lane & 15, fq = lane >> 4;
  const int nN = N / 128, nU = (Mrows / 256) * nN, nt = K / 64;
  const int lrow = tid >> 3, lkc = tid & 7;
  for (int u = ustart; u < nU; u += ustride) {
    const int pm = u / nN, pn = u - pm * nN;
    if (skip_ctx_tiles && (pm % 9) == 8) continue;
    const bf16_t* Ag = A + (size_t)(pm * 256 + lrow) * lda + lkc * 8;
    const bf16_t* Bg = Bt + (size_t)(pn * 128 + lrow) * ldb + lkc * 8;
    f32x4 acc[4][4];
#pragma unroll
    for (int m = 0; m < 4; ++m)
#pragma unroll
      for (int n = 0; n < 4; ++n) acc[m][n] = (f32x4){0.f, 0.f, 0.f, 0.f};
    u32x4 ra[4], rb[2];
#pragma unroll
    for (int i = 0; i < 4; ++i) ra[i] = *(const u32x4*)(Ag + (size_t)(64 * i) * lda);
#pragma unroll
    for (int i = 0; i < 2; ++i) rb[i] = *(const u32x4*)(Bg + (size_t)(64 * i) * ldb);
    {
      LAS unsigned char* sa = lds + lrow * G_AS + lkc * 16; LAS unsigned char* sb = lds + G_ATILE + lrow * G_AS + lkc * 16;
#pragma unroll
      for (int i = 0; i < 4; ++i) *(LAS u32x4*)(sa + i * 64 * G_AS) = ra[i];
#pragma unroll
      for (int i = 0; i < 2; ++i) *(LAS u32x4*)(sb + i * 64 * G_AS) = rb[i];
    }
    __syncthreads();
    for (int t = 0; t < nt; ++t) {
      const bool more = (t + 1 < nt);
      if (more) {
#pragma unroll
        for (int i = 0; i < 4; ++i) ra[i] = *(const u32x4*)(Ag + (size_t)(64 * i) * lda + (t + 1) * 64);
#pragma unroll
        for (int i = 0; i < 2; ++i) rb[i] = *(const u32x4*)(Bg + (size_t)(64 * i) * ldb + (t + 1) * 64);
      }
      const LAS unsigned char* st = lds + (t & 1) * G_STAGE;
      const LAS unsigned char* pa = st + (wr * 64 + fr) * G_AS + fq * 16;
      const LAS unsigned char* pb = st + G_ATILE + (wc * 64 + fr) * G_AS + fq * 16;
#pragma unroll
      for (int ks = 0; ks < 2; ++ks) {
        bf16x8 af[4], bfr[4];
#pragma unroll
        for (int m = 0; m < 4; ++m) af[m] = *(const LAS bf16x8*)(pa + m * 16 * G_AS + ks * 64);
#pragma unroll
        for (int n = 0; n < 4; ++n) bfr[n] = *(const LAS bf16x8*)(pb + n * 16 * G_AS + ks * 64);
#pragma unroll
        for (int m = 0; m < 4; ++m)
#pragma unroll
          for (int n = 0; n < 4; ++n) acc[m][n] = __builtin_amdgcn_mfma_f32_16x16x32_bf16(bfr[n], af[m], acc[m][n], 0, 0, 0);
      }
      if (more) {
        LAS unsigned char* sa = lds + ((t + 1) & 1) * G_STAGE + lrow * G_AS + lkc * 16; LAS unsigned char* sb = sa + G_ATILE;
#pragma unroll
        for (int i = 0; i < 4; ++i) *(LAS u32x4*)(sa + i * 64 * G_AS) = ra[i];
#pragma unroll
        for (int i = 0; i < 2; ++i) *(LAS u32x4*)(sb + i * 64 * G_AS) = rb[i];
      }
      __syncthreads();
    }
#pragma unroll
    for (int m = 0; m < 4; ++m)
#pragma unroll
      for (int n = 0; n < 4; ++n) epi(pm * 256 + wr * 64 + m * 16 + fr, pn * 128 + wc * 64 + n * 16 + fq * 4, acc[m][n]);
  }
}

namespace pg8 {
#define PG8_LAS __attribute__((address_space(3)))
typedef unsigned short bf16_t;
typedef short bf16x8 __attribute__((ext_vector_type(8)));
typedef float f32x4 __attribute__((ext_vector_type(4)));
typedef unsigned u32x4 __attribute__((ext_vector_type(4)));
constexpr int BM = 256, BK = 64, HALF = 128, HTB = HALF * BK * 2  , STAGE_BYTES = 8 * HTB, NXCD = 8, WGM = 8;

__host__ __device__ __forceinline__ int lds_byte(int r, int c) { const int st = (r >> 4) * 2 + (c >> 5), rr = r & 15, cc = c & 31, ob = rr * 64 + cc * 2; return st * 1024 + (ob ^ (((ob >> 9) & 1) << 5)); }
__host__ __device__ __forceinline__ void stage_rc(int b, int& R, int& C) { const int st = b / 1024, sb = b % 1024, swz = sb ^ (((sb >> 9) & 1) << 5); R = (st >> 1) * 16 + swz / 64; C = (st & 1) * 32 + (swz % 64) / 2; }
__host__ __device__ __forceinline__ int perm32(int rho) { const int n = rho >> 4, i = rho & 15; return 8 * (i >> 2) + 4 * n + (i & 3); }

struct Unit { int pm, pn; };
struct Gemm { const bf16_t* A; const bf16_t* Bt; int M, N, K; };

struct StaticOrder {
    int nM, nN, nwg, G, c;
    __host__ __device__ void init(int M, int N, int G_, int c_) { nM = M / BM; nN = N / BM; nwg = nM * nN; G = G_; c = c_; }
    __host__ __device__ bool next(int i, Unit& u) const {
        const long L = (long)i * G + c; if (L >= nwg) return false;
        int wgid = (int)L; { const int q = nwg / NXCD, r = nwg % NXCD, xcd = wgid % NXCD, off = wgid / NXCD; wgid = (xcd < r ? xcd * (q + 1) : r * (q + 1) + (xcd - r) * q) + off; }
        const int nig = WGM * nN, gid = wgid / nig, fm = gid * WGM, gsz = (nM - fm) < WGM ? (nM - fm) : WGM;
        u.pm = fm + ((wgid % nig) % gsz); u.pn = (wgid % nig) / gsz; return true;
    }
    __device__ __forceinline__ void a_ready(const Unit&) const {}
    __device__ __forceinline__ void done(const Unit&) const {}
};
struct LatentOrder {
    StaticOrder base; bool skip;
    __host__ __device__ void init(int M_, int N_, int G_, int c_, bool skip_) { skip = skip_; base.init(skip_ ? (M_ / 9) * 8 : M_, N_, G_, c_); }
    __host__ __device__ bool next(int i, Unit& u) const { if (!base.next(i, u)) return false; if (skip) u.pm += u.pm >> 3; return true; }
    __device__ __forceinline__ void a_ready(const Unit&) const {}
    __device__ __forceinline__ void done(const Unit&) const {}
};
struct EpiBf16P { static constexpr bool PERM = true, AFTER_DRAIN = false; bf16_t* O; int ldc; float sc;
  __device__ __forceinline__ void operator()(const f32x4 (&acc)[2][2][4][2], const Unit& u, int wr, int wc, int fr, int fq) const {
    const int row0 = u.pm * BM + wr * 64 + fr, col0 = u.pn * BM + wc * 32 + 8 * fq;
#pragma unroll
    for (int ai = 0; ai < 2; ++ai)
#pragma unroll
      for (int m = 0; m < 4; ++m) { bf16_t* rowp = O + (size_t)(row0 + ai * HALF + m * 16) * ldc + col0;
#pragma unroll
        for (int bj = 0; bj < 2; ++bj) { const f32x4 v0 = acc[ai][bj][m][0] * sc, v1 = acc[ai][bj][m][1] * sc;
          *(u32x4*)(rowp + bj * HALF) = (u32x4){pk2(v0[0], v0[1]), pk2(v0[2], v0[3]), pk2(v1[0], v1[1]), pk2(v1[2], v1[3])}; } }
  } };
struct EpiResidN { static constexpr bool PERM = false, AFTER_DRAIN = false; const float* sl; const float* sc; bool src_f32; bf16_t* xl; bf16_t* xc; const float* modl; int which; bool live; float osc;
  __device__ __forceinline__ void operator()(const f32x4 (&acc)[2][2][4][2], const Unit& u, int wr, int wc, int fr, int fq) const {
    if (!live) return;
    const int row0 = u.pm * BM + wr * 64 + fr, col0 = u.pn * BM + wc * 32 + 4 * fq;
    const int b = (u.pm * BM) / TPB, s0 = u.pm * BM - b * TPB; const int bi = (s0 >= SEQ) ? 8 : b;
    const float* gp = modl + (size_t)(bi * 6 + which) * D + col0;
#pragma unroll
    for (int bj = 0; bj < 2; ++bj)
#pragma unroll
      for (int n = 0; n < 2; ++n) { const f32x4 gt = *(const f32x4*)(gp + bj * HALF + n * 16) * osc;
#pragma unroll
        for (int ai = 0; ai < 2; ++ai)
#pragma unroll
          for (int m = 0; m < 4; ++m) { const int rr = row0 + ai * HALF + m * 16, cc = col0 + bj * HALF + n * 16;
            bf16_t* xp = xrow_ptr(xl, xc, rr) + cc; f32x4 xv;
            if (src_f32) xv = *(const f32x4*)(xsrc_ptr(sl, sc, rr) + cc);
            else { const u32x2 w = *(const u32x2*)xp; xv = (f32x4){bf_lo(w.x), bf_hi(w.x), bf_lo(w.y), bf_hi(w.y)}; }
            xv += gt * acc[ai][bj][m][n]; *(u32x2*)xp = (u32x2){pk2(xv.x, xv.y), pk2(xv.z, xv.w)}; } }
  } };
template <class Epi, class Sched, bool ALIGN_EPI = false, bool SP2 = false, bool FP8 = false>
__device__ __forceinline__ void gemm_phase(PG8_LAS unsigned char* lds, const Gemm g, const Sched& S, const Epi& E, int wv) {
    const int tid = otid(wv), wid = __builtin_amdgcn_readfirstlane(tid >> 6), lane = tid & 63, wr = wid >> 2, wc = wid & 3, fr = lane & 15, fq = lane >> 4;
    const int K = g.K, nt = K / BK;
    unsigned voffA[2], voffB[2];
#pragma unroll
    for (int i = 0; i < 2; ++i) { int R, C; stage_rc(tid * 16 + i * 8192, R, C); const int Rb = Epi::PERM ? ((R & ~31) + perm32(R & 31)) : R;
        voffA[i] = (unsigned)(R * K + C) * 2u; voffB[i] = (unsigned)(Rb * K + C) * 2u; }
    const size_t kstep = (size_t)(BK * 2);
    const size_t hstep = (size_t)HALF * K * 2;
    const size_t tstep = 2 * hstep;
    const unsigned ldsw = (unsigned)wid * 1024u;
    const int aoff = lds_byte(wr * 64 + fr, fq * 8), boff = lds_byte(wc * 32 + fr, fq * 8);
#define PG8_SA(b, h) (((b) * 2 + (h)) * HTB)
#define PG8_SB(b, h) ((4 + (b) * 2 + (h)) * HTB)
#define PG8_STAGE(bufoff, gbase, voff) do { _Pragma("unroll") for (int _i = 0; _i < 2; ++_i) \
        __builtin_amdgcn_global_load_lds((const unsigned*)((const char*)(gbase) + (voff)[_i]), (PG8_LAS unsigned*)(lds + (bufoff) + ldsw + _i * 8192), 16, 0, 0); } while (0)
#define PG8_LDA(dst, b, h) do { _Pragma("unroll") for (int m = 0; m < 4; ++m) _Pragma("unroll") for (int k = 0; k < 2; ++k) dst[m][k] = *(const PG8_LAS bf16x8*)(lds + PG8_SA(b, h) + aoff + m * 2048 + k * 1024); } while (0)
#define PG8_LDB(dst, b, h) do { _Pragma("unroll") for (int n = 0; n < 2; ++n) _Pragma("unroll") for (int k = 0; k < 2; ++k) dst[n][k] = *(const PG8_LAS bf16x8*)(lds + PG8_SB(b, h) + boff + n * 2048 + k * 1024); } while (0)
#define PG8_MMA(ai, bj, At, Bt) do { __builtin_amdgcn_s_setprio(1); _Pragma("unroll") for (int m = 0; m < 4; ++m) _Pragma("unroll") for (int n = 0; n < 2; ++n) _Pragma("unroll") for (int k = 0; k < 2; ++k) { \
        if constexpr (FP8) { const long2_t a2_ = __builtin_bit_cast(long2_t, At[m][k]), b2_ = __builtin_bit_cast(long2_t, Bt[n][k]); \
          acc[ai][bj][m][n] = __builtin_amdgcn_mfma_f32_16x16x32_fp8_fp8(b2_[0], a2_[0], acc[ai][bj][m][n], 0, 0, 0); \
          acc[ai][bj][m][n] = __builtin_amdgcn_mfma_f32_16x16x32_fp8_fp8(b2_[1], a2_[1], acc[ai][bj][m][n], 0, 0, 0); } \
        else acc[ai][bj][m][n] = __builtin_amdgcn_mfma_f32_16x16x32_bf16(Bt[n][k], At[m][k], acc[ai][bj][m][n], 0, 0, 0); } __builtin_amdgcn_s_setprio(0); } while (0)
#define PG8_WAIT_V(n) asm volatile("s_waitcnt vmcnt(" #n ")" ::: "memory")
#define PG8_WAIT_L(n) asm volatile("s_waitcnt lgkmcnt(" #n ")" ::: "memory")
#define PG8_BAR __builtin_amdgcn_s_barrier()
#define PG8_SCHED __builtin_amdgcn_sched_barrier(0)
    Unit cur, nxt; int ui = 0;
    if (!S.next(0, cur)) return;
    f32x4 acc[2][2][4][2];
#pragma unroll
    for (int a = 0; a < 2; ++a)
#pragma unroll
        for (int b = 0; b < 2; ++b)
#pragma unroll
            for (int m = 0; m < 4; ++m)
#pragma unroll
                for (int n = 0; n < 2; ++n) acc[a][b][m][n] = (f32x4){0.f, 0.f, 0.f, 0.f};
    bf16x8 At[4][2], B0[2][2], B1[2][2];
    const char* cA = (const char*)g.A + (size_t)cur.pm * tstep; const char* cB = (const char*)g.Bt + (size_t)cur.pn * tstep;
    S.a_ready(cur);
    if constexpr (SP2) {
        PG8_STAGE(PG8_SB(0, 0), cB, voffB); PG8_STAGE(PG8_SB(0, 1), cB + hstep, voffB); PG8_STAGE(PG8_SA(0, 0), cA, voffA); PG8_STAGE(PG8_SA(0, 1), cA + hstep, voffA);
        if (wr == 1) PG8_BAR;
        PG8_WAIT_V(2); PG8_BAR;
        PG8_STAGE(PG8_SB(1, 0), cB + kstep, voffB); PG8_STAGE(PG8_SA(1, 0), cA + kstep, voffA); PG8_STAGE(PG8_SB(1, 1), cB + hstep + kstep, voffB);
        PG8_WAIT_V(6); PG8_BAR;
    } else {
        PG8_STAGE(PG8_SB(0, 0), cB, voffB); PG8_STAGE(PG8_SA(0, 0), cA, voffA); PG8_STAGE(PG8_SB(0, 1), cB + hstep, voffB); PG8_STAGE(PG8_SA(0, 1), cA + hstep, voffA);
        if (wr == 1) PG8_BAR;
        PG8_WAIT_V(4); PG8_BAR;
        PG8_STAGE(PG8_SB(1, 0), cB + kstep, voffB); PG8_STAGE(PG8_SA(1, 0), cA + kstep, voffA); PG8_STAGE(PG8_SB(1, 1), cB + hstep + kstep, voffB);
        PG8_WAIT_V(6); PG8_BAR;
    }
    for (;;) {
        const bool has_next = S.next(ui + 1, nxt);
        const char* nA = has_next ? (const char*)g.A + (size_t)nxt.pm * tstep : cA; const char* nB = has_next ? (const char*)g.Bt + (size_t)nxt.pn * tstep : cB;
        for (int t = 0; t < nt; t += 2) {
            const bool last = (t == nt - 2);
            const char* a1 = cA + (size_t)(t + 1) * kstep;
            const char* a2 = last ? nA : cA + (size_t)(t + 2) * kstep; const char* b2 = last ? nB : cB + (size_t)(t + 2) * kstep;
            const char* a3 = a2 + kstep; const char* b3 = b2 + kstep;
            if (last && has_next) S.a_ready(nxt);
            if constexpr (SP2) {
            PG8_LDB(B0, 0, 0); PG8_LDB(B1, 0, 1); PG8_SCHED; PG8_LDA(At, 0, 0); PG8_STAGE(PG8_SA(1, 1), a1 + hstep, voffA);
            PG8_WAIT_V(8); PG8_WAIT_L(0); PG8_BAR; PG8_MMA(0, 0, At, B0); PG8_MMA(0, 1, At, B1); PG8_BAR; PG8_SCHED;
            PG8_LDA(At, 0, 1); PG8_STAGE(PG8_SB(0, 0), b2, voffB); PG8_STAGE(PG8_SB(0, 1), b2 + hstep, voffB); PG8_STAGE(PG8_SA(0, 0), a2, voffA);
            PG8_WAIT_V(8); PG8_WAIT_L(0); PG8_BAR; PG8_MMA(1, 0, At, B0); PG8_MMA(1, 1, At, B1); PG8_BAR; PG8_SCHED;
            PG8_LDB(B0, 1, 0); PG8_LDB(B1, 1, 1); PG8_SCHED; PG8_LDA(At, 1, 0); PG8_STAGE(PG8_SA(0, 1), a2 + hstep, voffA);
            PG8_WAIT_V(8); PG8_WAIT_L(0); PG8_BAR; PG8_MMA(0, 0, At, B0); PG8_MMA(0, 1, At, B1); PG8_BAR; PG8_SCHED;
            PG8_LDA(At, 1, 1); PG8_STAGE(PG8_SB(1, 0), b3, voffB); PG8_STAGE(PG8_SB(1, 1), b3 + hstep, voffB); PG8_STAGE(PG8_SA(1, 0), a3, voffA);
            PG8_WAIT_V(8); PG8_WAIT_L(0); PG8_BAR; PG8_MMA(1, 0, At, B0); PG8_MMA(1, 1, At, B1); PG8_BAR; PG8_SCHED;
            } else {
            PG8_LDB(B0, 0, 0); PG8_SCHED; PG8_LDA(At, 0, 0); PG8_STAGE(PG8_SA(1, 1), a1 + hstep, voffA);
            PG8_WAIT_L(8); PG8_BAR; PG8_WAIT_L(0); PG8_MMA(0, 0, At, B0); PG8_BAR; PG8_SCHED;
            PG8_LDB(B1, 0, 1); PG8_STAGE(PG8_SB(0, 0), b2, voffB);
            PG8_BAR; PG8_WAIT_L(0); PG8_MMA(0, 1, At, B1); PG8_BAR;
            PG8_LDA(At, 0, 1); PG8_STAGE(PG8_SA(0, 0), a2, voffA);
            PG8_BAR; PG8_WAIT_L(0); PG8_MMA(1, 0, At, B0); PG8_BAR; PG8_SCHED;
            PG8_STAGE(PG8_SB(0, 1), b2 + hstep, voffB);
            PG8_WAIT_V(6); PG8_BAR; PG8_MMA(1, 1, At, B1); PG8_BAR;
            PG8_LDB(B0, 1, 0); PG8_SCHED; PG8_LDA(At, 1, 0); PG8_STAGE(PG8_SA(0, 1), a2 + hstep, voffA);
            PG8_WAIT_L(8); PG8_BAR; PG8_WAIT_L(0); PG8_MMA(0, 0, At, B0); PG8_BAR; PG8_SCHED;
            PG8_LDB(B1, 1, 1); PG8_STAGE(PG8_SB(1, 0), b3, voffB);
            PG8_BAR; PG8_WAIT_L(0); PG8_MMA(0, 1, At, B1); PG8_BAR;
            PG8_LDA(At, 1, 1); PG8_STAGE(PG8_SA(1, 0), a3, voffA);
            PG8_BAR; PG8_WAIT_L(0); PG8_MMA(1, 0, At, B0); PG8_BAR; PG8_SCHED;
            PG8_STAGE(PG8_SB(1, 1), b3 + hstep, voffB);
            PG8_WAIT_V(6); PG8_BAR; PG8_MMA(1, 1, At, B1); PG8_BAR;
            }
        }
        if constexpr (ALIGN_EPI) { if (wr == 0) PG8_BAR; }
        if constexpr (!Epi::AFTER_DRAIN) { E(acc, cur, wr, wc, fr, fq); S.done(cur); }
        if (!has_next) break;
#pragma unroll
        for (int a = 0; a < 2; ++a)
#pragma unroll
            for (int b = 0; b < 2; ++b)
#pragma unroll
                for (int m = 0; m < 4; ++m)
#pragma unroll
                    for (int n = 0; n < 2; ++n) acc[a][b][m][n] = (f32x4){0.f, 0.f, 0.f, 0.f};
        cur = nxt; cA = nA; cB = nB; ++ui;
        if constexpr (ALIGN_EPI) { if (wr == 1) PG8_BAR; }
    }
    PG8_WAIT_V(0);
    if constexpr (!ALIGN_EPI) { if (wr == 0) PG8_BAR; }
    PG8_BAR;
    if constexpr (Epi::AFTER_DRAIN) { E.fused(acc, cur, wr, wc, fr, fq, lds, wid, lane); S.done(cur); }
#undef PG8_SA
#undef PG8_SB
#undef PG8_STAGE
#undef PG8_LDA
#undef PG8_LDB
#undef PG8_MMA
#undef PG8_WAIT_V
#undef PG8_WAIT_L
#undef PG8_BAR
#undef PG8_SCHED
}
}
#define UNPACK8(W, V, O) do { V[O + 0] = bf_lo(W.x); V[O + 1] = bf_hi(W.x); V[O + 2] = bf_lo(W.y); V[O + 3] = bf_hi(W.y); V[O + 4] = bf_lo(W.z); V[O + 5] = bf_hi(W.z); V[O + 6] = bf_lo(W.w); V[O + 7] = bf_hi(W.w); } while (0)
#define PACK8(V, O, SC) (u32x4){pk2(V[O] * SC, V[O + 1] * SC), pk2(V[O + 2] * SC, V[O + 3] * SC), pk2(V[O + 4] * SC, V[O + 5] * SC), pk2(V[O + 6] * SC, V[O + 7] * SC)}
__device__ __forceinline__ void headnorm96(const bf16_t* srcA, const bf16_t* srcB, bf16_t* dst, const float* __restrict__ g, float outscale, bool rope, int rowpos, int colpos,
                                           const float* __restrict__ tab8, int j) {
  const u32x4 w0 = *(const u32x4*)(srcA + j * 8), w1 = *(const u32x4*)(srcA + 32 + j * 8), w2 = *(const u32x4*)(srcB + j * 8);
  float v[24];
  UNPACK8(w0, v, 0); UNPACK8(w1, v, 8); UNPACK8(w2, v, 16);
  float ss = 0.f;
#pragma unroll
  for (int e = 0; e < 24; ++e) ss += v[e] * v[e];
  ss += __shfl_xor(ss, 1); ss += __shfl_xor(ss, 2);
  const float rstd = rsqrtf(ss * (1.f / 96.f) + EPS);
#pragma unroll
  for (int e = 0; e < 8; ++e) { v[e] *= rstd * g[j * 8 + e]; v[8 + e] *= rstd * g[32 + j * 8 + e]; v[16 + e] *= rstd * g[64 + j * 8 + e]; }
  const int pos = (j < 2) ? rowpos : colpos;
#pragma unroll
  for (int e = 0; e < 8; ++e) {
    const float own = v[16 + e], oth = __shfl_xor(own, 1);
    const f32x2_t cs = *(const f32x2_t*)(tab8 + (pos * 8 + e) * 2);
    const float res = (j & 1) ? (oth * cs.y + own * cs.x) : (own * cs.x - oth * cs.y);
    if (rope) v[16 + e] = res;
  }
  *(u32x4*)(dst + j * 8) = PACK8(v, 0, outscale); *(u32x4*)(dst + 32 + j * 8) = PACK8(v, 8, outscale); *(u32x4*)(dst + 64 + j * 8) = PACK8(v, 16, outscale);
}
__device__ __forceinline__ void headnorm64(const bf16_t* q, bf16_t* qd, const float* __restrict__ g, float outscale, bool rope, int rowpos, int colpos, const float* __restrict__ tab16, int j) {
  const u32x4 w0 = *(const u32x4*)(q + j * 8), w1 = *(const u32x4*)(q + 32 + j * 8);
  float v[16];
  UNPACK8(w0, v, 0); UNPACK8(w1, v, 8);
  float ss = 0.f;
#pragma unroll
  for (int e = 0; e < 16; ++e) ss += v[e] * v[e];
  ss += __shfl_xor(ss, 1); ss += __shfl_xor(ss, 2);
  const float rstd = rsqrtf(ss * (1.f / 64.f) + EPS);
#pragma unroll
  for (int e = 0; e < 8; ++e) { v[e] *= rstd * g[j * 8 + e]; v[8 + e] *= rstd * g[32 + j * 8 + e]; }
#pragma unroll
  for (int e = 0; e < 8; ++e) {
    const int i = (j & 1) * 8 + e;
    const float own0 = v[e], oth0 = __shfl_xor(own0, 2), own1 = v[8 + e], oth1 = __shfl_xor(own1, 2);
    const f32x2_t cr = *(const f32x2_t*)(tab16 + (rowpos * 16 + i) * 2), cc = *(const f32x2_t*)(tab16 + (colpos * 16 + i) * 2);
    const float r0 = (j >> 1) ? (oth0 * cr.y + own0 * cr.x) : (own0 * cr.x - oth0 * cr.y);
    const float r1 = (j >> 1) ? (oth1 * cc.y + own1 * cc.x) : (own1 * cc.x - oth1 * cc.y);
    if (rope) { v[e] = r0; v[8 + e] = r1; }
  }
  *(u32x4*)(qd + j * 8) = PACK8(v, 0, outscale); *(u32x4*)(qd + 32 + j * 8) = PACK8(v, 8, outscale);
}

template <int DQK, int DV, int NS, bool WINDOW>
__device__ __forceinline__ void attn_unit(LAS unsigned char* lds, const bf16_t* __restrict__ Qb, int qsoff, int ldq, const bf16_t* __restrict__ Kb, int ksoff, int ldk,
                                          const bf16_t* __restrict__ Vb, int ldv, int q0, int ta0, int ta1, int tb0, int tb1, bool has_sink, float sink_l2, float kmax,
                                          unsigned char* __restrict__ Ob, int ldo, float lam, const float* __restrict__ gsub, int wv) {
  constexpr int KS = DQK * 2 + 16, KTB = 64 * KS, VS = (DV == 64) ? 192 : 320, VOFF = NS * KTB, VTB = 64 * VS, STG = VOFF + VTB;
  constexpr int KCR = DQK / 8, KCH = 64 * KCR, VCR = DV / 8, VCH = 64 * VCR, NCH = NS * KCH + VCH, NI = (NCH + NTHREADS - 1) / NTHREADS;
  constexpr int NDB = DV / 32, NKS = DQK / 16;
  static_assert(3 * STG <= LDS_BYTES - 16 && (NS == 1 || 4 * DV * 32 * 4 <= 3 * STG), "LDS");
  const int tid = otid(wv), lane = tid & 63, wid = tid >> 6, l31 = lane & 31, hi = lane >> 5;
  const int grp = wid >> 2;
  const int qsub = (NS == 1) ? wid : (wid & 3), stream = (NS == 1) ? 0 : grp;
  const int qrow = q0 + qsub * 32 + l31;
  bf16x8 qf[NKS];
  float qn2 = 0.f;
#pragma unroll
  for (int ks = 0; ks < NKS; ++ks) {
    const u32x4 w = *(const u32x4*)(Qb + (size_t)stream * qsoff + (size_t)qrow * ldq + ks * 16 + hi * 8);
    qf[ks] = __builtin_bit_cast(bf16x8, w);
    const float a0 = bf_lo(w.x), a1 = bf_hi(w.x), a2 = bf_lo(w.y), a3 = bf_hi(w.y), a4 = bf_lo(w.z), a5 = bf_hi(w.z), a6 = bf_lo(w.w), a7 = bf_hi(w.w);
    qn2 += a0 * a0 + a1 * a1 + a2 * a2 + a3 * a3 + a4 * a4 + a5 * a5 + a6 * a6 + a7 * a7;
  }
  qn2 += __shfl_xor(qn2, 32);
  const float negmb = -(sqrtf(qn2) * kmax);
  f32x16 negmv;
  if (DV == 64) {
#pragma unroll
    for (int r = 0; r < 16; ++r) negmv[r] = negmb;
    asm volatile("" : "+v"(negmv));
  }
  f32x16 o[NDB];
#pragma unroll
  for (int db = 0; db < NDB; ++db)
#pragma unroll
    for (int r = 0; r < 16; ++r) o[db][r] = 0.f;
  float lrun = 0.f;
  const int n1 = ta1 - ta0, ntl = n1 + (tb1 - tb0);
  u32x4 st[NI];
  f32x16 p0, p1;
  const LAS unsigned char* klb = lds + stream * KTB + l31 * KS + hi * 16;
  const LAS unsigned char* vlb = lds + VOFF + (4 * hi + ((lane & 15) >> 2)) * VS + (16 * ((lane >> 4) & 1) + 4 * (lane & 3)) * 2;
#define ATT_TILE(i_) (((i_) < n1) ? ta0 + (i_) : tb0 + ((i_) - n1))
#define ATT_LOAD(T_) do { const int t__ = (T_); _Pragma("unroll") for (int ii = 0; ii < NI; ++ii) { const int c = tid + ii * NTHREADS; if (c < NCH) { \
      if (c < NS * KCH) { const int s_ = c / KCH, cc = c - s_ * KCH, row = cc / KCR, kc = cc - row * KCR; st[ii] = *(const u32x4*)(Kb + (size_t)s_ * ksoff + (size_t)(t__ * 64 + row) * ldk + kc * 8); } \
      else { const int cc = c - NS * KCH, row = cc / VCR, vc = cc - row * VCR; st[ii] = *(const u32x4*)(Vb + (size_t)(t__ * 64 + row) * ldv + vc * 8); } } } } while (0)
#define ATT_STORE(BO_) do { LAS unsigned char* sb__ = lds + (BO_); _Pragma("unroll") for (int ii = 0; ii < NI; ++ii) { const int c = tid + ii * NTHREADS; if (c < NCH) { \
      if (c < NS * KCH) { const int s_ = c / KCH, cc = c - s_ * KCH, row = cc / KCR, kc = cc - row * KCR; *(LAS u32x4*)(sb__ + s_ * KTB + row * KS + kc * 16) = st[ii]; } \
      else { const int cc = c - NS * KCH, row = cc / VCR, vc = cc - row * VCR; *(LAS u32x4*)(sb__ + VOFF + row * VS + vc * 16) = st[ii]; } } } } while (0)
#define ATT_FLAGS(T_, ACT_, MSK_) do { ACT_ = true; MSK_ = false; if (WINDOW && (T_) < 32) { const int qlo = q0 + qsub * 32, qhi = qlo + 31, klo = (T_) * 64, khi = klo + 63; \
      ACT_ = !(khi < qlo - 128 || klo > qhi + 128); MSK_ = (khi - qlo > 128) || (qhi - klo > 128); } } while (0)
  constexpr int KB1 = NKS / 2;
  bf16x8 kf[2 * KB1];
#define ATT_QK_READ1(BO_) do { const LAS unsigned char* kl = klb + (BO_); \
      _Pragma("unroll") for (int ks = 0; ks < KB1; ++ks) { kf[2 * ks] = *(const LAS bf16x8*)(kl + ks * 32); kf[2 * ks + 1] = *(const LAS bf16x8*)(kl + 32 * KS + ks * 32); } \
      __builtin_amdgcn_sched_barrier(0); } while (0)
#define ATT_QK_REST(BO_) do { const LAS unsigned char* kl = klb + (BO_); \
      __builtin_amdgcn_sched_barrier(0); \
      if (DV == 64) { p0 = __builtin_amdgcn_mfma_f32_32x32x16_bf16(kf[0], qf[0], negmv, 0, 0, 0); p1 = __builtin_amdgcn_mfma_f32_32x32x16_bf16(kf[1], qf[0], negmv, 0, 0, 0); } \
      else { _Pragma("unroll") for (int r = 0; r < 16; ++r) { p0[r] = negmb; p1[r] = negmb; } p0 = __builtin_amdgcn_mfma_f32_32x32x16_bf16(kf[0], qf[0], p0, 0, 0, 0); p1 = __builtin_amdgcn_mfma_f32_32x32x16_bf16(kf[1], qf[0], p1, 0, 0, 0); } \
      _Pragma("unroll") for (int ks = 1; ks < KB1; ++ks) { p0 = __builtin_amdgcn_mfma_f32_32x32x16_bf16(kf[2 * ks], qf[ks], p0, 0, 0, 0); p1 = __builtin_amdgcn_mfma_f32_32x32x16_bf16(kf[2 * ks + 1], qf[ks], p1, 0, 0, 0); } \
      __builtin_amdgcn_sched_barrier(0); \
      _Pragma("unroll") for (int ks = KB1; ks < NKS; ++ks) { kf[2 * (ks - KB1)] = *(const LAS bf16x8*)(kl + ks * 32); kf[2 * (ks - KB1) + 1] = *(const LAS bf16x8*)(kl + 32 * KS + ks * 32); } \
      __builtin_amdgcn_sched_barrier(0); \
      _Pragma("unroll") for (int ks = KB1; ks < NKS; ++ks) { p0 = __builtin_amdgcn_mfma_f32_32x32x16_bf16(kf[2 * (ks - KB1)], qf[ks], p0, 0, 0, 0); p1 = __builtin_amdgcn_mfma_f32_32x32x16_bf16(kf[2 * (ks - KB1) + 1], qf[ks], p1, 0, 0, 0); } \
      __builtin_amdgcn_sched_barrier(0); } while (0)
#define ATT_VREAD(G_) do { _Pragma("unroll") for (int d2 = 0; d2 < GD; ++d2) _Pragma("unroll") for (int kb = 0; kb < 2; ++kb) _Pragma("unroll") for (int s_ = 0; s_ < 2; ++s_) { \
        const LAS unsigned char* vp = vl + (kb * 32 + 16 * s_) * VS + ((G_) * GD + d2) * 64; \
        vlo[d2 * 4 + kb * 2 + s_] = __builtin_amdgcn_ds_read_tr16_b64_v4i16((LAS v4i16_t*)vp); vhi[d2 * 4 + kb * 2 + s_] = __builtin_amdgcn_ds_read_tr16_b64_v4i16((LAS v4i16_t*)(vp + 8 * VS)); } } while (0)
#define ATT_PVM(G_) do { _Pragma("unroll") for (int d2 = 0; d2 < GD; ++d2) _Pragma("unroll") for (int kb = 0; kb < 2; ++kb) _Pragma("unroll") for (int s_ = 0; s_ < 2; ++s_) { \
        const v4i16_t lo_ = vlo[d2 * 4 + kb * 2 + s_], hi_ = vhi[d2 * 4 + kb * 2 + s_]; \
        const bf16x8 vf = (bf16x8){lo_[0], lo_[1], lo_[2], lo_[3], hi_[0], hi_[1], hi_[2], hi_[3]}; \
        o[(G_) * GD + d2] = __builtin_amdgcn_mfma_f32_32x32x16_bf16(vf, __builtin_bit_cast(bf16x8, pw[kb][s_]), o[(G_) * GD + d2], 0, 0, 0); } } while (0)
#define ATT_SPV(T_, BO_, MSK_) do { const LAS unsigned char* vl = vlb + (BO_); constexpr int GD = (DV == 128) ? 1 : 2; v4i16_t vlo[4 * GD], vhi[4 * GD]; \
      ATT_VREAD(0); __builtin_amdgcn_sched_barrier(0); \
      if (WINDOW && (MSK_)) { _Pragma("unroll") for (int r = 0; r < 16; ++r) { const int d0 = (T_) * 64 + crow(r, hi) - qrow, d1 = d0 + 32; \
          if (d0 > 128 || d0 < -128) p0[r] = -INFINITY; if (d1 > 128 || d1 < -128) p1[r] = -INFINITY; } } \
      _Pragma("unroll") for (int r = 0; r < 16; ++r) { p0[r] = __builtin_amdgcn_exp2f(p0[r]); p1[r] = __builtin_amdgcn_exp2f(p1[r]); } \
      u32x4 pw[2][2]; \
      _Pragma("unroll") for (int s_ = 0; s_ < 2; ++s_) { \
        pw[0][s_] = (u32x4){pk2(p0[8 * s_], p0[8 * s_ + 1]), pk2(p0[8 * s_ + 2], p0[8 * s_ + 3]), pk2(p0[8 * s_ + 4], p0[8 * s_ + 5]), pk2(p0[8 * s_ + 6], p0[8 * s_ + 7])}; \
        pw[1][s_] = (u32x4){pk2(p1[8 * s_], p1[8 * s_ + 1]), pk2(p1[8 * s_ + 2], p1[8 * s_ + 3]), pk2(p1[8 * s_ + 4], p1[8 * s_ + 5]), pk2(p1[8 * s_ + 6], p1[8 * s_ + 7])}; } \
      _Pragma("unroll") for (int kb = 0; kb < 2; ++kb) _Pragma("unroll") for (int s_ = 0; s_ < 2; ++s_) { \
        lrun = dot2bf(pw[kb][s_].x, 0x3f803f80u, lrun); lrun = dot2bf(pw[kb][s_].y, 0x3f803f80u, lrun); lrun = dot2bf(pw[kb][s_].z, 0x3f803f80u, lrun); lrun = dot2bf(pw[kb][s_].w, 0x3f803f80u, lrun); } \
      __builtin_amdgcn_sched_barrier(0); \
      ATT_PVM(0); \
      _Pragma("unroll") for (int g_ = 1; g_ < NDB / GD; ++g_) { __builtin_amdgcn_sched_barrier(0); ATT_VREAD(g_); __builtin_amdgcn_sched_barrier(0); ATT_PVM(g_); } } while (0)
  ATT_LOAD(ATT_TILE(0));
  ATT_STORE(0);
  if (ntl > 1) ATT_LOAD(ATT_TILE(1));
  __syncthreads();
  int bo_prev = 0, bo_cur = 0, bo_next = STG;
  for (int i = 0; i <= ntl; ++i) {
    if (grp == 0) {
      if (i < ntl) {
        const int t = ATT_TILE(i);
        bool act, msk; ATT_FLAGS(t, act, msk);
        if (act) ATT_QK_READ1(bo_cur);
        if (i + 1 < ntl) ATT_STORE(bo_next);
        if (i + 2 < ntl) ATT_LOAD(ATT_TILE(i + 2));
        if (act) { ATT_QK_REST(bo_cur); ATT_SPV(t, bo_cur, msk); }
      }
    } else {
      if (i >= 1) { const int tp = ATT_TILE(i - 1); bool act, msk; ATT_FLAGS(tp, act, msk); if (act) ATT_SPV(tp, bo_prev, msk); }
      if (i < ntl) {
        const int t = ATT_TILE(i);
        bool act, msk; ATT_FLAGS(t, act, msk);
        if (act) ATT_QK_READ1(bo_cur);
        if (i + 1 < ntl) ATT_STORE(bo_next);
        if (i + 2 < ntl) ATT_LOAD(ATT_TILE(i + 2));
        if (act) ATT_QK_REST(bo_cur);
      }
    }
    bo_prev = bo_cur; bo_cur = bo_next; bo_next = (bo_next == 2 * STG) ? 0 : bo_next + STG;
    __syncthreads();
  }
#undef ATT_LOAD
#undef ATT_STORE
#undef ATT_TILE
#undef ATT_FLAGS
#undef ATT_QK_READ1
#undef ATT_QK_REST
#undef ATT_VREAD
#undef ATT_PVM
#undef ATT_SPV
  float ltot = lrun + __shfl_xor(lrun, 32);
  if (has_sink) ltot += __builtin_amdgcn_exp2f(sink_l2 + negmb);
  const float inv = 1.f / ltot;
  if (NS == 1) {
    unsigned char* op = Ob + (size_t)qrow * ldo + 4 * hi; const float is_ = inv * OSC;
#pragma unroll
    for (int db = 0; db < NDB; ++db)
#pragma unroll
      for (int r4 = 0; r4 < 4; ++r4)
        *(unsigned*)(op + db * 32 + 8 * r4) = pk4_fp8(o[db][4 * r4] * is_, o[db][4 * r4 + 1] * is_, o[db][4 * r4 + 2] * is_, o[db][4 * r4 + 3] * is_);
  } else {
    LAS float* ex = (LAS float*)lds + qsub * (DV * 32);
    if (stream == 1) {
#pragma unroll
      for (int db = 0; db < NDB; ++db)
#pragma unroll
        for (int r = 0; r < 16; ++r) ex[(db * 32 + crow(r, hi)) * 32 + l31] = o[db][r] * inv;
    }
    __syncthreads();
    if (stream == 0) {
      float ss = 0.f;
#pragma unroll
      for (int db = 0; db < NDB; ++db)
#pragma unroll
        for (int r = 0; r < 16; ++r) { const float v = o[db][r] * inv - lam * ex[(db * 32 + crow(r, hi)) * 32 + l31]; o[db][r] = v; ss += v * v; }
      ss += __shfl_xor(ss, 32);
      const float rs = rsqrtf(ss * (1.f / DV) + EPS) * (1.f - LAM_INIT);
      unsigned char* op = Ob + (size_t)qrow * ldo + 4 * hi; const float rs_ = rs * OSC;
#pragma unroll
      for (int db = 0; db < NDB; ++db)
#pragma unroll
        for (int r4 = 0; r4 < 4; ++r4) {
          const f32x4 g4 = *(const f32x4*)(gsub + db * 32 + 8 * r4 + 4 * hi);
          *(unsigned*)(op + db * 32 + 8 * r4) = pk4_fp8(o[db][4 * r4] * rs_ * g4.x, o[db][4 * r4 + 1] * rs_ * g4.y, o[db][4 * r4 + 2] * rs_ * g4.z, o[db][4 * r4 + 3] * rs_ * g4.w);
        }
    }
    __syncthreads();
  }
}

template <int DQK, int DV, bool WINDOW>
__device__ __forceinline__ void attn_unit_p(LAS unsigned char* lds, const bf16_t* __restrict__ Qb, int ldq, const bf16_t* __restrict__ Kb, int ldk, const bf16_t* __restrict__ Vb, int ldv,
                                            int q0, int ta0, int ta1, int tb0, int tb1, bool has_sink, float sink_l2, float kmax, unsigned char* __restrict__ Ob, int ldo, int wv) {
  static_assert(DV == 64 && !WINDOW, "pipelined form: DV = 64, no window");
  constexpr int KS = DQK * 2 + 16, KTB = 64 * KS, VS = 192, VOFF = KTB, VTB = 64 * VS, STG = VOFF + VTB;
  constexpr int KCR = DQK / 8, KCH = 64 * KCR, VCR = DV / 8, VCH = 64 * VCR, NCH = KCH + VCH, NI = (NCH + NTHREADS - 1) / NTHREADS;
  constexpr int NKS = DQK / 16, NQK = 2 * NKS, NPV = 8, EG = (NQK >= 12) ? 8 : NQK - 2;
  static_assert(3 * STG <= LDS_BYTES - 16, "LDS");
  const int tid = otid(wv), lane = tid & 63, wid = tid >> 6, l31 = lane & 31, hi = lane >> 5;
  const int qrow = q0 + wid * 32 + l31;
  bf16x8 qf[NKS];
  float qn2 = 0.f;
#pragma unroll
  for (int ks = 0; ks < NKS; ++ks) {
    const u32x4 w = *(const u32x4*)(Qb + (size_t)qrow * ldq + ks * 16 + hi * 8);
    qf[ks] = __builtin_bit_cast(bf16x8, w);
    const float a0 = bf_lo(w.x), a1 = bf_hi(w.x), a2 = bf_lo(w.y), a3 = bf_hi(w.y), a4 = bf_lo(w.z), a5 = bf_hi(w.z), a6 = bf_lo(w.w), a7 = bf_hi(w.w);
    qn2 += a0 * a0 + a1 * a1 + a2 * a2 + a3 * a3 + a4 * a4 + a5 * a5 + a6 * a6 + a7 * a7;
  }
  qn2 += __shfl_xor(qn2, 32);
  const float negmb = -(sqrtf(qn2) * kmax);
  f32x16 negmv;
#pragma unroll
  for (int r = 0; r < 16; ++r) negmv[r] = negmb;
  asm volatile("" : "+v"(negmv));
  f32x16 o[2];
#pragma unroll
  for (int db = 0; db < 2; ++db)
#pragma unroll
    for (int r = 0; r < 16; ++r) o[db][r] = 0.f;
  float lrun = 0.f;
  const int n1 = ta1 - ta0, ntl = n1 + (tb1 - tb0);
  u32x4 st[NI];
  f32x16 pA0, pA1, pB0, pB1;
  bf16x8 kw[3];
  v4i16_t vwl[3], vwh[3];
  u32x4 pw[2][2];
  const LAS unsigned char* klb = lds + l31 * KS + hi * 16;
  const LAS unsigned char* vlb = lds + VOFF + (4 * hi + ((lane & 15) >> 2)) * VS + (16 * ((lane >> 4) & 1) + 4 * (lane & 3)) * 2;
#define ATT_TILE(i_) (((i_) < n1) ? ta0 + (i_) : tb0 + ((i_) - n1))
  unsigned gof[NI], lof[NI];
#pragma unroll
  for (int ii = 0; ii < NI; ++ii) { const int cw = (wv + 8 * ii) * 64, c = cw + lane;
    if (cw < KCH) { const int row = c / KCR, kc = c - row * KCR; gof[ii] = (unsigned)(row * ldk + kc * 8) * 2u; lof[ii] = (unsigned)(row * KS + kc * 16); }
    else { const int cc = c - KCH, row = cc / VCR, vc = cc - row * VCR; gof[ii] = (unsigned)(row * ldv + vc * 8) * 2u; lof[ii] = (unsigned)(VOFF + row * VS + vc * 16); } }
#define ATT_LOAD(T_) do { const int t__ = (T_); _Pragma("unroll") for (int ii = 0; ii < NI; ++ii) { const int cw = (wv + 8 * ii) * 64; if (cw < NCH) { \
      const char* gb__ = (cw < KCH) ? (const char*)Kb + (size_t)t__ * 128 * ldk : (const char*)Vb + (size_t)t__ * 128 * ldv; st[ii] = *(const u32x4*)(gb__ + gof[ii]); } } } while (0)
#define ATT_STORE(BO_) do { _Pragma("unroll") for (int ii = 0; ii < NI; ++ii) { const int cw = (wv + 8 * ii) * 64; if (cw < NCH) *(LAS u32x4*)(lds + (BO_) + lof[ii]) = st[ii]; } } while (0)
#define SB_() __builtin_amdgcn_sched_barrier(0)
#define KRD1(BO_, G_) do { kw[(G_) % 3] = *(const LAS bf16x8*)(klb + (BO_) + ((G_) & 1) * 32 * KS + ((G_) >> 1) * 32); } while (0)
#define VRDG(BO_, G_) do { const LAS unsigned char* vp = vlb + (BO_) + ((((G_) >> 2) & 1) * 32 + 16 * (((G_) >> 1) & 1)) * VS + ((G_) & 1) * 64; \
      vwl[(G_) % 3] = __builtin_amdgcn_ds_read_tr16_b64_v4i16((LAS v4i16_t*)vp); vwh[(G_) % 3] = __builtin_amdgcn_ds_read_tr16_b64_v4i16((LAS v4i16_t*)(vp + 8 * VS)); } while (0)
#define QKM(R0_, R1_, G_) do { const int ks_ = (G_) >> 1; \
      if (((G_) & 1) == 0) R0_ = __builtin_amdgcn_mfma_f32_32x32x16_bf16(kw[(G_) % 3], qf[ks_], (ks_ == 0) ? negmv : R0_, 0, 0, 0); \
      else R1_ = __builtin_amdgcn_mfma_f32_32x32x16_bf16(kw[(G_) % 3], qf[ks_], (ks_ == 0) ? negmv : R1_, 0, 0, 0); } while (0)
#define PVM(G_) do { const int d2_ = (G_) & 1, kb_ = ((G_) >> 2) & 1, s_ = ((G_) >> 1) & 1; \
      const v4i16_t lo_ = vwl[(G_) % 3], hi_ = vwh[(G_) % 3]; const bf16x8 vf = (bf16x8){lo_[0], lo_[1], lo_[2], lo_[3], hi_[0], hi_[1], hi_[2], hi_[3]}; \
      o[d2_] = __builtin_amdgcn_mfma_f32_32x32x16_bf16(vf, __builtin_bit_cast(bf16x8, pw[kb_][s_]), o[d2_], 0, 0, 0); } while (0)
#define PACK1(P_, KB_, C_) do { const int s_ = (C_) >> 2, e_ = (C_) & 3; pw[KB_][s_][e_] = pk2(P_[8 * s_ + 2 * e_], P_[8 * s_ + 2 * e_ + 1]); } while (0)
#define EXPR(P_, LO_, HI_) do { _Pragma("unroll") for (int x_ = (LO_); x_ < (HI_); ++x_) { float e_ = __builtin_amdgcn_exp2f(P_[x_]); asm volatile("" : "+v"(e_)); P_[x_] = e_; } } while (0)
#define SUMR(P_, LO_, HI_) do { _Pragma("unroll") for (int x_ = (LO_); x_ < (HI_); ++x_) lrun += P_[x_]; asm volatile("" : "+v"(lrun)); } while (0)
#define FILL_A(E0_, E1_, G_) do { \
      if ((G_) < EG) EXPR(E1_, ((G_) * 16) / EG, (((G_) + 1) * 16) / EG); \
      if ((G_) >= 1 && (G_) <= EG) SUMR(E1_, (((G_) - 1) * 16) / EG, ((G_) * 16) / EG); \
      if ((G_) < EG) { _Pragma("unroll") for (int c = ((G_) * 8) / EG; c < (((G_) + 1) * 8) / EG; ++c) PACK1(E0_, 0, c); } \
      else { _Pragma("unroll") for (int c = (((G_) - EG) * 8) / (NQK - EG); c < (((G_) - EG + 1) * 8) / (NQK - EG); ++c) PACK1(E1_, 1, c); } } while (0)
#define FILL_B(R0_, G_) do { EXPR(R0_, 2 * (G_), 2 * (G_) + 2); if ((G_) >= 1) SUMR(R0_, 2 * (G_) - 2, 2 * (G_)); if ((G_) == NPV - 1) SUMR(R0_, 14, 16); } while (0)
#define STEP_MID(R0_, R1_, E0_, E1_, BOC_, BOP_) do { \
      _Pragma("unroll") for (int g = 0; g < NQK; ++g) { \
        QKM(R0_, R1_, g); \
        if (g + 2 < NQK) KRD1(BOC_, g + 2); \
        if (g >= NQK - 2) VRDG(BOP_, g - (NQK - 2)); \
        FILL_A(E0_, E1_, g); \
        SB_(); } \
      _Pragma("unroll") for (int g = 0; g < NPV; ++g) { \
        PVM(g); \
        if (g + 2 < NPV) VRDG(BOP_, g + 2); \
        FILL_B(R0_, g); \
        SB_(); } } while (0)
#define STEP_HEAD(R0_, R1_, BOC_) do { \
      _Pragma("unroll") for (int g = 0; g < NQK; ++g) { QKM(R0_, R1_, g); if (g + 2 < NQK) KRD1(BOC_, g + 2); SB_(); } \
      _Pragma("unroll") for (int g = 0; g < NPV; ++g) { FILL_B(R0_, g); } SB_(); } while (0)
#define STEP_TAIL(E0_, E1_, BOP_) do { \
      VRDG(BOP_, 0); VRDG(BOP_, 1); \
      _Pragma("unroll") for (int g = 0; g < NQK; ++g) FILL_A(E0_, E1_, g); SB_(); \
      _Pragma("unroll") for (int g = 0; g < NPV; ++g) { PVM(g); if (g + 2 < NPV) VRDG(BOP_, g + 2); SB_(); } } while (0)
#define STEP_PRE(I_, KR_) do { const int i__ = (I_); \
      if (KR_) { KRD1(bo_cur, 0); KRD1(bo_cur, 1); } \
      if (i__ + 1 < ntl) ATT_STORE(bo_next); \
      if (i__ + 2 < ntl) ATT_LOAD(ATT_TILE(i__ + 2)); \
      SB_(); } while (0)
#define STEP_POST() do { bo_prev = bo_cur; bo_cur = bo_next; bo_next = (bo_next == 2 * STG) ? 0 : bo_next + STG; __syncthreads(); } while (0)
  ATT_LOAD(ATT_TILE(0));
  ATT_STORE(0);
  if (ntl > 1) ATT_LOAD(ATT_TILE(1));
  __syncthreads();
  int bo_prev = 0, bo_cur = 0, bo_next = STG;
  STEP_PRE(0, true); STEP_HEAD(pA0, pA1, bo_cur); STEP_POST();
  int it = 1;
  for (; it + 1 < ntl; it += 2) {
    STEP_PRE(it, true); STEP_MID(pB0, pB1, pA0, pA1, bo_cur, bo_prev); STEP_POST();
    STEP_PRE(it + 1, true); STEP_MID(pA0, pA1, pB0, pB1, bo_cur, bo_prev); STEP_POST();
  }
  if (it < ntl) {
    STEP_PRE(it, true); STEP_MID(pB0, pB1, pA0, pA1, bo_cur, bo_prev); STEP_POST();
    STEP_TAIL(pB0, pB1, bo_prev);
  } else {
    STEP_TAIL(pA0, pA1, bo_prev);
  }
  __syncthreads();
#undef ATT_TILE
#undef ATT_LOAD
#undef ATT_STORE
#undef SB_
#undef KRD1
#undef VRDG
#undef QKM
#undef PVM
#undef PACK1
#undef EXPR
#undef SUMR
#undef FILL_A
#undef FILL_B
#undef STEP_MID
#undef STEP_HEAD
#undef STEP_TAIL
#undef STEP_PRE
#undef STEP_POST
  float ltot = lrun + __shfl_xor(lrun, 32);
  if (has_sink) ltot += __builtin_amdgcn_exp2f(sink_l2 + negmb);
  const float is_ = OSC / ltot;
  unsigned char* op = Ob + (size_t)qrow * ldo + 4 * hi;
#pragma unroll
  for (int db = 0; db < 2; ++db)
#pragma unroll
    for (int r4 = 0; r4 < 4; ++r4)
      *(unsigned*)(op + db * 32 + 8 * r4) = pk4_fp8(o[db][4 * r4] * is_, o[db][4 * r4 + 1] * is_, o[db][4 * r4 + 2] * is_, o[db][4 * r4 + 3] * is_);
}

#define TOPK_INSERT(ARR, KEY) do { unsigned k__ = (KEY); _Pragma("unroll") for (int t_ = 0; t_ < 16; ++t_) { const unsigned h__ = max(ARR[t_], k__); k__ = min(ARR[t_], k__); ARR[t_] = h__; } } while (0)
__device__ __forceinline__ void peer_phase(LAS unsigned char* lds, const bf16_t* __restrict__ S, const unsigned char* __restrict__ H, const unsigned char* __restrict__ U, const unsigned char* __restrict__ V, float uinv, float vinv,
                                           const float* __restrict__ modl, bf16_t* xl, bf16_t* xc, float* outf, bool last, bool live, unsigned char* Hn, const float* __restrict__ gn, const float* __restrict__ modn, int wv) {
  const int tid_ = otid(wv); const int lane = tid_ & 63, wid = tid_ >> 6;
  LAS unsigned* keysL = (LAS unsigned*)(lds + wid * 9216);
  LAS u32x2* resL = (LAS u32x2*)(lds + wid * 9216 + 4096);
  LAS float* wL = (LAS float*)(lds + wid * 9216 + 8192);
  const int ngroups = last ? (NB * SEQ / 4) : (M / 4);
  for (int g = blockIdx.x * NWAVES + wid; g < ngroups; g += gridDim.x * NWAVES) {
    const int r0 = last ? (g / (SEQ / 4)) * TPB + (g % (SEQ / 4)) * 4 : g * 4;
    const int tok = lane >> 4, hc = lane & 15;
    unsigned top[16];
    const bf16_t* sp = S + (size_t)(r0 + tok) * 2048 + hc * 128;
#define CE_DESC(A_, B_) do { const unsigned h__ = max(A_, B_), l__ = min(A_, B_); A_ = h__; B_ = l__; } while (0)
#pragma unroll 1
    for (int j0 = 0; j0 < 128; j0 += 16) {
      unsigned blk[16];
      { const u32x4 v0 = *(const u32x4*)(sp + j0), v1 = *(const u32x4*)(sp + j0 + 8);
        const unsigned base = (unsigned)(127 - j0);
        blk[0] = (f2ord(bf_lo(v0.x)) & ~127u) | (base - 0u);  blk[1] = (f2ord(bf_hi(v0.x)) & ~127u) | (base - 1u);
        blk[2] = (f2ord(bf_lo(v0.y)) & ~127u) | (base - 2u);  blk[3] = (f2ord(bf_hi(v0.y)) & ~127u) | (base - 3u);
        blk[4] = (f2ord(bf_lo(v0.z)) & ~127u) | (base - 4u);  blk[5] = (f2ord(bf_hi(v0.z)) & ~127u) | (base - 5u);
        blk[6] = (f2ord(bf_lo(v0.w)) & ~127u) | (base - 6u);  blk[7] = (f2ord(bf_hi(v0.w)) & ~127u) | (base - 7u);
        blk[8] = (f2ord(bf_lo(v1.x)) & ~127u) | (base - 8u);  blk[9] = (f2ord(bf_hi(v1.x)) & ~127u) | (base - 9u);
        blk[10] = (f2ord(bf_lo(v1.y)) & ~127u) | (base - 10u); blk[11] = (f2ord(bf_hi(v1.y)) & ~127u) | (base - 11u);
        blk[12] = (f2ord(bf_lo(v1.z)) & ~127u) | (base - 12u); blk[13] = (f2ord(bf_hi(v1.z)) & ~127u) | (base - 13u);
        blk[14] = (f2ord(bf_lo(v1.w)) & ~127u) | (base - 14u); blk[15] = (f2ord(bf_hi(v1.w)) & ~127u) | (base - 15u); }
#pragma unroll
      for (int k = 2; k <= 16; k <<= 1)
#pragma unroll
        for (int j = k >> 1; j > 0; j >>= 1)
#pragma unroll
          for (int i = 0; i < 16; ++i) { const int l = i ^ j; if (l > i) { if ((i & k) == 0) CE_DESC(blk[i], blk[l]); else CE_DESC(blk[l], blk[i]); } }
      if (j0 == 0) {
#pragma unroll
        for (int i = 0; i < 16; ++i) top[i] = blk[i];
      } else {
#pragma unroll
        for (int i = 0; i < 16; ++i) top[i] = max(top[i], blk[15 - i]);
#pragma unroll
        for (int j = 8; j > 0; j >>= 1)
#pragma unroll
          for (int i = 0; i < 16; ++i) { const int l = i ^ j; if (l > i) CE_DESC(top[i], top[l]); }
      }
    }
#undef CE_DESC
#pragma unroll
    for (int i = 0; i < 16; ++i) keysL[lane * 16 + i] = top[i];
    float v0[16], v1[16];
#pragma unroll
    for (int i = 0; i < 16; ++i) { const unsigned t1 = __shfl_down(top[i], 1); v0[i] = ord2f(top[i] & ~127u); v1[i] = ord2f(t1 & ~127u); }
    unsigned cd[16];
#pragma unroll
    for (int i = 0; i < 16; ++i) cd[i] = 0u;
#pragma unroll
    for (int a = 0; a < 16; ++a)
#pragma unroll
      for (int b = 0; b < 16 / (a + 1); ++b) TOPK_INSERT(cd, (f2ord(v0[a] + v1[b]) & ~255u) | (unsigned)(255 - (a * 16 + b)));
    {
      float e[16]; float sum = 0.f; const float mx = ord2f(cd[0] & ~255u);
#pragma unroll
      for (int k = 0; k < 16; ++k) { e[k] = __expf(ord2f(cd[k] & ~255u) - mx); sum += e[k]; }
      const float inv = 1.f / sum;
      const int lp1 = (lane + 1) & 63;
#pragma unroll
      for (int k = 0; k < 16; ++k) {
        const int pos = 255 - (int)(cd[k] & 255u), a = pos >> 4, b = pos & 15;
        const unsigned i1 = 127u - (keysL[lane * 16 + a] & 127u), i2 = 127u - (keysL[lp1 * 16 + b] & 127u);
        if ((hc & 1) == 0) resL[tok * 128 + (hc >> 1) * 16 + k] = (u32x2){i1 * 128u + i2, __float_as_uint(e[k] * inv)};
      }
    }
    for (int tk = 0; tk < 4; ++tk) {
      const int r = r0 + tk;
      float hf[16];
      { const bf16_t* hrow = (const bf16_t*)H + (size_t)r * D + lane * 16; const u32x4 ha = *(const u32x4*)hrow, hb = *(const u32x4*)(hrow + 8);
        hf[0] = bf_lo(ha.x); hf[1] = bf_hi(ha.x); hf[2] = bf_lo(ha.y); hf[3] = bf_hi(ha.y); hf[4] = bf_lo(ha.z); hf[5] = bf_hi(ha.z); hf[6] = bf_lo(ha.w); hf[7] = bf_hi(ha.w);
        hf[8] = bf_lo(hb.x); hf[9] = bf_hi(hb.x); hf[10] = bf_lo(hb.y); hf[11] = bf_hi(hb.y); hf[12] = bf_lo(hb.z); hf[13] = bf_hi(hb.z); hf[14] = bf_lo(hb.w); hf[15] = bf_hi(hb.w); }
      unsigned hq1a = 0u, hq1b = 0u, hq2a = 0u, hq2b = 0u; float hstep;
      { float ss = 0.f;
#pragma unroll
        for (int j = 0; j < 16; ++j) ss += hf[j] * hf[j];
        ss = wave_sum(ss);
        hstep = 0.5f * sqrtf(ss * (1.f / D) + 1e-20f); const float rs = 1.f / hstep;
#pragma unroll
        for (int j = 0; j < 16; ++j) {
          const float t = hf[j] * rs; int q1 = (int)rintf(t); q1 = min(7, max(-8, q1));
          int q2 = (int)rintf((t - (float)q1) * 16.f); q2 = min(7, max(-8, q2));
          if (j < 8) { hq1a |= ((unsigned)q1 & 15u) << (4 * j); hq2a |= ((unsigned)q2 & 15u) << (4 * j); }
          else { hq1b |= ((unsigned)q1 & 15u) << (4 * (j - 8)); hq2b |= ((unsigned)q2 & 15u) << (4 * (j - 8)); }
        } }
      const float uscale = uinv * hstep * (1.f / 16.f);
      f32x2_t o2[8];
#pragma unroll
      for (int j = 0; j < 8; ++j) o2[j] = (f32x2_t){0.f, 0.f};
      const bool b5 = (lane & 32) != 0, b4 = (lane & 16) != 0, b3 = (lane & 8) != 0, b2 = (lane & 4) != 0;
      const int ei = (lane >> 2) & 15;
      u32x2 ua[16], va[16], ub[16], vb[16];
      const unsigned lane8 = (unsigned)lane * 8u;
#define PEER_LOAD(UU, VV, BT) do { _Pragma("unroll") for (int i = 0; i < 16; ++i) { const unsigned o_ = resL[tk * 128 + (BT) * 16 + i].x * 512u + lane8;     \
        UU[i] = *(const u32x2*)(U + o_); VV[i] = *(const u32x2*)(V + o_); } } while (0)
#define PEER_PROC(UU, VV, BT) do { float d[16]; \
        _Pragma("unroll") for (int i = 0; i < 16; ++i) { const int w0 = (int)UU[i].x, w1 = (int)UU[i].y; \
          const int i1 = __builtin_amdgcn_sdot8(w1, (int)hq1b, __builtin_amdgcn_sdot8(w0, (int)hq1a, 0, false), false); \
          const int i2 = __builtin_amdgcn_sdot8(w1, (int)hq2b, __builtin_amdgcn_sdot8(w0, (int)hq2a, 0, false), false); \
          d[i] = (float)(i1 * 16 + i2); } \
        float k8[8], k4[4], k2[2], k1; \
        _Pragma("unroll") for (int i = 0; i < 8; ++i) { const auto r_ = __builtin_amdgcn_permlane32_swap(__float_as_uint(d[i]), __float_as_uint(d[8 + i]), false, false); k8[i] = __uint_as_float(r_[0]) + __uint_as_float(r_[1]); } \
        _Pragma("unroll") for (int i = 0; i < 4; ++i) { const auto r_ = __builtin_amdgcn_permlane16_swap(__float_as_uint(k8[i]), __float_as_uint(k8[4 + i]), false, false); k4[i] = __uint_as_float(r_[0]) + __uint_as_float(r_[1]); } \
        _Pragma("unroll") for (int i = 0; i < 2; ++i) { \
          const float sa = k4[i] + __int_as_float(__builtin_amdgcn_update_dpp(0, __float_as_int(k4[i]), 0x128, 0xf, 0xf, false)); \
          const float sb = k4[2 + i] + __int_as_float(__builtin_amdgcn_update_dpp(0, __float_as_int(k4[2 + i]), 0x128, 0xf, 0xf, false)); \
          k2[i] = b3 ? sb : sa; } \
        { const float keep = b2 ? k2[1] : k2[0], send = b2 ? k2[0] : k2[1]; k1 = keep + __shfl_xor(send, 4); } \
        k1 += __shfl_xor(k1, 2); k1 += __shfl_xor(k1, 1); \
        const float tot = k1 * uscale; \
        const float gate = __uint_as_float(resL[tk * 128 + (BT) * 16 + ei].y); \
        const float wact = 0.5f * tot * (1.f + erff(tot * 0.70710678118f)) * gate * vinv; \
        _Pragma("unroll") for (int i = 0; i < 16; ++i) { const float wi = __int_as_float(__builtin_amdgcn_readlane(__float_as_int(wact), 4 * i)); const f32x2_t w2 = {wi, wi}; const unsigned w0 = VV[i].x, w1 = VV[i].y; \
          o2[0] = __builtin_elementwise_fma(__builtin_amdgcn_cvt_scalef32_pk_f32_fp4(w0, 1.0f, 0), w2, o2[0]); o2[1] = __builtin_elementwise_fma(__builtin_amdgcn_cvt_scalef32_pk_f32_fp4(w0, 1.0f, 1), w2, o2[1]); \
          o2[2] = __builtin_elementwise_fma(__builtin_amdgcn_cvt_scalef32_pk_f32_fp4(w0, 1.0f, 2), w2, o2[2]); o2[3] = __builtin_elementwise_fma(__builtin_amdgcn_cvt_scalef32_pk_f32_fp4(w0, 1.0f, 3), w2, o2[3]); \
          o2[4] = __builtin_elementwise_fma(__builtin_amdgcn_cvt_scalef32_pk_f32_fp4(w1, 1.0f, 0), w2, o2[4]); o2[5] = __builtin_elementwise_fma(__builtin_amdgcn_cvt_scalef32_pk_f32_fp4(w1, 1.0f, 1), w2, o2[5]); \
          o2[6] = __builtin_elementwise_fma(__builtin_amdgcn_cvt_scalef32_pk_f32_fp4(w1, 1.0f, 2), w2, o2[6]); o2[7] = __builtin_elementwise_fma(__builtin_amdgcn_cvt_scalef32_pk_f32_fp4(w1, 1.0f, 3), w2, o2[7]); } } while (0)
      PEER_LOAD(ua, va, 0);
      for (int bt = 0; bt < 8; bt += 2) {
        PEER_LOAD(ub, vb, bt + 1);
        PEER_PROC(ua, va, bt);
        if (bt + 2 < 8) PEER_LOAD(ua, va, bt + 2);
        PEER_PROC(ub, vb, bt + 1);
      }
#undef PEER_LOAD
#undef PEER_PROC
      if (live) {
        const int b = r / TPB, s = r - b * TPB; const int bi = (s >= SEQ) ? 8 : b;
        bf16_t* xp = xrow_ptr(xl, xc, r) + lane * 16; const float* gt = modl + (size_t)(bi * 6 + 5) * D + lane * 16;
        f32x4 xn[4]; float ss = 0.f;
        { const u32x4 xa = *(const u32x4*)xp, xb = *(const u32x4*)(xp + 8);
          xn[0] = (f32x4){bf_lo(xa.x), bf_hi(xa.x), bf_lo(xa.y), bf_hi(xa.y)}; xn[1] = (f32x4){bf_lo(xa.z), bf_hi(xa.z), bf_lo(xa.w), bf_hi(xa.w)};
          xn[2] = (f32x4){bf_lo(xb.x), bf_hi(xb.x), bf_lo(xb.y), bf_hi(xb.y)}; xn[3] = (f32x4){bf_lo(xb.z), bf_hi(xb.z), bf_lo(xb.w), bf_hi(xb.w)}; }
#pragma unroll
        for (int q = 0; q < 4; ++q) {
          const f32x4 gv = ((const f32x4*)gt)[q];
          xn[q] += gv * (f32x4){o2[2 * q].x, o2[2 * q].y, o2[2 * q + 1].x, o2[2 * q + 1].y};
          ss += xn[q].x * xn[q].x + xn[q].y * xn[q].y + xn[q].z * xn[q].z + xn[q].w * xn[q].w;
        }
        if (last) {
          float* op = outf + (size_t)(b * SEQ + s) * D + lane * 16;
#pragma unroll
          for (int q = 0; q < 4; ++q) ((f32x4*)op)[q] = xn[q];
        } else {
          *(u32x4*)xp = (u32x4){pk2(xn[0].x, xn[0].y), pk2(xn[0].z, xn[0].w), pk2(xn[1].x, xn[1].y), pk2(xn[1].z, xn[1].w)};
          *(u32x4*)(xp + 8) = (u32x4){pk2(xn[2].x, xn[2].y), pk2(xn[2].z, xn[2].w), pk2(xn[3].x, xn[3].y), pk2(xn[3].z, xn[3].w)};
        }
        if (Hn != nullptr) {
          ss = wave_sum(ss);
          const float rstd = rsqrtf(ss * (1.f / D) + EPS);
          const float* sh = modn + (size_t)(bi * 6) * D + lane * 16; const float* sc = sh + D; const float* gg = gn + lane * 16;
          u32x4 h0;
#pragma unroll
          for (int q = 0; q < 4; ++q) {
            const f32x4 g4 = ((const f32x4*)gg)[q], s4 = ((const f32x4*)sc)[q], h4 = ((const f32x4*)sh)[q];
            const f32x4 y = (xn[q] * rstd * g4 * (1.f + s4) + h4) * ASC;
            h0[q] = pk4_fp8(y.x, y.y, y.z, y.w);
          }
          *(u32x4*)(Hn + (size_t)r * D + lane * 16) = h0;
        }
      }
    }
  }
}

#define XB_TMO      128
#define XB_XCNT(j)  (256  + 64 * (j))
#define XB_XSUB(j)  (1280 + 64 * (j))
#define XB_XGEN(j)  (2304 + 64 * (j))
#define XB_TOP      3328
#define XB_TOPGEN   3392
#define XCD_BAR_WORDS 3456
#define XB_SPIN_CAP (1u << 20)
__device__ __forceinline__ unsigned xb_ld(unsigned* p)              { return __hip_atomic_load(p, __ATOMIC_RELAXED, __HIP_MEMORY_SCOPE_AGENT); }
__device__ __forceinline__ unsigned xb_add(unsigned* p, unsigned v) { return __hip_atomic_fetch_add(p, v, __ATOMIC_RELAXED, __HIP_MEMORY_SCOPE_AGENT); }
__device__ __forceinline__ unsigned xb_xcc_id() { return (unsigned)__builtin_amdgcn_s_getreg((3 << 11) | 20) & 0xFu; }
#define XB_SPIN(cond, bar) do { unsigned _sp = 0; while (cond) { __builtin_amdgcn_s_sleep(1); \
    if ((++_sp & 255u) == 0u) { if (xb_ld(&(bar)[XB_TMO])) break; if (_sp > XB_SPIN_CAP) { atomicAdd(&(bar)[XB_TMO], 1u); break; } } } } while (0)
struct XcdBarrier { unsigned* bar; unsigned x; volatile LAS unsigned* st; };
__device__ __forceinline__ XcdBarrier xcd_barrier_post(unsigned* bar, volatile LAS unsigned* st) {
    XcdBarrier b; b.bar = bar; b.x = xb_xcc_id(); b.st = st;
    if (threadIdx.x == 0) (void)xb_add(&bar[XB_XCNT(b.x)], 1u);
    return b;
}
__device__ __forceinline__ void xcd_barrier_complete(unsigned* bar, unsigned x, unsigned& nloc, unsigned& nx) {
    const unsigned G = gridDim.x * gridDim.y * gridDim.z;
    unsigned sum, cnt, mine, sp = 0u;
    for (;;) {
        sum = 0u; cnt = 0u; mine = 0u;
#pragma unroll
        for (unsigned j = 0; j < 16; ++j) { const unsigned c = xb_ld(&bar[XB_XCNT(j)]); sum += c; cnt += (c > 0u) ? 1u : 0u; mine = (j == x) ? c : mine; }
        if (sum == G) break;
        __builtin_amdgcn_s_sleep(1);
        if ((++sp & 255u) == 0u) { if (xb_ld(&bar[XB_TMO])) break; if (sp > XB_SPIN_CAP) { atomicAdd(&bar[XB_TMO], 1u); break; } }
    }
    nloc = mine > 0u ? mine : 1u; nx = cnt > 0u ? cnt : 1u;
}
__device__ __forceinline__ void xcd_barrier(const XcdBarrier& b, int wv) {
    asm volatile("s_waitcnt vmcnt(0)" ::: "memory");
    __syncthreads();
    if (otid(wv) == 0) {
        unsigned* bar = b.bar;
        __builtin_amdgcn_s_waitcnt(0);
        unsigned nloc = b.st[0], nx = b.st[1];
        if (nloc == 0u) { xcd_barrier_complete(bar, b.x, nloc, nx); b.st[0] = nloc; b.st[1] = nx; }
        const unsigned old = xb_add(&bar[XB_XSUB(b.x)], 1u);
        const unsigned gen = old / nloc;
        if (old + 1u == (gen + 1u) * nloc) {
            __builtin_amdgcn_fence(__ATOMIC_RELEASE, "agent");
            asm volatile("s_waitcnt vmcnt(0)" ::: "memory");
            const unsigned og = xb_add(&bar[XB_TOP], 1u);
            const unsigned tg = og / nx;
            if (og + 1u == (tg + 1u) * nx) xb_add(&bar[XB_TOPGEN], 1u);
            else XB_SPIN(xb_ld(&bar[XB_TOPGEN]) == tg, bar);
            __builtin_amdgcn_fence(__ATOMIC_ACQUIRE, "agent");
            xb_add(&bar[XB_XGEN(b.x)], 1u);
            asm volatile("s_waitcnt vmcnt(0)" ::: "memory");
        } else {
            XB_SPIN(xb_ld(&bar[XB_XGEN(b.x)]) == gen, bar);
            __builtin_amdgcn_fence(__ATOMIC_ACQUIRE, "agent");
            asm volatile("s_waitcnt vmcnt(0)" ::: "memory");
        }
    }
    __syncthreads();
}

enum { ST_NORM = 0, ST_GEMM_BF16, ST_GEMM_F32, ST_GEMM_RESID, ST_LATNORM, ST_HN_MLA, ST_HN_DS, ST_ATTN_MLA, ST_ATTN_D, ST_ATTN_S, ST_PEER };
#define SV(t, v) ((t) | ((v) << 4))
#define SR(t, v) ((t) | ((v) << 4) | 0x80)
__device__ const unsigned char STEPS[3][24] = {
  {SV(ST_NORM, 0), SV(ST_GEMM_BF16, 0), SV(ST_LATNORM, 0), SV(ST_GEMM_BF16, 1), SV(ST_GEMM_BF16, 2), SV(ST_HN_MLA, 0), SV(ST_ATTN_MLA, 0), SV(ST_GEMM_RESID, 0), SV(ST_NORM, 1), SV(ST_GEMM_F32, 0), SV(ST_PEER, 0), 0xFF},
  {SV(ST_NORM, 0), SV(ST_GEMM_BF16, 0), SV(ST_HN_DS, 0), SV(ST_ATTN_D, 0), SV(ST_GEMM_RESID, 0), SV(ST_NORM, 1), SV(ST_GEMM_F32, 0), SV(ST_PEER, 0), 0xFF},
  {SV(ST_NORM, 0), SV(ST_GEMM_BF16, 0), SV(ST_HN_DS, 0), SV(ST_ATTN_S, 0), SV(ST_GEMM_RESID, 0), SV(ST_NORM, 1), SV(ST_GEMM_F32, 0), SV(ST_PEER, 0), 0xFF}};
__global__ void __launch_bounds__(NTHREADS, 2) mega(Params p) {
  extern __shared__ __attribute__((aligned(16))) unsigned char lds_raw[];
  LAS unsigned char* lds = (LAS unsigned char*)lds_raw;
  cg::grid_group grid = cg::this_grid();
  const int tid = threadIdx.x;
  const int wv_s = __builtin_amdgcn_readfirstlane(tid >> 6);
  unsigned char* ws = p.ws;
  float* modp = (float*)(ws + WS_MODP); float* mod = (float*)(ws + WS_MOD);
  float* tab8 = (float*)(ws + WS_TAB); float* tab16 = tab8 + 64 * 8 * 2; float* lamp = tab16 + 64 * 16 * 2;
  bf16_t* xl = (bf16_t*)(ws + WS_XL); bf16_t* xc = (bf16_t*)(ws + WS_XC);
  bf16_t* wdown_t = (bf16_t*)(ws + WS_WDOWN); bf16_t* wuq_t = (bf16_t*)(ws + WS_WUQ); bf16_t* wukv_t = (bf16_t*)(ws + WS_WUKV); bf16_t* mwo_t = (bf16_t*)(ws + WS_MWO);
  bf16_t* dqkv_t = (bf16_t*)(ws + WS_DQKV); bf16_t* dwo_t = (bf16_t*)(ws + WS_DWO); bf16_t* sqkv_t = (bf16_t*)(ws + WS_SQKV); bf16_t* swo_t = (bf16_t*)(ws + WS_SWO);
  bf16_t* pwq = (bf16_t*)(ws + WS_PWQ); bf16_t* pkeys = (bf16_t*)(ws + WS_PKEYS); bf16_t* weff_t = (bf16_t*)(ws + WS_WEFF);
  unsigned char* pu = ws + WS_PU; unsigned char* pv = ws + WS_PV;
  bf16_t* Hb = (bf16_t*)(ws + WS_H); bf16_t* Ob = (bf16_t*)(ws + WS_O);
  bf16_t* B1 = (bf16_t*)(ws + WS_BUF1); bf16_t* B2 = (bf16_t*)(ws + WS_BUF2); bf16_t* B3 = (bf16_t*)(ws + WS_BUF3); bf16_t* B4 = (bf16_t*)(ws + WS_BUF4);
  bf16_t* CQN = (bf16_t*)(ws + WS_CQN); bf16_t* CKVN = (bf16_t*)(ws + WS_CKVN); float* SC = (float*)(ws + WS_SC);

  volatile LAS unsigned* xb_st = (volatile LAS unsigned*)(lds + LDS_BYTES - 16);
  if (tid < 4) xb_st[tid] = 0u;
  __syncthreads();
  (void)xcd_barrier_post((unsigned*)ws, xb_st);
  int phc = 0;
#define PH_BEGIN {
#define PH_END } ++phc; if (phc == 1) grid.sync(); else { XcdBarrier xb_; xb_.bar = (unsigned*)p.ws; xb_.x = xb_xcc_id(); xb_.st = (volatile LAS unsigned*)(lds + LDS_BYTES - 16); xcd_barrier(xb_, wv_s); }

  PH_BEGIN
    int rot = 0;
    for (int j = 0; j < 2; ++j) {
      tr_job<true>(lds, p.mla_w_down + (size_t)j * 1024 * 1056, (unsigned char*)wdown_t + (size_t)j * 1280 * 1024, 1024, 1056, 1280, rot);
      tr_job<true>(lds, p.mla_w_uq + (size_t)j * 768 * 1536, (unsigned char*)wuq_t + (size_t)j * 1536 * 768, 768, 1536, 1536, rot);
      tr_job<false>(lds, p.mla_w_ukv + (size_t)j * 256 * 2048, wukv_t + (size_t)j * 2048 * 256, 256, 2048, 2048, rot);
      tr_job<true>(lds, p.mla_w_o + (size_t)j * 1024 * 1024, (unsigned char*)mwo_t + (size_t)j * 1024 * 1024, 1024, 1024, 1024, rot);
    }
    tr_job<true>(lds, p.diff_w_qkv, dqkv_t, 1024, 3072, 3072, rot);
    tr_job<true>(lds, p.diff_w_o, dwo_t, 1024, 1024, 1024, rot);
    tr_job<true>(lds, p.swa_w_qkv, sqkv_t, 1024, 1536, 1536, rot);
    tr_job<true>(lds, p.swa_w_o, swo_t, 1024, 1024, 1024, rot);
    ada_job(lds, p, modp);
    cvt_job(p.peer_w_q, pwq, (size_t)4 * 1024 * 2048 / 8);
    cvt_job(p.peer_keys, pkeys, (size_t)4 * 16 * 128 * 128 / 8);
    {
      const int wv = tid >> 6, ln = tid & 63, l = wv >> 1; const float* t = ((wv & 1) ? p.peer_v : p.peer_u) + (size_t)l * 16384 * 1024;
      float ss = 0.f;
#pragma unroll
      for (int q = 0; q < 8; ++q) { const f32x4 v = ((const f32x4*)t)[ln + 64 * q]; ss += v.x * v.x + v.y * v.y + v.z * v.z + v.w * v.w; }
      ss = wave_sum(ss);
      const float rms = sqrtf(ss * (1.f / 2048.f));
      if (blockIdx.x == 0 && ln == 0) lamp[4 + wv] = (wv & 1) ? rms * 0.5f : rms * 0.34f;
    }
    if (blockIdx.x == 0 && tid == 0) {
      const float** t = (const float**)(ws + WS_PTRS);
      t[0] = p.x; t[1] = p.c; t[2] = p.ctx; t[3] = p.c_ctx; t[4] = p.ada_w; t[5] = p.ada_b; t[6] = p.norm_mix; t[7] = p.norm_ffn;
      t[8] = p.mla_w_down; t[9] = p.mla_g_cq; t[10] = p.mla_g_ckv; t[11] = p.mla_w_uq; t[12] = p.mla_w_ukv; t[13] = p.mla_g_q; t[14] = p.mla_g_k; t[15] = p.mla_w_o;
      t[16] = p.diff_w_qkv; t[17] = p.diff_g_q; t[18] = p.diff_g_k; t[19] = p.diff_lambda; t[20] = p.diff_g_sub; t[21] = p.diff_w_o;
      t[22] = p.swa_w_qkv; t[23] = p.swa_g_q; t[24] = p.swa_g_k; t[25] = p.swa_sink; t[26] = p.swa_w_o; t[27] = p.peer_w_q; t[28] = p.peer_keys; t[29] = p.peer_u; t[30] = p.peer_v;
    }
    if (blockIdx.x == gridDim.x - 1) {
      for (int i = tid; i < 64 * 8; i += NTHREADS) { const int pos = i >> 3, j = i & 7; const float ang = (float)pos * powf(10000.f, -(float)j / 8.f); tab8[2 * i] = cosf(ang); tab8[2 * i + 1] = sinf(ang); }
      for (int i = tid; i < 64 * 16; i += NTHREADS) { const int pos = i >> 4, j = i & 15; const float ang = (float)pos * powf(10000.f, -(float)j / 16.f); tab16[2 * i] = cosf(ang); tab16[2 * i + 1] = sinf(ang); }
      if (tid >= 64 && tid < 68) {
        const int q = tid - 64; const float* g = (q < 2) ? p.mla_g_k + q * 96 : (q == 2) ? p.diff_g_k : p.swa_g_k; const int n = (q < 2) ? 96 : 64;
        float mx = 0.f; for (int i = 0; i < n; ++i) mx = fmaxf(mx, fabsf(g[i]));
        lamp[12 + q] = sqrtf((float)n) * mx * 1.002f;
      }
      if (tid == 0) { float s01 = 0.f, s23 = 0.f; for (int i = 0; i < 64; ++i) { s01 += p.diff_lambda[i] * p.diff_lambda[64 + i]; s23 += p.diff_lambda[128 + i] * p.diff_lambda[192 + i]; }
        lamp[0] = expf(s01) - expf(s23) + LAM_INIT; }
    }
  PH_END
  PH_BEGIN
    for (int i = blockIdx.x * NTHREADS + tid; i < 4 * 9 * 6144; i += gridDim.x * NTHREADS) {
      const int col = i % 6144, l = i / (9 * 6144); float a = p.ada_b[l * 6144 + col];
#pragma unroll
      for (int kc = 0; kc < 64; ++kc) a += modp[(size_t)kc * (4 * 9 * 6144) + i];
      mod[i] = a;
    }
    for (int U = blockIdx.x; U < 256; U += gridDim.x) {
      const int q = U >> 2, l = q >> 4, hc = q & 15;
      gemm_phase(lds, pwq + (size_t)l * 1024 * 2048 + hc * 128, 2048, pkeys + (size_t)q * 128 * 128, 128, 1024, 128, 128, false,
                 EpiBf16T{weff_t + (size_t)l * 2048 * 1024 + (size_t)hc * 128 * 1024, 1024}, U & 3, 4);
    }
  PH_END

  for (int l = 0; l < 4; ++l) {
    int kind = l % 3; asm volatile("" : "+s"(kind));
    const bool last = (l == 3);
    for (int ss = 0; STEPS[kind][ss] != 0xFF; ++ss) {
      unsigned long long w_ = (unsigned long long)p.ws; asm volatile("" : "+s"(w_));
      unsigned char* w = (unsigned char*)(GAS unsigned char*)w_;
      const unsigned long long* tab = (const unsigned long long*)(w + WS_PTRS);
#define IN_(i) ((const float*)(GAS const float*)tab[i])
      bf16_t* xl = (bf16_t*)(w + WS_XL); bf16_t* xc = (bf16_t*)(w + WS_XC);
      const float* modl = (const float*)(w + WS_MOD) + (size_t)l * 9 * 6144;
      const float* tab8 = (const float*)(w + WS_TAB); const float* tab16 = tab8 + 64 * 8 * 2; const float* lamp = tab16 + 64 * 16 * 2;
      unsigned char* Hb = w + WS_H; unsigned char* Ob = w + WS_O; float* SC = (float*)(w + WS_SC);
      unsigned char* H8 = w + WS_O + 18 * MiB;
      bf16_t* LAT = (bf16_t*)(w + WS_BUF1); bf16_t* QP = (bf16_t*)(w + WS_BUF2); bf16_t* KV = (bf16_t*)(w + WS_BUF3); bf16_t* KB = (bf16_t*)(w + WS_BUF4); bf16_t* QKV = LAT;
      unsigned char* CQN = w + WS_CQN; bf16_t* CKVN = (bf16_t*)(w + WS_CKVN);
      bf16_t* QN = (bf16_t*)(w + WS_SC);
      const int ent = STEPS[kind][ss]; const int ty = ent & 15, var = (ent >> 4) & 7; const bool live = (ent & 0x80) == 0 || (p.phase == 777);
      int lo_ = l; asm volatile("" : "+s"(lo_)); const int j = (lo_ >= 3) ? 1 : 0;
      bool sync = true;
      if (ty == ST_NORM) {
        const bool first = (var == 0);
        if (first && l > 0) sync = false;
        else norm_phase(IN_(0), IN_(2), xl, xc, first && l == 0, (first ? IN_(6) : IN_(7)) + l * D, modl, first ? 0 : 3, first ? H8 : Hb, first, last && !first, wv_s);
      } else if (ty == ST_GEMM_BF16) {
        const void* A = H8; const void* Bt; bf16_t* O; int N, K = 1024;
        if (kind == 0) {
          if (var == 0) { Bt = w + WS_WDOWN + (size_t)j * 1280 * 1024; N = 1280; O = LAT; }
          else if (var == 1) { A = CQN; Bt = w + WS_WUQ + (size_t)j * 1536 * 768; N = 1536; K = 768; O = QP; sync = false; }
          else { A = CKVN; Bt = (const bf16_t*)(w + WS_WUKV) + (size_t)j * 2048 * 256; N = 2048; K = 256; O = KV; }
        } else if (kind == 1) { Bt = w + WS_DQKV; N = 3072; O = QKV; }
        else { Bt = w + WS_SQKV; N = 1536; O = QKV; }
        pg8::LatentOrder S; S.init(M, N, gridDim.x, blockIdx.x, last && kind == 0 && var == 1);
        if (kind == 0 && var == 2) pg8::gemm_phase<pg8::EpiBf16P, pg8::LatentOrder, true, true, false>(lds, pg8::Gemm{(const bf16_t*)A, (const bf16_t*)Bt, M, N, K}, S, pg8::EpiBf16P{O, N, 1.f}, wv_s);
        else pg8::gemm_phase<pg8::EpiBf16P, pg8::LatentOrder, true, true, true>(lds, pg8::Gemm{(const bf16_t*)A, (const bf16_t*)Bt, M, N, K / 2}, S, pg8::EpiBf16P{O, N, 1.f / (ASC * WSC)}, wv_s);

        {
          const int nwg_ = (false ? (M / 9) * 8 / 256 : M / 256) * (N / 256), rem_ = nwg_ % (int)gridDim.x;
          if ((rem_ == 0 || (int)blockIdx.x >= rem_) && ((var == 0) ? 0 : -1) >= 0) {
            const int E_ = (rem_ == 0) ? (int)gridDim.x : (int)gridDim.x - rem_, e_ = (rem_ == 0) ? (int)blockIdx.x : (int)blockIdx.x - rem_;
            const int s0_ = (((var == 0) ? 0 : -1) == 0) ? 0 : (((var == 0) ? 0 : -1) == 1) ? 9600 : 21000, s1_ = (((var == 0) ? 0 : -1) == 0) ? 9600 : (((var == 0) ? 0 : -1) == 1) ? 21000 : 32768;
            const int per_ = (s1_ - s0_ + E_ - 1) / E_, a_ = s0_ + e_ * per_, b_ = min(s1_, a_ + per_);
            const float su_ = 1.f / lamp[4 + 2 * l], sv_ = 1.f / lamp[5 + 2 * l];
            conv_rows(IN_(29) + (size_t)l * 16384 * 1024, IN_(30) + (size_t)l * 16384 * 1024, w + WS_PU + (size_t)l * 16384 * 512, w + WS_PV + (size_t)l * 16384 * 512, su_, sv_, a_, b_, otid(wv_s));
          }
        }
      } else if (ty == ST_GEMM_RESID) {
        const unsigned char* Bt = (kind == 0) ? w + WS_MWO + (size_t)j * 1024 * 1024 : (kind == 1) ? w + WS_DWO : w + WS_SWO;
        pg8::LatentOrder S; S.init(M, 1024, gridDim.x, blockIdx.x, last);
        pg8::gemm_phase<pg8::EpiResidN, pg8::LatentOrder, true, true, true>(lds, pg8::Gemm{(const bf16_t*)Ob, (const bf16_t*)Bt, M, 1024, 512}, S, pg8::EpiResidN{IN_(0), IN_(2), l == 0, xl, xc, modl, 2, live, 1.f / (OSC * WSC)}, wv_s);

        {
          const int nwg_ = (last ? (M / 9) * 8 / 256 : M / 256) * (1024 / 256), rem_ = nwg_ % (int)gridDim.x;
          if ((rem_ == 0 || (int)blockIdx.x >= rem_) && 1 >= 0) {
            const int E_ = (rem_ == 0) ? (int)gridDim.x : (int)gridDim.x - rem_, e_ = (rem_ == 0) ? (int)blockIdx.x : (int)blockIdx.x - rem_;
            const int s0_ = (1 == 0) ? 0 : (1 == 1) ? 9600 : 21000, s1_ = (1 == 0) ? 9600 : (1 == 1) ? 21000 : 32768;
            const int per_ = (s1_ - s0_ + E_ - 1) / E_, a_ = s0_ + e_ * per_, b_ = min(s1_, a_ + per_);
            const float su_ = 1.f / lamp[4 + 2 * l], sv_ = 1.f / lamp[5 + 2 * l];
            conv_rows(IN_(29) + (size_t)l * 16384 * 1024, IN_(30) + (size_t)l * 16384 * 1024, w + WS_PU + (size_t)l * 16384 * 512, w + WS_PV + (size_t)l * 16384 * 512, su_, sv_, a_, b_, otid(wv_s));
          }
        }
      } else if (ty == ST_GEMM_F32) {
        pg8::LatentOrder S; S.init(M, 2048, gridDim.x, blockIdx.x, last);
        pg8::gemm_phase<pg8::EpiBf16P, pg8::LatentOrder, true, true, false>(lds, pg8::Gemm{(const bf16_t*)Hb, (const bf16_t*)(w + WS_WEFF) + (size_t)l * 2048 * 1024, M, 2048, 1024}, S, pg8::EpiBf16P{(bf16_t*)SC, 2048, 1.f}, wv_s);

        {
          const int nwg_ = (last ? (M / 9) * 8 / 256 : M / 256) * (2048 / 256), rem_ = nwg_ % (int)gridDim.x;
          if ((rem_ == 0 || (int)blockIdx.x >= rem_) && 2 >= 0) {
            const int E_ = (rem_ == 0) ? (int)gridDim.x : (int)gridDim.x - rem_, e_ = (rem_ == 0) ? (int)blockIdx.x : (int)blockIdx.x - rem_;
            const int s0_ = (2 == 0) ? 0 : (2 == 1) ? 9600 : 21000, s1_ = (2 == 0) ? 9600 : (2 == 1) ? 21000 : 32768;
            const int per_ = (s1_ - s0_ + E_ - 1) / E_, a_ = s0_ + e_ * per_, b_ = min(s1_, a_ + per_);
            const float su_ = 1.f / lamp[4 + 2 * l], sv_ = 1.f / lamp[5 + 2 * l];
            conv_rows(IN_(29) + (size_t)l * 16384 * 1024, IN_(30) + (size_t)l * 16384 * 1024, w + WS_PU + (size_t)l * 16384 * 512, w + WS_PV + (size_t)l * 16384 * 512, su_, sv_, a_, b_, otid(wv_s));
          }
        }
      } else if (ty == ST_LATNORM) {
        latnorm_phase(LAT, IN_(9) + j * 768, IN_(10) + j * 256, CQN, CKVN, wv_s);
      } else if (ty == ST_HN_MLA) {
        const float qs = 0.10206207261596577f * LOG2E;
        for (int gi = blockIdx.x * NTHREADS + otid(wv_s); gi < M * 32 * 4; gi += gridDim.x * NTHREADS) {
          const int i = gi >> 2, jl = gi & 3, r = i >> 5, it = i & 31, h = it & 15; const int b = r / TPB, s = r - b * TPB; const bool lat = s < SEQ;
          if (it < 16) { const bf16_t* q = QP + (size_t)r * 1536 + h * 96; headnorm96(q, q + 64, QN + (size_t)r * 1536 + h * 96, IN_(13) + j * 96, qs, lat, s >> 6, s & 63, tab8, jl); }
          else headnorm96(KV + (size_t)r * 2048 + h * 128, LAT + (size_t)r * 1280 + 1024, KB + (size_t)r * 1536 + h * 96, IN_(14) + j * 96, 1.f, lat, s >> 6, s & 63, tab8, jl);
        }
      } else if (ty == ST_HN_DS) {
        const float qs = 0.125f * LOG2E;
        const int ipr = (kind == 1) ? 32 : 20, pitch = (kind == 1) ? 3072 : 1536, npitch = (kind == 1) ? 2048 : 1280;
        const float* gq = (kind == 1) ? IN_(17) : IN_(23); const float* gk = (kind == 1) ? IN_(18) : IN_(24);
        for (int gi = blockIdx.x * NTHREADS + otid(wv_s); gi < M * ipr * 4; gi += gridDim.x * NTHREADS) {
          const int i = gi >> 2, jl = gi & 3; int r, it; if (kind == 1) { r = i >> 5; it = i & 31; } else { r = i / 20; it = i - r * 20; }
          const int b = r / TPB, s = r - b * TPB; const bool lat = s < SEQ;
          const bf16_t* q = QKV + (size_t)r * pitch + it * 64;
          headnorm64(q, QN + (size_t)r * npitch + it * 64, (it < 16) ? gq : gk, (it < 16) ? qs : 1.f, lat, s >> 6, s & 63, tab16, jl);
        }
      } else if (ty == ST_ATTN_MLA) {
        const int nu = last ? 1024 : 1152;
        for (int u = blockIdx.x; u < nu; u += gridDim.x) {
          int bh, q0, ta0; if (u < 1024) { const int x = u & 7, y = u >> 3; bh = ((y >> 3) << 3) + x; q0 = (y & 7) * 256; ta0 = 0; } else { bh = u - 1024; q0 = SEQ; ta0 = 32; }
          const int b = bh >> 4, h = bh & 15; const size_t rb = (size_t)b * TPB;
          attn_unit_p<96, 64, false>(lds, QN + rb * 1536 + h * 96, 1536, KB + rb * 1536 + h * 96, 1536, KV + rb * 2048 + h * 128 + 64, 2048,
                                     q0, ta0, 36, 0, 0, false, 0.f, lamp[12 + j], Ob + rb * D + h * 64, D, wv_s);
        }
      } else if (ty == ST_ATTN_D) {
        const float lam = lamp[0];
        for (int u = blockIdx.x; u < 1152; u += gridDim.x) {
          int bh, q0, ta0; if (u < 1024) { const int x = u & 7, y = u >> 3; bh = ((y >> 4) << 3) + x; q0 = (y & 15) * 128; ta0 = 0; } else { bh = (u - 1024) >> 1; q0 = SEQ + ((u - 1024) & 1) * 128; ta0 = 32; }
          const int b = bh >> 3, h = bh & 7; const size_t rb = (size_t)b * TPB;
          attn_unit<64, 128, 2, false>(lds, QN + rb * 2048 + h * 128, 64, 2048, QN + rb * 2048 + 1024 + h * 128, 64, 2048, QKV + rb * 3072 + 2048 + h * 128, 3072,
                                       q0, ta0, 36, 0, 0, false, 0.f, lamp[14], Ob + rb * D + h * 128, D, lam, IN_(20), wv_s);
        }
      } else if (ty == ST_ATTN_S) {
        for (int u = blockIdx.x; u < 1152; u += gridDim.x) {
          int bh, q0, ta0, ta1; if (u < 1024) { const int x = u & 7, y = u >> 3; bh = ((y >> 3) << 3) + x; q0 = (y & 7) * 256; ta0 = max(0, q0 / 64 - 2); ta1 = min(32, q0 / 64 + 6); } else { bh = u - 1024; q0 = SEQ; ta0 = 0; ta1 = 0; }
          const int b = bh >> 4, h = bh & 15, kvh = h >> 2; const size_t rb = (size_t)b * TPB;
          attn_unit<64, 64, 1, true>(lds, QN + rb * 1280 + h * 64, 0, 1280, QN + rb * 1280 + 1024 + kvh * 64, 0, 1280, QKV + rb * 1536 + 1280 + kvh * 64, 1536,
                                     q0, ta0, ta1, 32, 36, true, IN_(25)[h] * LOG2E, lamp[15], Ob + rb * D + h * 64, D, 0.f, nullptr, wv_s);
        }
      } else {
        peer_phase(lds, (const bf16_t*)SC, Hb, w + WS_PU + (size_t)l * 16384 * 512, w + WS_PV + (size_t)l * 16384 * 512, lamp[4 + 2 * l], lamp[5 + 2 * l], modl, xl, xc, p.out, last, live, last ? nullptr : H8, IN_(6) + (l + 1) * D, modl + 9 * 6144, wv_s);
      }
#undef IN_
      if (sync) { XcdBarrier xb_; xb_.bar = (unsigned*)p.ws; xb_.x = xb_xcc_id(); xb_.st = (volatile LAS unsigned*)(lds + LDS_BYTES - 16); xcd_barrier(xb_, wv_s); }
    }
  }
#undef PH_BEGIN
#undef PH_END
}

extern "C" void kernel_launch(void* const* d_in, const int* in_sizes, int n_in, void* d_out, int out_size, void* d_ws, size_t ws_size, hipStream_t stream) {
  static int grid_blocks = 0;
  if (grid_blocks == 0) {
    int dev = 0, cus = 0, per_cu = 0;
    if (n_in != 31 || out_size != NB * SEQ * D || ws_size < WS_TOTAL) { fprintf(stderr, "kernel_launch: unexpected shapes (n_in %d out %d ws %zu)\n", n_in, out_size, ws_size); grid_blocks = -1; return; }
    (void)hipGetDevice(&dev);
    (void)hipDeviceGetAttribute(&cus, hipDeviceAttributeMultiprocessorCount, dev);
    (void)hipFuncSetAttribute((const void*)mega, hipFuncAttributeMaxDynamicSharedMemorySize, LDS_BYTES);
    (void)hipOccupancyMaxActiveBlocksPerMultiprocessor(&per_cu, (const void*)mega, NTHREADS, LDS_BYTES);
    if (per_cu < 1) { fprintf(stderr, "kernel_launch: occupancy query says %d blocks/CU\n", per_cu); per_cu = 1; }
    grid_blocks = cus;
  }
  if (grid_blocks < 0) return;
  (void)hipMemsetAsync(d_ws, 0, 16384, stream);
  Params p{};
  const float** f = (const float**)&p;
  for (int i = 0; i < 31; ++i) f[i] = (const float*)d_in[i];
  p.out = (float*)d_out; p.ws = (unsigned char*)d_ws;
  p.single = 1; p.phase = 0;
  void* args[] = {&p};
  hipError_t e = hipLaunchCooperativeKernel((const void*)mega, dim3(grid_blocks), dim3(NTHREADS), args, LDS_BYTES, stream);
  if (e != hipSuccess) fprintf(stderr, "cooperative launch failed: %s (grid %d)\n", hipGetErrorString(e), grid_blocks);
}
```

```cpp
#include <hip/hip_runtime.h>
#include <hip/hip_cooperative_groups.h>
#include <cstdio>
#include <cstdint>
namespace cg = cooperative_groups;

#define LAS __attribute__((address_space(3)))
#define GAS __attribute__((address_space(1)))
typedef unsigned short bf16_t;
typedef short bf16x8 __attribute__((ext_vector_type(8)));
typedef short v4i16_t __attribute__((ext_vector_type(4)));
typedef float f32x4 __attribute__((ext_vector_type(4)));
typedef float f32x16 __attribute__((ext_vector_type(16)));
typedef unsigned u32x4 __attribute__((ext_vector_type(4)));
typedef unsigned u32x2 __attribute__((ext_vector_type(2)));
typedef long long2_t __attribute__((ext_vector_type(2)));
typedef float f32x2_t __attribute__((ext_vector_type(2)));
typedef __bf16 bf16x2_t __attribute__((ext_vector_type(2)));

constexpr int D = 1024, NB = 8, SEQ = 2048, NCTX = 256, TPB = SEQ + NCTX  , M = NB * TPB  ;
constexpr int NTHREADS = 512, NWAVES = 8;
constexpr float EPS = 1e-6f;
constexpr float LOG2E = 1.4426950408889634f;
constexpr float LAM_INIT = 0.35550907f;
constexpr float ASC = 8.f, WSC = 64.f, OSC = 64.f;
constexpr size_t MiB = 1u << 20;
constexpr size_t WS_PTRS = 32768;
constexpr size_t WS_MODP = 352 * MiB  , WS_MOD = 8 * MiB, WS_TAB = 9 * MiB, WS_XC = 10 * MiB;
constexpr size_t WS_WDOWN = 18 * MiB, WS_WUQ = 23 * MiB, WS_WUKV = 28 * MiB, WS_MWO = 30 * MiB, WS_DQKV = 34 * MiB, WS_DWO = 40 * MiB;
constexpr size_t WS_SQKV = 42 * MiB, WS_SWO = 45 * MiB, WS_PWQ = 47 * MiB, WS_PKEYS = 63 * MiB, WS_WEFF = 65 * MiB;
constexpr size_t WS_PU = 96 * MiB, WS_PV = 224 * MiB, WS_H = 352 * MiB, WS_O = 388 * MiB, WS_BUF1 = 424 * MiB, WS_BUF2 = 532 * MiB;
constexpr size_t WS_BUF3 = 586 * MiB, WS_BUF4 = 658 * MiB, WS_CQN = 712 * MiB, WS_CKVN = 739 * MiB, WS_SC = 748 * MiB, WS_END = 892 * MiB;
constexpr size_t WS_XL = 896 * MiB, WS_TOTAL = 928 * MiB;
constexpr int LDS_BYTES = 147456;


struct Params {
  const float *x, *c, *ctx, *c_ctx, *ada_w, *ada_b, *norm_mix, *norm_ffn;
  const float *mla_w_down, *mla_g_cq, *mla_g_ckv, *mla_w_uq, *mla_w_ukv, *mla_g_q, *mla_g_k, *mla_w_o;
  const float *diff_w_qkv, *diff_g_q, *diff_g_k, *diff_lambda, *diff_g_sub, *diff_w_o;
  const float *swa_w_qkv, *swa_g_q, *swa_g_k, *swa_sink, *swa_w_o;
  const float *peer_w_q, *peer_keys, *peer_u, *peer_v;
  float* out; unsigned char* ws;
  int single, phase;
};

__device__ __forceinline__ int opaque_tid() { int t = threadIdx.x; asm volatile("" : "+v"(t)); return t; }
__device__ __forceinline__ int otid(int wv) { int w = wv; asm volatile("" : "+s"(w)); unsigned m = ~0u; asm volatile("" : "+s"(m)); const int l = (int)__builtin_amdgcn_mbcnt_hi(m, __builtin_amdgcn_mbcnt_lo(m, 0u)); return (w << 6) | l; }
__device__ __forceinline__ unsigned pk2(float lo, float hi) { f32x2_t v = {lo, hi}; bf16x2_t b = __builtin_convertvector(v, bf16x2_t); return __builtin_bit_cast(unsigned, b); }
__device__ __forceinline__ unsigned pk4_fp8(float a, float b, float c, float d) { int w = 0; w = __builtin_amdgcn_cvt_pk_fp8_f32(a, b, w, false); w = __builtin_amdgcn_cvt_pk_fp8_f32(c, d, w, true); return (unsigned)w; }
__device__ __forceinline__ float bf_lo(unsigned u) { return __uint_as_float(u << 16); }
__device__ __forceinline__ float bf_hi(unsigned u) { return __uint_as_float(u & 0xffff0000u); }
__device__ __forceinline__ float wave_sum(float v) {
#pragma unroll
  for (int o = 32; o >= 1; o >>= 1) v += __shfl_xor(v, o);
  return v;
}
__device__ __forceinline__ float dot2bf(unsigned a, unsigned b, float c) { return __builtin_amdgcn_fdot2_f32_bf16(__builtin_bit_cast(bf16x2_t, a), __builtin_bit_cast(bf16x2_t, b), c, false); }
__device__ __forceinline__ int crow(int r, int hi) { return (r & 3) + 8 * (r >> 2) + 4 * hi; }
__device__ __forceinline__ unsigned f2ord(float f) { unsigned u = __float_as_uint(f); return (u & 0x80000000u) ? ~u : (u | 0x80000000u); }
__device__ __forceinline__ float ord2f(unsigned o) { return __uint_as_float((o & 0x80000000u) ? (o & 0x7fffffffu) : ~o); }
__device__ __forceinline__ bf16_t* xrow_ptr(bf16_t* xl, bf16_t* xc, int r) {
  const int b = r / TPB, s = r - b * TPB;
  return (s < SEQ) ? xl + (size_t)(b * SEQ + s) * D : xc + (size_t)(b * NCTX + (s - SEQ)) * D;
}
__device__ __forceinline__ const float* xsrc_ptr(const float* sl, const float* sc, int r) {
  const int b = r / TPB, s = r - b * TPB;
  return (s < SEQ) ? sl + (size_t)(b * SEQ + s) * D : sc + (size_t)(b * NCTX + (s - SEQ)) * D;
}
template <bool F8>
__device__ __forceinline__ void tr_job(LAS unsigned char* lds, const float* __restrict__ W, void* __restrict__ Wt_, int K, int N, int Npad, int& rot) {
  LAS float* tile = (LAS float*)lds;
  const int nnb = Npad / 64, nit = (K / 64) * nnb, tid = opaque_tid();
  const int vb = ((int)blockIdx.x - rot % (int)gridDim.x + (int)gridDim.x) % (int)gridDim.x;
  rot += (nit + 3) / 4;
  for (int it0 = vb * 4; it0 < nit; it0 += gridDim.x * 4) {
    f32x4 v[4][2];
#pragma unroll
    for (int q = 0; q < 4; ++q) {
      const int it = it0 + q, kb = it / nnb, nb = it - kb * nnb, k0 = kb * 64, n0 = nb * 64;
#pragma unroll
      for (int i = 0; i < 2; ++i) {
        const int idx = tid + i * 512, kk = idx >> 4, nc = (idx & 15) * 4;
        v[q][i] = (f32x4){0.f, 0.f, 0.f, 0.f};
        if (it < nit && n0 + nc < N) v[q][i] = *(const f32x4*)(W + (size_t)(k0 + kk) * N + n0 + nc);
      }
    }
#pragma unroll
    for (int q = 0; q < 4; ++q)
#pragma unroll
      for (int i = 0; i < 2; ++i) {
        const int idx = tid + i * 512, kk = idx >> 4, nc = (idx & 15) * 4; LAS float* t = tile + q * (64 * 65) + kk * 65 + nc;
        t[0] = v[q][i].x; t[1] = v[q][i].y; t[2] = v[q][i].z; t[3] = v[q][i].w;
      }
    __syncthreads();
#pragma unroll
    for (int q = 0; q < 4; ++q) {
      const int it = it0 + q;
      if (it < nit) {
        const int kb = it / nnb, nb = it - kb * nnb, k0 = kb * 64, n0 = nb * 64;
        const int n = tid >> 3, kc = tid & 7;
        float f[8];
#pragma unroll
        for (int j = 0; j < 8; ++j) f[j] = tile[q * (64 * 65) + (kc * 8 + j) * 65 + n];
        if (F8) *(u32x2*)((unsigned char*)Wt_ + (size_t)(n0 + n) * K + k0 + kc * 8) = (u32x2){pk4_fp8(f[0] * WSC, f[1] * WSC, f[2] * WSC, f[3] * WSC), pk4_fp8(f[4] * WSC, f[5] * WSC, f[6] * WSC, f[7] * WSC)};
        else *(u32x4*)((bf16_t*)Wt_ + (size_t)(n0 + n) * K + k0 + kc * 8) = (u32x4){pk2(f[0], f[1]), pk2(f[2], f[3]), pk2(f[4], f[5]), pk2(f[6], f[7])};
      }
    }
    __syncthreads();
  }
}
__device__ __forceinline__ void cvt_job(const float* __restrict__ src, bf16_t* __restrict__ dst, size_t n8) {
  for (size_t i = (size_t)blockIdx.x * NTHREADS + threadIdx.x; i < n8; i += (size_t)gridDim.x * NTHREADS) {
    const f32x4 a = ((const f32x4*)src)[2 * i], b = ((const f32x4*)src)[2 * i + 1];
    ((u32x4*)dst)[i] = (u32x4){pk2(a.x, a.y), pk2(a.z, a.w), pk2(b.x, b.y), pk2(b.z, b.w)};
  }
}
__device__ __forceinline__ unsigned q4pack(f32x4 a, f32x4 b, float sc) {
  const float v[8] = {a.x, a.y, a.z, a.w, b.x, b.y, b.z, b.w}; unsigned w = 0u;
#pragma unroll
  for (int j = 0; j < 8; ++j) { int q = (int)rintf(v[j] * sc); q = min(7, max(-8, q)); w |= ((unsigned)q & 15u) << (4 * j); }
  return w;
}
__device__ __forceinline__ void conv_rows(const float* __restrict__ usrc, const float* __restrict__ vsrc, unsigned char* __restrict__ udst, unsigned char* __restrict__ vdst, float su, float sv, int r0, int r1, int tid) {
  for (int r = r0 + (tid >> 6); r < r1; r += NWAVES) {
    const bool isv = r >= 16384; const int rr = isv ? r - 16384 : r; const int c = (tid & 63);
    const f32x4* sp = (const f32x4*)((isv ? vsrc : usrc) + (size_t)rr * 1024) + c * 4;
    const f32x4 a = sp[0], b = sp[1], cc = sp[2], d = sp[3];
    u32x2 o;
    if (isv) {
      unsigned w0 = 0u, w1 = 0u;
      w0 = __builtin_amdgcn_cvt_scalef32_pk_fp4_f32(w0, a.x * sv, a.y * sv, 1.0f, 0); w0 = __builtin_amdgcn_cvt_scalef32_pk_fp4_f32(w0, a.z * sv, a.w * sv, 1.0f, 1);
      w0 = __builtin_amdgcn_cvt_scalef32_pk_fp4_f32(w0, b.x * sv, b.y * sv, 1.0f, 2); w0 = __builtin_amdgcn_cvt_scalef32_pk_fp4_f32(w0, b.z * sv, b.w * sv, 1.0f, 3);
      w1 = __builtin_amdgcn_cvt_scalef32_pk_fp4_f32(w1, cc.x * sv, cc.y * sv, 1.0f, 0); w1 = __builtin_amdgcn_cvt_scalef32_pk_fp4_f32(w1, cc.z * sv, cc.w * sv, 1.0f, 1);
      w1 = __builtin_amdgcn_cvt_scalef32_pk_fp4_f32(w1, d.x * sv, d.y * sv, 1.0f, 2); w1 = __builtin_amdgcn_cvt_scalef32_pk_fp4_f32(w1, d.z * sv, d.w * sv, 1.0f, 3);
      o = (u32x2){w0, w1};
    } else o = (u32x2){q4pack(a, b, su), q4pack(cc, d, su)};
    *(u32x2*)((isv ? vdst : udst) + (size_t)rr * 512 + c * 8) = o;
  }
}
__device__ __forceinline__ void ada_job(LAS unsigned char* lds, const Params& p, float* __restrict__ modp) {
  LAS float* s = (LAS float*)lds;
  const int tid = opaque_tid();
  for (int u = blockIdx.x; u < 768; u += gridDim.x) {
    const int l = u / 192, r = u - l * 192, cc = r >> 6, kc = r & 63;
    __syncthreads();
    if (tid < 144) { const int bi = tid >> 4, k = tid & 15; const float c = (bi < 8) ? p.c[bi * D + kc * 16 + k] : p.c_ctx[kc * 16 + k]; s[tid] = c / (1.f + __expf(-c)); }
    __syncthreads();
    f32x4 acc[9];
#pragma unroll
    for (int bi = 0; bi < 9; ++bi) acc[bi] = (f32x4){0.f, 0.f, 0.f, 0.f};
    const float* w = p.ada_w + ((size_t)l * D + kc * 16) * 6144 + cc * 2048 + tid * 4;
#pragma unroll
    for (int h = 0; h < 2; ++h) {
      f32x4 wv[8];
#pragma unroll
      for (int k = 0; k < 8; ++k) wv[k] = *(const f32x4*)(w + (size_t)(h * 8 + k) * 6144);
#pragma unroll
      for (int k = 0; k < 8; ++k)
#pragma unroll
        for (int bi = 0; bi < 9; ++bi) acc[bi] += s[bi * 16 + h * 8 + k] * wv[k];
    }
#pragma unroll
    for (int bi = 0; bi < 9; ++bi) *(f32x4*)(modp + (((size_t)kc * 4 + l) * 9 + bi) * 6144 + cc * 2048 + tid * 4) = acc[bi];
  }
}

__device__ __forceinline__ void norm_phase(const float* sl, const float* sc_, bf16_t* xl, bf16_t* xc, bool src_f32, const float* __restrict__ g, const float* __restrict__ modl, int which, unsigned char* __restrict__ H, bool out_f8, bool skip_ctx, int wv) {
  const int tid_ = otid(wv); const int lane = tid_ & 63, wid = tid_ >> 6;
  for (int r = blockIdx.x * NWAVES + wid; r < M; r += gridDim.x * NWAVES) {
    const int b = r / TPB, s = r - b * TPB; const bool isctx = s >= SEQ;
    if (skip_ctx && isctx) continue;
    const int bi = isctx ? 8 : b;
    const float* sh = modl + (size_t)(bi * 6 + which) * D; const float* sc = sh + D;
    f32x4 v[4]; float ss = 0.f;
    if (src_f32) {
      const float* xr = xsrc_ptr(sl, sc_, r);
#pragma unroll
      for (int j = 0; j < 4; ++j) v[j] = ((const f32x4*)xr)[lane + 64 * j];
    } else {
      const bf16_t* xr = xrow_ptr(xl, xc, r);
#pragma unroll
      for (int j = 0; j < 4; ++j) { const u32x2 w = ((const u32x2*)xr)[lane + 64 * j]; v[j] = (f32x4){bf_lo(w.x), bf_hi(w.x), bf_lo(w.y), bf_hi(w.y)}; }
    }
#pragma unroll
    for (int j = 0; j < 4; ++j) ss += v[j].x * v[j].x + v[j].y * v[j].y + v[j].z * v[j].z + v[j].w * v[j].w;
    ss = wave_sum(ss);
    const float rstd = rsqrtf(ss * (1.f / D) + EPS);
#pragma unroll
    for (int j = 0; j < 4; ++j) {
      const int c4 = lane + 64 * j;
      const f32x4 g4 = ((const f32x4*)g)[c4], s4 = ((const f32x4*)sc)[c4], h4 = ((const f32x4*)sh)[c4];
      const f32x4 y = v[j] * rstd * g4 * (1.f + s4) + h4;
      if (out_f8) *(unsigned*)(H + (size_t)r * D + c4 * 4) = pk4_fp8(y.x * ASC, y.y * ASC, y.z * ASC, y.w * ASC);
      else *(u32x2*)((bf16_t*)H + (size_t)r * D + c4 * 4) = (u32x2){pk2(y.x, y.y), pk2(y.z, y.w)};
    }
  }
}
__device__ __forceinline__ void latnorm_phase(const bf16_t* __restrict__ LAT, const float* __restrict__ gcq, const float* __restrict__ gckv, unsigned char* __restrict__ CQN, bf16_t* __restrict__ CKVN, int wv) {
  const int tid_ = otid(wv); const int lane = tid_ & 63, wid = tid_ >> 6;
  for (int r = blockIdx.x * NWAVES + wid; r < M; r += gridDim.x * NWAVES) {
    const bf16_t* lr = LAT + (size_t)r * 1280;
    float q[12], kv[4]; float sq = 0.f, sk = 0.f;
#pragma unroll
    for (int j = 0; j < 3; ++j) { const u32x2 w = *(const u32x2*)(lr + lane * 4 + 256 * j); q[4 * j] = bf_lo(w.x); q[4 * j + 1] = bf_hi(w.x); q[4 * j + 2] = bf_lo(w.y); q[4 * j + 3] = bf_hi(w.y); }
    { const u32x2 w = *(const u32x2*)(lr + 768 + lane * 4); kv[0] = bf_lo(w.x); kv[1] = bf_hi(w.x); kv[2] = bf_lo(w.y); kv[3] = bf_hi(w.y); }
#pragma unroll
    for (int j = 0; j < 12; ++j) sq += q[j] * q[j];
#pragma unroll
    for (int j = 0; j < 4; ++j) sk += kv[j] * kv[j];
    sq = wave_sum(sq); sk = wave_sum(sk);
    const float rq = rsqrtf(sq * (1.f / 768.f) + EPS), rk = rsqrtf(sk * (1.f / 256.f) + EPS);
#pragma unroll
    for (int j = 0; j < 3; ++j) { const int c = lane * 4 + 256 * j; const f32x4 g4 = *(const f32x4*)(gcq + c);
      *(unsigned*)(CQN + (size_t)r * 768 + c) = pk4_fp8(q[4 * j] * rq * g4.x * ASC, q[4 * j + 1] * rq * g4.y * ASC, q[4 * j + 2] * rq * g4.z * ASC, q[4 * j + 3] * rq * g4.w * ASC); }
    { const int c = lane * 4; const f32x4 g4 = *(const f32x4*)(gckv + c);
      *(u32x2*)(CKVN + (size_t)r * 256 + c) = (u32x2){pk2(kv[0] * rk * g4.x, kv[1] * rk * g4.y), pk2(kv[2] * rk * g4.z, kv[3] * rk * g4.w)}; }
  }
}

constexpr int G_AS = 144;
constexpr int G_ATILE = 256 * G_AS, G_BTILE = 128 * G_AS, G_STAGE = G_ATILE + G_BTILE;
struct EpiFp8T { unsigned char* C; int ldc;
  __device__ __forceinline__ void operator()(int row, int col, f32x4 v) const { const unsigned w = pk4_fp8(v.x * WSC, v.y * WSC, v.z * WSC, v.w * WSC);
    C[(size_t)(col + 0) * ldc + row] = (unsigned char)(w & 255u); C[(size_t)(col + 1) * ldc + row] = (unsigned char)((w >> 8) & 255u); C[(size_t)(col + 2) * ldc + row] = (unsigned char)((w >> 16) & 255u); C[(size_t)(col + 3) * ldc + row] = (unsigned char)(w >> 24); } };
struct EpiBf16T { bf16_t* C; int ldc;
  __device__ __forceinline__ void operator()(int row, int col, f32x4 v) const {
    C[(size_t)(col + 0) * ldc + row] = (bf16_t)(pk2(v.x, 0.f) & 0xffffu); C[(size_t)(col + 1) * ldc + row] = (bf16_t)(pk2(v.y, 0.f) & 0xffffu);
    C[(size_t)(col + 2) * ldc + row] = (bf16_t)(pk2(v.z, 0.f) & 0xffffu); C[(size_t)(col + 3) * ldc + row] = (bf16_t)(pk2(v.w, 0.f) & 0xffffu); } };
template <class Epi>
__device__ __forceinline__ void gemm_phase(LAS unsigned char* lds, const bf16_t* __restrict__ A, int lda, const bf16_t* __restrict__ Bt, int ldb,
                                           int Mrows, int N, int K, bool skip_ctx_tiles, const Epi epi, int ustart, int ustride) {
  const int tid = opaque_tid(), lane = tid & 63, wid = tid >> 6, wr = wid >> 1, wc = wid & 1, fr = lane & 15, fq = lane >> 4;
  const int nN = N / 128, nU = (Mrows / 256) * nN, nt = K / 64;
  const int lrow = tid >> 3, lkc = tid & 7;
  for (int u = ustart; u < nU; u += ustride) {
    const int pm = u / nN, pn = u - pm * nN;
    if (skip_ctx_tiles && (pm % 9) == 8) continue;
    const bf16_t* Ag = A + (size_t)(pm * 256 + lrow) * lda + lkc * 8;
    const bf16_t* Bg = Bt + (size_t)(pn * 128 + lrow) * ldb + lkc * 8;
    f32x4 acc[4][4];
#pragma unroll
    for (int m = 0; m < 4; ++m)
#pragma unroll
      for (int n = 0; n < 4; ++n) acc[m][n] = (f32x4){0.f, 0.f, 0.f, 0.f};
    u32x4 ra[4], rb[2];
#pragma unroll
    for (int i = 0; i < 4; ++i) ra[i] = *(const u32x4*)(Ag + (size_t)(64 * i) * lda);
#pragma unroll
    for (int i = 0; i < 2; ++i) rb[i] = *(const u32x4*)(Bg + (size_t)(64 * i) * ldb);
    {
      LAS unsigned char* sa = lds + lrow * G_AS + lkc * 16; LAS unsigned char* sb = lds + G_ATILE + lrow * G_AS + lkc * 16;
#pragma unroll
      for (int i = 0; i < 4; ++i) *(LAS u32x4*)(sa + i * 64 * G_AS) = ra[i];
#pragma unroll
      for (int i = 0; i < 2; ++i) *(LAS u32x4*)(sb + i * 64 * G_AS) = rb[i];
    }
    __syncthreads();
    for (int t = 0; t < nt; ++t) {
      const bool more = (t + 1 < nt);
      if (more) {
#pragma unroll
        for (int i = 0; i < 4; ++i) ra[i] = *(const u32x4*)(Ag + (size_t)(64 * i) * lda + (t + 1) * 64);
#pragma unroll
        for (int i = 0; i < 2; ++i) rb[i] = *(const u32x4*)(Bg + (size_t)(64 * i) * ldb + (t + 1) * 64);
      }
      const LAS unsigned char* st = lds + (t & 1) * G_STAGE;
      const LAS unsigned char* pa = st + (wr * 64 + fr) * G_AS + fq * 16;
      const LAS unsigned char* pb = st + G_ATILE + (wc * 64 + fr) * G_AS + fq * 16;
#pragma unroll
      for (int ks = 0; ks < 2; ++ks) {
        bf16x8 af[4], bfr[4];
#pragma unroll
        for (int m = 0; m < 4; ++m) af[m] = *(const LAS bf16x8*)(pa + m * 16 * G_AS + ks * 64);
#pragma unroll
        for (int n = 0; n < 4; ++n) bfr[n] = *(const LAS bf16x8*)(pb + n * 16 * G_AS + ks * 64);
#pragma unroll
        for (int m = 0; m < 4; ++m)
#pragma unroll
          for (int n = 0; n < 4; ++n) acc[m][n] = __builtin_amdgcn_mfma_f32_16x16x32_bf16(bfr[n], af[m], acc[m][n], 0, 0, 0);
      }
      if (more) {
        LAS unsigned char* sa = lds + ((t + 1) & 1) * G_STAGE + lrow * G_AS + lkc * 16; LAS unsigned char* sb = sa + G_ATILE;
#pragma unroll
        for (int i = 0; i < 4; ++i) *(LAS u32x4*)(sa + i * 64 * G_AS) = ra[i];
#pragma unroll
        for (int i = 0; i < 2; ++i) *(LAS u32x4*)(sb + i * 64 * G_AS) = rb[i];
      }
      __syncthreads();
    }
#pragma unroll
    for (int m = 0; m < 4; ++m)
#pragma unroll
      for (int n = 0; n < 4; ++n) epi(pm * 256 + wr * 64 + m * 16 + fr, pn * 128 + wc * 64 + n * 16 + fq * 4, acc[m][n]);
  }
}

namespace pg8 {
#define PG8_LAS __attribute__((address_space(3)))
typedef unsigned short bf16_t;
typedef short bf16x8 __attribute__((ext_vector_type(8)));
typedef float f32x4 __attribute__((ext_vector_type(4)));
typedef unsigned u32x4 __attribute__((ext_vector_type(4)));
constexpr int BM = 256, BK = 64, HALF = 128, HTB = HALF * BK * 2  , STAGE_BYTES = 8 * HTB, NXCD = 8, WGM = 8;

__host__ __device__ __forceinline__ int lds_byte(int r, int c) { const int st = (r >> 4) * 2 + (c >> 5), rr = r & 15, cc = c & 31, ob = rr * 64 + cc * 2; return st * 1024 + (ob ^ (((ob >> 9) & 1) << 5)); }
__host__ __device__ __forceinline__ void stage_rc(int b, int& R, int& C) { const int st = b / 1024, sb = b % 1024, swz = sb ^ (((sb >> 9) & 1) << 5); R = (st >> 1) * 16 + swz / 64; C = (st & 1) * 32 + (swz % 64) / 2; }
__host__ __device__ __forceinline__ int perm32(int rho) { const int n = rho >> 4, i = rho & 15; return 8 * (i >> 2) + 4 * n + (i & 3); }

struct Unit { int pm, pn; };
struct Gemm { const bf16_t* A; const bf16_t* Bt; int M, N, K; };

struct StaticOrder {
    int nM, nN, nwg, G, c;
    __host__ __device__ void init(int M, int N, int G_, int c_) { nM = M / BM; nN = N / BM; nwg = nM * nN; G = G_; c = c_; }
    __host__ __device__ bool next(int i, Unit& u) const {
        const long L = (long)i * G + c; if (L >= nwg) return false;
        int wgid = (int)L; { const int q = nwg / NXCD, r = nwg % NXCD, xcd = wgid % NXCD, off = wgid / NXCD; wgid = (xcd < r ? xcd * (q + 1) : r * (q + 1) + (xcd - r) * q) + off; }
        const int nig = WGM * nN, gid = wgid / nig, fm = gid * WGM, gsz = (nM - fm) < WGM ? (nM - fm) : WGM;
        u.pm = fm + ((wgid % nig) % gsz); u.pn = (wgid % nig) / gsz; return true;
    }
    __device__ __forceinline__ void a_ready(const Unit&) const {}
    __device__ __forceinline__ void done(const Unit&) const {}
};
struct LatentOrder {
    StaticOrder base; bool skip;
    __host__ __device__ void init(int M_, int N_, int G_, int c_, bool skip_) { skip = skip_; base.init(skip_ ? (M_ / 9) * 8 : M_, N_, G_, c_); }
    __host__ __device__ bool next(int i, Unit& u) const { if (!base.next(i, u)) return false; if (skip) u.pm += u.pm >> 3; return true; }
    __device__ __forceinline__ void a_ready(const Unit&) const {}
    __device__ __forceinline__ void done(const Unit&) const {}
};
struct EpiBf16P { static constexpr bool PERM = true, AFTER_DRAIN = false; bf16_t* O; int ldc; float sc;
  __device__ __forceinline__ void operator()(const f32x4 (&acc)[2][2][4][2], const Unit& u, int wr, int wc, int fr, int fq) const {
    const int row0 = u.pm * BM + wr * 64 + fr, col0 = u.pn * BM + wc * 32 + 8 * fq;
#pragma unroll
    for (int ai = 0; ai < 2; ++ai)
#pragma unroll
      for (int m = 0; m < 4; ++m) { bf16_t* rowp = O + (size_t)(row0 + ai * HALF + m * 16) * ldc + col0;
#pragma unroll
        for (int bj = 0; bj < 2; ++bj) { const f32x4 v0 = acc[ai][bj][m][0] * sc, v1 = acc[ai][bj][m][1] * sc;
          *(u32x4*)(rowp + bj * HALF) = (u32x4){pk2(v0[0], v0[1]), pk2(v0[2], v0[3]), pk2(v1[0], v1[1]), pk2(v1[2], v1[3])}; } }
  } };
struct EpiResidN { static constexpr bool PERM = false, AFTER_DRAIN = false; const float* sl; const float* sc; bool src_f32; bf16_t* xl; bf16_t* xc; const float* modl; int which; bool live; float osc;
  __device__ __forceinline__ void operator()(const f32x4 (&acc)[2][2][4][2], const Unit& u, int wr, int wc, int fr, int fq) const {
    if (!live) return;
    const int row0 = u.pm * BM + wr * 64 + fr, col0 = u.pn * BM + wc * 32 + 4 * fq;
    const int b = (u.pm * BM) / TPB, s0 = u.pm * BM - b * TPB; const int bi = (s0 >= SEQ) ? 8 : b;
    const float* gp = modl + (size_t)(bi * 6 + which) * D + col0;
#pragma unroll
    for (int bj = 0; bj < 2; ++bj)
#pragma unroll
      for (int n = 0; n < 2; ++n) { const f32x4 gt = *(const f32x4*)(gp + bj * HALF + n * 16) * osc;
#pragma unroll
        for (int ai = 0; ai < 2; ++ai)
#pragma unroll
          for (int m = 0; m < 4; ++m) { const int rr = row0 + ai * HALF + m * 16, cc = col0 + bj * HALF + n * 16;
            bf16_t* xp = xrow_ptr(xl, xc, rr) + cc; f32x4 xv;
            if (src_f32) xv = *(const f32x4*)(xsrc_ptr(sl, sc, rr) + cc);
            else { const u32x2 w = *(const u32x2*)xp; xv = (f32x4){bf_lo(w.x), bf_hi(w.x), bf_lo(w.y), bf_hi(w.y)}; }
            xv += gt * acc[ai][bj][m][n]; *(u32x2*)xp = (u32x2){pk2(xv.x, xv.y), pk2(xv.z, xv.w)}; } }
  } };
template <class Epi, class Sched, bool ALIGN_EPI = false, bool SP2 = false, bool FP8 = false>
__device__ __forceinline__ void gemm_phase(PG8_LAS unsigned char* lds, const Gemm g, const Sched& S, const Epi& E, int wv) {
    const int tid = otid(wv), wid = __builtin_amdgcn_readfirstlane(tid >> 6), lane = tid & 63, wr = wid >> 2, wc = wid & 3, fr = lane & 15, fq = lane >> 4;
    const int K = g.K, nt = K / BK;
    unsigned voffA[2], voffB[2];
#pragma unroll
    for (int i = 0; i < 2; ++i) { int R, C; stage_rc(tid * 16 + i * 8192, R, C); const int Rb = Epi::PERM ? ((R & ~31) + perm32(R & 31)) : R;
        voffA[i] = (unsigned)(R * K + C) * 2u; voffB[i] = (unsigned)(Rb * K + C) * 2u; }
    const size_t kstep = (size_t)(BK * 2);
    const size_t hstep = (size_t)HALF * K * 2;
    const size_t tstep = 2 * hstep;
    const unsigned ldsw = (unsigned)wid * 1024u;
    const int aoff = lds_byte(wr * 64 + fr, fq * 8), boff = lds_byte(wc * 32 + fr, fq * 8);
#define PG8_SA(b, h) (((b) * 2 + (h)) * HTB)
#define PG8_SB(b, h) ((4 + (b) * 2 + (h)) * HTB)
#define PG8_STAGE(bufoff, gbase, voff) do { _Pragma("unroll") for (int _i = 0; _i < 2; ++_i) \
        __builtin_amdgcn_global_load_lds((const unsigned*)((const char*)(gbase) + (voff)[_i]), (PG8_LAS unsigned*)(lds + (bufoff) + ldsw + _i * 8192), 16, 0, 0); } while (0)
#define PG8_LDA(dst, b, h) do { _Pragma("unroll") for (int m = 0; m < 4; ++m) _Pragma("unroll") for (int k = 0; k < 2; ++k) dst[m][k] = *(const PG8_LAS bf16x8*)(lds + PG8_SA(b, h) + aoff + m * 2048 + k * 1024); } while (0)
#define PG8_LDB(dst, b, h) do { _Pragma("unroll") for (int n = 0; n < 2; ++n) _Pragma("unroll") for (int k = 0; k < 2; ++k) dst[n][k] = *(const PG8_LAS bf16x8*)(lds + PG8_SB(b, h) + boff + n * 2048 + k * 1024); } while (0)
#define PG8_MMA(ai, bj, At, Bt) do { __builtin_amdgcn_s_setprio(1); _Pragma("unroll") for (int m = 0; m < 4; ++m) _Pragma("unroll") for (int n = 0; n < 2; ++n) _Pragma("unroll") for (int k = 0; k < 2; ++k) { \
        if constexpr (FP8) { const long2_t a2_ = __builtin_bit_cast(long2_t, At[m][k]), b2_ = __builtin_bit_cast(long2_t, Bt[n][k]); \
          acc[ai][bj][m][n] = __builtin_amdgcn_mfma_f32_16x16x32_fp8_fp8(b2_[0], a2_[0], acc[ai][bj][m][n], 0, 0, 0); \
          acc[ai][bj][m][n] = __builtin_amdgcn_mfma_f32_16x16x32_fp8_fp8(b2_[1], a2_[1], acc[ai][bj][m][n], 0, 0, 0); } \
        else acc[ai][bj][m][n] = __builtin_amdgcn_mfma_f32_16x16x32_bf16(Bt[n][k], At[m][k], acc[ai][bj][m][n], 0, 0, 0); } __builtin_amdgcn_s_setprio(0); } while (0)
#define PG8_WAIT_V(n) asm volatile("s_waitcnt vmcnt(" #n ")" ::: "memory")
#define PG8_WAIT_L(n) asm volatile("s_waitcnt lgkmcnt(" #n ")" ::: "memory")
#define PG8_BAR __builtin_amdgcn_s_barrier()
#define PG8_SCHED __builtin_amdgcn_sched_barrier(0)
    Unit cur, nxt; int ui = 0;
    if (!S.next(0, cur)) return;
    f32x4 acc[2][2][4][2];
#pragma unroll
    for (int a = 0; a < 2; ++a)
#pragma unroll
        for (int b = 0; b < 2; ++b)
#pragma unroll
            for (int m = 0; m < 4; ++m)
#pragma unroll
                for (int n = 0; n < 2; ++n) acc[a][b][m][n] = (f32x4){0.f, 0.f, 0.f, 0.f};
    bf16x8 At[4][2], B0[2][2], B1[2][2];
    const char* cA = (const char*)g.A + (size_t)cur.pm * tstep; const char* cB = (const char*)g.Bt + (size_t)cur.pn * tstep;
    S.a_ready(cur);
    if constexpr (SP2) {
        PG8_STAGE(PG8_SB(0, 0), cB, voffB); PG8_STAGE(PG8_SB(0, 1), cB + hstep, voffB); PG8_STAGE(PG8_SA(0, 0), cA, voffA); PG8_STAGE(PG8_SA(0, 1), cA + hstep, voffA);
        if (wr == 1) PG8_BAR;
        PG8_WAIT_V(2); PG8_BAR;
        PG8_STAGE(PG8_SB(1, 0), cB + kstep, voffB); PG8_STAGE(PG8_SA(1, 0), cA + kstep, voffA); PG8_STAGE(PG8_SB(1, 1), cB + hstep + kstep, voffB);
        PG8_WAIT_V(6); PG8_BAR;
    } else {
        PG8_STAGE(PG8_SB(0, 0), cB, voffB); PG8_STAGE(PG8_SA(0, 0), cA, voffA); PG8_STAGE(PG8_SB(0, 1), cB + hstep, voffB); PG8_STAGE(PG8_SA(0, 1), cA + hstep, voffA);
        if (wr == 1) PG8_BAR;
        PG8_WAIT_V(4); PG8_BAR;
        PG8_STAGE(PG8_SB(1, 0), cB + kstep, voffB); PG8_STAGE(PG8_SA(1, 0), cA + kstep, voffA); PG8_STAGE(PG8_SB(1, 1), cB + hstep + kstep, voffB);
        PG8_WAIT_V(6); PG8_BAR;
    }
    for (;;) {
        const bool has_next = S.next(ui + 1, nxt);
        const char* nA = has_next ? (const char*)g.A + (size_t)nxt.pm * tstep : cA; const char* nB = has_next ? (const char*)g.Bt + (size_t)nxt.pn * tstep : cB;
        for (int t = 0; t < nt; t += 2) {
            const bool last = (t == nt - 2);
            const char* a1 = cA + (size_t)(t + 1) * kstep;
            const char* a2 = last ? nA : cA + (size_t)(t + 2) * kstep; const char* b2 = last ? nB : cB + (size_t)(t + 2) * kstep;
            const char* a3 = a2 + kstep; const char* b3 = b2 + kstep;
            if (last && has_next) S.a_ready(nxt);
            if constexpr (SP2) {
            PG8_LDB(B0, 0, 0); PG8_LDB(B1, 0, 1); PG8_SCHED; PG8_LDA(At, 0, 0); PG8_STAGE(PG8_SA(1, 1), a1 + hstep, voffA);
            PG8_WAIT_V(8); PG8_WAIT_L(0); PG8_BAR; PG8_MMA(0, 0, At, B0); PG8_MMA(0, 1, At, B1); PG8_BAR; PG8_SCHED;
            PG8_LDA(At, 0, 1); PG8_STAGE(PG8_SB(0, 0), b2, voffB); PG8_STAGE(PG8_SB(0, 1), b2 + hstep, voffB); PG8_STAGE(PG8_SA(0, 0), a2, voffA);
            PG8_WAIT_V(8); PG8_WAIT_L(0); PG8_BAR; PG8_MMA(1, 0, At, B0); PG8_MMA(1, 1, At, B1); PG8_BAR; PG8_SCHED;
            PG8_LDB(B0, 1, 0); PG8_LDB(B1, 1, 1); PG8_SCHED; PG8_LDA(At, 1, 0); PG8_STAGE(PG8_SA(0, 1), a2 + hstep, voffA);
            PG8_WAIT_V(8); PG8_WAIT_L(0); PG8_BAR; PG8_MMA(0, 0, At, B0); PG8_MMA(0, 1, At, B1); PG8_BAR; PG8_SCHED;
            PG8_LDA(At, 1, 1); PG8_STAGE(PG8_SB(1, 0), b3, voffB); PG8_STAGE(PG8_SB(1, 1), b3 + hstep, voffB); PG8_STAGE(PG8_SA(1, 0), a3, voffA);
            PG8_WAIT_V(8); PG8_WAIT_L(0); PG8_BAR; PG8_MMA(1, 0, At, B0); PG8_MMA(1, 1, At, B1); PG8_BAR; PG8_SCHED;
            } else {
            PG8_LDB(B0, 0, 0); PG8_SCHED; PG8_LDA(At, 0, 0); PG8_STAGE(PG8_SA(1, 1), a1 + hstep, voffA);
            PG8_WAIT_L(8); PG8_BAR; PG8_WAIT_L(0); PG8_MMA(0, 0, At, B0); PG8_BAR; PG8_SCHED;
            PG8_LDB(B1, 0, 1); PG8_STAGE(PG8_SB(0, 0), b2, voffB);
            PG8_BAR; PG8_WAIT_L(0); PG8_MMA(0, 1, At, B1); PG8_BAR;
            PG8_LDA(At, 0, 1); PG8_STAGE(PG8_SA(0, 0), a2, voffA);
            PG8_BAR; PG8_WAIT_L(0); PG8_MMA(1, 0, At, B0); PG8_BAR; PG8_SCHED;
            PG8_STAGE(PG8_SB(0, 1), b2 + hstep, voffB);
            PG8_WAIT_V(6); PG8_BAR; PG8_MMA(1, 1, At, B1); PG8_BAR;
            PG8_LDB(B0, 1, 0); PG8_SCHED; PG8_LDA(At, 1, 0); PG8_STAGE(PG8_SA(0, 1), a2 + hstep, voffA);
            PG8_WAIT_L(8); PG8_BAR; PG8_WAIT_L(0); PG8_MMA(0, 0, At, B0); PG8_BAR; PG8_SCHED;
            PG8_LDB(B1, 1, 1); PG8_STAGE(PG8_SB(1, 0), b3, voffB);
            PG8_BAR; PG8_WAIT_L(0); PG8_MMA(0, 1, At, B1); PG8_BAR;
            PG8_LDA(At, 1, 1); PG8_STAGE(PG8_SA(1, 0), a3, voffA);
            PG8_BAR; PG8_WAIT_L(0); PG8_MMA(1, 0, At, B0); PG8_BAR; PG8_SCHED;
            PG8_STAGE(PG8_SB(1, 1), b3 + hstep, voffB);
            PG8_WAIT_V(6); PG8_BAR; PG8_MMA(1, 1, At, B1); PG8_BAR;
            }
        }
        if constexpr (ALIGN_EPI) { if (wr == 0) PG8_BAR; }
        if constexpr (!Epi::AFTER_DRAIN) { E(acc, cur, wr, wc, fr, fq); S.done(cur); }
        if (!has_next) break;
#pragma unroll
        for (int a = 0; a < 2; ++a)
#pragma unroll
            for (int b = 0; b < 2; ++b)
#pragma unroll
                for (int m = 0; m < 4; ++m)
#pragma unroll
                    for (int n = 0; n < 2; ++n) acc[a][b][m][n] = (f32x4){0.f, 0.f, 0.f, 0.f};
        cur = nxt; cA = nA; cB = nB; ++ui;
        if constexpr (ALIGN_EPI) { if (wr == 1) PG8_BAR; }
    }
    PG8_WAIT_V(0);
    if constexpr (!ALIGN_EPI) { if (wr == 0) PG8_BAR; }
    PG8_BAR;
    if constexpr (Epi::AFTER_DRAIN) { E.fused(acc, cur, wr, wc, fr, fq, lds, wid, lane); S.done(cur); }
#undef PG8_SA
#undef PG8_SB
#undef PG8_STAGE
#undef PG8_LDA
#undef PG8_LDB
#undef PG8_MMA
#undef PG8_WAIT_V
#undef PG8_WAIT_L
#undef PG8_BAR
#undef PG8_SCHED
}
}
#define UNPACK8(W, V, O) do { V[O + 0] = bf_lo(W.x); V[O + 1] = bf_hi(W.x); V[O + 2] = bf_lo(W.y); V[O + 3] = bf_hi(W.y); V[O + 4] = bf_lo(W.z); V[O + 5] = bf_hi(W.z); V[O + 6] = bf_lo(W.w); V[O + 7] = bf_hi(W.w); } while (0)
#define PACK8(V, O, SC) (u32x4){pk2(V[O] * SC, V[O + 1] * SC), pk2(V[O + 2] * SC, V[O + 3] * SC), pk2(V[O + 4] * SC, V[O + 5] * SC), pk2(V[O + 6] * SC, V[O + 7] * SC)}
__device__ __forceinline__ void headnorm96(const bf16_t* srcA, const bf16_t* srcB, bf16_t* dst, const float* __restrict__ g, float outscale, bool rope, int rowpos, int colpos,
                                           const float* __restrict__ tab8, int j) {
  const u32x4 w0 = *(const u32x4*)(srcA + j * 8), w1 = *(const u32x4*)(srcA + 32 + j * 8), w2 = *(const u32x4*)(srcB + j * 8);
  float v[24];
  UNPACK8(w0, v, 0); UNPACK8(w1, v, 8); UNPACK8(w2, v, 16);
  float ss = 0.f;
#pragma unroll
  for (int e = 0; e < 24; ++e) ss += v[e] * v[e];
  ss += __shfl_xor(ss, 1); ss += __shfl_xor(ss, 2);
  const float rstd = rsqrtf(ss * (1.f / 96.f) + EPS);
#pragma unroll
  for (int e = 0; e < 8; ++e) { v[e] *= rstd * g[j * 8 + e]; v[8 + e] *= rstd * g[32 + j * 8 + e]; v[16 + e] *= rstd * g[64 + j * 8 + e]; }
  const int pos = (j < 2) ? rowpos : colpos;
#pragma unroll
  for (int e = 0; e < 8; ++e) {
    const float own = v[16 + e], oth = __shfl_xor(own, 1);
    const f32x2_t cs = *(const f32x2_t*)(tab8 + (pos * 8 + e) * 2);
    const float res = (j & 1) ? (oth * cs.y + own * cs.x) : (own * cs.x - oth * cs.y);
    if (rope) v[16 + e] = res;
  }
  *(u32x4*)(dst + j * 8) = PACK8(v, 0, outscale); *(u32x4*)(dst + 32 + j * 8) = PACK8(v, 8, outscale); *(u32x4*)(dst + 64 + j * 8) = PACK8(v, 16, outscale);
}
__device__ __forceinline__ void headnorm64(const bf16_t* q, bf16_t* qd, const float* __restrict__ g, float outscale, bool rope, int rowpos, int colpos, const float* __restrict__ tab16, int j) {
  const u32x4 w0 = *(const u32x4*)(q + j * 8), w1 = *(const u32x4*)(q + 32 + j * 8);
  float v[16];
  UNPACK8(w0, v, 0); UNPACK8(w1, v, 8);
  float ss = 0.f;
#pragma unroll
  for (int e = 0; e < 16; ++e) ss += v[e] * v[e];
  ss += __shfl_xor(ss, 1); ss += __shfl_xor(ss, 2);
  const float rstd = rsqrtf(ss * (1.f / 64.f) + EPS);
#pragma unroll
  for (int e = 0; e < 8; ++e) { v[e] *= rstd * g[j * 8 + e]; v[8 + e] *= rstd * g[32 + j * 8 + e]; }
#pragma unroll
  for (int e = 0; e < 8; ++e) {
    const int i = (j & 1) * 8 + e;
    const float own0 = v[e], oth0 = __shfl_xor(own0, 2), own1 = v[8 + e], oth1 = __shfl_xor(own1, 2);
    const f32x2_t cr = *(const f32x2_t*)(tab16 + (rowpos * 16 + i) * 2), cc = *(const f32x2_t*)(tab16 + (colpos * 16 + i) * 2);
    const float r0 = (j >> 1) ? (oth0 * cr.y + own0 * cr.x) : (own0 * cr.x - oth0 * cr.y);
    const float r1 = (j >> 1) ? (oth1 * cc.y + own1 * cc.x) : (own1 * cc.x - oth1 * cc.y);
    if (rope) { v[e] = r0; v[8 + e] = r1; }
  }
  *(u32x4*)(qd + j * 8) = PACK8(v, 0, outscale); *(u32x4*)(qd + 32 + j * 8) = PACK8(v, 8, outscale);
}

template <int DQK, int DV, int NS, bool WINDOW>
__device__ __forceinline__ void attn_unit(LAS unsigned char* lds, const bf16_t* __restrict__ Qb, int qsoff, int ldq, const bf16_t* __restrict__ Kb, int ksoff, int ldk,
                                          const bf16_t* __restrict__ Vb, int ldv, int q0, int ta0, int ta1, int tb0, int tb1, bool has_sink, float sink_l2, float kmax,
                                          unsigned char* __restrict__ Ob, int ldo, float lam, const float* __restrict__ gsub, int wv) {
  constexpr int KS = DQK * 2 + 16, KTB = 64 * KS, VS = (DV == 64) ? 192 : 320, VOFF = NS * KTB, VTB = 64 * VS, STG = VOFF + VTB;
  constexpr int KCR = DQK / 8, KCH = 64 * KCR, VCR = DV / 8, VCH = 64 * VCR, NCH = NS * KCH + VCH, NI = (NCH + NTHREADS - 1) / NTHREADS;
  constexpr int NDB = DV / 32, NKS = DQK / 16;
  static_assert(3 * STG <= LDS_BYTES - 16 && (NS == 1 || 4 * DV * 32 * 4 <= 3 * STG), "LDS");
  const int tid = otid(wv), lane = tid & 63, wid = tid >> 6, l31 = lane & 31, hi = lane >> 5;
  const int grp = wid >> 2;
  const int qsub = (NS == 1) ? wid : (wid & 3), stream = (NS == 1) ? 0 : grp;
  const int qrow = q0 + qsub * 32 + l31;
  bf16x8 qf[NKS];
  float qn2 = 0.f;
#pragma unroll
  for (int ks = 0; ks < NKS; ++ks) {
    const u32x4 w = *(const u32x4*)(Qb + (size_t)stream * qsoff + (size_t)qrow * ldq + ks * 16 + hi * 8);
    qf[ks] = __builtin_bit_cast(bf16x8, w);
    const float a0 = bf_lo(w.x), a1 = bf_hi(w.x), a2 = bf_lo(w.y), a3 = bf_hi(w.y), a4 = bf_lo(w.z), a5 = bf_hi(w.z), a6 = bf_lo(w.w), a7 = bf_hi(w.w);
    qn2 += a0 * a0 + a1 * a1 + a2 * a2 + a3 * a3 + a4 * a4 + a5 * a5 + a6 * a6 + a7 * a7;
  }
  qn2 += __shfl_xor(qn2, 32);
  const float negmb = -(sqrtf(qn2) * kmax);
  f32x16 negmv;
  if (DV == 64) {
#pragma unroll
    for (int r = 0; r < 16; ++r) negmv[r] = negmb;
    asm volatile("" : "+v"(negmv));
  }
  f32x16 o[NDB];
#pragma unroll
  for (int db = 0; db < NDB; ++db)
#pragma unroll
    for (int r = 0; r < 16; ++r) o[db][r] = 0.f;
  float lrun = 0.f;
  const int n1 = ta1 - ta0, ntl = n1 + (tb1 - tb0);
  u32x4 st[NI];
  f32x16 p0, p1;
  const LAS unsigned char* klb = lds + stream * KTB + l31 * KS + hi * 16;
  const LAS unsigned char* vlb = lds + VOFF + (4 * hi + ((lane & 15) >> 2)) * VS + (16 * ((lane >> 4) & 1) + 4 * (lane & 3)) * 2;
#define ATT_TILE(i_) (((i_) < n1) ? ta0 + (i_) : tb0 + ((i_) - n1))
#define ATT_LOAD(T_) do { const int t__ = (T_); _Pragma("unroll") for (int ii = 0; ii < NI; ++ii) { const int c = tid + ii * NTHREADS; if (c < NCH) { \
      if (c < NS * KCH) { const int s_ = c / KCH, cc = c - s_ * KCH, row = cc / KCR, kc = cc - row * KCR; st[ii] = *(const u32x4*)(Kb + (size_t)s_ * ksoff + (size_t)(t__ * 64 + row) * ldk + kc * 8); } \
      else { const int cc = c - NS * KCH, row = cc / VCR, vc = cc - row * VCR; st[ii] = *(const u32x4*)(Vb + (size_t)(t__ * 64 + row) * ldv + vc * 8); } } } } while (0)
#define ATT_STORE(BO_) do { LAS unsigned char* sb__ = lds + (BO_); _Pragma("unroll") for (int ii = 0; ii < NI; ++ii) { const int c = tid + ii * NTHREADS; if (c < NCH) { \
      if (c < NS * KCH) { const int s_ = c / KCH, cc = c - s_ * KCH, row = cc / KCR, kc = cc - row * KCR; *(LAS u32x4*)(sb__ + s_ * KTB + row * KS + kc * 16) = st[ii]; } \
      else { const int cc = c - NS * KCH, row = cc / VCR, vc = cc - row * VCR; *(LAS u32x4*)(sb__ + VOFF + row * VS + vc * 16) = st[ii]; } } } } while (0)
#define ATT_FLAGS(T_, ACT_, MSK_) do { ACT_ = true; MSK_ = false; if (WINDOW && (T_) < 32) { const int qlo = q0 + qsub * 32, qhi = qlo + 31, klo = (T_) * 64, khi = klo + 63; \
      ACT_ = !(khi < qlo - 128 || klo > qhi + 128); MSK_ = (khi - qlo > 128) || (qhi - klo > 128); } } while (0)
  constexpr int KB1 = NKS / 2;
  bf16x8 kf[2 * KB1];
#define ATT_QK_READ1(BO_) do { const LAS unsigned char* kl = klb + (BO_); \
      _Pragma("unroll") for (int ks = 0; ks < KB1; ++ks) { kf[2 * ks] = *(const LAS bf16x8*)(kl + ks * 32); kf[2 * ks + 1] = *(const LAS bf16x8*)(kl + 32 * KS + ks * 32); } \
      __builtin_amdgcn_sched_barrier(0); } while (0)
#define ATT_QK_REST(BO_) do { const LAS unsigned char* kl = klb + (BO_); \
      __builtin_amdgcn_sched_barrier(0); \
      if (DV == 64) { p0 = __builtin_amdgcn_mfma_f32_32x32x16_bf16(kf[0], qf[0], negmv, 0, 0, 0); p1 = __builtin_amdgcn_mfma_f32_32x32x16_bf16(kf[1], qf[0], negmv, 0, 0, 0); } \
      else { _Pragma("unroll") for (int r = 0; r < 16; ++r) { p0[r] = negmb; p1[r] = negmb; } p0 = __builtin_amdgcn_mfma_f32_32x32x16_bf16(kf[0], qf[0], p0, 0, 0, 0); p1 = __builtin_amdgcn_mfma_f32_32x32x16_bf16(kf[1], qf[0], p1, 0, 0, 0); } \
      _Pragma("unroll") for (int ks = 1; ks < KB1; ++ks) { p0 = __builtin_amdgcn_mfma_f32_32x32x16_bf16(kf[2 * ks], qf[ks], p0, 0, 0, 0); p1 = __builtin_amdgcn_mfma_f32_32x32x16_bf16(kf[2 * ks + 1], qf[ks], p1, 0, 0, 0); } \
      __builtin_amdgcn_sched_barrier(0); \
      _Pragma("unroll") for (int ks = KB1; ks < NKS; ++ks) { kf[2 * (ks - KB1)] = *(const LAS bf16x8*)(kl + ks * 32); kf[2 * (ks - KB1) + 1] = *(const LAS bf16x8*)(kl + 32 * KS + ks * 32); } \
      __builtin_amdgcn_sched_barrier(0); \
      _Pragma("unroll") for (int ks = KB1; ks < NKS; ++ks) { p0 = __builtin_amdgcn_mfma_f32_32x32x16_bf16(kf[2 * (ks - KB1)], qf[ks], p0, 0, 0, 0); p1 = __builtin_amdgcn_mfma_f32_32x32x16_bf16(kf[2 * (ks - KB1) + 1], qf[ks], p1, 0, 0, 0); } \
      __builtin_amdgcn_sched_barrier(0); } while (0)
#define ATT_VREAD(G_) do { _Pragma("unroll") for (int d2 = 0; d2 < GD; ++d2) _Pragma("unroll") for (int kb = 0; kb < 2; ++kb) _Pragma("unroll") for (int s_ = 0; s_ < 2; ++s_) { \
        const LAS unsigned char* vp = vl + (kb * 32 + 16 * s_) * VS + ((G_) * GD + d2) * 64; \
        vlo[d2 * 4 + kb * 2 + s_] = __builtin_amdgcn_ds_read_tr16_b64_v4i16((LAS v4i16_t*)vp); vhi[d2 * 4 + kb * 2 + s_] = __builtin_amdgcn_ds_read_tr16_b64_v4i16((LAS v4i16_t*)(vp + 8 * VS)); } } while (0)
#define ATT_PVM(G_) do { _Pragma("unroll") for (int d2 = 0; d2 < GD; ++d2) _Pragma("unroll") for (int kb = 0; kb < 2; ++kb) _Pragma("unroll") for (int s_ = 0; s_ < 2; ++s_) { \
        const v4i16_t lo_ = vlo[d2 * 4 + kb * 2 + s_], hi_ = vhi[d2 * 4 + kb * 2 + s_]; \
        const bf16x8 vf = (bf16x8){lo_[0], lo_[1], lo_[2], lo_[3], hi_[0], hi_[1], hi_[2], hi_[3]}; \
        o[(G_) * GD + d2] = __builtin_amdgcn_mfma_f32_32x32x16_bf16(vf, __builtin_bit_cast(bf16x8, pw[kb][s_]), o[(G_) * GD + d2], 0, 0, 0); } } while (0)
#define ATT_SPV(T_, BO_, MSK_) do { const LAS unsigned char* vl = vlb + (BO_); constexpr int GD = (DV == 128) ? 1 : 2; v4i16_t vlo[4 * GD], vhi[4 * GD]; \
      ATT_VREAD(0); __builtin_amdgcn_sched_barrier(0); \
      if (WINDOW && (MSK_)) { _Pragma("unroll") for (int r = 0; r < 16; ++r) { const int d0 = (T_) * 64 + crow(r, hi) - qrow, d1 = d0 + 32; \
          if (d0 > 128 || d0 < -128) p0[r] = -INFINITY; if (d1 > 128 || d1 < -128) p1[r] = -INFINITY; } } \
      _Pragma("unroll") for (int r = 0; r < 16; ++r) { p0[r] = __builtin_amdgcn_exp2f(p0[r]); p1[r] = __builtin_amdgcn_exp2f(p1[r]); } \
      u32x4 pw[2][2]; \
      _Pragma("unroll") for (int s_ = 0; s_ < 2; ++s_) { \
        pw[0][s_] = (u32x4){pk2(p0[8 * s_], p0[8 * s_ + 1]), pk2(p0[8 * s_ + 2], p0[8 * s_ + 3]), pk2(p0[8 * s_ + 4], p0[8 * s_ + 5]), pk2(p0[8 * s_ + 6], p0[8 * s_ + 7])}; \
        pw[1][s_] = (u32x4){pk2(p1[8 * s_], p1[8 * s_ + 1]), pk2(p1[8 * s_ + 2], p1[8 * s_ + 3]), pk2(p1[8 * s_ + 4], p1[8 * s_ + 5]), pk2(p1[8 * s_ + 6], p1[8 * s_ + 7])}; } \
      _Pragma("unroll") for (int kb = 0; kb < 2; ++kb) _Pragma("unroll") for (int s_ = 0; s_ < 2; ++s_) { \
        lrun = dot2bf(pw[kb][s_].x, 0x3f803f80u, lrun); lrun = dot2bf(pw[kb][s_].y, 0x3f803f80u, lrun); lrun = dot2bf(pw[kb][s_].z, 0x3f803f80u, lrun); lrun = dot2bf(pw[kb][s_].w, 0x3f803f80u, lrun); } \
      __builtin_amdgcn_sched_barrier(0); \
      ATT_PVM(0); \
      _Pragma("unroll") for (int g_ = 1; g_ < NDB / GD; ++g_) { __builtin_amdgcn_sched_barrier(0); ATT_VREAD(g_); __builtin_amdgcn_sched_barrier(0); ATT_PVM(g_); } } while (0)
  ATT_LOAD(ATT_TILE(0));
  ATT_STORE(0);
  if (ntl > 1) ATT_LOAD(ATT_TILE(1));
  __syncthreads();
  int bo_prev = 0, bo_cur = 0, bo_next = STG;
  for (int i = 0; i <= ntl; ++i) {
    if (grp == 0) {
      if (i < ntl) {
        const int t = ATT_TILE(i);
        bool act, msk; ATT_FLAGS(t, act, msk);
        if (act) ATT_QK_READ1(bo_cur);
        if (i + 1 < ntl) ATT_STORE(bo_next);
        if (i + 2 < ntl) ATT_LOAD(ATT_TILE(i + 2));
        if (act) { ATT_QK_REST(bo_cur); ATT_SPV(t, bo_cur, msk); }
      }
    } else {
      if (i >= 1) { const int tp = ATT_TILE(i - 1); bool act, msk; ATT_FLAGS(tp, act, msk); if (act) ATT_SPV(tp, bo_prev, msk); }
      if (i < ntl) {
        const int t = ATT_TILE(i);
        bool act, msk; ATT_FLAGS(t, act, msk);
        if (act) ATT_QK_READ1(bo_cur);
        if (i + 1 < ntl) ATT_STORE(bo_next);
        if (i + 2 < ntl) ATT_LOAD(ATT_TILE(i + 2));
        if (act) ATT_QK_REST(bo_cur);
      }
    }
    bo_prev = bo_cur; bo_cur = bo_next; bo_next = (bo_next == 2 * STG) ? 0 : bo_next + STG;
    __syncthreads();
  }
#undef ATT_LOAD
#undef ATT_STORE
#undef ATT_TILE
#undef ATT_FLAGS
#undef ATT_QK_READ1
#undef ATT_QK_REST
#undef ATT_VREAD
#undef ATT_PVM
#undef ATT_SPV
  float ltot = lrun + __shfl_xor(lrun, 32);
  if (has_sink) ltot += __builtin_amdgcn_exp2f(sink_l2 + negmb);
  const float inv = 1.f / ltot;
  if (NS == 1) {
    unsigned char* op = Ob + (size_t)qrow * ldo + 4 * hi; const float is_ = inv * OSC;
#pragma unroll
    for (int db = 0; db < NDB; ++db)
#pragma unroll
      for (int r4 = 0; r4 < 4; ++r4)
        *(unsigned*)(op + db * 32 + 8 * r4) = pk4_fp8(o[db][4 * r4] * is_, o[db][4 * r4 + 1] * is_, o[db][4 * r4 + 2] * is_, o[db][4 * r4 + 3] * is_);
  } else {
    LAS float* ex = (LAS float*)lds + qsub * (DV * 32);
    if (stream == 1) {
#pragma unroll
      for (int db = 0; db < NDB; ++db)
#pragma unroll
        for (int r = 0; r < 16; ++r) ex[(db * 32 + crow(r, hi)) * 32 + l31] = o[db][r] * inv;
    }
    __syncthreads();
    if (stream == 0) {
      float ss = 0.f;
#pragma unroll
      for (int db = 0; db < NDB; ++db)
#pragma unroll
        for (int r = 0; r < 16; ++r) { const float v = o[db][r] * inv - lam * ex[(db * 32 + crow(r, hi)) * 32 + l31]; o[db][r] = v; ss += v * v; }
      ss += __shfl_xor(ss, 32);
      const float rs = rsqrtf(ss * (1.f / DV) + EPS) * (1.f - LAM_INIT);
      unsigned char* op = Ob + (size_t)qrow * ldo + 4 * hi; const float rs_ = rs * OSC;
#pragma unroll
      for (int db = 0; db < NDB; ++db)
#pragma unroll
        for (int r4 = 0; r4 < 4; ++r4) {
          const f32x4 g4 = *(const f32x4*)(gsub + db * 32 + 8 * r4 + 4 * hi);
          *(unsigned*)(op + db * 32 + 8 * r4) = pk4_fp8(o[db][4 * r4] * rs_ * g4.x, o[db][4 * r4 + 1] * rs_ * g4.y, o[db][4 * r4 + 2] * rs_ * g4.z, o[db][4 * r4 + 3] * rs_ * g4.w);
        }
    }
    __syncthreads();
  }
}

template <int DQK, int DV, bool WINDOW>
__device__ __forceinline__ void attn_unit_p(LAS unsigned char* lds, const bf16_t* __restrict__ Qb, int ldq, const bf16_t* __restrict__ Kb, int ldk, const bf16_t* __restrict__ Vb, int ldv,
                                            int q0, int ta0, int ta1, int tb0, int tb1, bool has_sink, float sink_l2, float kmax, unsigned char* __restrict__ Ob, int ldo, int wv) {
  static_assert(DV == 64 && !WINDOW, "pipelined form: DV = 64, no window");
  constexpr int KS = DQK * 2 + 16, KTB = 64 * KS, VS = 192, VOFF = KTB, VTB = 64 * VS, STG = VOFF + VTB;
  constexpr int KCR = DQK / 8, KCH = 64 * KCR, VCR = DV / 8, VCH = 64 * VCR, NCH = KCH + VCH, NI = (NCH + NTHREADS - 1) / NTHREADS;
  constexpr int NKS = DQK / 16, NQK = 2 * NKS, NPV = 8, EG = (NQK >= 12) ? 8 : NQK - 2;
  static_assert(3 * STG <= LDS_BYTES - 16, "LDS");
  const int tid = otid(wv), lane = tid & 63, wid = tid >> 6, l31 = lane & 31, hi = lane >> 5;
  const int qrow = q0 + wid * 32 + l31;
  bf16x8 qf[NKS];
  float qn2 = 0.f;
#pragma unroll
  for (int ks = 0; ks < NKS; ++ks) {
    const u32x4 w = *(const u32x4*)(Qb + (size_t)qrow * ldq + ks * 16 + hi * 8);
    qf[ks] = __builtin_bit_cast(bf16x8, w);
    const float a0 = bf_lo(w.x), a1 = bf_hi(w.x), a2 = bf_lo(w.y), a3 = bf_hi(w.y), a4 = bf_lo(w.z), a5 = bf_hi(w.z), a6 = bf_lo(w.w), a7 = bf_hi(w.w);
    qn2 += a0 * a0 + a1 * a1 + a2 * a2 + a3 * a3 + a4 * a4 + a5 * a5 + a6 * a6 + a7 * a7;
  }
  qn2 += __shfl_xor(qn2, 32);
  const float negmb = -(sqrtf(qn2) * kmax);
  f32x16 negmv;
#pragma unroll
  for (int r = 0; r < 16; ++r) negmv[r] = negmb;
  asm volatile("" : "+v"(negmv));
  f32x16 o[2];
#pragma unroll
  for (int db = 0; db < 2; ++db)
#pragma unroll
    for (int r = 0; r < 16; ++r) o[db][r] = 0.f;
  float lrun = 0.f;
  const int n1 = ta1 - ta0, ntl = n1 + (tb1 - tb0);
  u32x4 st[NI];
  f32x16 pA0, pA1, pB0, pB1;
  bf16x8 kw[3];
  v4i16_t vwl[3], vwh[3];
  u32x4 pw[2][2];
  const LAS unsigned char* klb = lds + l31 * KS + hi * 16;
  const LAS unsigned char* vlb = lds + VOFF + (4 * hi + ((lane & 15) >> 2)) * VS + (16 * ((lane >> 4) & 1) + 4 * (lane & 3)) * 2;
#define ATT_TILE(i_) (((i_) < n1) ? ta0 + (i_) : tb0 + ((i_) - n1))
  unsigned gof[NI], lof[NI];
#pragma unroll
  for (int ii = 0; ii < NI; ++ii) { const int cw = (wv + 8 * ii) * 64, c = cw + lane;
    if (cw < KCH) { const int row = c / KCR, kc = c - row * KCR; gof[ii] = (unsigned)(row * ldk + kc * 8) * 2u; lof[ii] = (unsigned)(row * KS + kc * 16); }
    else { const int cc = c - KCH, row = cc / VCR, vc = cc - row * VCR; gof[ii] = (unsigned)(row * ldv + vc * 8) * 2u; lof[ii] = (unsigned)(VOFF + row * VS + vc * 16); } }
#define ATT_LOAD(T_) do { const int t__ = (T_); _Pragma("unroll") for (int ii = 0; ii < NI; ++ii) { const int cw = (wv + 8 * ii) * 64; if (cw < NCH) { \
      const char* gb__ = (cw < KCH) ? (const char*)Kb + (size_t)t__ * 128 * ldk : (const char*)Vb + (size_t)t__ * 128 * ldv; st[ii] = *(const u32x4*)(gb__ + gof[ii]); } } } while (0)
#define ATT_STORE(BO_) do { _Pragma("unroll") for (int ii = 0; ii < NI; ++ii) { const int cw = (wv + 8 * ii) * 64; if (cw < NCH) *(LAS u32x4*)(lds + (BO_) + lof[ii]) = st[ii]; } } while (0)
#define SB_() __builtin_amdgcn_sched_barrier(0)
#define KRD1(BO_, G_) do { kw[(G_) % 3] = *(const LAS bf16x8*)(klb + (BO_) + ((G_) & 1) * 32 * KS + ((G_) >> 1) * 32); } while (0)
#define VRDG(BO_, G_) do { const LAS unsigned char* vp = vlb + (BO_) + ((((G_) >> 2) & 1) * 32 + 16 * (((G_) >> 1) & 1)) * VS + ((G_) & 1) * 64; \
      vwl[(G_) % 3] = __builtin_amdgcn_ds_read_tr16_b64_v4i16((LAS v4i16_t*)vp); vwh[(G_) % 3] = __builtin_amdgcn_ds_read_tr16_b64_v4i16((LAS v4i16_t*)(vp + 8 * VS)); } while (0)
#define QKM(R0_, R1_, G_) do { const int ks_ = (G_) >> 1; \
      if (((G_) & 1) == 0) R0_ = __builtin_amdgcn_mfma_f32_32x32x16_bf16(kw[(G_) % 3], qf[ks_], (ks_ == 0) ? negmv : R0_, 0, 0, 0); \
      else R1_ = __builtin_amdgcn_mfma_f32_32x32x16_bf16(kw[(G_) % 3], qf[ks_], (ks_ == 0) ? negmv : R1_, 0, 0, 0); } while (0)
#define PVM(G_) do { const int d2_ = (G_) & 1, kb_ = ((G_) >> 2) & 1, s_ = ((G_) >> 1) & 1; \
      const v4i16_t lo_ = vwl[(G_) % 3], hi_ = vwh[(G_) % 3]; const bf16x8 vf = (bf16x8){lo_[0], lo_[1], lo_[2], lo_[3], hi_[0], hi_[1], hi_[2], hi_[3]}; \
      o[d2_] = __builtin_amdgcn_mfma_f32_32x32x16_bf16(vf, __builtin_bit_cast(bf16x8, pw[kb_][s_]), o[d2_], 0, 0, 0); } while (0)
#define PACK1(P_, KB_, C_) do { const int s_ = (C_) >> 2, e_ = (C_) & 3; pw[KB_][s_][e_] = pk2(P_[8 * s_ + 2 * e_], P_[8 * s_ + 2 * e_ + 1]); } while (0)
#define EXPR(P_, LO_, HI_) do { _Pragma("unroll") for (int x_ = (LO_); x_ < (HI_); ++x_) { float e_ = __builtin_amdgcn_exp2f(P_[x_]); asm volatile("" : "+v"(e_)); P_[x_] = e_; } } while (0)
#define SUMR(P_, LO_, HI_) do { _Pragma("unroll") for (int x_ = (LO_); x_ < (HI_); ++x_) lrun += P_[x_]; asm volatile("" : "+v"(lrun)); } while (0)
#define FILL_A(E0_, E1_, G_) do { \
      if ((G_) < EG) EXPR(E1_, ((G_) * 16) / EG, (((G_) + 1) * 16) / EG); \
      if ((G_) >= 1 && (G_) <= EG) SUMR(E1_, (((G_) - 1) * 16) / EG, ((G_) * 16) / EG); \
      if ((G_) < EG) { _Pragma("unroll") for (int c = ((G_) * 8) / EG; c < (((G_) + 1) * 8) / EG; ++c) PACK1(E0_, 0, c); } \
      else { _Pragma("unroll") for (int c = (((G_) - EG) * 8) / (NQK - EG); c < (((G_) - EG + 1) * 8) / (NQK - EG); ++c) PACK1(E1_, 1, c); } } while (0)
#define FILL_B(R0_, G_) do { EXPR(R0_, 2 * (G_), 2 * (G_) + 2); if ((G_) >= 1) SUMR(R0_, 2 * (G_) - 2, 2 * (G_)); if ((G_) == NPV - 1) SUMR(R0_, 14, 16); } while (0)
#define STEP_MID(R0_, R1_, E0_, E1_, BOC_, BOP_) do { \
      _Pragma("unroll") for (int g = 0; g < NQK; ++g) { \
        QKM(R0_, R1_, g); \
        if (g + 2 < NQK) KRD1(BOC_, g + 2); \
        if (g >= NQK - 2) VRDG(BOP_, g - (NQK - 2)); \
        FILL_A(E0_, E1_, g); \
        SB_(); } \
      _Pragma("unroll") for (int g = 0; g < NPV; ++g) { \
        PVM(g); \
        if (g + 2 < NPV) VRDG(BOP_, g + 2); \
        FILL_B(R0_, g); \
        SB_(); } } while (0)
#define STEP_HEAD(R0_, R1_, BOC_) do { \
      _Pragma("unroll") for (int g = 0; g < NQK; ++g) { QKM(R0_, R1_, g); if (g + 2 < NQK) KRD1(BOC_, g + 2); SB_(); } \
      _Pragma("unroll") for (int g = 0; g < NPV; ++g) { FILL_B(R0_, g); } SB_(); } while (0)
#define STEP_TAIL(E0_, E1_, BOP_) do { \
      VRDG(BOP_, 0); VRDG(BOP_, 1); \
      _Pragma("unroll") for (int g = 0; g < NQK; ++g) FILL_A(E0_, E1_, g); SB_(); \
      _Pragma("unroll") for (int g = 0; g < NPV; ++g) { PVM(g); if (g + 2 < NPV) VRDG(BOP_, g + 2); SB_(); } } while (0)
#define STEP_PRE(I_, KR_) do { const int i__ = (I_); \
      if (KR_) { KRD1(bo_cur, 0); KRD1(bo_cur, 1); } \
      if (i__ + 1 < ntl) ATT_STORE(bo_next); \
      if (i__ + 2 < ntl) ATT_LOAD(ATT_TILE(i__ + 2)); \
      SB_(); } while (0)
#define STEP_POST() do { bo_prev = bo_cur; bo_cur = bo_next; bo_next = (bo_next == 2 * STG) ? 0 : bo_next + STG; __syncthreads(); } while (0)
  ATT_LOAD(ATT_TILE(0));
  ATT_STORE(0);
  if (ntl > 1) ATT_LOAD(ATT_TILE(1));
  __syncthreads();
  int bo_prev = 0, bo_cur = 0, bo_next = STG;
  STEP_PRE(0, true); STEP_HEAD(pA0, pA1, bo_cur); STEP_POST();
  int it = 1;
  for (; it + 1 < ntl; it += 2) {
    STEP_PRE(it, true); STEP_MID(pB0, pB1, pA0, pA1, bo_cur, bo_prev); STEP_POST();
    STEP_PRE(it + 1, true); STEP_MID(pA0, pA1, pB0, pB1, bo_cur, bo_prev); STEP_POST();
  }
  if (it < ntl) {
    STEP_PRE(it, true); STEP_MID(pB0, pB1, pA0, pA1, bo_cur, bo_prev); STEP_POST();
    STEP_TAIL(pB0, pB1, bo_prev);
  } else {
    STEP_TAIL(pA0, pA1, bo_prev);
  }
  __syncthreads();
#undef ATT_TILE
#undef ATT_LOAD
#undef ATT_STORE
#undef SB_
#undef KRD1
#undef VRDG
#undef QKM
#undef PVM
#undef PACK1
#undef EXPR
#undef SUMR
#undef FILL_A
#undef FILL_B
#undef STEP_MID
#undef STEP_HEAD
#undef STEP_TAIL
#undef STEP_PRE
#undef STEP_POST
  float ltot = lrun + __shfl_xor(lrun, 32);
  if (has_sink) ltot += __builtin_amdgcn_exp2f(sink_l2 + negmb);
  const float is_ = OSC / ltot;
  unsigned char* op = Ob + (size_t)qrow * ldo + 4 * hi;
#pragma unroll
  for (int db = 0; db < 2; ++db)
#pragma unroll
    for (int r4 = 0; r4 < 4; ++r4)
      *(unsigned*)(op + db * 32 + 8 * r4) = pk4_fp8(o[db][4 * r4] * is_, o[db][4 * r4 + 1] * is_, o[db][4 * r4 + 2] * is_, o[db][4 * r4 + 3] * is_);
}

#define TOPK_INSERT(ARR, KEY) do { unsigned k__ = (KEY); _Pragma("unroll") for (int t_ = 0; t_ < 16; ++t_) { const unsigned h__ = max(ARR[t_], k__); k__ = min(ARR[t_], k__); ARR[t_] = h__; } } while (0)
__device__ __forceinline__ void peer_phase(LAS unsigned char* lds, const bf16_t* __restrict__ S, const unsigned char* __restrict__ H, const unsigned char* __restrict__ U, const unsigned char* __restrict__ V, float uinv, float vinv,
                                           const float* __restrict__ modl, bf16_t* xl, bf16_t* xc, float* outf, bool last, bool live, unsigned char* Hn, const float* __restrict__ gn, const float* __restrict__ modn, int wv) {
  const int tid_ = otid(wv); const int lane = tid_ & 63, wid = tid_ >> 6;
  LAS unsigned* keysL = (LAS unsigned*)(lds + wid * 9216);
  LAS u32x2* resL = (LAS u32x2*)(lds + wid * 9216 + 4096);
  LAS float* wL = (LAS float*)(lds + wid * 9216 + 8192);
  const int ngroups = last ? (NB * SEQ / 4) : (M / 4);
  const int nwav = gridDim.x * NWAVES, nfull = (ngroups / nwav) * nwav, nitems = nfull + (ngroups - nfull) * 4;
  for (int q = blockIdx.x * NWAVES + wid; q < nitems; q += nwav) {
    const int g = (q < nfull) ? q : nfull + ((q - nfull) >> 2);
    const int tk0 = (q < nfull) ? 0 : ((q - nfull) & 3), tk1 = (q < nfull) ? 4 : tk0 + 1;
    const int r0 = last ? (g / (SEQ / 4)) * TPB + (g % (SEQ / 4)) * 4 : g * 4;
    const int tok = lane >> 4, hc = lane & 15;
    unsigned top[16];
    const bf16_t* sp = S + (size_t)(r0 + tok) * 2048 + hc * 128;
#define CE_DESC(A_, B_) do { const unsigned h__ = max(A_, B_), l__ = min(A_, B_); A_ = h__; B_ = l__; } while (0)
#pragma unroll 1
    for (int j0 = 0; j0 < 128; j0 += 16) {
      unsigned blk[16];
      { const u32x4 v0 = *(const u32x4*)(sp + j0), v1 = *(const u32x4*)(sp + j0 + 8);
        const unsigned base = (unsigned)(127 - j0);
        blk[0] = (f2ord(bf_lo(v0.x)) & ~127u) | (base - 0u);  blk[1] = (f2ord(bf_hi(v0.x)) & ~127u) | (base - 1u);
        blk[2] = (f2ord(bf_lo(v0.y)) & ~127u) | (base - 2u);  blk[3] = (f2ord(bf_hi(v0.y)) & ~127u) | (base - 3u);
        blk[4] = (f2ord(bf_lo(v0.z)) & ~127u) | (base - 4u);  blk[5] = (f2ord(bf_hi(v0.z)) & ~127u) | (base - 5u);
        blk[6] = (f2ord(bf_lo(v0.w)) & ~127u) | (base - 6u);  blk[7] = (f2ord(bf_hi(v0.w)) & ~127u) | (base - 7u);
        blk[8] = (f2ord(bf_lo(v1.x)) & ~127u) | (base - 8u);  blk[9] = (f2ord(bf_hi(v1.x)) & ~127u) | (base - 9u);
        blk[10] = (f2ord(bf_lo(v1.y)) & ~127u) | (base - 10u); blk[11] = (f2ord(bf_hi(v1.y)) & ~127u) | (base - 11u);
        blk[12] = (f2ord(bf_lo(v1.z)) & ~127u) | (base - 12u); blk[13] = (f2ord(bf_hi(v1.z)) & ~127u) | (base - 13u);
        blk[14] = (f2ord(bf_lo(v1.w)) & ~127u) | (base - 14u); blk[15] = (f2ord(bf_hi(v1.w)) & ~127u) | (base - 15u); }
#pragma unroll
      for (int k = 2; k <= 16; k <<= 1)
#pragma unroll
        for (int j = k >> 1; j > 0; j >>= 1)
#pragma unroll
          for (int i = 0; i < 16; ++i) { const int l = i ^ j; if (l > i) { if ((i & k) == 0) CE_DESC(blk[i], blk[l]); else CE_DESC(blk[l], blk[i]); } }
      if (j0 == 0) {
#pragma unroll
        for (int i = 0; i < 16; ++i) top[i] = blk[i];
      } else {
#pragma unroll
        for (int i = 0; i < 16; ++i) top[i] = max(top[i], blk[15 - i]);
#pragma unroll
        for (int j = 8; j > 0; j >>= 1)
#pragma unroll
          for (int i = 0; i < 16; ++i) { const int l = i ^ j; if (l > i) CE_DESC(top[i], top[l]); }
      }
    }
#undef CE_DESC
#pragma unroll
    for (int i = 0; i < 16; ++i) keysL[lane * 16 + i] = top[i];
    float v0[16], v1[16];
#pragma unroll
    for (int i = 0; i < 16; ++i) { const unsigned t1 = __shfl_down(top[i], 1); v0[i] = ord2f(top[i] & ~127u); v1[i] = ord2f(t1 & ~127u); }
    unsigned cd[16];
#pragma unroll
    for (int i = 0; i < 16; ++i) cd[i] = 0u;
#pragma unroll
    for (int a = 0; a < 16; ++a)
#pragma unroll
      for (int b = 0; b < 16 / (a + 1); ++b) TOPK_INSERT(cd, (f2ord(v0[a] + v1[b]) & ~255u) | (unsigned)(255 - (a * 16 + b)));
    {
      float e[16]; float sum = 0.f; const float mx = ord2f(cd[0] & ~255u);
#pragma unroll
      for (int k = 0; k < 16; ++k) { e[k] = __expf(ord2f(cd[k] & ~255u) - mx); sum += e[k]; }
      const float inv = 1.f / sum;
      const int lp1 = (lane + 1) & 63;
#pragma unroll
      for (int k = 0; k < 16; ++k) {
        const int pos = 255 - (int)(cd[k] & 255u), a = pos >> 4, b = pos & 15;
        const unsigned i1 = 127u - (keysL[lane * 16 + a] & 127u), i2 = 127u - (keysL[lp1 * 16 + b] & 127u);
        if ((hc & 1) == 0) resL[tok * 128 + (hc >> 1) * 16 + k] = (u32x2){i1 * 128u + i2, __float_as_uint(e[k] * inv)};
      }
    }
    for (int tk = tk0; tk < tk1; ++tk) {
      const int r = r0 + tk;
      float hf[16];
      { const bf16_t* hrow = (const bf16_t*)H + (size_t)r * D + lane * 16; const u32x4 ha = *(const u32x4*)hrow, hb = *(const u32x4*)(hrow + 8);
        hf[0] = bf_lo(ha.x); hf[1] = bf_hi(ha.x); hf[2] = bf_lo(ha.y); hf[3] = bf_hi(ha.y); hf[4] = bf_lo(ha.z); hf[5] = bf_hi(ha.z); hf[6] = bf_lo(ha.w); hf[7] = bf_hi(ha.w);
        hf[8] = bf_lo(hb.x); hf[9] = bf_hi(hb.x); hf[10] = bf_lo(hb.y); hf[11] = bf_hi(hb.y); hf[12] = bf_lo(hb.z); hf[13] = bf_hi(hb.z); hf[14] = bf_lo(hb.w); hf[15] = bf_hi(hb.w); }
      unsigned hq1a = 0u, hq1b = 0u, hq2a = 0u, hq2b = 0u; float hstep;
      { float ss = 0.f;
#pragma unroll
        for (int j = 0; j < 16; ++j) ss += hf[j] * hf[j];
        ss = wave_sum(ss);
        hstep = 0.5f * sqrtf(ss * (1.f / D) + 1e-20f); const float rs = 1.f / hstep;
#pragma unroll
        for (int j = 0; j < 16; ++j) {
          const float t = hf[j] * rs; int q1 = (int)rintf(t); q1 = min(7, max(-8, q1));
          int q2 = (int)rintf((t - (float)q1) * 16.f); q2 = min(7, max(-8, q2));
          if (j < 8) { hq1a |= ((unsigned)q1 & 15u) << (4 * j); hq2a |= ((unsigned)q2 & 15u) << (4 * j); }
          else { hq1b |= ((unsigned)q1 & 15u) << (4 * (j - 8)); hq2b |= ((unsigned)q2 & 15u) << (4 * (j - 8)); }
        } }
      const float uscale = uinv * hstep * (1.f / 16.f);
      f32x2_t o2[8];
#pragma unroll
      for (int j = 0; j < 8; ++j) o2[j] = (f32x2_t){0.f, 0.f};
      const bool b5 = (lane & 32) != 0, b4 = (lane & 16) != 0, b3 = (lane & 8) != 0, b2 = (lane & 4) != 0;
      const int ei = (lane >> 2) & 15;
      u32x2 ua[16], va[16], ub[16], vb[16];
      const unsigned lane8 = (unsigned)lane * 8u;
#define PEER_LOAD(UU, VV, BT) do { _Pragma("unroll") for (int i = 0; i < 16; ++i) { const unsigned o_ = resL[tk * 128 + (BT) * 16 + i].x * 512u + lane8;     \
        UU[i] = *(const u32x2*)(U + o_); VV[i] = *(const u32x2*)(V + o_); } } while (0)
#define PEER_PROC(UU, VV, BT) do { float d[16]; \
        _Pragma("unroll") for (int i = 0; i < 16; ++i) { const int w0 = (int)UU[i].x, w1 = (int)UU[i].y; \
          const int i1 = __builtin_amdgcn_sdot8(w1, (int)hq1b, __builtin_amdgcn_sdot8(w0, (int)hq1a, 0, false), false); \
          const int i2 = __builtin_amdgcn_sdot8(w1, (int)hq2b, __builtin_amdgcn_sdot8(w0, (int)hq2a, 0, false), false); \
          d[i] = (float)(i1 * 16 + i2); } \
        float k8[8], k4[4], k2[2], k1; \
        _Pragma("unroll") for (int i = 0; i < 8; ++i) { const auto r_ = __builtin_amdgcn_permlane32_swap(__float_as_uint(d[i]), __float_as_uint(d[8 + i]), false, false); k8[i] = __uint_as_float(r_[0]) + __uint_as_float(r_[1]); } \
        _Pragma("unroll") for (int i = 0; i < 4; ++i) { const auto r_ = __builtin_amdgcn_permlane16_swap(__float_as_uint(k8[i]), __float_as_uint(k8[4 + i]), false, false); k4[i] = __uint_as_float(r_[0]) + __uint_as_float(r_[1]); } \
        _Pragma("unroll") for (int i = 0; i < 2; ++i) { \
          const float sa = k4[i] + __int_as_float(__builtin_amdgcn_update_dpp(0, __float_as_int(k4[i]), 0x128, 0xf, 0xf, false)); \
          const float sb = k4[2 + i] + __int_as_float(__builtin_amdgcn_update_dpp(0, __float_as_int(k4[2 + i]), 0x128, 0xf, 0xf, false)); \
          k2[i] = b3 ? sb : sa; } \
        { const float keep = b2 ? k2[1] : k2[0], send = b2 ? k2[0] : k2[1]; k1 = keep + __shfl_xor(send, 4); } \
        k1 += __shfl_xor(k1, 2); k1 += __shfl_xor(k1, 1); \
        const float tot = k1 * uscale; \
        const float gate = __uint_as_float(resL[tk * 128 + (BT) * 16 + ei].y); \
        const float wact = 0.5f * tot * (1.f + erff(tot * 0.70710678118f)) * gate * vinv; \
        _Pragma("unroll") for (int i = 0; i < 16; ++i) { const float wi = __int_as_float(__builtin_amdgcn_readlane(__float_as_int(wact), 4 * i)); const f32x2_t w2 = {wi, wi}; const unsigned w0 = VV[i].x, w1 = VV[i].y; \
          o2[0] = __builtin_elementwise_fma(__builtin_amdgcn_cvt_scalef32_pk_f32_fp4(w0, 1.0f, 0), w2, o2[0]); o2[1] = __builtin_elementwise_fma(__builtin_amdgcn_cvt_scalef32_pk_f32_fp4(w0, 1.0f, 1), w2, o2[1]); \
          o2[2] = __builtin_elementwise_fma(__builtin_amdgcn_cvt_scalef32_pk_f32_fp4(w0, 1.0f, 2), w2, o2[2]); o2[3] = __builtin_elementwise_fma(__builtin_amdgcn_cvt_scalef32_pk_f32_fp4(w0, 1.0f, 3), w2, o2[3]); \
          o2[4] = __builtin_elementwise_fma(__builtin_amdgcn_cvt_scalef32_pk_f32_fp4(w1, 1.0f, 0), w2, o2[4]); o2[5] = __builtin_elementwise_fma(__builtin_amdgcn_cvt_scalef32_pk_f32_fp4(w1, 1.0f, 1), w2, o2[5]); \
          o2[6] = __builtin_elementwise_fma(__builtin_amdgcn_cvt_scalef32_pk_f32_fp4(w1, 1.0f, 2), w2, o2[6]); o2[7] = __builtin_elementwise_fma(__builtin_amdgcn_cvt_scalef32_pk_f32_fp4(w1, 1.0f, 3), w2, o2[7]); } } while (0)
      PEER_LOAD(ua, va, 0);
      for (int bt = 0; bt < 8; bt += 2) {
        PEER_LOAD(ub, vb, bt + 1);
        PEER_PROC(ua, va, bt);
        if (bt + 2 < 8) PEER_LOAD(ua, va, bt + 2);
        PEER_PROC(ub, vb, bt + 1);
      }
#undef PEER_LOAD
#undef PEER_PROC
      if (live) {
        const int b = r / TPB, s = r - b * TPB; const int bi = (s >= SEQ) ? 8 : b;
        bf16_t* xp = xrow_ptr(xl, xc, r) + lane * 16; const float* gt = modl + (size_t)(bi * 6 + 5) * D + lane * 16;
        f32x4 xn[4]; float ss = 0.f;
        { const u32x4 xa = *(const u32x4*)xp, xb = *(const u32x4*)(xp + 8);
          xn[0] = (f32x4){bf_lo(xa.x), bf_hi(xa.x), bf_lo(xa.y), bf_hi(xa.y)}; xn[1] = (f32x4){bf_lo(xa.z), bf_hi(xa.z), bf_lo(xa.w), bf_hi(xa.w)};
          xn[2] = (f32x4){bf_lo(xb.x), bf_hi(xb.x), bf_lo(xb.y), bf_hi(xb.y)}; xn[3] = (f32x4){bf_lo(xb.z), bf_hi(xb.z), bf_lo(xb.w), bf_hi(xb.w)}; }
#pragma unroll
        for (int q = 0; q < 4; ++q) {
          const f32x4 gv = ((const f32x4*)gt)[q];
          xn[q] += gv * (f32x4){o2[2 * q].x, o2[2 * q].y, o2[2 * q + 1].x, o2[2 * q + 1].y};
          ss += xn[q].x * xn[q].x + xn[q].y * xn[q].y + xn[q].z * xn[q].z + xn[q].w * xn[q].w;
        }
        if (last) {
          float* op = outf + (size_t)(b * SEQ + s) * D + lane * 16;
#pragma unroll
          for (int q = 0; q < 4; ++q) ((f32x4*)op)[q] = xn[q];
        } else {
          *(u32x4*)xp = (u32x4){pk2(xn[0].x, xn[0].y), pk2(xn[0].z, xn[0].w), pk2(xn[1].x, xn[1].y), pk2(xn[1].z, xn[1].w)};
          *(u32x4*)(xp + 8) = (u32x4){pk2(xn[2].x, xn[2].y), pk2(xn[2].z, xn[2].w), pk2(xn[3].x, xn[3].y), pk2(xn[3].z, xn[3].w)};
        }
        if (Hn != nullptr) {
          ss = wave_sum(ss);
          const float rstd = rsqrtf(ss * (1.f / D) + EPS);
          const float* sh = modn + (size_t)(bi * 6) * D + lane * 16; const float* sc = sh + D; const float* gg = gn + lane * 16;
          u32x4 h0;
#pragma unroll
          for (int q = 0; q < 4; ++q) {
            const f32x4 g4 = ((const f32x4*)gg)[q], s4 = ((const f32x4*)sc)[q], h4 = ((const f32x4*)sh)[q];
            const f32x4 y = (xn[q] * rstd * g4 * (1.f + s4) + h4) * ASC;
            h0[q] = pk4_fp8(y.x, y.y, y.z, y.w);
          }
          *(u32x4*)(Hn + (size_t)r * D + lane * 16) = h0;
        }
      }
    }
  }
}

#define XB_TMO      128
#define XB_XCNT(j)  (256  + 64 * (j))
#define XB_XSUB(j)  (1280 + 64 * (j))
#define XB_XGEN(j)  (2304 + 64 * (j))
#define XB_TOP      3328
#define XB_TOPGEN   3392
#define XCD_BAR_WORDS 3456
#define XB_SPIN_CAP (1u << 20)
__device__ __forceinline__ unsigned xb_ld(unsigned* p)              { return __hip_atomic_load(p, __ATOMIC_RELAXED, __HIP_MEMORY_SCOPE_AGENT); }
__device__ __forceinline__ unsigned xb_add(unsigned* p, unsigned v) { return __hip_atomic_fetch_add(p, v, __ATOMIC_RELAXED, __HIP_MEMORY_SCOPE_AGENT); }
__device__ __forceinline__ unsigned xb_xcc_id() { return (unsigned)__builtin_amdgcn_s_getreg((3 << 11) | 20) & 0xFu; }
#define XB_SPIN(cond, bar) do { unsigned _sp = 0; while (cond) { __builtin_amdgcn_s_sleep(1); \
    if ((++_sp & 255u) == 0u) { if (xb_ld(&(bar)[XB_TMO])) break; if (_sp > XB_SPIN_CAP) { atomicAdd(&(bar)[XB_TMO], 1u); break; } } } } while (0)
struct XcdBarrier { unsigned* bar; unsigned x; volatile LAS unsigned* st; };
__device__ __forceinline__ XcdBarrier xcd_barrier_post(unsigned* bar, volatile LAS unsigned* st) {
    XcdBarrier b; b.bar = bar; b.x = xb_xcc_id(); b.st = st;
    if (threadIdx.x == 0) (void)xb_add(&bar[XB_XCNT(b.x)], 1u);
    return b;
}
__device__ __forceinline__ void xcd_barrier_complete(unsigned* bar, unsigned x, unsigned& nloc, unsigned& nx) {
    const unsigned G = gridDim.x * gridDim.y * gridDim.z;
    unsigned sum, cnt, mine, sp = 0u;
    for (;;) {
        sum = 0u; cnt = 0u; mine = 0u;
#pragma unroll
        for (unsigned j = 0; j < 16; ++j) { const unsigned c = xb_ld(&bar[XB_XCNT(j)]); sum += c; cnt += (c > 0u) ? 1u : 0u; mine = (j == x) ? c : mine; }
        if (sum == G) break;
        __builtin_amdgcn_s_sleep(1);
        if ((++sp & 255u) == 0u) { if (xb_ld(&bar[XB_TMO])) break; if (sp > XB_SPIN_CAP) { atomicAdd(&bar[XB_TMO], 1u); break; } }
    }
    nloc = mine > 0u ? mine : 1u; nx = cnt > 0u ? cnt : 1u;
}
__device__ __forceinline__ void xcd_barrier(const XcdBarrier& b, int wv) {
    asm volatile("s_waitcnt vmcnt(0)" ::: "memory");
    __syncthreads();
    if (otid(wv) == 0) {
        unsigned* bar = b.bar;
        __builtin_amdgcn_s_waitcnt(0);
        unsigned nloc = b.st[0], nx = b.st[1];
        if (nloc == 0u) { xcd_barrier_complete(bar, b.x, nloc, nx); b.st[0] = nloc; b.st[1] = nx; }
        const unsigned old = xb_add(&bar[XB_XSUB(b.x)], 1u);
        const unsigned gen = old / nloc;
        if (old + 1u == (gen + 1u) * nloc) {
            __builtin_amdgcn_fence(__ATOMIC_RELEASE, "agent");
            asm volatile("s_waitcnt vmcnt(0)" ::: "memory");
            const unsigned og = xb_add(&bar[XB_TOP], 1u);
            const unsigned tg = og / nx;
            if (og + 1u == (tg + 1u) * nx) xb_add(&bar[XB_TOPGEN], 1u);
            else XB_SPIN(xb_ld(&bar[XB_TOPGEN]) == tg, bar);
            __builtin_amdgcn_fence(__ATOMIC_ACQUIRE, "agent");
            xb_add(&bar[XB_XGEN(b.x)], 1u);
            asm volatile("s_waitcnt vmcnt(0)" ::: "memory");
        } else {
            XB_SPIN(xb_ld(&bar[XB_XGEN(b.x)]) == gen, bar);
            __builtin_amdgcn_fence(__ATOMIC_ACQUIRE, "agent");
            asm volatile("s_waitcnt vmcnt(0)" ::: "memory");
        }
    }
    __syncthreads();
}

enum { ST_NORM = 0, ST_GEMM_BF16, ST_GEMM_F32, ST_GEMM_RESID, ST_LATNORM, ST_HN_MLA, ST_HN_DS, ST_ATTN_MLA, ST_ATTN_D, ST_ATTN_S, ST_PEER };
#define SV(t, v) ((t) | ((v) << 4))
#define SR(t, v) ((t) | ((v) << 4) | 0x80)
__device__ const unsigned char STEPS[3][24] = {
  {SV(ST_NORM, 0), SV(ST_GEMM_BF16, 0), SV(ST_LATNORM, 0), SV(ST_GEMM_BF16, 1), SV(ST_GEMM_BF16, 2), SV(ST_HN_MLA, 0), SV(ST_ATTN_MLA, 0), SV(ST_GEMM_RESID, 0), SV(ST_NORM, 1), SV(ST_GEMM_F32, 0), SV(ST_PEER, 0), 0xFF},
  {SV(ST_NORM, 0), SV(ST_GEMM_BF16, 0), SV(ST_HN_DS, 0), SV(ST_ATTN_D, 0), SV(ST_GEMM_RESID, 0), SV(ST_NORM, 1), SV(ST_GEMM_F32, 0), SV(ST_PEER, 0), 0xFF},
  {SV(ST_NORM, 0), SV(ST_GEMM_BF16, 0), SV(ST_HN_DS, 0), SV(ST_ATTN_S, 0), SV(ST_GEMM_RESID, 0), SV(ST_NORM, 1), SV(ST_GEMM_F32, 0), SV(ST_PEER, 0), 0xFF}};
__global__ void __launch_bounds__(NTHREADS, 2) mega(Params p) {
  extern __shared__ __attribute__((aligned(16))) unsigned char lds_raw[];
  LAS unsigned char* lds = (LAS unsigned char*)lds_raw;
  cg::grid_group grid = cg::this_grid();
  const int tid = threadIdx.x;
  const int wv_s = __builtin_amdgcn_readfirstlane(tid >> 6);
  unsigned char* ws = p.ws;
  float* modp = (float*)(ws + WS_MODP); float* mod = (float*)(ws + WS_MOD);
  float* tab8 = (float*)(ws + WS_TAB); float* tab16 = tab8 + 64 * 8 * 2; float* lamp = tab16 + 64 * 16 * 2;
  bf16_t* xl = (bf16_t*)(ws + WS_XL); bf16_t* xc = (bf16_t*)(ws + WS_XC);
  bf16_t* wdown_t = (bf16_t*)(ws + WS_WDOWN); bf16_t* wuq_t = (bf16_t*)(ws + WS_WUQ); bf16_t* wukv_t = (bf16_t*)(ws + WS_WUKV); bf16_t* mwo_t = (bf16_t*)(ws + WS_MWO);
  bf16_t* dqkv_t = (bf16_t*)(ws + WS_DQKV); bf16_t* dwo_t = (bf16_t*)(ws + WS_DWO); bf16_t* sqkv_t = (bf16_t*)(ws + WS_SQKV); bf16_t* swo_t = (bf16_t*)(ws + WS_SWO);
  bf16_t* pwq = (bf16_t*)(ws + WS_PWQ); bf16_t* pkeys = (bf16_t*)(ws + WS_PKEYS); bf16_t* weff_t = (bf16_t*)(ws + WS_WEFF);
  unsigned char* pu = ws + WS_PU; unsigned char* pv = ws + WS_PV;
  bf16_t* Hb = (bf16_t*)(ws + WS_H); bf16_t* Ob = (bf16_t*)(ws + WS_O);
  bf16_t* B1 = (bf16_t*)(ws + WS_BUF1); bf16_t* B2 = (bf16_t*)(ws + WS_BUF2); bf16_t* B3 = (bf16_t*)(ws + WS_BUF3); bf16_t* B4 = (bf16_t*)(ws + WS_BUF4);
  bf16_t* CQN = (bf16_t*)(ws + WS_CQN); bf16_t* CKVN = (bf16_t*)(ws + WS_CKVN); float* SC = (float*)(ws + WS_SC);

  volatile LAS unsigned* xb_st = (volatile LAS unsigned*)(lds + LDS_BYTES - 16);
  if (tid < 4) xb_st[tid] = 0u;
  __syncthreads();
  (void)xcd_barrier_post((unsigned*)ws, xb_st);
  int phc = 0;
#define PH_BEGIN {
#define PH_END } ++phc; if (phc == 1) grid.sync(); else { XcdBarrier xb_; xb_.bar = (unsigned*)p.ws; xb_.x = xb_xcc_id(); xb_.st = (volatile LAS unsigned*)(lds + LDS_BYTES - 16); xcd_barrier(xb_, wv_s); }

  PH_BEGIN
    int rot = 0;
    for (int j = 0; j < 2; ++j) {
      tr_job<true>(lds, p.mla_w_down + (size_t)j * 1024 * 1056, (unsigned char*)wdown_t + (size_t)j * 1280 * 1024, 1024, 1056, 1280, rot);
      tr_job<true>(lds, p.mla_w_uq + (size_t)j * 768 * 1536, (unsigned char*)wuq_t + (size_t)j * 1536 * 768, 768, 1536, 1536, rot);
      tr_job<false>(lds, p.mla_w_ukv + (size_t)j * 256 * 2048, wukv_t + (size_t)j * 2048 * 256, 256, 2048, 2048, rot);
      tr_job<true>(lds, p.mla_w_o + (size_t)j * 1024 * 1024, (unsigned char*)mwo_t + (size_t)j * 1024 * 1024, 1024, 1024, 1024, rot);
    }
    tr_job<true>(lds, p.diff_w_qkv, dqkv_t, 1024, 3072, 3072, rot);
    tr_job<true>(lds, p.diff_w_o, dwo_t, 1024, 1024, 1024, rot);
    tr_job<true>(lds, p.swa_w_qkv, sqkv_t, 1024, 1536, 1536, rot);
    tr_job<true>(lds, p.swa_w_o, swo_t, 1024, 1024, 1024, rot);
    ada_job(lds, p, modp);
    cvt_job(p.peer_w_q, pwq, (size_t)4 * 1024 * 2048 / 8);
    cvt_job(p.peer_keys, pkeys, (size_t)4 * 16 * 128 * 128 / 8);
    {
      const int wv = tid >> 6, ln = tid & 63, l = wv >> 1; const float* t = ((wv & 1) ? p.peer_v : p.peer_u) + (size_t)l * 16384 * 1024;
      float ss = 0.f;
#pragma unroll
      for (int q = 0; q < 8; ++q) { const f32x4 v = ((const f32x4*)t)[ln + 64 * q]; ss += v.x * v.x + v.y * v.y + v.z * v.z + v.w * v.w; }
      ss = wave_sum(ss);
      const float rms = sqrtf(ss * (1.f / 2048.f));
      if (blockIdx.x == 0 && ln == 0) lamp[4 + wv] = (wv & 1) ? rms * 0.5f : rms * 0.34f;
    }
    if (blockIdx.x == 0 && tid == 0) {
      const float** t = (const float**)(ws + WS_PTRS);
      t[0] = p.x; t[1] = p.c; t[2] = p.ctx; t[3] = p.c_ctx; t[4] = p.ada_w; t[5] = p.ada_b; t[6] = p.norm_mix; t[7] = p.norm_ffn;
      t[8] = p.mla_w_down; t[9] = p.mla_g_cq; t[10] = p.mla_g_ckv; t[11] = p.mla_w_uq; t[12] = p.mla_w_ukv; t[13] = p.mla_g_q; t[14] = p.mla_g_k; t[15] = p.mla_w_o;
      t[16] = p.diff_w_qkv; t[17] = p.diff_g_q; t[18] = p.diff_g_k; t[19] = p.diff_lambda; t[20] = p.diff_g_sub; t[21] = p.diff_w_o;
      t[22] = p.swa_w_qkv; t[23] = p.swa_g_q; t[24] = p.swa_g_k; t[25] = p.swa_sink; t[26] = p.swa_w_o; t[27] = p.peer_w_q; t[28] = p.peer_keys; t[29] = p.peer_u; t[30] = p.peer_v;
    }
    if (blockIdx.x == gridDim.x - 1) {
      for (int i = tid; i < 64 * 8; i += NTHREADS) { const int pos = i >> 3, j = i & 7; const float ang = (float)pos * powf(10000.f, -(float)j / 8.f); tab8[2 * i] = cosf(ang); tab8[2 * i + 1] = sinf(ang); }
      for (int i = tid; i < 64 * 16; i += NTHREADS) { const int pos = i >> 4, j = i & 15; const float ang = (float)pos * powf(10000.f, -(float)j / 16.f); tab16[2 * i] = cosf(ang); tab16[2 * i + 1] = sinf(ang); }
      if (tid >= 64 && tid < 68) {
        const int q = tid - 64; const float* g = (q < 2) ? p.mla_g_k + q * 96 : (q == 2) ? p.diff_g_k : p.swa_g_k; const int n = (q < 2) ? 96 : 64;
        float mx = 0.f; for (int i = 0; i < n; ++i) mx = fmaxf(mx, fabsf(g[i]));
        lamp[12 + q] = sqrtf((float)n) * mx * 1.002f;
      }
      if (tid == 0) { float s01 = 0.f, s23 = 0.f; for (int i = 0; i < 64; ++i) { s01 += p.diff_lambda[i] * p.diff_lambda[64 + i]; s23 += p.diff_lambda[128 + i] * p.diff_lambda[192 + i]; }
        lamp[0] = expf(s01) - expf(s23) + LAM_INIT; }
    }
  PH_END
  PH_BEGIN
    for (int i = blockIdx.x * NTHREADS + tid; i < 4 * 9 * 6144; i += gridDim.x * NTHREADS) {
      const int col = i % 6144, l = i / (9 * 6144); float a = p.ada_b[l * 6144 + col];
#pragma unroll
      for (int kc = 0; kc < 64; ++kc) a += modp[(size_t)kc * (4 * 9 * 6144) + i];
      mod[i] = a;
    }
    for (int U = blockIdx.x; U < 256; U += gridDim.x) {
      const int q = U >> 2, l = q >> 4, hc = q & 15;
      gemm_phase(lds, pwq + (size_t)l * 1024 * 2048 + hc * 128, 2048, pkeys + (size_t)q * 128 * 128, 128, 1024, 128, 128, false,
                 EpiBf16T{weff_t + (size_t)l * 2048 * 1024 + (size_t)hc * 128 * 1024, 1024}, U & 3, 4);
    }
  PH_END

  for (int l = 0; l < 4; ++l) {
    int kind = l % 3; asm volatile("" : "+s"(kind));
    const bool last = (l == 3);
    for (int ss = 0; STEPS[kind][ss] != 0xFF; ++ss) {
      unsigned long long w_ = (unsigned long long)p.ws; asm volatile("" : "+s"(w_));
      unsigned char* w = (unsigned char*)(GAS unsigned char*)w_;
      const unsigned long long* tab = (const unsigned long long*)(w + WS_PTRS);
#define IN_(i) ((const float*)(GAS const float*)tab[i])
      bf16_t* xl = (bf16_t*)(w + WS_XL); bf16_t* xc = (bf16_t*)(w + WS_XC);
      const float* modl = (const float*)(w + WS_MOD) + (size_t)l * 9 * 6144;
      const float* tab8 = (const float*)(w + WS_TAB); const float* tab16 = tab8 + 64 * 8 * 2; const float* lamp = tab16 + 64 * 16 * 2;
      unsigned char* Hb = w + WS_H; unsigned char* Ob = w + WS_O; float* SC = (float*)(w + WS_SC);
      unsigned char* H8 = w + WS_O + 18 * MiB;
      bf16_t* LAT = (bf16_t*)(w + WS_BUF1); bf16_t* QP = (bf16_t*)(w + WS_BUF2); bf16_t* KV = (bf16_t*)(w + WS_BUF3); bf16_t* KB = (bf16_t*)(w + WS_BUF4); bf16_t* QKV = LAT;
      unsigned char* CQN = w + WS_CQN; bf16_t* CKVN = (bf16_t*)(w + WS_CKVN);
      bf16_t* QN = (bf16_t*)(w + WS_SC);
      const int ent = STEPS[kind][ss]; const int ty = ent & 15, var = (ent >> 4) & 7; const bool live = (ent & 0x80) == 0 || (p.phase == 777);
      int lo_ = l; asm volatile("" : "+s"(lo_)); const int j = (lo_ >= 3) ? 1 : 0;
      bool sync = true;
      if (ty == ST_NORM) {
        const bool first = (var == 0);
        if (first && l > 0) sync = false;
        else norm_phase(IN_(0), IN_(2), xl, xc, first && l == 0, (first ? IN_(6) : IN_(7)) + l * D, modl, first ? 0 : 3, first ? H8 : Hb, first, last && !first, wv_s);
      } else if (ty == ST_GEMM_BF16) {
        const void* A = H8; const void* Bt; bf16_t* O; int N, K = 1024;
        if (kind == 0) {
          if (var == 0) { Bt = w + WS_WDOWN + (size_t)j * 1280 * 1024; N = 1280; O = LAT; }
          else if (var == 1) { A = CQN; Bt = w + WS_WUQ + (size_t)j * 1536 * 768; N = 1536; K = 768; O = QP; sync = false; }
          else { A = CKVN; Bt = (const bf16_t*)(w + WS_WUKV) + (size_t)j * 2048 * 256; N = 2048; K = 256; O = KV; }
        } else if (kind == 1) { Bt = w + WS_DQKV; N = 3072; O = QKV; }
        else { Bt = w + WS_SQKV; N = 1536; O = QKV; }
        pg8::LatentOrder S; S.init(M, N, gridDim.x, blockIdx.x, last && kind == 0 && var == 1);
        if (kind == 0 && var == 2) pg8::gemm_phase<pg8::EpiBf16P, pg8::LatentOrder, true, true, false>(lds, pg8::Gemm{(const bf16_t*)A, (const bf16_t*)Bt, M, N, K}, S, pg8::EpiBf16P{O, N, 1.f}, wv_s);
        else pg8::gemm_phase<pg8::EpiBf16P, pg8::LatentOrder, true, true, true>(lds, pg8::Gemm{(const bf16_t*)A, (const bf16_t*)Bt, M, N, K / 2}, S, pg8::EpiBf16P{O, N, 1.f / (ASC * WSC)}, wv_s);

        {
          const int nwg_ = (false ? (M / 9) * 8 / 256 : M / 256) * (N / 256), rem_ = nwg_ % (int)gridDim.x;
          if ((rem_ == 0 || (int)blockIdx.x >= rem_) && ((var == 0) ? 0 : -1) >= 0) {
            const int E_ = (rem_ == 0) ? (int)gridDim.x : (int)gridDim.x - rem_, e_ = (rem_ == 0) ? (int)blockIdx.x : (int)blockIdx.x - rem_;
            const int s0_ = (((var == 0) ? 0 : -1) == 0) ? 0 : (((var == 0) ? 0 : -1) == 1) ? 9600 : 21000, s1_ = (((var == 0) ? 0 : -1) == 0) ? 9600 : (((var == 0) ? 0 : -1) == 1) ? 21000 : 32768;
            const int per_ = (s1_ - s0_ + E_ - 1) / E_, a_ = s0_ + e_ * per_, b_ = min(s1_, a_ + per_);
            const float su_ = 1.f / lamp[4 + 2 * l], sv_ = 1.f / lamp[5 + 2 * l];
            conv_rows(IN_(29) + (size_t)l * 16384 * 1024, IN_(30) + (size_t)l * 16384 * 1024, w + WS_PU + (size_t)l * 16384 * 512, w + WS_PV + (size_t)l * 16384 * 512, su_, sv_, a_, b_, otid(wv_s));
          }
        }
      } else if (ty == ST_GEMM_RESID) {
        const unsigned char* Bt = (kind == 0) ? w + WS_MWO + (size_t)j * 1024 * 1024 : (kind == 1) ? w + WS_DWO : w + WS_SWO;
        pg8::LatentOrder S; S.init(M, 1024, gridDim.x, blockIdx.x, last);
        pg8::gemm_phase<pg8::EpiResidN, pg8::LatentOrder, true, true, true>(lds, pg8::Gemm{(const bf16_t*)Ob, (const bf16_t*)Bt, M, 1024, 512}, S, pg8::EpiResidN{IN_(0), IN_(2), l == 0, xl, xc, modl, 2, live, 1.f / (OSC * WSC)}, wv_s);

        {
          const int nwg_ = (last ? (M / 9) * 8 / 256 : M / 256) * (1024 / 256), rem_ = nwg_ % (int)gridDim.x;
          if ((rem_ == 0 || (int)blockIdx.x >= rem_) && 1 >= 0) {
            const int E_ = (rem_ == 0) ? (int)gridDim.x : (int)gridDim.x - rem_, e_ = (rem_ == 0) ? (int)blockIdx.x : (int)blockIdx.x - rem_;
            const int s0_ = (1 == 0) ? 0 : (1 == 1) ? 9600 : 21000, s1_ = (1 == 0) ? 9600 : (1 == 1) ? 21000 : 32768;
            const int per_ = (s1_ - s0_ + E_ - 1) / E_, a_ = s0_ + e_ * per_, b_ = min(s1_, a_ + per_);
            const float su_ = 1.f / lamp[4 + 2 * l], sv_ = 1.f / lamp[5 + 2 * l];
            conv_rows(IN_(29) + (size_t)l * 16384 * 1024, IN_(30) + (size_t)l * 16384 * 1024, w + WS_PU + (size_t)l * 16384 * 512, w + WS_PV + (size_t)l * 16384 * 512, su_, sv_, a_, b_, otid(wv_s));
          }
        }
      } else if (ty == ST_GEMM_F32) {
        pg8::LatentOrder S; S.init(M, 2048, gridDim.x, blockIdx.x, last);
        pg8::gemm_phase<pg8::EpiBf16P, pg8::LatentOrder, true, true, false>(lds, pg8::Gemm{(const bf16_t*)Hb, (const bf16_t*)(w + WS_WEFF) + (size_t)l * 2048 * 1024, M, 2048, 1024}, S, pg8::EpiBf16P{(bf16_t*)SC, 2048, 1.f}, wv_s);

        {
          const int nwg_ = (last ? (M / 9) * 8 / 256 : M / 256) * (2048 / 256), rem_ = nwg_ % (int)gridDim.x;
          if ((rem_ == 0 || (int)blockIdx.x >= rem_) && 2 >= 0) {
            const int E_ = (rem_ == 0) ? (int)gridDim.x : (int)gridDim.x - rem_, e_ = (rem_ == 0) ? (int)blockIdx.x : (int)blockIdx.x - rem_;
            const int s0_ = (2 == 0) ? 0 : (2 == 1) ? 9600 : 21000, s1_ = (2 == 0) ? 9600 : (2 == 1) ? 21000 : 32768;
            const int per_ = (s1_ - s0_ + E_ - 1) / E_, a_ = s0_ + e_ * per_, b_ = min(s1_, a_ + per_);
            const float su_ = 1.f / lamp[4 + 2 * l], sv_ = 1.f / lamp[5 + 2 * l];
            conv_rows(IN_(29) + (size_t)l * 16384 * 1024, IN_(30) + (size_t)l * 16384 * 1024, w + WS_PU + (size_t)l * 16384 * 512, w + WS_PV + (size_t)l * 16384 * 512, su_, sv_, a_, b_, otid(wv_s));
          }
        }
      } else if (ty == ST_LATNORM) {
        latnorm_phase(LAT, IN_(9) + j * 768, IN_(10) + j * 256, CQN, CKVN, wv_s);
      } else if (ty == ST_HN_MLA) {
        const float qs = 0.10206207261596577f * LOG2E;
        for (int gi = blockIdx.x * NTHREADS + otid(wv_s); gi < M * 32 * 4; gi += gridDim.x * NTHREADS) {
          const int i = gi >> 2, jl = gi & 3, r = i >> 5, it = i & 31, h = it & 15; const int b = r / TPB, s = r - b * TPB; const bool lat = s < SEQ;
          if (it < 16) { const bf16_t* q = QP + (size_t)r * 1536 + h * 96; headnorm96(q, q + 64, QN + (size_t)r * 1536 + h * 96, IN_(13) + j * 96, qs, lat, s >> 6, s & 63, tab8, jl); }
          else headnorm96(KV + (size_t)r * 2048 + h * 128, LAT + (size_t)r * 1280 + 1024, KB + (size_t)r * 1536 + h * 96, IN_(14) + j * 96, 1.f, lat, s >> 6, s & 63, tab8, jl);
        }
      } else if (ty == ST_HN_DS) {
        const float qs = 0.125f * LOG2E;
        const int ipr = (kind == 1) ? 32 : 20, pitch = (kind == 1) ? 3072 : 1536, npitch = (kind == 1) ? 2048 : 1280;
        const float* gq = (kind == 1) ? IN_(17) : IN_(23); const float* gk = (kind == 1) ? IN_(18) : IN_(24);
        for (int gi = blockIdx.x * NTHREADS + otid(wv_s); gi < M * ipr * 4; gi += gridDim.x * NTHREADS) {
          const int i = gi >> 2, jl = gi & 3; int r, it; if (kind == 1) { r = i >> 5; it = i & 31; } else { r = i / 20; it = i - r * 20; }
          const int b = r / TPB, s = r - b * TPB; const bool lat = s < SEQ;
          const bf16_t* q = QKV + (size_t)r * pitch + it * 64;
          headnorm64(q, QN + (size_t)r * npitch + it * 64, (it < 16) ? gq : gk, (it < 16) ? qs : 1.f, lat, s >> 6, s & 63, tab16, jl);
        }
      } else if (ty == ST_ATTN_MLA) {
        const int nu = last ? 1024 : 1152;
        for (int u = blockIdx.x; u < nu; u += gridDim.x) {
          int bh, q0, ta0; if (u < 1024) { const int x = u & 7, y = u >> 3; bh = ((y >> 3) << 3) + x; q0 = (y & 7) * 256; ta0 = 0; } else { bh = u - 1024; q0 = SEQ; ta0 = 32; }
          const int b = bh >> 4, h = bh & 15; const size_t rb = (size_t)b * TPB;
          attn_unit_p<96, 64, false>(lds, QN + rb * 1536 + h * 96, 1536, KB + rb * 1536 + h * 96, 1536, KV + rb * 2048 + h * 128 + 64, 2048,
                                     q0, ta0, 36, 0, 0, false, 0.f, lamp[12 + j], Ob + rb * D + h * 64, D, wv_s);
        }
      } else if (ty == ST_ATTN_D) {
        const float lam = lamp[0];
        for (int u = blockIdx.x; u < 1152; u += gridDim.x) {
          int bh, q0, ta0; if (u < 1024) { const int x = u & 7, y = u >> 3; bh = ((y >> 4) << 3) + x; q0 = (y & 15) * 128; ta0 = 0; } else { bh = (u - 1024) >> 1; q0 = SEQ + ((u - 1024) & 1) * 128; ta0 = 32; }
          const int b = bh >> 3, h = bh & 7; const size_t rb = (size_t)b * TPB;
          attn_unit<64, 128, 2, false>(lds, QN + rb * 2048 + h * 128, 64, 2048, QN + rb * 2048 + 1024 + h * 128, 64, 2048, QKV + rb * 3072 + 2048 + h * 128, 3072,
                                       q0, ta0, 36, 0, 0, false, 0.f, lamp[14], Ob + rb * D + h * 128, D, lam, IN_(20), wv_s);
        }
      } else if (ty == ST_ATTN_S) {
        for (int u = blockIdx.x; u < 1152; u += gridDim.x) {
          int bh, q0, ta0, ta1; if (u < 1024) { const int x = u & 7, y = u >> 3; bh = ((y >> 3) << 3) + x; q0 = (y & 7) * 256; ta0 = max(0, q0 / 64 - 2); ta1 = min(32, q0 / 64 + 6); } else { bh = u - 1024; q0 = SEQ; ta0 = 0; ta1 = 0; }
          const int b = bh >> 4, h = bh & 15, kvh = h >> 2; const size_t rb = (size_t)b * TPB;
          attn_unit<64, 64, 1, true>(lds, QN + rb * 1280 + h * 64, 0, 1280, QN + rb * 1280 + 1024 + kvh * 64, 0, 1280, QKV + rb * 1536 + 1280 + kvh * 64, 1536,
                                     q0, ta0, ta1, 32, 36, true, IN_(25)[h] * LOG2E, lamp[15], Ob + rb * D + h * 64, D, 0.f, nullptr, wv_s);
        }
      } else {
        peer_phase(lds, (const bf16_t*)SC, Hb, w + WS_PU + (size_t)l * 16384 * 512, w + WS_PV + (size_t)l * 16384 * 512, lamp[4 + 2 * l], lamp[5 + 2 * l], modl, xl, xc, p.out, last, live, last ? nullptr : H8, IN_(6) + (l + 1) * D, modl + 9 * 6144, wv_s);
      }
#undef IN_
      if (sync) { XcdBarrier xb_; xb_.bar = (unsigned*)p.ws; xb_.x = xb_xcc_id(); xb_.st = (volatile LAS unsigned*)(lds + LDS_BYTES - 16); xcd_barrier(xb_, wv_s); }
    }
  }
#undef PH_BEGIN
#undef PH_END
}

extern "C" void kernel_launch(void* const* d_in, const int* in_sizes, int n_in, void* d_out, int out_size, void* d_ws, size_t ws_size, hipStream_t stream) {
  static int grid_blocks = 0;
  if (grid_blocks == 0) {
    int dev = 0, cus = 0, per_cu = 0;
    if (n_in != 31 || out_size != NB * SEQ * D || ws_size < WS_TOTAL) { fprintf(stderr, "kernel_launch: unexpected shapes (n_in %d out %d ws %zu)\n", n_in, out_size, ws_size); grid_blocks = -1; return; }
    (void)hipGetDevice(&dev);
    (void)hipDeviceGetAttribute(&cus, hipDeviceAttributeMultiprocessorCount, dev);
    (void)hipFuncSetAttribute((const void*)mega, hipFuncAttributeMaxDynamicSharedMemorySize, LDS_BYTES);
    (void)hipOccupancyMaxActiveBlocksPerMultiprocessor(&per_cu, (const void*)mega, NTHREADS, LDS_BYTES);
    if (per_cu < 1) { fprintf(stderr, "kernel_launch: occupancy query says %d blocks/CU\n", per_cu); per_cu = 1; }
    grid_blocks = cus;
  }
  if (grid_blocks < 0) return;
  (void)hipMemsetAsync(d_ws, 0, 16384, stream);
  Params p{};
  const float** f = (const float**)&p;
  for (int i = 0; i < 31; ++i) f[i] = (const float*)d_in[i];
  p.out = (float*)d_out; p.ws = (unsigned char*)d_ws;
  p.single = 1; p.phase = 0;
  void* args[] = {&p};
  hipError_t e = hipLaunchCooperativeKernel((const void*)mega, dim3(grid_blocks), dim3(NTHREADS), args, LDS_BYTES, stream);
  if (e != hipSuccess) fprintf(stderr, "cooperative launch failed: %s (grid %d)\n", hipGetErrorString(e), grid_blocks);
}
```

```cpp
#include <hip/hip_runtime.h>
#include <hip/hip_cooperative_groups.h>
#include <cstdio>
#include <cstdint>
namespace cg = cooperative_groups;

#define LAS __attribute__((address_space(3)))
#define GAS __attribute__((address_space(1)))
typedef unsigned short bf16_t;
typedef short bf16x8 __attribute__((ext_vector_type(8)));
typedef short v4i16_t __attribute__((ext_vector_type(4)));
typedef float f32x4 __attribute__((ext_vector_type(4)));
typedef float f32x16 __attribute__((ext_vector_type(16)));
typedef unsigned u32x4 __attribute__((ext_vector_type(4)));
typedef unsigned u32x2 __attribute__((ext_vector_type(2)));
typedef long long2_t __attribute__((ext_vector_type(2)));
typedef float f32x2_t __attribute__((ext_vector_type(2)));
typedef __bf16 bf16x2_t __attribute__((ext_vector_type(2)));

constexpr int D = 1024, NB = 8, SEQ = 2048, NCTX = 256, TPB = SEQ + NCTX  , M = NB * TPB  ;
constexpr int NTHREADS = 512, NWAVES = 8;
constexpr float EPS = 1e-6f;
constexpr float LOG2E = 1.4426950408889634f;
constexpr float LAM_INIT = 0.35550907f;
constexpr float ASC = 8.f, WSC = 64.f, OSC = 64.f;
constexpr size_t MiB = 1u << 20;
constexpr size_t WS_PTRS = 32768;
constexpr size_t WS_MODP = 352 * MiB  , WS_MOD = 8 * MiB, WS_TAB = 9 * MiB, WS_XC = 10 * MiB;
constexpr size_t WS_WDOWN = 18 * MiB, WS_WUQ = 23 * MiB, WS_WUKV = 28 * MiB, WS_MWO = 30 * MiB, WS_DQKV = 34 * MiB, WS_DWO = 40 * MiB;
constexpr size_t WS_SQKV = 42 * MiB, WS_SWO = 45 * MiB, WS_PWQ = 47 * MiB, WS_PKEYS = 63 * MiB, WS_WEFF = 65 * MiB;
constexpr size_t WS_PU = 96 * MiB, WS_PV = 224 * MiB, WS_H = 352 * MiB, WS_O = 388 * MiB, WS_BUF1 = 424 * MiB, WS_BUF2 = 532 * MiB;
constexpr size_t WS_BUF3 = 586 * MiB, WS_BUF4 = 658 * MiB, WS_CQN = 712 * MiB, WS_CKVN = 739 * MiB, WS_SC = 748 * MiB, WS_END = 892 * MiB;
constexpr size_t WS_XL = 896 * MiB, WS_TOTAL = 928 * MiB;
constexpr int LDS_BYTES = 147456;


struct Params {
  const float *x, *c, *ctx, *c_ctx, *ada_w, *ada_b, *norm_mix, *norm_ffn;
  const float *mla_w_down, *mla_g_cq, *mla_g_ckv, *mla_w_uq, *mla_w_ukv, *mla_g_q, *mla_g_k, *mla_w_o;
  const float *diff_w_qkv, *diff_g_q, *diff_g_k, *diff_lambda, *diff_g_sub, *diff_w_o;
  const float *swa_w_qkv, *swa_g_q, *swa_g_k, *swa_sink, *swa_w_o;
  const float *peer_w_q, *peer_keys, *peer_u, *peer_v;
  float* out; unsigned char* ws;
  int single, phase;
};

__device__ __forceinline__ int opaque_tid() { int t = threadIdx.x; asm volatile("" : "+v"(t)); return t; }
__device__ __forceinline__ int otid(int wv) { int w = wv; asm volatile("" : "+s"(w)); unsigned m = ~0u; asm volatile("" : "+s"(m)); const int l = (int)__builtin_amdgcn_mbcnt_hi(m, __builtin_amdgcn_mbcnt_lo(m, 0u)); return (w << 6) | l; }
__device__ __forceinline__ unsigned pk2(float lo, float hi) { f32x2_t v = {lo, hi}; bf16x2_t b = __builtin_convertvector(v, bf16x2_t); return __builtin_bit_cast(unsigned, b); }
__device__ __forceinline__ unsigned pk4_fp8(float a, float b, float c, float d) { int w = 0; w = __builtin_amdgcn_cvt_pk_fp8_f32(a, b, w, false); w = __builtin_amdgcn_cvt_pk_fp8_f32(c, d, w, true); return (unsigned)w; }
__device__ __forceinline__ float bf_lo(unsigned u) { return __uint_as_float(u << 16); }
__device__ __forceinline__ float bf_hi(unsigned u) { return __uint_as_float(u & 0xffff0000u); }
__device__ __forceinline__ float wave_sum(float v) {
#pragma unroll
  for (int o = 32; o >= 1; o >>= 1) v += __shfl_xor(v, o);
  return v;
}
__device__ __forceinline__ float dot2bf(unsigned a, unsigned b, float c) { return __builtin_amdgcn_fdot2_f32_bf16(__builtin_bit_cast(bf16x2_t, a), __builtin_bit_cast(bf16x2_t, b), c, false); }
__device__ __forceinline__ int crow(int r, int hi) { return (r & 3) + 8 * (r >> 2) + 4 * hi; }
__device__ __forceinline__ unsigned f2ord(float f) { unsigned u = __float_as_uint(f); return (u & 0x80000000u) ? ~u : (u | 0x80000000u); }
__device__ __forceinline__ float ord2f(unsigned o) { return __uint_as_float((o & 0x80000000u) ? (o & 0x7fffffffu) : ~o); }
__device__ __forceinline__ bf16_t* xrow_ptr(bf16_t* xl, bf16_t* xc, int r) {
  const int b = r / TPB, s = r - b * TPB;
  return (s < SEQ) ? xl + (size_t)(b * SEQ + s) * D : xc + (size_t)(b * NCTX + (s - SEQ)) * D;
}
__device__ __forceinline__ const float* xsrc_ptr(const float* sl, const float* sc, int r) {
  const int b = r / TPB, s = r - b * TPB;
  return (s < SEQ) ? sl + (size_t)(b * SEQ + s) * D : sc + (size_t)(b * NCTX + (s - SEQ)) * D;
}
template <bool F8>
__device__ __forceinline__ void tr_job(LAS unsigned char* lds, const float* __restrict__ W, void* __restrict__ Wt_, int K, int N, int Npad, int& rot) {
  LAS float* tile = (LAS float*)lds;
  const int nnb = Npad / 64, nit = (K / 64) * nnb, tid = opaque_tid();
  const int vb = ((int)blockIdx.x - rot % (int)gridDim.x + (int)gridDim.x) % (int)gridDim.x;
  rot += (nit + 3) / 4;
  for (int it0 = vb * 4; it0 < nit; it0 += gridDim.x * 4) {
    f32x4 v[4][2];
#pragma unroll
    for (int q = 0; q < 4; ++q) {
      const int it = it0 + q, kb = it / nnb, nb = it - kb * nnb, k0 = kb * 64, n0 = nb * 64;
#pragma unroll
      for (int i = 0; i < 2; ++i) {
        const int idx = tid + i * 512, kk = idx >> 4, nc = (idx & 15) * 4;
        v[q][i] = (f32x4){0.f, 0.f, 0.f, 0.f};
        if (it < nit && n0 + nc < N) v[q][i] = *(const f32x4*)(W + (size_t)(k0 + kk) * N + n0 + nc);
      }
    }
#pragma unroll
    for (int q = 0; q < 4; ++q)
#pragma unroll
      for (int i = 0; i < 2; ++i) {
        const int idx = tid + i * 512, kk = idx >> 4, nc = (idx & 15) * 4; LAS float* t = tile + q * (64 * 65) + kk * 65 + nc;
        t[0] = v[q][i].x; t[1] = v[q][i].y; t[2] = v[q][i].z; t[3] = v[q][i].w;
      }
    __syncthreads();
#pragma unroll
    for (int q = 0; q < 4; ++q) {
      const int it = it0 + q;
      if (it < nit) {
        const int kb = it / nnb, nb = it - kb * nnb, k0 = kb * 64, n0 = nb * 64;
        const int n = tid >> 3, kc = tid & 7;
        float f[8];
#pragma unroll
        for (int j = 0; j < 8; ++j) f[j] = tile[q * (64 * 65) + (kc * 8 + j) * 65 + n];
        if (F8) *(u32x2*)((unsigned char*)Wt_ + (size_t)(n0 + n) * K + k0 + kc * 8) = (u32x2){pk4_fp8(f[0] * WSC, f[1] * WSC, f[2] * WSC, f[3] * WSC), pk4_fp8(f[4] * WSC, f[5] * WSC, f[6] * WSC, f[7] * WSC)};
        else *(u32x4*)((bf16_t*)Wt_ + (size_t)(n0 + n) * K + k0 + kc * 8) = (u32x4){pk2(f[0], f[1]), pk2(f[2], f[3]), pk2(f[4], f[5]), pk2(f[6], f[7])};
      }
    }
    __syncthreads();
  }
}
__device__ __forceinline__ void cvt_job(const float* __restrict__ src, bf16_t* __restrict__ dst, size_t n8) {
  for (size_t i = (size_t)blockIdx.x * NTHREADS + threadIdx.x; i < n8; i += (size_t)gridDim.x * NTHREADS) {
    const f32x4 a = ((const f32x4*)src)[2 * i], b = ((const f32x4*)src)[2 * i + 1];
    ((u32x4*)dst)[i] = (u32x4){pk2(a.x, a.y), pk2(a.z, a.w), pk2(b.x, b.y), pk2(b.z, b.w)};
  }
}
__device__ __forceinline__ unsigned q4pack(f32x4 a, f32x4 b, float sc) {
  const float v[8] = {a.x, a.y, a.z, a.w, b.x, b.y, b.z, b.w}; unsigned w = 0u;
#pragma unroll
  for (int j = 0; j < 8; ++j) { int q = (int)rintf(v[j] * sc); q = min(7, max(-8, q)); w |= ((unsigned)q & 15u) << (4 * j); }
  return w;
}
__device__ __forceinline__ void conv_rows(const float* __restrict__ usrc, const float* __restrict__ vsrc, unsigned char* __restrict__ udst, unsigned char* __restrict__ vdst, float su, float sv, int r0, int r1, int tid) {
  for (int r = r0 + (tid >> 6); r < r1; r += NWAVES) {
    const bool isv = r >= 16384; const int rr = isv ? r - 16384 : r; const int c = (tid & 63);
    const f32x4* sp = (const f32x4*)((isv ? vsrc : usrc) + (size_t)rr * 1024) + c * 4;
    const f32x4 a = sp[0], b = sp[1], cc = sp[2], d = sp[3];
    u32x2 o;
    if (isv) {
      unsigned w0 = 0u, w1 = 0u;
      w0 = __builtin_amdgcn_cvt_scalef32_pk_fp4_f32(w0, a.x * sv, a.y * sv, 1.0f, 0); w0 = __builtin_amdgcn_cvt_scalef32_pk_fp4_f32(w0, a.z * sv, a.w * sv, 1.0f, 1);
      w0 = __builtin_amdgcn_cvt_scalef32_pk_fp4_f32(w0, b.x * sv, b.y * sv, 1.0f, 2); w0 = __builtin_amdgcn_cvt_scalef32_pk_fp4_f32(w0, b.z * sv, b.w * sv, 1.0f, 3);
      w1 = __builtin_amdgcn_cvt_scalef32_pk_fp4_f32(w1, cc.x * sv, cc.y * sv, 1.0f, 0); w1 = __builtin_amdgcn_cvt_scalef32_pk_fp4_f32(w1, cc.z * sv, cc.w * sv, 1.0f, 1);
      w1 = __builtin_amdgcn_cvt_scalef32_pk_fp4_f32(w1, d.x * sv, d.y * sv, 1.0f, 2); w1 = __builtin_amdgcn_cvt_scalef32_pk_fp4_f32(w1, d.z * sv, d.w * sv, 1.0f, 3);
      o = (u32x2){w0, w1};
    } else o = (u32x2){q4pack(a, b, su), q4pack(cc, d, su)};
    *(u32x2*)((isv ? vdst : udst) + (size_t)rr * 512 + c * 8) = o;
  }
}
__device__ __forceinline__ void ada_job(LAS unsigned char* lds, const Params& p, float* __restrict__ modp) {
  LAS float* s = (LAS float*)lds;
  const int tid = opaque_tid();
  for (int u = blockIdx.x; u < 768; u += gridDim.x) {
    const int l = u / 192, r = u - l * 192, cc = r >> 6, kc = r & 63;
    __syncthreads();
    if (tid < 144) { const int bi = tid >> 4, k = tid & 15; const float c = (bi < 8) ? p.c[bi * D + kc * 16 + k] : p.c_ctx[kc * 16 + k]; s[tid] = c / (1.f + __expf(-c)); }
    __syncthreads();
    f32x4 acc[9];
#pragma unroll
    for (int bi = 0; bi < 9; ++bi) acc[bi] = (f32x4){0.f, 0.f, 0.f, 0.f};
    const float* w = p.ada_w + ((size_t)l * D + kc * 16) * 6144 + cc * 2048 + tid * 4;
#pragma unroll
    for (int h = 0; h < 2; ++h) {
      f32x4 wv[8];
#pragma unroll
      for (int k = 0; k < 8; ++k) wv[k] = *(const f32x4*)(w + (size_t)(h * 8 + k) * 6144);
#pragma unroll
      for (int k = 0; k < 8; ++k)
#pragma unroll
        for (int bi = 0; bi < 9; ++bi) acc[bi] += s[bi * 16 + h * 8 + k] * wv[k];
    }
#pragma unroll
    for (int bi = 0; bi < 9; ++bi) *(f32x4*)(modp + (((size_t)kc * 4 + l) * 9 + bi) * 6144 + cc * 2048 + tid * 4) = acc[bi];
  }
}

__device__ __forceinline__ void norm_phase(const float* sl, const float* sc_, bf16_t* xl, bf16_t* xc, bool src_f32, const float* __restrict__ g, const float* __restrict__ modl, int which, unsigned char* __restrict__ H, bool out_f8, bool skip_ctx, int wv) {
  const int tid_ = otid(wv); const int lane = tid_ & 63, wid = tid_ >> 6;
  for (int r = blockIdx.x * NWAVES + wid; r < M; r += gridDim.x * NWAVES) {
    const int b = r / TPB, s = r - b * TPB; const bool isctx = s >= SEQ;
    if (skip_ctx && isctx) continue;
    const int bi = isctx ? 8 : b;
    const float* sh = modl + (size_t)(bi * 6 + which) * D; const float* sc = sh + D;
    f32x4 v[4]; float ss = 0.f;
    if (src_f32) {
      const float* xr = xsrc_ptr(sl, sc_, r);
#pragma unroll
      for (int j = 0; j < 4; ++j) v[j] = ((const f32x4*)xr)[lane + 64 * j];
    } else {
      const bf16_t* xr = xrow_ptr(xl, xc, r);
#pragma unroll
      for (int j = 0; j < 4; ++j) { const u32x2 w = ((const u32x2*)xr)[lane + 64 * j]; v[j] = (f32x4){bf_lo(w.x), bf_hi(w.x), bf_lo(w.y), bf_hi(w.y)}; }
    }
#pragma unroll
    for (int j = 0; j < 4; ++j) ss += v[j].x * v[j].x + v[j].y * v[j].y + v[j].z * v[j].z + v[j].w * v[j].w;
    ss = wave_sum(ss);
    const float rstd = rsqrtf(ss * (1.f / D) + EPS);
#pragma unroll
    for (int j = 0; j < 4; ++j) {
      const int c4 = lane + 64 * j;
      const f32x4 g4 = ((const f32x4*)g)[c4], s4 = ((const f32x4*)sc)[c4], h4 = ((const f32x4*)sh)[c4];
      const f32x4 y = v[j] * rstd * g4 * (1.f + s4) + h4;
      if (out_f8) *(unsigned*)(H + (size_t)r * D + c4 * 4) = pk4_fp8(y.x * ASC, y.y * ASC, y.z * ASC, y.w * ASC);
      else *(u32x2*)((bf16_t*)H + (size_t)r * D + c4 * 4) = (u32x2){pk2(y.x, y.y), pk2(y.z, y.w)};
    }
  }
}
__device__ __forceinline__ void latnorm_phase(const bf16_t* __restrict__ LAT, const float* __restrict__ gcq, const float* __restrict__ gckv, unsigned char* __restrict__ CQN, bf16_t* __restrict__ CKVN, int wv) {
  const int tid_ = otid(wv); const int lane = tid_ & 63, wid = tid_ >> 6;
  for (int r = blockIdx.x * NWAVES + wid; r < M; r += gridDim.x * NWAVES) {
    const bf16_t* lr = LAT + (size_t)r * 1280;
    float q[12], kv[4]; float sq = 0.f, sk = 0.f;
#pragma unroll
    for (int j = 0; j < 3; ++j) { const u32x2 w = *(const u32x2*)(lr + lane * 4 + 256 * j); q[4 * j] = bf_lo(w.x); q[4 * j + 1] = bf_hi(w.x); q[4 * j + 2] = bf_lo(w.y); q[4 * j + 3] = bf_hi(w.y); }
    { const u32x2 w = *(const u32x2*)(lr + 768 + lane * 4); kv[0] = bf_lo(w.x); kv[1] = bf_hi(w.x); kv[2] = bf_lo(w.y); kv[3] = bf_hi(w.y); }
#pragma unroll
    for (int j = 0; j < 12; ++j) sq += q[j] * q[j];
#pragma unroll
    for (int j = 0; j < 4; ++j) sk += kv[j] * kv[j];
    sq = wave_sum(sq); sk = wave_sum(sk);
    const float rq = rsqrtf(sq * (1.f / 768.f) + EPS), rk = rsqrtf(sk * (1.f / 256.f) + EPS);
#pragma unroll
    for (int j = 0; j < 3; ++j) { const int c = lane * 4 + 256 * j; const f32x4 g4 = *(const f32x4*)(gcq + c);
      *(unsigned*)(CQN + (size_t)r * 768 + c) = pk4_fp8(q[4 * j] * rq * g4.x * ASC, q[4 * j + 1] * rq * g4.y * ASC, q[4 * j + 2] * rq * g4.z * ASC, q[4 * j + 3] * rq * g4.w * ASC); }
    { const int c = lane * 4; const f32x4 g4 = *(const f32x4*)(gckv + c);
      *(u32x2*)(CKVN + (size_t)r * 256 + c) = (u32x2){pk2(kv[0] * rk * g4.x, kv[1] * rk * g4.y), pk2(kv[2] * rk * g4.z, kv[3] * rk * g4.w)}; }
  }
}

constexpr int G_AS = 144;
constexpr int G_ATILE = 256 * G_AS, G_BTILE = 128 * G_AS, G_STAGE = G_ATILE + G_BTILE;
struct EpiFp8T { unsigned char* C; int ldc;
  __device__ __forceinline__ void operator()(int row, int col, f32x4 v) const { const unsigned w = pk4_fp8(v.x * WSC, v.y * WSC, v.z * WSC, v.w * WSC);
    C[(size_t)(col + 0) * ldc + row] = (unsigned char)(w & 255u); C[(size_t)(col + 1) * ldc + row] = (unsigned char)((w >> 8) & 255u); C[(size_t)(col + 2) * ldc + row] = (unsigned char)((w >> 16) & 255u); C[(size_t)(col + 3) * ldc + row] = (unsigned char)(w >> 24); } };
struct EpiBf16T { bf16_t* C; int ldc;
  __device__ __forceinline__ void operator()(int row, int col, f32x4 v) const {
    C[(size_t)(col + 0) * ldc + row] = (bf16_t)(pk2(v.x, 0.f) & 0xffffu); C[(size_t)(col + 1) * ldc + row] = (bf16_t)(pk2(v.y, 0.f) & 0xffffu);
    C[(size_t)(col + 2) * ldc + row] = (bf16_t)(pk2(v.z, 0.f) & 0xffffu); C[(size_t)(col + 3) * ldc + row] = (bf16_t)(pk2(v.w, 0.f) & 0xffffu); } };
template <class Epi>
__device__ __forceinline__ void gemm_phase(LAS unsigned char* lds, const bf16_t* __restrict__ A, int lda, const bf16_t* __restrict__ Bt, int ldb,
                                           int Mrows, int N, int K, bool skip_ctx_tiles, const Epi epi, int ustart, int ustride) {
  const int tid = opaque_tid(), lane = tid & 63, wid = tid >> 6, wr = wid >> 1, wc = wid & 1, fr = lane & 15, fq = lane >> 4;
  const int nN = N / 128, nU = (Mrows / 256) * nN, nt = K / 64;
  const int lrow = tid >> 3, lkc = tid & 7;
  for (int u = ustart; u < nU; u += ustride) {
    const int pm = u / nN, pn = u - pm * nN;
    if (skip_ctx_tiles && (pm % 9) == 8) continue;
    const bf16_t* Ag = A + (size_t)(pm * 256 + lrow) * lda + lkc * 8;
    const bf16_t* Bg = Bt + (size_t)(pn * 128 + lrow) * ldb + lkc * 8;
    f32x4 acc[4][4];
#pragma unroll
    for (int m = 0; m < 4; ++m)
#pragma unroll
      for (int n = 0; n < 4; ++n) acc[m][n] = (f32x4){0.f, 0.f, 0.f, 0.f};
    u32x4 ra[4], rb[2];
#pragma unroll
    for (int i = 0; i < 4; ++i) ra[i] = *(const u32x4*)(Ag + (size_t)(64 * i) * lda);
#pragma unroll
    for (int i = 0; i < 2; ++i) rb[i] = *(const u32x4*)(Bg + (size_t)(64 * i) * ldb);
    {
      LAS unsigned char* sa = lds + lrow * G_AS + lkc * 16; LAS unsigned char* sb = lds + G_ATILE + lrow * G_AS + lkc * 16;
#pragma unroll
      for (int i = 0; i < 4; ++i) *(LAS u32x4*)(sa + i * 64 * G_AS) = ra[i];
#pragma unroll
      for (int i = 0; i < 2; ++i) *(LAS u32x4*)(sb + i * 64 * G_AS) = rb[i];
    }
    __syncthreads();
    for (int t = 0; t < nt; ++t) {
      const bool more = (t + 1 < nt);
      if (more) {
#pragma unroll
        for (int i = 0; i < 4; ++i) ra[i] = *(const u32x4*)(Ag + (size_t)(64 * i) * lda + (t + 1) * 64);
#pragma unroll
        for (int i = 0; i < 2; ++i) rb[i] = *(const u32x4*)(Bg + (size_t)(64 * i) * ldb + (t + 1) * 64);
      }
      const LAS unsigned char* st = lds + (t & 1) * G_STAGE;
      const LAS unsigned char* pa = st + (wr * 64 + fr) * G_AS + fq * 16;
      const LAS unsigned char* pb = st + G_ATILE + (wc * 64 + fr) * G_AS + fq * 16;
#pragma unroll
      for (int ks = 0; ks < 2; ++ks) {
        bf16x8 af[4], bfr[4];
#pragma unroll
        for (int m = 0; m < 4; ++m) af[m] = *(const LAS bf16x8*)(pa + m * 16 * G_AS + ks * 64);
#pragma unroll
        for (int n = 0; n < 4; ++n) bfr[n] = *(const LAS bf16x8*)(pb + n * 16 * G_AS + ks * 64);
#pragma unroll
        for (int m = 0; m < 4; ++m)
#pragma unroll
          for (int n = 0; n < 4; ++n) acc[m][n] = __builtin_amdgcn_mfma_f32_16x16x32_bf16(bfr[n], af[m], acc[m][n], 0, 0, 0);
      }
      if (more) {
        LAS unsigned char* sa = lds + ((t + 1) & 1) * G_STAGE + lrow * G_AS + lkc * 16; LAS unsigned char* sb = sa + G_ATILE;
#pragma unroll
        for (int i = 0; i < 4; ++i) *(LAS u32x4*)(sa + i * 64 * G_AS) = ra[i];
#pragma unroll
        for (int i = 0; i < 2; ++i) *(LAS u32x4*)(sb + i * 64 * G_AS) = rb[i];
      }
      __syncthreads();
    }
#pragma unroll
    for (int m = 0; m < 4; ++m)
#pragma unroll
      for (int n = 0; n < 4; ++n) epi(pm * 256 + wr * 64 + m * 16 + fr, pn * 128 + wc * 64 + n * 16 + fq * 4, acc[m][n]);
  }
}

namespace pg8 {
#define PG8_LAS __attribute__((address_space(3)))
typedef unsigned short bf16_t;
typedef short bf16x8 __attribute__((ext_vector_type(8)));
typedef float f32x4 __attribute__((ext_vector_type(4)));
typedef unsigned u32x4 __attribute__((ext_vector_type(4)));
constexpr int BM = 256, BK = 64, HALF = 128, HTB = HALF * BK * 2  , STAGE_BYTES = 8 * HTB, NXCD = 8, WGM = 8;

__host__ __device__ __forceinline__ int lds_byte(int r, int c) { const int st = (r >> 4) * 2 + (c >> 5), rr = r & 15, cc = c & 31, ob = rr * 64 + cc * 2; return st * 1024 + (ob ^ (((ob >> 9) & 1) << 5)); }
__host__ __device__ __forceinline__ void stage_rc(int b, int& R, int& C) { const int st = b / 1024, sb = b % 1024, swz = sb ^ (((sb >> 9) & 1) << 5); R = (st >> 1) * 16 + swz / 64; C = (st & 1) * 32 + (swz % 64) / 2; }
__host__ __device__ __forceinline__ int perm32(int rho) { const int n = rho >> 4, i = rho & 15; return 8 * (i >> 2) + 4 * n + (i & 3); }

struct Unit { int pm, pn; };
struct Gemm { const bf16_t* A; const bf16_t* Bt; int M, N, K; };

struct StaticOrder {
    int nM, nN, nwg, G, c;
    __host__ __device__ void init(int M, int N, int G_, int c_) { nM = M / BM; nN = N / BM; nwg = nM * nN; G = G_; c = c_; }
    __host__ __device__ bool next(int i, Unit& u) const {
        const long L = (long)i * G + c; if (L >= nwg) return false;
        int wgid = (int)L; { const int q = nwg / NXCD, r = nwg % NXCD, xcd = wgid % NXCD, off = wgid / NXCD; wgid = (xcd < r ? xcd * (q + 1) : r * (q + 1) + (xcd - r) * q) + off; }
        const int nig = WGM * nN, gid = wgid / nig, fm = gid * WGM, gsz = (nM - fm) < WGM ? (nM - fm) : WGM;
        u.pm = fm + ((wgid % nig) % gsz); u.pn = (wgid % nig) / gsz; return true;
    }
    __device__ __forceinline__ void a_ready(const Unit&) const {}
    __device__ __forceinline__ void done(const Unit&) const {}
};
struct LatentOrder {
    StaticOrder base; bool skip;
    __host__ __device__ void init(int M_, int N_, int G_, int c_, bool skip_) { skip = skip_; base.init(skip_ ? (M_ / 9) * 8 : M_, N_, G_, c_); }
    __host__ __device__ bool next(int i, Unit& u) const { if (!base.next(i, u)) return false; if (skip) u.pm += u.pm >> 3; return true; }
    __device__ __forceinline__ void a_ready(const Unit&) const {}
    __device__ __forceinline__ void done(const Unit&) const {}
};
struct EpiBf16P { static constexpr bool PERM = true, AFTER_DRAIN = false; bf16_t* O; int ldc; float sc;
  __device__ __forceinline__ void operator()(const f32x4 (&acc)[2][2][4][2], const Unit& u, int wr, int wc, int fr, int fq) const {
    const int row0 = u.pm * BM + wr * 64 + fr, col0 = u.pn * BM + wc * 32 + 8 * fq;
#pragma unroll
    for (int ai = 0; ai < 2; ++ai)
#pragma unroll
      for (int m = 0; m < 4; ++m) { bf16_t* rowp = O + (size_t)(row0 + ai * HALF + m * 16) * ldc + col0;
#pragma unroll
        for (int bj = 0; bj < 2; ++bj) { const f32x4 v0 = acc[ai][bj][m][0] * sc, v1 = acc[ai][bj][m][1] * sc;
          *(u32x4*)(rowp + bj * HALF) = (u32x4){pk2(v0[0], v0[1]), pk2(v0[2], v0[3]), pk2(v1[0], v1[1]), pk2(v1[2], v1[3])}; } }
  } };
struct EpiResidN { static constexpr bool PERM = false, AFTER_DRAIN = false; const float* sl; const float* sc; bool src_f32; bf16_t* xl; bf16_t* xc; const float* modl; int which; bool live; float osc;
  __device__ __forceinline__ void operator()(const f32x4 (&acc)[2][2][4][2], const Unit& u, int wr, int wc, int fr, int fq) const {
    if (!live) return;
    const int row0 = u.pm * BM + wr * 64 + fr, col0 = u.pn * BM + wc * 32 + 4 * fq;
    const int b = (u.pm * BM) / TPB, s0 = u.pm * BM - b * TPB; const int bi = (s0 >= SEQ) ? 8 : b;
    const float* gp = modl + (size_t)(bi * 6 + which) * D + col0;
#pragma unroll
    for (int bj = 0; bj < 2; ++bj)
#pragma unroll
      for (int n = 0; n < 2; ++n) { const f32x4 gt = *(const f32x4*)(gp + bj * HALF + n * 16) * osc;
#pragma unroll
        for (int ai = 0; ai < 2; ++ai)
#pragma unroll
          for (int m = 0; m < 4; ++m) { const int rr = row0 + ai * HALF + m * 16, cc = col0 + bj * HALF + n * 16;
            bf16_t* xp = xrow_ptr(xl, xc, rr) + cc; f32x4 xv;
            if (src_f32) xv = *(const f32x4*)(xsrc_ptr(sl, sc, rr) + cc);
            else { const u32x2 w = *(const u32x2*)xp; xv = (f32x4){bf_lo(w.x), bf_hi(w.x), bf_lo(w.y), bf_hi(w.y)}; }
            xv += gt * acc[ai][bj][m][n]; *(u32x2*)xp = (u32x2){pk2(xv.x, xv.y), pk2(xv.z, xv.w)}; } }
  } };
template <class Epi, class Sched, bool ALIGN_EPI = false, bool SP2 = false, bool FP8 = false>
__device__ __forceinline__ void gemm_phase(PG8_LAS unsigned char* lds, const Gemm g, const Sched& S, const Epi& E, int wv) {
    const int tid = otid(wv), wid = __builtin_amdgcn_readfirstlane(tid >> 6), lane = tid & 63, wr = wid >> 2, wc = wid & 3, fr = lane & 15, fq = lane >> 4;
    const int K = g.K, nt = K / BK;
    unsigned voffA[2], voffB[2];
#pragma unroll
    for (int i = 0; i < 2; ++i) { int R, C; stage_rc(tid * 16 + i * 8192, R, C); const int Rb = Epi::PERM ? ((R & ~31) + perm32(R & 31)) : R;
        voffA[i] = (unsigned)(R * K + C) * 2u; voffB[i] = (unsigned)(Rb * K + C) * 2u; }
    const size_t kstep = (size_t)(BK * 2);
    const size_t hstep = (size_t)HALF * K * 2;
    const size_t tstep = 2 * hstep;
    const unsigned ldsw = (unsigned)wid * 1024u;
    const int aoff = lds_byte(wr * 64 + fr, fq * 8), boff = lds_byte(wc * 32 + fr, fq * 8);
#define PG8_SA(b, h) (((b) * 2 + (h)) * HTB)
#define PG8_SB(b, h) ((4 + (b) * 2 + (h)) * HTB)
#define PG8_STAGE(bufoff, gbase, voff) do { _Pragma("unroll") for (int _i = 0; _i < 2; ++_i) \
        __builtin_amdgcn_global_load_lds((const unsigned*)((const char*)(gbase) + (voff)[_i]), (PG8_LAS unsigned*)(lds + (bufoff) + ldsw + _i * 8192), 16, 0, 0); } while (0)
#define PG8_LDA(dst, b, h) do { _Pragma("unroll") for (int m = 0; m < 4; ++m) _Pragma("unroll") for (int k = 0; k < 2; ++k) dst[m][k] = *(const PG8_LAS bf16x8*)(lds + PG8_SA(b, h) + aoff + m * 2048 + k * 1024); } while (0)
#define PG8_LDB(dst, b, h) do { _Pragma("unroll") for (int n = 0; n < 2; ++n) _Pragma("unroll") for (int k = 0; k < 2; ++k) dst[n][k] = *(const PG8_LAS bf16x8*)(lds + PG8_SB(b, h) + boff + n * 2048 + k * 1024); } while (0)
#define PG8_MMA(ai, bj, At, Bt) do { __builtin_amdgcn_s_setprio(1); _Pragma("unroll") for (int m = 0; m < 4; ++m) _Pragma("unroll") for (int n = 0; n < 2; ++n) _Pragma("unroll") for (int k = 0; k < 2; ++k) { \
        if constexpr (FP8) { const long2_t a2_ = __builtin_bit_cast(long2_t, At[m][k]), b2_ = __builtin_bit_cast(long2_t, Bt[n][k]); \
          acc[ai][bj][m][n] = __builtin_amdgcn_mfma_f32_16x16x32_fp8_fp8(b2_[0], a2_[0], acc[ai][bj][m][n], 0, 0, 0); \
          acc[ai][bj][m][n] = __builtin_amdgcn_mfma_f32_16x16x32_fp8_fp8(b2_[1], a2_[1], acc[ai][bj][m][n], 0, 0, 0); } \
        else acc[ai][bj][m][n] = __builtin_amdgcn_mfma_f32_16x16x32_bf16(Bt[n][k], At[m][k], acc[ai][bj][m][n], 0, 0, 0); } __builtin_amdgcn_s_setprio(0); } while (0)
#define PG8_WAIT_V(n) asm volatile("s_waitcnt vmcnt(" #n ")" ::: "memory")
#define PG8_WAIT_L(n) asm volatile("s_waitcnt lgkmcnt(" #n ")" ::: "memory")
#define PG8_BAR __builtin_amdgcn_s_barrier()
#define PG8_SCHED __builtin_amdgcn_sched_barrier(0)
    Unit cur, nxt; int ui = 0;
    if (!S.next(0, cur)) return;
    f32x4 acc[2][2][4][2];
#pragma unroll
    for (int a = 0; a < 2; ++a)
#pragma unroll
        for (int b = 0; b < 2; ++b)
#pragma unroll
            for (int m = 0; m < 4; ++m)
#pragma unroll
                for (int n = 0; n < 2; ++n) acc[a][b][m][n] = (f32x4){0.f, 0.f, 0.f, 0.f};
    bf16x8 At[4][2], B0[2][2], B1[2][2];
    const char* cA = (const char*)g.A + (size_t)cur.pm * tstep; const char* cB = (const char*)g.Bt + (size_t)cur.pn * tstep;
    S.a_ready(cur);
    if constexpr (SP2) {
        PG8_STAGE(PG8_SB(0, 0), cB, voffB); PG8_STAGE(PG8_SB(0, 1), cB + hstep, voffB); PG8_STAGE(PG8_SA(0, 0), cA, voffA); PG8_STAGE(PG8_SA(0, 1), cA + hstep, voffA);
        if (wr == 1) PG8_BAR;
        PG8_WAIT_V(2); PG8_BAR;
        PG8_STAGE(PG8_SB(1, 0), cB + kstep, voffB); PG8_STAGE(PG8_SA(1, 0), cA + kstep, voffA); PG8_STAGE(PG8_SB(1, 1), cB + hstep + kstep, voffB);
        PG8_WAIT_V(6); PG8_BAR;
    } else {
        PG8_STAGE(PG8_SB(0, 0), cB, voffB); PG8_STAGE(PG8_SA(0, 0), cA, voffA); PG8_STAGE(PG8_SB(0, 1), cB + hstep, voffB); PG8_STAGE(PG8_SA(0, 1), cA + hstep, voffA);
        if (wr == 1) PG8_BAR;
        PG8_WAIT_V(4); PG8_BAR;
        PG8_STAGE(PG8_SB(1, 0), cB + kstep, voffB); PG8_STAGE(PG8_SA(1, 0), cA + kstep, voffA); PG8_STAGE(PG8_SB(1, 1), cB + hstep + kstep, voffB);
        PG8_WAIT_V(6); PG8_BAR;
    }
    for (;;) {
        const bool has_next = S.next(ui + 1, nxt);
        const char* nA = has_next ? (const char*)g.A + (size_t)nxt.pm * tstep : cA; const char* nB = has_next ? (const char*)g.Bt + (size_t)nxt.pn * tstep : cB;
        for (int t = 0; t < nt; t += 2) {
            const bool last = (t == nt - 2);
            const char* a1 = cA + (size_t)(t + 1) * kstep;
            const char* a2 = last ? nA : cA + (size_t)(t + 2) * kstep; const char* b2 = last ? nB : cB + (size_t)(t + 2) * kstep;
            const char* a3 = a2 + kstep; const char* b3 = b2 + kstep;
            if (last && has_next) S.a_ready(nxt);
            if constexpr (SP2) {
            PG8_LDB(B0, 0, 0); PG8_LDB(B1, 0, 1); PG8_SCHED; PG8_LDA(At, 0, 0); PG8_STAGE(PG8_SA(1, 1), a1 + hstep, voffA);
            PG8_WAIT_V(8); PG8_WAIT_L(0); PG8_BAR; PG8_MMA(0, 0, At, B0); PG8_MMA(0, 1, At, B1); PG8_BAR; PG8_SCHED;
            PG8_LDA(At, 0, 1); PG8_STAGE(PG8_SB(0, 0), b2, voffB); PG8_STAGE(PG8_SB(0, 1), b2 + hstep, voffB); PG8_STAGE(PG8_SA(0, 0), a2, voffA);
            PG8_WAIT_V(8); PG8_WAIT_L(0); PG8_BAR; PG8_MMA(1, 0, At, B0); PG8_MMA(1, 1, At, B1); PG8_BAR; PG8_SCHED;
            PG8_LDB(B0, 1, 0); PG8_LDB(B1, 1, 1); PG8_SCHED; PG8_LDA(At, 1, 0); PG8_STAGE(PG8_SA(0, 1), a2 + hstep, voffA);
            PG8_WAIT_V(8); PG8_WAIT_L(0); PG8_BAR; PG8_MMA(0, 0, At, B0); PG8_MMA(0, 1, At, B1); PG8_BAR; PG8_SCHED;
            PG8_LDA(At, 1, 1); PG8_STAGE(PG8_SB(1, 0), b3, voffB); PG8_STAGE(PG8_SB(1, 1), b3 + hstep, voffB); PG8_STAGE(PG8_SA(1, 0), a3, voffA);
            PG8_WAIT_V(8); PG8_WAIT_L(0); PG8_BAR; PG8_MMA(1, 0, At, B0); PG8_MMA(1, 1, At, B1); PG8_BAR; PG8_SCHED;
            } else {
            PG8_LDB(B0, 0, 0); PG8_SCHED; PG8_LDA(At, 0, 0); PG8_STAGE(PG8_SA(1, 1), a1 + hstep, voffA);
            PG8_WAIT_L(8); PG8_BAR; PG8_WAIT_L(0); PG8_MMA(0, 0, At, B0); PG8_BAR; PG8_SCHED;
            PG8_LDB(B1, 0, 1); PG8_STAGE(PG8_SB(0, 0), b2, voffB);
            PG8_BAR; PG8_WAIT_L(0); PG8_MMA(0, 1, At, B1); PG8_BAR;
            PG8_LDA(At, 0, 1); PG8_STAGE(PG8_SA(0, 0), a2, voffA);
            PG8_BAR; PG8_WAIT_L(0); PG8_MMA(1, 0, At, B0); PG8_BAR; PG8_SCHED;
            PG8_STAGE(PG8_SB(0, 1), b2 + hstep, voffB);
            PG8_WAIT_V(6); PG8_BAR; PG8_MMA(1, 1, At, B1); PG8_BAR;
            PG8_LDB(B0, 1, 0); PG8_SCHED; PG8_LDA(At, 1, 0); PG8_STAGE(PG8_SA(0, 1), a2 + hstep, voffA);
            PG8_WAIT_L(8); PG8_BAR; PG8_WAIT_L(0); PG8_MMA(0, 0, At, B0); PG8_BAR; PG8_SCHED;
            PG8_LDB(B1, 1, 1); PG8_STAGE(PG8_SB(1, 0), b3, voffB);
            PG8_BAR; PG8_WAIT_L(0); PG8_MMA(0, 1, At, B1); PG8_BAR;
            PG8_LDA(At, 1, 1); PG8_STAGE(PG8_SA(1, 0), a3, voffA);
            PG8_BAR; PG8_WAIT_L(0); PG8_MMA(1, 0, At, B0); PG8_BAR; PG8_SCHED;
            PG8_STAGE(PG8_SB(1, 1), b3 + hstep, voffB);
            PG8_WAIT_V(6); PG8_BAR; PG8_MMA(1, 1, At, B1); PG8_BAR;
            }
        }
        if constexpr (ALIGN_EPI) { if (wr == 0) PG8_BAR; }
        if constexpr (!Epi::AFTER_DRAIN) { E(acc, cur, wr, wc, fr, fq); S.done(cur); }
        if (!has_next) break;
#pragma unroll
        for (int a = 0; a < 2; ++a)
#pragma unroll
            for (int b = 0; b < 2; ++b)
#pragma unroll
                for (int m = 0; m < 4; ++m)
#pragma unroll
                    for (int n = 0; n < 2; ++n) acc[a][b][m][n] = (f32x4){0.f, 0.f, 0.f, 0.f};
        cur = nxt; cA = nA; cB = nB; ++ui;
        if constexpr (ALIGN_EPI) { if (wr == 1) PG8_BAR; }
    }
    PG8_WAIT_V(0);
    if constexpr (!ALIGN_EPI) { if (wr == 0) PG8_BAR; }
    PG8_BAR;
    if constexpr (Epi::AFTER_DRAIN) { E.fused(acc, cur, wr, wc, fr, fq, lds, wid, lane); S.done(cur); }
#undef PG8_SA
#undef PG8_SB
#undef PG8_STAGE
#undef PG8_LDA
#undef PG8_LDB
#undef PG8_MMA
#undef PG8_WAIT_V
#undef PG8_WAIT_L
#undef PG8_BAR
#undef PG8_SCHED
}
}
#define UNPACK8(W, V, O) do { V[O + 0] = bf_lo(W.x); V[O + 1] = bf_hi(W.x); V[O + 2] = bf_lo(W.y); V[O + 3] = bf_hi(W.y); V[O + 4] = bf_lo(W.z); V[O + 5] = bf_hi(W.z); V[O + 6] = bf_lo(W.w); V[O + 7] = bf_hi(W.w); } while (0)
#define PACK8(V, O, SC) (u32x4){pk2(V[O] * SC, V[O + 1] * SC), pk2(V[O + 2] * SC, V[O + 3] * SC), pk2(V[O + 4] * SC, V[O + 5] * SC), pk2(V[O + 6] * SC, V[O + 7] * SC)}
__device__ __forceinline__ void headnorm96(const bf16_t* srcA, const bf16_t* srcB, bf16_t* dst, const float* __restrict__ g, float outscale, bool rope, int rowpos, int colpos,
                                           const float* __restrict__ tab8, int j) {
  const u32x4 w0 = *(const u32x4*)(srcA + j * 8), w1 = *(const u32x4*)(srcA + 32 + j * 8), w2 = *(const u32x4*)(srcB + j * 8);
  float v[24];
  UNPACK8(w0, v, 0); UNPACK8(w1, v, 8); UNPACK8(w2, v, 16);
  float ss = 0.f;
#pragma unroll
  for (int e = 0; e < 24; ++e) ss += v[e] * v[e];
  ss += __shfl_xor(ss, 1); ss += __shfl_xor(ss, 2);
  const float rstd = rsqrtf(ss * (1.f / 96.f) + EPS);
#pragma unroll
  for (int e = 0; e < 8; ++e) { v[e] *= rstd * g[j * 8 + e]; v[8 + e] *= rstd * g[32 + j * 8 + e]; v[16 + e] *= rstd * g[64 + j * 8 + e]; }
  const int pos = (j < 2) ? rowpos : colpos;
#pragma unroll
  for (int e = 0; e < 8; ++e) {
    const float own = v[16 + e], oth = __shfl_xor(own, 1);
    const f32x2_t cs = *(const f32x2_t*)(tab8 + (pos * 8 + e) * 2);
    const float res = (j & 1) ? (oth * cs.y + own * cs.x) : (own * cs.x - oth * cs.y);
    if (rope) v[16 + e] = res;
  }
  *(u32x4*)(dst + j * 8) = PACK8(v, 0, outscale); *(u32x4*)(dst + 32 + j * 8) = PACK8(v, 8, outscale); *(u32x4*)(dst + 64 + j * 8) = PACK8(v, 16, outscale);
}
__device__ __forceinline__ void headnorm64(const bf16_t* q, bf16_t* qd, const float* __restrict__ g, float outscale, bool rope, int rowpos, int colpos, const float* __restrict__ tab16, int j) {
  const u32x4 w0 = *(const u32x4*)(q + j * 8), w1 = *(const u32x4*)(q + 32 + j * 8);
  float v[16];
  UNPACK8(w0, v, 0); UNPACK8(w1, v, 8);
  float ss = 0.f;
#pragma unroll
  for (int e = 0; e < 16; ++e) ss += v[e] * v[e];
  ss += __shfl_xor(ss, 1); ss += __shfl_xor(ss, 2);
  const float rstd = rsqrtf(ss * (1.f / 64.f) + EPS);
#pragma unroll
  for (int e = 0; e < 8; ++e) { v[e] *= rstd * g[j * 8 + e]; v[8 + e] *= rstd * g[32 + j * 8 + e]; }
#pragma unroll
  for (int e = 0; e < 8; ++e) {
    const int i = (j & 1) * 8 + e;
    const float own0 = v[e], oth0 = __shfl_xor(own0, 2), own1 = v[8 + e], oth1 = __shfl_xor(own1, 2);
    const f32x2_t cr = *(const f32x2_t*)(tab16 + (rowpos * 16 + i) * 2), cc = *(const f32x2_t*)(tab16 + (colpos * 16 + i) * 2);
    const float r0 = (j >> 1) ? (oth0 * cr.y + own0 * cr.x) : (own0 * cr.x - oth0 * cr.y);
    const float r1 = (j >> 1) ? (oth1 * cc.y + own1 * cc.x) : (own1 * cc.x - oth1 * cc.y);
    if (rope) { v[e] = r0; v[8 + e] = r1; }
  }
  *(u32x4*)(qd + j * 8) = PACK8(v, 0, outscale); *(u32x4*)(qd + 32 + j * 8) = PACK8(v, 8, outscale);
}

template <int DQK, int DV, int NS, bool WINDOW>
__device__ __forceinline__ void attn_unit(LAS unsigned char* lds, const bf16_t* __restrict__ Qb, int qsoff, int ldq, const bf16_t* __restrict__ Kb, int ksoff, int ldk,
                                          const bf16_t* __restrict__ Vb, int ldv, int q0, int ta0, int ta1, int tb0, int tb1, bool has_sink, float sink_l2, float kmax,
                                          unsigned char* __restrict__ Ob, int ldo, float lam, const float* __restrict__ gsub, int wv) {
  constexpr int KS = DQK * 2 + 16, KTB = 64 * KS, VS = (DV == 64) ? 192 : 320, VOFF = NS * KTB, VTB = 64 * VS, STG = VOFF + VTB;
  constexpr int KCR = DQK / 8, KCH = 64 * KCR, VCR = DV / 8, VCH = 64 * VCR, NCH = NS * KCH + VCH, NI = (NCH + NTHREADS - 1) / NTHREADS;
  constexpr int NDB = DV / 32, NKS = DQK / 16;
  static_assert(3 * STG <= LDS_BYTES - 16 && (NS == 1 || 4 * DV * 32 * 4 <= 3 * STG), "LDS");
  const int tid = otid(wv), lane = tid & 63, wid = tid >> 6, l31 = lane & 31, hi = lane >> 5;
  const int grp = wid >> 2;
  const int qsub = (NS == 1) ? wid : (wid & 3), stream = (NS == 1) ? 0 : grp;
  const int qrow = q0 + qsub * 32 + l31;
  bf16x8 qf[NKS];
  float qn2 = 0.f;
#pragma unroll
  for (int ks = 0; ks < NKS; ++ks) {
    const u32x4 w = *(const u32x4*)(Qb + (size_t)stream * qsoff + (size_t)qrow * ldq + ks * 16 + hi * 8);
    qf[ks] = __builtin_bit_cast(bf16x8, w);
    const float a0 = bf_lo(w.x), a1 = bf_hi(w.x), a2 = bf_lo(w.y), a3 = bf_hi(w.y), a4 = bf_lo(w.z), a5 = bf_hi(w.z), a6 = bf_lo(w.w), a7 = bf_hi(w.w);
    qn2 += a0 * a0 + a1 * a1 + a2 * a2 + a3 * a3 + a4 * a4 + a5 * a5 + a6 * a6 + a7 * a7;
  }
  qn2 += __shfl_xor(qn2, 32);
  const float negmb = -(sqrtf(qn2) * kmax);
  f32x16 negmv;
  if (DV == 64) {
#pragma unroll
    for (int r = 0; r < 16; ++r) negmv[r] = negmb;
    asm volatile("" : "+v"(negmv));
  }
  f32x16 o[NDB];
#pragma unroll
  for (int db = 0; db < NDB; ++db)
#pragma unroll
    for (int r = 0; r < 16; ++r) o[db][r] = 0.f;
  float lrun = 0.f;
  const int n1 = ta1 - ta0, ntl = n1 + (tb1 - tb0);
  u32x4 st[NI];
  f32x16 p0, p1;
  const LAS unsigned char* klb = lds + stream * KTB + l31 * KS + hi * 16;
  const LAS unsigned char* vlb = lds + VOFF + (4 * hi + ((lane & 15) >> 2)) * VS + (16 * ((lane >> 4) & 1) + 4 * (lane & 3)) * 2;
#define ATT_TILE(i_) (((i_) < n1) ? ta0 + (i_) : tb0 + ((i_) - n1))
#define ATT_LOAD(T_) do { const int t__ = (T_); _Pragma("unroll") for (int ii = 0; ii < NI; ++ii) { const int c = tid + ii * NTHREADS; if (c < NCH) { \
      if (c < NS * KCH) { const int s_ = c / KCH, cc = c - s_ * KCH, row = cc / KCR, kc = cc - row * KCR; st[ii] = *(const u32x4*)(Kb + (size_t)s_ * ksoff + (size_t)(t__ * 64 + row) * ldk + kc * 8); } \
      else { const int cc = c - NS * KCH, row = cc / VCR, vc = cc - row * VCR; st[ii] = *(const u32x4*)(Vb + (size_t)(t__ * 64 + row) * ldv + vc * 8); } } } } while (0)
#define ATT_STORE(BO_) do { LAS unsigned char* sb__ = lds + (BO_); _Pragma("unroll") for (int ii = 0; ii < NI; ++ii) { const int c = tid + ii * NTHREADS; if (c < NCH) { \
      if (c < NS * KCH) { const int s_ = c / KCH, cc = c - s_ * KCH, row = cc / KCR, kc = cc - row * KCR; *(LAS u32x4*)(sb__ + s_ * KTB + row * KS + kc * 16) = st[ii]; } \
      else { const int cc = c - NS * KCH, row = cc / VCR, vc = cc - row * VCR; *(LAS u32x4*)(sb__ + VOFF + row * VS + vc * 16) = st[ii]; } } } } while (0)
#define ATT_FLAGS(T_, ACT_, MSK_) do { ACT_ = true; MSK_ = false; if (WINDOW && (T_) < 32) { const int qlo = q0 + qsub * 32, qhi = qlo + 31, klo = (T_) * 64, khi = klo + 63; \
      ACT_ = !(khi < qlo - 128 || klo > qhi + 128); MSK_ = (khi - qlo > 128) || (qhi - klo > 128); } } while (0)
  constexpr int KB1 = NKS / 2;
  bf16x8 kf[2 * KB1];
#define ATT_QK_READ1(BO_) do { const LAS unsigned char* kl = klb + (BO_); \
      _Pragma("unroll") for (int ks = 0; ks < KB1; ++ks) { kf[2 * ks] = *(const LAS bf16x8*)(kl + ks * 32); kf[2 * ks + 1] = *(const LAS bf16x8*)(kl + 32 * KS + ks * 32); } \
      __builtin_amdgcn_sched_barrier(0); } while (0)
#define ATT_QK_REST(BO_) do { const LAS unsigned char* kl = klb + (BO_); \
      __builtin_amdgcn_sched_barrier(0); \
      if (DV == 64) { p0 = __builtin_amdgcn_mfma_f32_32x32x16_bf16(kf[0], qf[0], negmv, 0, 0, 0); p1 = __builtin_amdgcn_mfma_f32_32x32x16_bf16(kf[1], qf[0], negmv, 0, 0, 0); } \
      else { _Pragma("unroll") for (int r = 0; r < 16; ++r) { p0[r] = negmb; p1[r] = negmb; } p0 = __builtin_amdgcn_mfma_f32_32x32x16_bf16(kf[0], qf[0], p0, 0, 0, 0); p1 = __builtin_amdgcn_mfma_f32_32x32x16_bf16(kf[1], qf[0], p1, 0, 0, 0); } \
      _Pragma("unroll") for (int ks = 1; ks < KB1; ++ks) { p0 = __builtin_amdgcn_mfma_f32_32x32x16_bf16(kf[2 * ks], qf[ks], p0, 0, 0, 0); p1 = __builtin_amdgcn_mfma_f32_32x32x16_bf16(kf[2 * ks + 1], qf[ks], p1, 0, 0, 0); } \
      __builtin_amdgcn_sched_barrier(0); \
      _Pragma("unroll") for (int ks = KB1; ks < NKS; ++ks) { kf[2 * (ks - KB1)] = *(const LAS bf16x8*)(kl + ks * 32); kf[2 * (ks - KB1) + 1] = *(const LAS bf16x8*)(kl + 32 * KS + ks * 32); } \
      __builtin_amdgcn_sched_barrier(0); \
      _Pragma("unroll") for (int ks = KB1; ks < NKS; ++ks) { p0 = __builtin_amdgcn_mfma_f32_32x32x16_bf16(kf[2 * (ks - KB1)], qf[ks], p0, 0, 0, 0); p1 = __builtin_amdgcn_mfma_f32_32x32x16_bf16(kf[2 * (ks - KB1) + 1], qf[ks], p1, 0, 0, 0); } \
      __builtin_amdgcn_sched_barrier(0); } while (0)
#define ATT_VREAD(G_) do { _Pragma("unroll") for (int d2 = 0; d2 < GD; ++d2) _Pragma("unroll") for (int kb = 0; kb < 2; ++kb) _Pragma("unroll") for (int s_ = 0; s_ < 2; ++s_) { \
        const LAS unsigned char* vp = vl + (kb * 32 + 16 * s_) * VS + ((G_) * GD + d2) * 64; \
        vlo[d2 * 4 + kb * 2 + s_] = __builtin_amdgcn_ds_read_tr16_b64_v4i16((LAS v4i16_t*)vp); vhi[d2 * 4 + kb * 2 + s_] = __builtin_amdgcn_ds_read_tr16_b64_v4i16((LAS v4i16_t*)(vp + 8 * VS)); } } while (0)
#define ATT_PVM(G_) do { _Pragma("unroll") for (int d2 = 0; d2 < GD; ++d2) _Pragma("unroll") for (int kb = 0; kb < 2; ++kb) _Pragma("unroll") for (int s_ = 0; s_ < 2; ++s_) { \
        const v4i16_t lo_ = vlo[d2 * 4 + kb * 2 + s_], hi_ = vhi[d2 * 4 + kb * 2 + s_]; \
        const bf16x8 vf = (bf16x8){lo_[0], lo_[1], lo_[2], lo_[3], hi_[0], hi_[1], hi_[2], hi_[3]}; \
        o[(G_) * GD + d2] = __builtin_amdgcn_mfma_f32_32x32x16_bf16(vf, __builtin_bit_cast(bf16x8, pw[kb][s_]), o[(G_) * GD + d2], 0, 0, 0); } } while (0)
#define ATT_SPV(T_, BO_, MSK_) do { const LAS unsigned char* vl = vlb + (BO_); constexpr int GD = (DV == 128) ? 1 : 2; v4i16_t vlo[4 * GD], vhi[4 * GD]; \
      ATT_VREAD(0); __builtin_amdgcn_sched_barrier(0); \
      if (WINDOW && (MSK_)) { _Pragma("unroll") for (int r = 0; r < 16; ++r) { const int d0 = (T_) * 64 + crow(r, hi) - qrow, d1 = d0 + 32; \
          if (d0 > 128 || d0 < -128) p0[r] = -INFINITY; if (d1 > 128 || d1 < -128) p1[r] = -INFINITY; } } \
      _Pragma("unroll") for (int r = 0; r < 16; ++r) { p0[r] = __builtin_amdgcn_exp2f(p0[r]); p1[r] = __builtin_amdgcn_exp2f(p1[r]); } \
      u32x4 pw[2][2]; \
      _Pragma("unroll") for (int s_ = 0; s_ < 2; ++s_) { \
        pw[0][s_] = (u32x4){pk2(p0[8 * s_], p0[8 * s_ + 1]), pk2(p0[8 * s_ + 2], p0[8 * s_ + 3]), pk2(p0[8 * s_ + 4], p0[8 * s_ + 5]), pk2(p0[8 * s_ + 6], p0[8 * s_ + 7])}; \
        pw[1][s_] = (u32x4){pk2(p1[8 * s_], p1[8 * s_ + 1]), pk2(p1[8 * s_ + 2], p1[8 * s_ + 3]), pk2(p1[8 * s_ + 4], p1[8 * s_ + 5]), pk2(p1[8 * s_ + 6], p1[8 * s_ + 7])}; } \
      _Pragma("unroll") for (int kb = 0; kb < 2; ++kb) _Pragma("unroll") for (int s_ = 0; s_ < 2; ++s_) { \
        lrun = dot2bf(pw[kb][s_].x, 0x3f803f80u, lrun); lrun = dot2bf(pw[kb][s_].y, 0x3f803f80u, lrun); lrun = dot2bf(pw[kb][s_].z, 0x3f803f80u, lrun); lrun = dot2bf(pw[kb][s_].w, 0x3f803f80u, lrun); } \
      __builtin_amdgcn_sched_barrier(0); \
      ATT_PVM(0); \
      _Pragma("unroll") for (int g_ = 1; g_ < NDB / GD; ++g_) { __builtin_amdgcn_sched_barrier(0); ATT_VREAD(g_); __builtin_amdgcn_sched_barrier(0); ATT_PVM(g_); } } while (0)
  ATT_LOAD(ATT_TILE(0));
  ATT_STORE(0);
  if (ntl > 1) ATT_LOAD(ATT_TILE(1));
  __syncthreads();
  int bo_prev = 0, bo_cur = 0, bo_next = STG;
  for (int i = 0; i <= ntl; ++i) {
    if (grp == 0) {
      if (i < ntl) {
        const int t = ATT_TILE(i);
        bool act, msk; ATT_FLAGS(t, act, msk);
        if (act) ATT_QK_READ1(bo_cur);
        if (i + 1 < ntl) ATT_STORE(bo_next);
        if (i + 2 < ntl) ATT_LOAD(ATT_TILE(i + 2));
        if (act) { ATT_QK_REST(bo_cur); ATT_SPV(t, bo_cur, msk); }
      }
    } else {
      if (i >= 1) { const int tp = ATT_TILE(i - 1); bool act, msk; ATT_FLAGS(tp, act, msk); if (act) ATT_SPV(tp, bo_prev, msk); }
      if (i < ntl) {
        const int t = ATT_TILE(i);
        bool act, msk; ATT_FLAGS(t, act, msk);
        if (act) ATT_QK_READ1(bo_cur);
        if (i + 1 < ntl) ATT_STORE(bo_next);
        if (i + 2 < ntl) ATT_LOAD(ATT_TILE(i + 2));
        if (act) ATT_QK_REST(bo_cur);
      }
    }
    bo_prev = bo_cur; bo_cur = bo_next; bo_next = (bo_next == 2 * STG) ? 0 : bo_next + STG;
    __syncthreads();
  }
#undef ATT_LOAD
#undef ATT_STORE
#undef ATT_TILE
#undef ATT_FLAGS
#undef ATT_QK_READ1
#undef ATT_QK_REST
#undef ATT_VREAD
#undef ATT_PVM
#undef ATT_SPV
  float ltot = lrun + __shfl_xor(lrun, 32);
  if (has_sink) ltot += __builtin_amdgcn_exp2f(sink_l2 + negmb);
  const float inv = 1.f / ltot;
  if (NS == 1) {
    unsigned char* op = Ob + (size_t)qrow * ldo + 4 * hi; const float is_ = inv * OSC;
#pragma unroll
    for (int db = 0; db < NDB; ++db)
#pragma unroll
      for (int r4 = 0; r4 < 4; ++r4)
        *(unsigned*)(op + db * 32 + 8 * r4) = pk4_fp8(o[db][4 * r4] * is_, o[db][4 * r4 + 1] * is_, o[db][4 * r4 + 2] * is_, o[db][4 * r4 + 3] * is_);
  } else {
    LAS float* ex = (LAS float*)lds + qsub * (DV * 32);
    if (stream == 1) {
#pragma unroll
      for (int db = 0; db < NDB; ++db)
#pragma unroll
        for (int r = 0; r < 16; ++r) ex[(db * 32 + crow(r, hi)) * 32 + l31] = o[db][r] * inv;
    }
    __syncthreads();
    if (stream == 0) {
      float ss = 0.f;
#pragma unroll
      for (int db = 0; db < NDB; ++db)
#pragma unroll
        for (int r = 0; r < 16; ++r) { const float v = o[db][r] * inv - lam * ex[(db * 32 + crow(r, hi)) * 32 + l31]; o[db][r] = v; ss += v * v; }
      ss += __shfl_xor(ss, 32);
      const float rs = rsqrtf(ss * (1.f / DV) + EPS) * (1.f - LAM_INIT);
      unsigned char* op = Ob + (size_t)qrow * ldo + 4 * hi; const float rs_ = rs * OSC;
#pragma unroll
      for (int db = 0; db < NDB; ++db)
#pragma unroll
        for (int r4 = 0; r4 < 4; ++r4) {
          const f32x4 g4 = *(const f32x4*)(gsub + db * 32 + 8 * r4 + 4 * hi);
          *(unsigned*)(op + db * 32 + 8 * r4) = pk4_fp8(o[db][4 * r4] * rs_ * g4.x, o[db][4 * r4 + 1] * rs_ * g4.y, o[db][4 * r4 + 2] * rs_ * g4.z, o[db][4 * r4 + 3] * rs_ * g4.w);
        }
    }
    __syncthreads();
  }
}

template <int DQK, int DV, bool WINDOW>
__device__ __forceinline__ void attn_unit_p(LAS unsigned char* lds, const bf16_t* __restrict__ Qb, int ldq, const bf16_t* __restrict__ Kb, int ldk, const bf16_t* __restrict__ Vb, int ldv,
                                            int q0, int ta0, int ta1, int tb0, int tb1, bool has_sink, float sink_l2, float kmax, unsigned char* __restrict__ Ob, int ldo, int wv) {
  static_assert(DV == 64 && !WINDOW, "pipelined form: DV = 64, no window");
  constexpr int KS = DQK * 2 + 16, KTB = 64 * KS, VS = 192, VOFF = KTB, VTB = 64 * VS, STG = VOFF + VTB;
  constexpr int KCR = DQK / 8, KCH = 64 * KCR, VCR = DV / 8, VCH = 64 * VCR, NCH = KCH + VCH, NI = (NCH + NTHREADS - 1) / NTHREADS;
  constexpr int NKS = DQK / 16, NQK = 2 * NKS, NPV = 8, EG = (NQK >= 12) ? 8 : NQK - 2;
  static_assert(3 * STG <= LDS_BYTES - 16, "LDS");
  const int tid = otid(wv), lane = tid & 63, wid = tid >> 6, l31 = lane & 31, hi = lane >> 5;
  const int qrow = q0 + wid * 32 + l31;
  bf16x8 qf[NKS];
  float qn2 = 0.f;
#pragma unroll
  for (int ks = 0; ks < NKS; ++ks) {
    const u32x4 w = *(const u32x4*)(Qb + (size_t)qrow * ldq + ks * 16 + hi * 8);
    qf[ks] = __builtin_bit_cast(bf16x8, w);
    const float a0 = bf_lo(w.x), a1 = bf_hi(w.x), a2 = bf_lo(w.y), a3 = bf_hi(w.y), a4 = bf_lo(w.z), a5 = bf_hi(w.z), a6 = bf_lo(w.w), a7 = bf_hi(w.w);
    qn2 += a0 * a0 + a1 * a1 + a2 * a2 + a3 * a3 + a4 * a4 + a5 * a5 + a6 * a6 + a7 * a7;
  }
  qn2 += __shfl_xor(qn2, 32);
  const float negmb = -(sqrtf(qn2) * kmax);
  f32x16 negmv;
#pragma unroll
  for (int r = 0; r < 16; ++r) negmv[r] = negmb;
  asm volatile("" : "+v"(negmv));
  f32x16 o[2];
#pragma unroll
  for (int db = 0; db < 2; ++db)
#pragma unroll
    for (int r = 0; r < 16; ++r) o[db][r] = 0.f;
  float lrun = 0.f;
  const int n1 = ta1 - ta0, ntl = n1 + (tb1 - tb0);
  u32x4 st[NI];
  f32x16 pA0, pA1, pB0, pB1;
  bf16x8 kw[3];
  v4i16_t vwl[3], vwh[3];
  u32x4 pw[2][2];
  const LAS unsigned char* klb = lds + l31 * KS + hi * 16;
  const LAS unsigned char* vlb = lds + VOFF + (4 * hi + ((lane & 15) >> 2)) * VS + (16 * ((lane >> 4) & 1) + 4 * (lane & 3)) * 2;
#define ATT_TILE(i_) (((i_) < n1) ? ta0 + (i_) : tb0 + ((i_) - n1))
  unsigned gof[NI], lof[NI];
#pragma unroll
  for (int ii = 0; ii < NI; ++ii) { const int cw = (wv + 8 * ii) * 64, c = cw + lane;
    if (cw < KCH) { const int row = c / KCR, kc = c - row * KCR; gof[ii] = (unsigned)(row * ldk + kc * 8) * 2u; lof[ii] = (unsigned)(row * KS + kc * 16); }
    else { const int cc = c - KCH, row = cc / VCR, vc = cc - row * VCR; gof[ii] = (unsigned)(row * ldv + vc * 8) * 2u; lof[ii] = (unsigned)(VOFF + row * VS + vc * 16); } }
#define ATT_LOAD(T_) do { const int t__ = (T_); _Pragma("unroll") for (int ii = 0; ii < NI; ++ii) { const int cw = (wv + 8 * ii) * 64; if (cw < NCH) { \
      const char* gb__ = (cw < KCH) ? (const char*)Kb + (size_t)t__ * 128 * ldk : (const char*)Vb + (size_t)t__ * 128 * ldv; st[ii] = *(const u32x4*)(gb__ + gof[ii]); } } } while (0)
#define ATT_STORE(BO_) do { _Pragma("unroll") for (int ii = 0; ii < NI; ++ii) { const int cw = (wv + 8 * ii) * 64; if (cw < NCH) *(LAS u32x4*)(lds + (BO_) + lof[ii]) = st[ii]; } } while (0)
#define SB_() __builtin_amdgcn_sched_barrier(0)
#define KRD1(BO_, G_) do { kw[(G_) % 3] = *(const LAS bf16x8*)(klb + (BO_) + ((G_) & 1) * 32 * KS + ((G_) >> 1) * 32); } while (0)
#define VRDG(BO_, G_) do { const LAS unsigned char* vp = vlb + (BO_) + ((((G_) >> 2) & 1) * 32 + 16 * (((G_) >> 1) & 1)) * VS + ((G_) & 1) * 64; \
      vwl[(G_) % 3] = __builtin_amdgcn_ds_read_tr16_b64_v4i16((LAS v4i16_t*)vp); vwh[(G_) % 3] = __builtin_amdgcn_ds_read_tr16_b64_v4i16((LAS v4i16_t*)(vp + 8 * VS)); } while (0)
#define QKM(R0_, R1_, G_) do { const int ks_ = (G_) >> 1; \
      if (((G_) & 1) == 0) R0_ = __builtin_amdgcn_mfma_f32_32x32x16_bf16(kw[(G_) % 3], qf[ks_], (ks_ == 0) ? negmv : R0_, 0, 0, 0); \
      else R1_ = __builtin_amdgcn_mfma_f32_32x32x16_bf16(kw[(G_) % 3], qf[ks_], (ks_ == 0) ? negmv : R1_, 0, 0, 0); } while (0)
#define PVM(G_) do { const int d2_ = (G_) & 1, kb_ = ((G_) >> 2) & 1, s_ = ((G_) >> 1) & 1; \
      const v4i16_t lo_ = vwl[(G_) % 3], hi_ = vwh[(G_) % 3]; const bf16x8 vf = (bf16x8){lo_[0], lo_[1], lo_[2], lo_[3], hi_[0], hi_[1], hi_[2], hi_[3]}; \
      o[d2_] = __builtin_amdgcn_mfma_f32_32x32x16_bf16(vf, __builtin_bit_cast(bf16x8, pw[kb_][s_]), o[d2_], 0, 0, 0); } while (0)
#define PACK1(P_, KB_, C_) do { const int s_ = (C_) >> 2, e_ = (C_) & 3; pw[KB_][s_][e_] = pk2(P_[8 * s_ + 2 * e_], P_[8 * s_ + 2 * e_ + 1]); } while (0)
#define EXPR(P_, LO_, HI_) do { _Pragma("unroll") for (int x_ = (LO_); x_ < (HI_); ++x_) { float e_ = __builtin_amdgcn_exp2f(P_[x_]); asm volatile("" : "+v"(e_)); P_[x_] = e_; } } while (0)
#define SUMR(P_, LO_, HI_) do { _Pragma("unroll") for (int x_ = (LO_); x_ < (HI_); ++x_) lrun += P_[x_]; asm volatile("" : "+v"(lrun)); } while (0)
#define FILL_A(E0_, E1_, G_) do { \
      if ((G_) < EG) EXPR(E1_, ((G_) * 16) / EG, (((G_) + 1) * 16) / EG); \
      if ((G_) >= 1 && (G_) <= EG) SUMR(E1_, (((G_) - 1) * 16) / EG, ((G_) * 16) / EG); \
      if ((G_) < EG) { _Pragma("unroll") for (int c = ((G_) * 8) / EG; c < (((G_) + 1) * 8) / EG; ++c) PACK1(E0_, 0, c); } \
      else { _Pragma("unroll") for (int c = (((G_) - EG) * 8) / (NQK - EG); c < (((G_) - EG + 1) * 8) / (NQK - EG); ++c) PACK1(E1_, 1, c); } } while (0)
#define FILL_B(R0_, G_) do { EXPR(R0_, 2 * (G_), 2 * (G_) + 2); if ((G_) >= 1) SUMR(R0_, 2 * (G_) - 2, 2 * (G_)); if ((G_) == NPV - 1) SUMR(R0_, 14, 16); } while (0)
#define STEP_MID(R0_, R1_, E0_, E1_, BOC_, BOP_) do { \
      _Pragma("unroll") for (int g = 0; g < NQK; ++g) { \
        QKM(R0_, R1_, g); \
        if (g + 2 < NQK) KRD1(BOC_, g + 2); \
        if (g >= NQK - 2) VRDG(BOP_, g - (NQK - 2)); \
        FILL_A(E0_, E1_, g); \
        SB_(); } \
      _Pragma("unroll") for (int g = 0; g < NPV; ++g) { \
        PVM(g); \
        if (g + 2 < NPV) VRDG(BOP_, g + 2); \
        FILL_B(R0_, g); \
        SB_(); } } while (0)
#define STEP_HEAD(R0_, R1_, BOC_) do { \
      _Pragma("unroll") for (int g = 0; g < NQK; ++g) { QKM(R0_, R1_, g); if (g + 2 < NQK) KRD1(BOC_, g + 2); SB_(); } \
      _Pragma("unroll") for (int g = 0; g < NPV; ++g) { FILL_B(R0_, g); } SB_(); } while (0)
#define STEP_TAIL(E0_, E1_, BOP_) do { \
      VRDG(BOP_, 0); VRDG(BOP_, 1); \
      _Pragma("unroll") for (int g = 0; g < NQK; ++g) FILL_A(E0_, E1_, g); SB_(); \
      _Pragma("unroll") for (int g = 0; g < NPV; ++g) { PVM(g); if (g + 2 < NPV) VRDG(BOP_, g + 2); SB_(); } } while (0)
#define STEP_PRE(I_, KR_) do { const int i__ = (I_); \
      if (KR_) { KRD1(bo_cur, 0); KRD1(bo_cur, 1); } \
      if (i__ + 1 < ntl) ATT_STORE(bo_next); \
      if (i__ + 2 < ntl) ATT_LOAD(ATT_TILE(i__ + 2)); \
      SB_(); } while (0)
#define STEP_POST() do { bo_prev = bo_cur; bo_cur = bo_next; bo_next = (bo_next == 2 * STG) ? 0 : bo_next + STG; __syncthreads(); } while (0)
  ATT_LOAD(ATT_TILE(0));
  ATT_STORE(0);
  if (ntl > 1) ATT_LOAD(ATT_TILE(1));
  __syncthreads();
  int bo_prev = 0, bo_cur = 0, bo_next = STG;
  STEP_PRE(0, true); STEP_HEAD(pA0, pA1, bo_cur); STEP_POST();
  int it = 1;
  for (; it + 1 < ntl; it += 2) {
    STEP_PRE(it, true); STEP_MID(pB0, pB1, pA0, pA1, bo_cur, bo_prev); STEP_POST();
    STEP_PRE(it + 1, true); STEP_MID(pA0, pA1, pB0, pB1, bo_cur, bo_prev); STEP_POST();
  }
  if (it < ntl) {
    STEP_PRE(it, true); STEP_MID(pB0, pB1, pA0, pA1, bo_cur, bo_prev); STEP_POST();
    STEP_TAIL(pB0, pB1, bo_prev);
  } else {
    STEP_TAIL(pA0, pA1, bo_prev);
  }
  __syncthreads();
#undef ATT_TILE
#undef ATT_LOAD
#undef ATT_STORE
#undef SB_
#undef KRD1
#undef VRDG
#undef QKM
#undef PVM
#undef PACK1
#undef EXPR
#undef SUMR
#undef FILL_A
#undef FILL_B
#undef STEP_MID
#undef STEP_HEAD
#undef STEP_TAIL
#undef STEP_PRE
#undef STEP_POST
  float ltot = lrun + __shfl_xor(lrun, 32);
  if (has_sink) ltot += __builtin_amdgcn_exp2f(sink_l2 + negmb);
  const float is_ = OSC / ltot;
  unsigned char* op = Ob + (size_t)qrow * ldo + 4 * hi;
#pragma unroll
  for (int db = 0; db < 2; ++db)
#pragma unroll
    for (int r4 = 0; r4 < 4; ++r4)
      *(unsigned*)(op + db * 32 + 8 * r4) = pk4_fp8(o[db][4 * r4] * is_, o[db][4 * r4 + 1] * is_, o[db][4 * r4 + 2] * is_, o[db][4 * r4 + 3] * is_);
}

#define TOPK_INSERT(ARR, KEY) do { unsigned k__ = (KEY); _Pragma("unroll") for (int t_ = 0; t_ < 16; ++t_) { const unsigned h__ = max(ARR[t_], k__); k__ = min(ARR[t_], k__); ARR[t_] = h__; } } while (0)
__device__ __forceinline__ void peer_phase(LAS unsigned char* lds, const bf16_t* __restrict__ S, const unsigned char* __restrict__ H, const unsigned char* __restrict__ U, const unsigned char* __restrict__ V, float uinv, float vinv,
                                           const float* __restrict__ modl, bf16_t* xl, bf16_t* xc, float* outf, bool last, bool live, unsigned char* Hn, const float* __restrict__ gn, const float* __restrict__ modn, int wv) {
  const int tid_ = otid(wv); const int lane = tid_ & 63, wid = tid_ >> 6;
  LAS unsigned* keysL = (LAS unsigned*)(lds + wid * 9216);
  LAS u32x2* resL = (LAS u32x2*)(lds + wid * 9216 + 4096);
  LAS float* wL = (LAS float*)(lds + wid * 9216 + 8192);
  const int ngroups = last ? (NB * SEQ / 4) : (M / 4);
  const int nwav = gridDim.x * NWAVES, nfull = (ngroups / nwav) * nwav, nitems = nfull + (ngroups - nfull) * 4;
  for (int q = blockIdx.x * NWAVES + wid; q < nitems; q += nwav) {
    const int g = (q < nfull) ? q : nfull + ((q - nfull) >> 2);
    const int tk0 = (q < nfull) ? 0 : ((q - nfull) & 3), tk1 = (q < nfull) ? 4 : tk0 + 1;
    const int r0 = last ? (g / (SEQ / 4)) * TPB + (g % (SEQ / 4)) * 4 : g * 4;
    const int tok = lane >> 4, hc = lane & 15;
    unsigned top[16];
    const bf16_t* sp = S + (size_t)(r0 + tok) * 2048 + hc * 128;
#define CE_DESC(A_, B_) do { const unsigned h__ = max(A_, B_), l__ = min(A_, B_); A_ = h__; B_ = l__; } while (0)
#pragma unroll 1
    for (int j0 = 0; j0 < 128; j0 += 16) {
      unsigned blk[16];
      { const u32x4 v0 = *(const u32x4*)(sp + j0), v1 = *(const u32x4*)(sp + j0 + 8);
        const unsigned base = (unsigned)(127 - j0);
        blk[0] = (f2ord(bf_lo(v0.x)) & ~127u) | (base - 0u);  blk[1] = (f2ord(bf_hi(v0.x)) & ~127u) | (base - 1u);
        blk[2] = (f2ord(bf_lo(v0.y)) & ~127u) | (base - 2u);  blk[3] = (f2ord(bf_hi(v0.y)) & ~127u) | (base - 3u);
        blk[4] = (f2ord(bf_lo(v0.z)) & ~127u) | (base - 4u);  blk[5] = (f2ord(bf_hi(v0.z)) & ~127u) | (base - 5u);
        blk[6] = (f2ord(bf_lo(v0.w)) & ~127u) | (base - 6u);  blk[7] = (f2ord(bf_hi(v0.w)) & ~127u) | (base - 7u);
        blk[8] = (f2ord(bf_lo(v1.x)) & ~127u) | (base - 8u);  blk[9] = (f2ord(bf_hi(v1.x)) & ~127u) | (base - 9u);
        blk[10] = (f2ord(bf_lo(v1.y)) & ~127u) | (base - 10u); blk[11] = (f2ord(bf_hi(v1.y)) & ~127u) | (base - 11u);
        blk[12] = (f2ord(bf_lo(v1.z)) & ~127u) | (base - 12u); blk[13] = (f2ord(bf_hi(v1.z)) & ~127u) | (base - 13u);
        blk[14] = (f2ord(bf_lo(v1.w)) & ~127u) | (base - 14u); blk[15] = (f2ord(bf_hi(v1.w)) & ~127u) | (base - 15u); }
#pragma unroll
      for (int k = 2; k <= 16; k <<= 1)
#pragma unroll
        for (int j = k >> 1; j > 0; j >>= 1)
#pragma unroll
          for (int i = 0; i < 16; ++i) { const int l = i ^ j; if (l > i) { if ((i & k) == 0) CE_DESC(blk[i], blk[l]); else CE_DESC(blk[l], blk[i]); } }
      if (j0 == 0) {
#pragma unroll
        for (int i = 0; i < 16; ++i) top[i] = blk[i];
      } else {
#pragma unroll
        for (int i = 0; i < 16; ++i) top[i] = max(top[i], blk[15 - i]);
#pragma unroll
        for (int j = 8; j > 0; j >>= 1)
#pragma unroll
          for (int i = 0; i < 16; ++i) { const int l = i ^ j; if (l > i) CE_DESC(top[i], top[l]); }
      }
    }
#undef CE_DESC
#pragma unroll
    for (int i = 0; i < 16; ++i) keysL[lane * 16 + i] = top[i];
    float v0[16], v1[16];
#pragma unroll
    for (int i = 0; i < 16; ++i) { const unsigned t1 = __shfl_down(top[i], 1); v0[i] = ord2f(top[i] & ~127u); v1[i] = ord2f(t1 & ~127u); }
    unsigned cd[16];
#pragma unroll
    for (int i = 0; i < 16; ++i) cd[i] = 0u;
#pragma unroll
    for (int a = 0; a < 16; ++a)
#pragma unroll
      for (int b = 0; b < 16 / (a + 1); ++b) TOPK_INSERT(cd, (f2ord(v0[a] + v1[b]) & ~255u) | (unsigned)(255 - (a * 16 + b)));
    {
      float e[16]; float sum = 0.f; const float mx = ord2f(cd[0] & ~255u);
#pragma unroll
      for (int k = 0; k < 16; ++k) { e[k] = __expf(ord2f(cd[k] & ~255u) - mx); sum += e[k]; }
      const float inv = 1.f / sum;
      const int lp1 = (lane + 1) & 63;
#pragma unroll
      for (int k = 0; k < 16; ++k) {
        const int pos = 255 - (int)(cd[k] & 255u), a = pos >> 4, b = pos & 15;
        const unsigned i1 = 127u - (keysL[lane * 16 + a] & 127u), i2 = 127u - (keysL[lp1 * 16 + b] & 127u);
        if ((hc & 1) == 0) resL[tok * 128 + (hc >> 1) * 16 + k] = (u32x2){i1 * 128u + i2, __float_as_uint(e[k] * inv)};
      }
    }
    for (int tk = tk0; tk < tk1; ++tk) {
      const int r = r0 + tk;
      u32x2 ua[16], va[16], ub[16], vb[16];
      const unsigned lane8 = (unsigned)lane * 8u;
#define PEER_LOAD(UU, VV, BT) do { _Pragma("unroll") for (int i = 0; i < 16; ++i) { const unsigned o_ = resL[tk * 128 + (BT) * 16 + i].x * 512u + lane8;     \
        UU[i] = *(const u32x2*)(U + o_); VV[i] = *(const u32x2*)(V + o_); } } while (0)
      PEER_LOAD(ua, va, 0);
      float hf[16];
      { const bf16_t* hrow = (const bf16_t*)H + (size_t)r * D + lane * 16; const u32x4 ha = *(const u32x4*)hrow, hb = *(const u32x4*)(hrow + 8);
        hf[0] = bf_lo(ha.x); hf[1] = bf_hi(ha.x); hf[2] = bf_lo(ha.y); hf[3] = bf_hi(ha.y); hf[4] = bf_lo(ha.z); hf[5] = bf_hi(ha.z); hf[6] = bf_lo(ha.w); hf[7] = bf_hi(ha.w);
        hf[8] = bf_lo(hb.x); hf[9] = bf_hi(hb.x); hf[10] = bf_lo(hb.y); hf[11] = bf_hi(hb.y); hf[12] = bf_lo(hb.z); hf[13] = bf_hi(hb.z); hf[14] = bf_lo(hb.w); hf[15] = bf_hi(hb.w); }
      unsigned hq1a = 0u, hq1b = 0u, hq2a = 0u, hq2b = 0u; float hstep;
      { float ss = 0.f;
#pragma unroll
        for (int j = 0; j < 16; ++j) ss += hf[j] * hf[j];
        ss = wave_sum(ss);
        hstep = 0.5f * sqrtf(ss * (1.f / D) + 1e-20f); const float rs = 1.f / hstep;
#pragma unroll
        for (int j = 0; j < 16; ++j) {
          const float t = hf[j] * rs; int q1 = (int)rintf(t); q1 = min(7, max(-8, q1));
          int q2 = (int)rintf((t - (float)q1) * 16.f); q2 = min(7, max(-8, q2));
          if (j < 8) { hq1a |= ((unsigned)q1 & 15u) << (4 * j); hq2a |= ((unsigned)q2 & 15u) << (4 * j); }
          else { hq1b |= ((unsigned)q1 & 15u) << (4 * (j - 8)); hq2b |= ((unsigned)q2 & 15u) << (4 * (j - 8)); }
        } }
      const float uscale = uinv * hstep * (1.f / 16.f);
      f32x2_t o2[8];
#pragma unroll
      for (int j = 0; j < 8; ++j) o2[j] = (f32x2_t){0.f, 0.f};
      const bool b5 = (lane & 32) != 0, b4 = (lane & 16) != 0, b3 = (lane & 8) != 0, b2 = (lane & 4) != 0;
      const int ei = (lane >> 2) & 15;
#define PEER_PROC(UU, VV, BT) do { float d[16]; \
        _Pragma("unroll") for (int i = 0; i < 16; ++i) { const int w0 = (int)UU[i].x, w1 = (int)UU[i].y; \
          const int i1 = __builtin_amdgcn_sdot8(w1, (int)hq1b, __builtin_amdgcn_sdot8(w0, (int)hq1a, 0, false), false); \
          const int i2 = __builtin_amdgcn_sdot8(w1, (int)hq2b, __builtin_amdgcn_sdot8(w0, (int)hq2a, 0, false), false); \
          d[i] = (float)(i1 * 16 + i2); } \
        float k8[8], k4[4], k2[2], k1; \
        _Pragma("unroll") for (int i = 0; i < 8; ++i) { const auto r_ = __builtin_amdgcn_permlane32_swap(__float_as_uint(d[i]), __float_as_uint(d[8 + i]), false, false); k8[i] = __uint_as_float(r_[0]) + __uint_as_float(r_[1]); } \
        _Pragma("unroll") for (int i = 0; i < 4; ++i) { const auto r_ = __builtin_amdgcn_permlane16_swap(__float_as_uint(k8[i]), __float_as_uint(k8[4 + i]), false, false); k4[i] = __uint_as_float(r_[0]) + __uint_as_float(r_[1]); } \
        _Pragma("unroll") for (int i = 0; i < 2; ++i) { \
          const float sa = k4[i] + __int_as_float(__builtin_amdgcn_update_dpp(0, __float_as_int(k4[i]), 0x128, 0xf, 0xf, false)); \
          const float sb = k4[2 + i] + __int_as_float(__builtin_amdgcn_update_dpp(0, __float_as_int(k4[2 + i]), 0x128, 0xf, 0xf, false)); \
          k2[i] = b3 ? sb : sa; } \
        { const float keep = b2 ? k2[1] : k2[0], send = b2 ? k2[0] : k2[1]; k1 = keep + __shfl_xor(send, 4); } \
        k1 += __shfl_xor(k1, 2); k1 += __shfl_xor(k1, 1); \
        const float tot = k1 * uscale; \
        const float gate = __uint_as_float(resL[tk * 128 + (BT) * 16 + ei].y); \
        const float wact = 0.5f * tot * (1.f + erff(tot * 0.70710678118f)) * gate * vinv; \
        _Pragma("unroll") for (int i = 0; i < 16; ++i) { const float wi = __int_as_float(__builtin_amdgcn_readlane(__float_as_int(wact), 4 * i)); const f32x2_t w2 = {wi, wi}; const unsigned w0 = VV[i].x, w1 = VV[i].y; \
          o2[0] = __builtin_elementwise_fma(__builtin_amdgcn_cvt_scalef32_pk_f32_fp4(w0, 1.0f, 0), w2, o2[0]); o2[1] = __builtin_elementwise_fma(__builtin_amdgcn_cvt_scalef32_pk_f32_fp4(w0, 1.0f, 1), w2, o2[1]); \
          o2[2] = __builtin_elementwise_fma(__builtin_amdgcn_cvt_scalef32_pk_f32_fp4(w0, 1.0f, 2), w2, o2[2]); o2[3] = __builtin_elementwise_fma(__builtin_amdgcn_cvt_scalef32_pk_f32_fp4(w0, 1.0f, 3), w2, o2[3]); \
          o2[4] = __builtin_elementwise_fma(__builtin_amdgcn_cvt_scalef32_pk_f32_fp4(w1, 1.0f, 0), w2, o2[4]); o2[5] = __builtin_elementwise_fma(__builtin_amdgcn_cvt_scalef32_pk_f32_fp4(w1, 1.0f, 1), w2, o2[5]); \
          o2[6] = __builtin_elementwise_fma(__builtin_amdgcn_cvt_scalef32_pk_f32_fp4(w1, 1.0f, 2), w2, o2[6]); o2[7] = __builtin_elementwise_fma(__builtin_amdgcn_cvt_scalef32_pk_f32_fp4(w1, 1.0f, 3), w2, o2[7]); } } while (0)
      for (int bt = 0; bt < 8; bt += 2) {
        PEER_LOAD(ub, vb, bt + 1);
        PEER_PROC(ua, va, bt);
        if (bt + 2 < 8) PEER_LOAD(ua, va, bt + 2);
        PEER_PROC(ub, vb, bt + 1);
      }
#undef PEER_LOAD
#undef PEER_PROC
      if (live) {
        const int b = r / TPB, s = r - b * TPB; const int bi = (s >= SEQ) ? 8 : b;
        bf16_t* xp = xrow_ptr(xl, xc, r) + lane * 16; const float* gt = modl + (size_t)(bi * 6 + 5) * D + lane * 16;
        f32x4 xn[4]; float ss = 0.f;
        { const u32x4 xa = *(const u32x4*)xp, xb = *(const u32x4*)(xp + 8);
          xn[0] = (f32x4){bf_lo(xa.x), bf_hi(xa.x), bf_lo(xa.y), bf_hi(xa.y)}; xn[1] = (f32x4){bf_lo(xa.z), bf_hi(xa.z), bf_lo(xa.w), bf_hi(xa.w)};
          xn[2] = (f32x4){bf_lo(xb.x), bf_hi(xb.x), bf_lo(xb.y), bf_hi(xb.y)}; xn[3] = (f32x4){bf_lo(xb.z), bf_hi(xb.z), bf_lo(xb.w), bf_hi(xb.w)}; }
#pragma unroll
        for (int q = 0; q < 4; ++q) {
          const f32x4 gv = ((const f32x4*)gt)[q];
          xn[q] += gv * (f32x4){o2[2 * q].x, o2[2 * q].y, o2[2 * q + 1].x, o2[2 * q + 1].y};
          ss += xn[q].x * xn[q].x + xn[q].y * xn[q].y + xn[q].z * xn[q].z + xn[q].w * xn[q].w;
        }
        if (last) {
          float* op = outf + (size_t)(b * SEQ + s) * D + lane * 16;
#pragma unroll
          for (int q = 0; q < 4; ++q) ((f32x4*)op)[q] = xn[q];
        } else {
          *(u32x4*)xp = (u32x4){pk2(xn[0].x, xn[0].y), pk2(xn[0].z, xn[0].w), pk2(xn[1].x, xn[1].y), pk2(xn[1].z, xn[1].w)};
          *(u32x4*)(xp + 8) = (u32x4){pk2(xn[2].x, xn[2].y), pk2(xn[2].z, xn[2].w), pk2(xn[3].x, xn[3].y), pk2(xn[3].z, xn[3].w)};
        }
        if (Hn != nullptr) {
          ss = wave_sum(ss);
          const float rstd = rsqrtf(ss * (1.f / D) + EPS);
          const float* sh = modn + (size_t)(bi * 6) * D + lane * 16; const float* sc = sh + D; const float* gg = gn + lane * 16;
          u32x4 h0;
#pragma unroll
          for (int q = 0; q < 4; ++q) {
            const f32x4 g4 = ((const f32x4*)gg)[q], s4 = ((const f32x4*)sc)[q], h4 = ((const f32x4*)sh)[q];
            const f32x4 y = (xn[q] * rstd * g4 * (1.f + s4) + h4) * ASC;
            h0[q] = pk4_fp8(y.x, y.y, y.z, y.w);
          }
          *(u32x4*)(Hn + (size_t)r * D + lane * 16) = h0;
        }
      }
    }
  }
}

#define XB_TMO      128
#define XB_XCNT(j)  (256  + 64 * (j))
#define XB_XSUB(j)  (1280 + 64 * (j))
#define XB_XGEN(j)  (2304 + 64 * (j))
#define XB_TOP      3328
#define XB_TOPGEN   3392
#define XCD_BAR_WORDS 3456
#define XB_SPIN_CAP (1u << 20)
__device__ __forceinline__ unsigned xb_ld(unsigned* p)              { return __hip_atomic_load(p, __ATOMIC_RELAXED, __HIP_MEMORY_SCOPE_AGENT); }
__device__ __forceinline__ unsigned xb_add(unsigned* p, unsigned v) { return __hip_atomic_fetch_add(p, v, __ATOMIC_RELAXED, __HIP_MEMORY_SCOPE_AGENT); }
__device__ __forceinline__ unsigned xb_xcc_id() { return (unsigned)__builtin_amdgcn_s_getreg((3 << 11) | 20) & 0xFu; }
#define XB_SPIN(cond, bar) do { unsigned _sp = 0; while (cond) { __builtin_amdgcn_s_sleep(1); \
    if ((++_sp & 255u) == 0u) { if (xb_ld(&(bar)[XB_TMO])) break; if (_sp > XB_SPIN_CAP) { atomicAdd(&(bar)[XB_TMO], 1u); break; } } } } while (0)
struct XcdBarrier { unsigned* bar; unsigned x; volatile LAS unsigned* st; };
__device__ __forceinline__ XcdBarrier xcd_barrier_post(unsigned* bar, volatile LAS unsigned* st) {
    XcdBarrier b; b.bar = bar; b.x = xb_xcc_id(); b.st = st;
    if (threadIdx.x == 0) (void)xb_add(&bar[XB_XCNT(b.x)], 1u);
    return b;
}
__device__ __forceinline__ void xcd_barrier_complete(unsigned* bar, unsigned x, unsigned& nloc, unsigned& nx) {
    const unsigned G = gridDim.x * gridDim.y * gridDim.z;
    unsigned sum, cnt, mine, sp = 0u;
    for (;;) {
        sum = 0u; cnt = 0u; mine = 0u;
#pragma unroll
        for (unsigned j = 0; j < 16; ++j) { const unsigned c = xb_ld(&bar[XB_XCNT(j)]); sum += c; cnt += (c > 0u) ? 1u : 0u; mine = (j == x) ? c : mine; }
        if (sum == G) break;
        __builtin_amdgcn_s_sleep(1);
        if ((++sp & 255u) == 0u) { if (xb_ld(&bar[XB_TMO])) break; if (sp > XB_SPIN_CAP) { atomicAdd(&bar[XB_TMO], 1u); break; } }
    }
    nloc = mine > 0u ? mine : 1u; nx = cnt > 0u ? cnt : 1u;
}
__device__ __forceinline__ void xcd_barrier(const XcdBarrier& b, int wv) {
    asm volatile("s_waitcnt vmcnt(0)" ::: "memory");
    __syncthreads();
    if (otid(wv) == 0) {
        unsigned* bar = b.bar;
        __builtin_amdgcn_s_waitcnt(0);
        unsigned nloc = b.st[0], nx = b.st[1];
        if (nloc == 0u) { xcd_barrier_complete(bar, b.x, nloc, nx); b.st[0] = nloc; b.st[1] = nx; }
        const unsigned old = xb_add(&bar[XB_XSUB(b.x)], 1u);
        const unsigned gen = old / nloc;
        if (old + 1u == (gen + 1u) * nloc) {
            __builtin_amdgcn_fence(__ATOMIC_RELEASE, "agent");
            asm volatile("s_waitcnt vmcnt(0)" ::: "memory");
            const unsigned og = xb_add(&bar[XB_TOP], 1u);
            const unsigned tg = og / nx;
            if (og + 1u == (tg + 1u) * nx) xb_add(&bar[XB_TOPGEN], 1u);
            else XB_SPIN(xb_ld(&bar[XB_TOPGEN]) == tg, bar);
            __builtin_amdgcn_fence(__ATOMIC_ACQUIRE, "agent");
            xb_add(&bar[XB_XGEN(b.x)], 1u);
            asm volatile("s_waitcnt vmcnt(0)" ::: "memory");
        } else {
            XB_SPIN(xb_ld(&bar[XB_XGEN(b.x)]) == gen, bar);
            __builtin_amdgcn_fence(__ATOMIC_ACQUIRE, "agent");
            asm volatile("s_waitcnt vmcnt(0)" ::: "memory");
        }
    }
    __syncthreads();
}

enum { ST_NORM = 0, ST_GEMM_BF16, ST_GEMM_F32, ST_GEMM_RESID, ST_LATNORM, ST_HN_MLA, ST_HN_DS, ST_ATTN_MLA, ST_ATTN_D, ST_ATTN_S, ST_PEER };
#define SV(t, v) ((t) | ((v) << 4))
#define SR(t, v) ((t) | ((v) << 4) | 0x80)
__device__ const unsigned char STEPS[3][24] = {
  {SV(ST_NORM, 0), SV(ST_GEMM_BF16, 0), SV(ST_LATNORM, 0), SV(ST_GEMM_BF16, 1), SV(ST_GEMM_BF16, 2), SV(ST_HN_MLA, 0), SV(ST_ATTN_MLA, 0), SV(ST_GEMM_RESID, 0), SV(ST_NORM, 1), SV(ST_GEMM_F32, 0), SV(ST_PEER, 0), 0xFF},
  {SV(ST_NORM, 0), SV(ST_GEMM_BF16, 0), SV(ST_HN_DS, 0), SV(ST_ATTN_D, 0), SV(ST_GEMM_RESID, 0), SV(ST_NORM, 1), SV(ST_GEMM_F32, 0), SV(ST_PEER, 0), 0xFF},
  {SV(ST_NORM, 0), SV(ST_GEMM_BF16, 0), SV(ST_HN_DS, 0), SV(ST_ATTN_S, 0), SV(ST_GEMM_RESID, 0), SV(ST_NORM, 1), SV(ST_GEMM_F32, 0), SV(ST_PEER, 0), 0xFF}};
__global__ void __launch_bounds__(NTHREADS, 2) mega(Params p) {
  extern __shared__ __attribute__((aligned(16))) unsigned char lds_raw[];
  LAS unsigned char* lds = (LAS unsigned char*)lds_raw;
  cg::grid_group grid = cg::this_grid();
  const int tid = threadIdx.x;
  const int wv_s = __builtin_amdgcn_readfirstlane(tid >> 6);
  unsigned char* ws = p.ws;
  float* modp = (float*)(ws + WS_MODP); float* mod = (float*)(ws + WS_MOD);
  float* tab8 = (float*)(ws + WS_TAB); float* tab16 = tab8 + 64 * 8 * 2; float* lamp = tab16 + 64 * 16 * 2;
  bf16_t* xl = (bf16_t*)(ws + WS_XL); bf16_t* xc = (bf16_t*)(ws + WS_XC);
  bf16_t* wdown_t = (bf16_t*)(ws + WS_WDOWN); bf16_t* wuq_t = (bf16_t*)(ws + WS_WUQ); bf16_t* wukv_t = (bf16_t*)(ws + WS_WUKV); bf16_t* mwo_t = (bf16_t*)(ws + WS_MWO);
  bf16_t* dqkv_t = (bf16_t*)(ws + WS_DQKV); bf16_t* dwo_t = (bf16_t*)(ws + WS_DWO); bf16_t* sqkv_t = (bf16_t*)(ws + WS_SQKV); bf16_t* swo_t = (bf16_t*)(ws + WS_SWO);
  bf16_t* pwq = (bf16_t*)(ws + WS_PWQ); bf16_t* pkeys = (bf16_t*)(ws + WS_PKEYS); bf16_t* weff_t = (bf16_t*)(ws + WS_WEFF);
  unsigned char* pu = ws + WS_PU; unsigned char* pv = ws + WS_PV;
  bf16_t* Hb = (bf16_t*)(ws + WS_H); bf16_t* Ob = (bf16_t*)(ws + WS_O);
  bf16_t* B1 = (bf16_t*)(ws + WS_BUF1); bf16_t* B2 = (bf16_t*)(ws + WS_BUF2); bf16_t* B3 = (bf16_t*)(ws + WS_BUF3); bf16_t* B4 = (bf16_t*)(ws + WS_BUF4);
  bf16_t* CQN = (bf16_t*)(ws + WS_CQN); bf16_t* CKVN = (bf16_t*)(ws + WS_CKVN); float* SC = (float*)(ws + WS_SC);

  volatile LAS unsigned* xb_st = (volatile LAS unsigned*)(lds + LDS_BYTES - 16);
  if (tid < 4) xb_st[tid] = 0u;
  __syncthreads();
  (void)xcd_barrier_post((unsigned*)ws, xb_st);
  int phc = 0;
#define PH_BEGIN {
#define PH_END } ++phc; if (phc == 1) grid.sync(); else { XcdBarrier xb_; xb_.bar = (unsigned*)p.ws; xb_.x = xb_xcc_id(); xb_.st = (volatile LAS unsigned*)(lds + LDS_BYTES - 16); xcd_barrier(xb_, wv_s); }

  PH_BEGIN
    int rot = 0;
    for (int j = 0; j < 2; ++j) {
      tr_job<true>(lds, p.mla_w_down + (size_t)j * 1024 * 1056, (unsigned char*)wdown_t + (size_t)j * 1280 * 1024, 1024, 1056, 1280, rot);
      tr_job<true>(lds, p.mla_w_uq + (size_t)j * 768 * 1536, (unsigned char*)wuq_t + (size_t)j * 1536 * 768, 768, 1536, 1536, rot);
      tr_job<false>(lds, p.mla_w_ukv + (size_t)j * 256 * 2048, wukv_t + (size_t)j * 2048 * 256, 256, 2048, 2048, rot);
      tr_job<true>(lds, p.mla_w_o + (size_t)j * 1024 * 1024, (unsigned char*)mwo_t + (size_t)j * 1024 * 1024, 1024, 1024, 1024, rot);
    }
    tr_job<true>(lds, p.diff_w_qkv, dqkv_t, 1024, 3072, 3072, rot);
    tr_job<true>(lds, p.diff_w_o, dwo_t, 1024, 1024, 1024, rot);
    tr_job<true>(lds, p.swa_w_qkv, sqkv_t, 1024, 1536, 1536, rot);
    tr_job<true>(lds, p.swa_w_o, swo_t, 1024, 1024, 1024, rot);
    ada_job(lds, p, modp);
    cvt_job(p.peer_w_q, pwq, (size_t)4 * 1024 * 2048 / 8);
    cvt_job(p.peer_keys, pkeys, (size_t)4 * 16 * 128 * 128 / 8);
    {
      const int wv = tid >> 6, ln = tid & 63, l = wv >> 1; const float* t = ((wv & 1) ? p.peer_v : p.peer_u) + (size_t)l * 16384 * 1024;
      float ss = 0.f;
#pragma unroll
      for (int q = 0; q < 8; ++q) { const f32x4 v = ((const f32x4*)t)[ln + 64 * q]; ss += v.x * v.x + v.y * v.y + v.z * v.z + v.w * v.w; }
      ss = wave_sum(ss);
      const float rms = sqrtf(ss * (1.f / 2048.f));
      if (blockIdx.x == 0 && ln == 0) lamp[4 + wv] = (wv & 1) ? rms * 0.5f : rms * 0.34f;
    }
    if (blockIdx.x == 0 && tid == 0) {
      const float** t = (const float**)(ws + WS_PTRS);
      t[0] = p.x; t[1] = p.c; t[2] = p.ctx; t[3] = p.c_ctx; t[4] = p.ada_w; t[5] = p.ada_b; t[6] = p.norm_mix; t[7] = p.norm_ffn;
      t[8] = p.mla_w_down; t[9] = p.mla_g_cq; t[10] = p.mla_g_ckv; t[11] = p.mla_w_uq; t[12] = p.mla_w_ukv; t[13] = p.mla_g_q; t[14] = p.mla_g_k; t[15] = p.mla_w_o;
      t[16] = p.diff_w_qkv; t[17] = p.diff_g_q; t[18] = p.diff_g_k; t[19] = p.diff_lambda; t[20] = p.diff_g_sub; t[21] = p.diff_w_o;
      t[22] = p.swa_w_qkv; t[23] = p.swa_g_q; t[24] = p.swa_g_k; t[25] = p.swa_sink; t[26] = p.swa_w_o; t[27] = p.peer_w_q; t[28] = p.peer_keys; t[29] = p.peer_u; t[30] = p.peer_v;
    }
    if (blockIdx.x == gridDim.x - 1) {
      for (int i = tid; i < 64 * 8; i += NTHREADS) { const int pos = i >> 3, j = i & 7; const float ang = (float)pos * powf(10000.f, -(float)j / 8.f); tab8[2 * i] = cosf(ang); tab8[2 * i + 1] = sinf(ang); }
      for (int i = tid; i < 64 * 16; i += NTHREADS) { const int pos = i >> 4, j = i & 15; const float ang = (float)pos * powf(10000.f, -(float)j / 16.f); tab16[2 * i] = cosf(ang); tab16[2 * i + 1] = sinf(ang); }
      if (tid >= 64 && tid < 68) {
        const int q = tid - 64; const float* g = (q < 2) ? p.mla_g_k + q * 96 : (q == 2) ? p.diff_g_k : p.swa_g_k; const int n = (q < 2) ? 96 : 64;
        float mx = 0.f; for (int i = 0; i < n; ++i) mx = fmaxf(mx, fabsf(g[i]));
        lamp[12 + q] = sqrtf((float)n) * mx * 1.002f;
      }
      if (tid == 0) { float s01 = 0.f, s23 = 0.f; for (int i = 0; i < 64; ++i) { s01 += p.diff_lambda[i] * p.diff_lambda[64 + i]; s23 += p.diff_lambda[128 + i] * p.diff_lambda[192 + i]; }
        lamp[0] = expf(s01) - expf(s23) + LAM_INIT; }
    }
  PH_END
  PH_BEGIN
    for (int i = blockIdx.x * NTHREADS + tid; i < 4 * 9 * 6144; i += gridDim.x * NTHREADS) {
      const int col = i % 6144, l = i / (9 * 6144); float a = p.ada_b[l * 6144 + col];
#pragma unroll
      for (int kc = 0; kc < 64; ++kc) a += modp[(size_t)kc * (4 * 9 * 6144) + i];
      mod[i] = a;
    }
    for (int U = blockIdx.x; U < 256; U += gridDim.x) {
      const int q = U >> 2, l = q >> 4, hc = q & 15;
      gemm_phase(lds, pwq + (size_t)l * 1024 * 2048 + hc * 128, 2048, pkeys + (size_t)q * 128 * 128, 128, 1024, 128, 128, false,
                 EpiBf16T{weff_t + (size_t)l * 2048 * 1024 + (size_t)hc * 128 * 1024, 1024}, U & 3, 4);
    }
  PH_END

  for (int l = 0; l < 4; ++l) {
    int kind = l % 3; asm volatile("" : "+s"(kind));
    const bool last = (l == 3);
    for (int ss = 0; STEPS[kind][ss] != 0xFF; ++ss) {
      unsigned long long w_ = (unsigned long long)p.ws; asm volatile("" : "+s"(w_));
      unsigned char* w = (unsigned char*)(GAS unsigned char*)w_;
      const unsigned long long* tab = (const unsigned long long*)(w + WS_PTRS);
#define IN_(i) ((const float*)(GAS const float*)tab[i])
      bf16_t* xl = (bf16_t*)(w + WS_XL); bf16_t* xc = (bf16_t*)(w + WS_XC);
      const float* modl = (const float*)(w + WS_MOD) + (size_t)l * 9 * 6144;
      const float* tab8 = (const float*)(w + WS_TAB); const float* tab16 = tab8 + 64 * 8 * 2; const float* lamp = tab16 + 64 * 16 * 2;
      unsigned char* Hb = w + WS_H; unsigned char* Ob = w + WS_O; float* SC = (float*)(w + WS_SC);
      unsigned char* H8 = w + WS_O + 18 * MiB;
      bf16_t* LAT = (bf16_t*)(w + WS_BUF1); bf16_t* QP = (bf16_t*)(w + WS_BUF2); bf16_t* KV = (bf16_t*)(w + WS_BUF3); bf16_t* KB = (bf16_t*)(w + WS_BUF4); bf16_t* QKV = LAT;
      unsigned char* CQN = w + WS_CQN; bf16_t* CKVN = (bf16_t*)(w + WS_CKVN);
      bf16_t* QN = (bf16_t*)(w + WS_SC);
      const int ent = STEPS[kind][ss]; const int ty = ent & 15, var = (ent >> 4) & 7; const bool live = (ent & 0x80) == 0 || (p.phase == 777);
      int lo_ = l; asm volatile("" : "+s"(lo_)); const int j = (lo_ >= 3) ? 1 : 0;
      bool sync = true;
      if (ty == ST_NORM) {
        const bool first = (var == 0);
        if (first && l > 0) sync = false;
        else norm_phase(IN_(0), IN_(2), xl, xc, first && l == 0, (first ? IN_(6) : IN_(7)) + l * D, modl, first ? 0 : 3, first ? H8 : Hb, first, last && !first, wv_s);
      } else if (ty == ST_GEMM_BF16) {
        const void* A = H8; const void* Bt; bf16_t* O; int N, K = 1024;
        if (kind == 0) {
          if (var == 0) { Bt = w + WS_WDOWN + (size_t)j * 1280 * 1024; N = 1280; O = LAT; }
          else if (var == 1) { A = CQN; Bt = w + WS_WUQ + (size_t)j * 1536 * 768; N = 1536; K = 768; O = QP; sync = false; }
          else { A = CKVN; Bt = (const bf16_t*)(w + WS_WUKV) + (size_t)j * 2048 * 256; N = 2048; K = 256; O = KV; }
        } else if (kind == 1) { Bt = w + WS_DQKV; N = 3072; O = QKV; }
        else { Bt = w + WS_SQKV; N = 1536; O = QKV; }
        pg8::LatentOrder S; S.init(M, N, gridDim.x, blockIdx.x, last && kind == 0 && var == 1);
        if (kind == 0 && var == 2) pg8::gemm_phase<pg8::EpiBf16P, pg8::LatentOrder, true, true, false>(lds, pg8::Gemm{(const bf16_t*)A, (const bf16_t*)Bt, M, N, K}, S, pg8::EpiBf16P{O, N, 1.f}, wv_s);
        else pg8::gemm_phase<pg8::EpiBf16P, pg8::LatentOrder, true, true, true>(lds, pg8::Gemm{(const bf16_t*)A, (const bf16_t*)Bt, M, N, K / 2}, S, pg8::EpiBf16P{O, N, 1.f / (ASC * WSC)}, wv_s);

        {
          const int nwg_ = (false ? (M / 9) * 8 / 256 : M / 256) * (N / 256), rem_ = nwg_ % (int)gridDim.x;
          if ((rem_ == 0 || (int)blockIdx.x >= rem_) && ((var == 0) ? 0 : -1) >= 0) {
            const int E_ = (rem_ == 0) ? (int)gridDim.x : (int)gridDim.x - rem_, e_ = (rem_ == 0) ? (int)blockIdx.x : (int)blockIdx.x - rem_;
            const int s0_ = (((var == 0) ? 0 : -1) == 0) ? 0 : (((var == 0) ? 0 : -1) == 1) ? 9600 : 21000, s1_ = (((var == 0) ? 0 : -1) == 0) ? 9600 : (((var == 0) ? 0 : -1) == 1) ? 21000 : 32768;
            const int per_ = (s1_ - s0_ + E_ - 1) / E_, a_ = s0_ + e_ * per_, b_ = min(s1_, a_ + per_);
            const float su_ = 1.f / lamp[4 + 2 * l], sv_ = 1.f / lamp[5 + 2 * l];
            conv_rows(IN_(29) + (size_t)l * 16384 * 1024, IN_(30) + (size_t)l * 16384 * 1024, w + WS_PU + (size_t)l * 16384 * 512, w + WS_PV + (size_t)l * 16384 * 512, su_, sv_, a_, b_, otid(wv_s));
          }
        }
      } else if (ty == ST_GEMM_RESID) {
        const unsigned char* Bt = (kind == 0) ? w + WS_MWO + (size_t)j * 1024 * 1024 : (kind == 1) ? w + WS_DWO : w + WS_SWO;
        pg8::LatentOrder S; S.init(M, 1024, gridDim.x, blockIdx.x, last);
        pg8::gemm_phase<pg8::EpiResidN, pg8::LatentOrder, true, true, true>(lds, pg8::Gemm{(const bf16_t*)Ob, (const bf16_t*)Bt, M, 1024, 512}, S, pg8::EpiResidN{IN_(0), IN_(2), l == 0, xl, xc, modl, 2, live, 1.f / (OSC * WSC)}, wv_s);

        {
          const int nwg_ = (last ? (M / 9) * 8 / 256 : M / 256) * (1024 / 256), rem_ = nwg_ % (int)gridDim.x;
          if ((rem_ == 0 || (int)blockIdx.x >= rem_) && 1 >= 0) {
            const int E_ = (rem_ == 0) ? (int)gridDim.x : (int)gridDim.x - rem_, e_ = (rem_ == 0) ? (int)blockIdx.x : (int)blockIdx.x - rem_;
            const int s0_ = (1 == 0) ? 0 : (1 == 1) ? 9600 : 21000, s1_ = (1 == 0) ? 9600 : (1 == 1) ? 21000 : 32768;
            const int per_ = (s1_ - s0_ + E_ - 1) / E_, a_ = s0_ + e_ * per_, b_ = min(s1_, a_ + per_);
            const float su_ = 1.f / lamp[4 + 2 * l], sv_ = 1.f / lamp[5 + 2 * l];
            conv_rows(IN_(29) + (size_t)l * 16384 * 1024, IN_(30) + (size_t)l * 16384 * 1024, w + WS_PU + (size_t)l * 16384 * 512, w + WS_PV + (size_t)l * 16384 * 512, su_, sv_, a_, b_, otid(wv_s));
          }
        }
      } else if (ty == ST_GEMM_F32) {
        pg8::LatentOrder S; S.init(M, 2048, gridDim.x, blockIdx.x, last);
        pg8::gemm_phase<pg8::EpiBf16P, pg8::LatentOrder, true, true, false>(lds, pg8::Gemm{(const bf16_t*)Hb, (const bf16_t*)(w + WS_WEFF) + (size_t)l * 2048 * 1024, M, 2048, 1024}, S, pg8::EpiBf16P{(bf16_t*)SC, 2048, 1.f}, wv_s);

        {
          const int nwg_ = (last ? (M / 9) * 8 / 256 : M / 256) * (2048 / 256), rem_ = nwg_ % (int)gridDim.x;
          if ((rem_ == 0 || (int)blockIdx.x >= rem_) && 2 >= 0) {
            const int E_ = (rem_ == 0) ? (int)gridDim.x : (int)gridDim.x - rem_, e_ = (rem_ == 0) ? (int)blockIdx.x : (int)blockIdx.x - rem_;
            const int s0_ = (2 == 0) ? 0 : (2 == 1) ? 9600 : 21000, s1_ = (2 == 0) ? 9600 : (2 == 1) ? 21000 : 32768;
            const int per_ = (s1_ - s0_ + E_ - 1) / E_, a_ = s0_ + e_ * per_, b_ = min(s1_, a_ + per_);
            const float su_ = 1.f / lamp[4 + 2 * l], sv_ = 1.f / lamp[5 + 2 * l];
            conv_rows(IN_(29) + (size_t)l * 16384 * 1024, IN_(30) + (size_t)l * 16384 * 1024, w + WS_PU + (size_t)l * 16384 * 512, w + WS_PV + (size_t)l * 16384 * 512, su_, sv_, a_, b_, otid(wv_s));
          }
        }
      } else if (ty == ST_LATNORM) {
        latnorm_phase(LAT, IN_(9) + j * 768, IN_(10) + j * 256, CQN, CKVN, wv_s);
      } else if (ty == ST_HN_MLA) {
        const float qs = 0.10206207261596577f * LOG2E;
        for (int gi = blockIdx.x * NTHREADS + otid(wv_s); gi < M * 32 * 4; gi += gridDim.x * NTHREADS) {
          const int i = gi >> 2, jl = gi & 3, r = i >> 5, it = i & 31, h = it & 15; const int b = r / TPB, s = r - b * TPB; const bool lat = s < SEQ;
          if (it < 16) { const bf16_t* q = QP + (size_t)r * 1536 + h * 96; headnorm96(q, q + 64, QN + (size_t)r * 1536 + h * 96, IN_(13) + j * 96, qs, lat, s >> 6, s & 63, tab8, jl); }
          else headnorm96(KV + (size_t)r * 2048 + h * 128, LAT + (size_t)r * 1280 + 1024, KB + (size_t)r * 1536 + h * 96, IN_(14) + j * 96, 1.f, lat, s >> 6, s & 63, tab8, jl);
        }
      } else if (ty == ST_HN_DS) {
        const float qs = 0.125f * LOG2E;
        const int ipr = (kind == 1) ? 32 : 20, pitch = (kind == 1) ? 3072 : 1536, npitch = (kind == 1) ? 2048 : 1280;
        const float* gq = (kind == 1) ? IN_(17) : IN_(23); const float* gk = (kind == 1) ? IN_(18) : IN_(24);
        for (int gi = blockIdx.x * NTHREADS + otid(wv_s); gi < M * ipr * 4; gi += gridDim.x * NTHREADS) {
          const int i = gi >> 2, jl = gi & 3; int r, it; if (kind == 1) { r = i >> 5; it = i & 31; } else { r = i / 20; it = i - r * 20; }
          const int b = r / TPB, s = r - b * TPB; const bool lat = s < SEQ;
          const bf16_t* q = QKV + (size_t)r * pitch + it * 64;
          headnorm64(q, QN + (size_t)r * npitch + it * 64, (it < 16) ? gq : gk, (it < 16) ? qs : 1.f, lat, s >> 6, s & 63, tab16, jl);
        }
      } else if (ty == ST_ATTN_MLA) {
        const int nu = last ? 1024 : 1152;
        for (int u = blockIdx.x; u < nu; u += gridDim.x) {
          int bh, q0, ta0; if (u < 1024) { const int x = u & 7, y = u >> 3; bh = ((y >> 3) << 3) + x; q0 = (y & 7) * 256; ta0 = 0; } else { bh = u - 1024; q0 = SEQ; ta0 = 32; }
          const int b = bh >> 4, h = bh & 15; const size_t rb = (size_t)b * TPB;
          attn_unit_p<96, 64, false>(lds, QN + rb * 1536 + h * 96, 1536, KB + rb * 1536 + h * 96, 1536, KV + rb * 2048 + h * 128 + 64, 2048,
                                     q0, ta0, 36, 0, 0, false, 0.f, lamp[12 + j], Ob + rb * D + h * 64, D, wv_s);
        }
      } else if (ty == ST_ATTN_D) {
        const float lam = lamp[0];
        for (int u = blockIdx.x; u < 1152; u += gridDim.x) {
          int bh, q0, ta0; if (u < 1024) { const int x = u & 7, y = u >> 3; bh = ((y >> 4) << 3) + x; q0 = (y & 15) * 128; ta0 = 0; } else { bh = (u - 1024) >> 1; q0 = SEQ + ((u - 1024) & 1) * 128; ta0 = 32; }
          const int b = bh >> 3, h = bh & 7; const size_t rb = (size_t)b * TPB;
          attn_unit<64, 128, 2, false>(lds, QN + rb * 2048 + h * 128, 64, 2048, QN + rb * 2048 + 1024 + h * 128, 64, 2048, QKV + rb * 3072 + 2048 + h * 128, 3072,
                                       q0, ta0, 36, 0, 0, false, 0.f, lamp[14], Ob + rb * D + h * 128, D, lam, IN_(20), wv_s);
        }
      } else if (ty == ST_ATTN_S) {
        for (int u = blockIdx.x; u < 1152; u += gridDim.x) {
          int bh, q0, ta0, ta1; if (u < 1024) { const int x = u & 7, y = u >> 3; bh = ((y >> 3) << 3) + x; q0 = (y & 7) * 256; ta0 = max(0, q0 / 64 - 2); ta1 = min(32, q0 / 64 + 6); } else { bh = u - 1024; q0 = SEQ; ta0 = 0; ta1 = 0; }
          const int b = bh >> 4, h = bh & 15, kvh = h >> 2; const size_t rb = (size_t)b * TPB;
          attn_unit<64, 64, 1, true>(lds, QN + rb * 1280 + h * 64, 0, 1280, QN + rb * 1280 + 1024 + kvh * 64, 0, 1280, QKV + rb * 1536 + 1280 + kvh * 64, 1536,
                                     q0, ta0, ta1, 32, 36, true, IN_(25)[h] * LOG2E, lamp[15], Ob + rb * D + h * 64, D, 0.f, nullptr, wv_s);
        }
      } else {
        peer_phase(lds, (const bf16_t*)SC, Hb, w + WS_PU + (size_t)l * 16384 * 512, w + WS_PV + (size_t)l * 16384 * 512, lamp[4 + 2 * l], lamp[5 + 2 * l], modl, xl, xc, p.out, last, live, last ? nullptr : H8, IN_(6) + (l + 1) * D, modl + 9 * 6144, wv_s);
      }
#undef IN_
      if (sync) { XcdBarrier xb_; xb_.bar = (unsigned*)p.ws; xb_.x = xb_xcc_id(); xb_.st = (volatile LAS unsigned*)(lds + LDS_BYTES - 16); xcd_barrier(xb_, wv_s); }
    }
  }
#undef PH_BEGIN
#undef PH_END
}

extern "C" void kernel_launch(void* const* d_in, const int* in_sizes, int n_in, void* d_out, int out_size, void* d_ws, size_t ws_size, hipStream_t stream) {
  static int grid_blocks = 0;
  if (grid_blocks == 0) {
    int dev = 0, cus = 0, per_cu = 0;
    if (n_in != 31 || out_size != NB * SEQ * D || ws_size < WS_TOTAL) { fprintf(stderr, "kernel_launch: unexpected shapes (n_in %d out %d ws %zu)\n", n_in, out_size, ws_size); grid_blocks = -1; return; }
    (void)hipGetDevice(&dev);
    (void)hipDeviceGetAttribute(&cus, hipDeviceAttributeMultiprocessorCount, dev);
    (void)hipFuncSetAttribute((const void*)mega, hipFuncAttributeMaxDynamicSharedMemorySize, LDS_BYTES);
    (void)hipOccupancyMaxActiveBlocksPerMultiprocessor(&per_cu, (const void*)mega, NTHREADS, LDS_BYTES);
    if (per_cu < 1) { fprintf(stderr, "kernel_launch: occupancy query says %d blocks/CU\n", per_cu); per_cu = 1; }
    grid_blocks = cus;
  }
  if (grid_blocks < 0) return;
  (void)hipMemsetAsync(d_ws, 0, 16384, stream);
  Params p{};
  const float** f = (const float**)&p;
  for (int i = 0; i < 31; ++i) f[i] = (const float*)d_in[i];
  p.out = (float*)d_out; p.ws = (unsigned char*)d_ws;
  p.single = 1; p.phase = 0;
  void* args[] = {&p};
  hipError_t e = hipLaunchCooperativeKernel((const void*)mega, dim3(grid_blocks), dim3(NTHREADS), args, LDS_BYTES, stream);
  if (e != hipSuccess) fprintf(stderr, "cooperative launch failed: %s (grid %d)\n", hipGetErrorString(e), grid_blocks);
}
```

```cpp
#include <hip/hip_runtime.h>
#include <hip/hip_cooperative_groups.h>
#include <cstdio>
#include <cstdint>
namespace cg = cooperative_groups;

#define LAS __attribute__((address_space(3)))
#define GAS __attribute__((address_space(1)))
typedef unsigned short bf16_t;
typedef short bf16x8 __attribute__((ext_vector_type(8)));
typedef short v4i16_t __attribute__((ext_vector_type(4)));
typedef float f32x4 __attribute__((ext_vector_type(4)));
typedef float f32x16 __attribute__((ext_vector_type(16)));
typedef unsigned u32x4 __attribute__((ext_vector_type(4)));
typedef unsigned u32x2 __attribute__((ext_vector_type(2)));
typedef long long2_t __attribute__((ext_vector_type(2)));
typedef float f32x2_t __attribute__((ext_vector_type(2)));
typedef __bf16 bf16x2_t __attribute__((ext_vector_type(2)));

constexpr int D = 1024, NB = 8, SEQ = 2048, NCTX = 256, TPB = SEQ + NCTX  , M = NB * TPB  ;
constexpr int NTHREADS = 512, NWAVES = 8;
constexpr float EPS = 1e-6f;
constexpr float LOG2E = 1.4426950408889634f;
constexpr float LAM_INIT = 0.35550907f;
constexpr float ASC = 8.f, WSC = 64.f, OSC = 64.f;
constexpr size_t MiB = 1u << 20;
constexpr size_t WS_PTRS = 32768;
constexpr size_t WS_MODP = 352 * MiB  , WS_MOD = 8 * MiB, WS_TAB = 9 * MiB, WS_XC = 10 * MiB;
constexpr size_t WS_WDOWN = 18 * MiB, WS_WUQ = 23 * MiB, WS_WUKV = 28 * MiB, WS_MWO = 30 * MiB, WS_DQKV = 34 * MiB, WS_DWO = 40 * MiB;
constexpr size_t WS_SQKV = 42 * MiB, WS_SWO = 45 * MiB, WS_PWQ = 47 * MiB, WS_PKEYS = 63 * MiB, WS_WEFF = 65 * MiB;
constexpr size_t WS_PU = 96 * MiB, WS_PV = 224 * MiB, WS_H = 352 * MiB, WS_O = 388 * MiB, WS_BUF1 = 424 * MiB, WS_BUF2 = 532 * MiB;
constexpr size_t WS_BUF3 = 586 * MiB, WS_BUF4 = 658 * MiB, WS_CQN = 712 * MiB, WS_CKVN = 739 * MiB, WS_SC = 748 * MiB, WS_END = 892 * MiB;
constexpr size_t WS_XL = 896 * MiB, WS_TOTAL = 928 * MiB;
constexpr int LDS_BYTES = 147456;


struct Params {
  const float *x, *c, *ctx, *c_ctx, *ada_w, *ada_b, *norm_mix, *norm_ffn;
  const float *mla_w_down, *mla_g_cq, *mla_g_ckv, *mla_w_uq, *mla_w_ukv, *mla_g_q, *mla_g_k, *mla_w_o;
  const float *diff_w_qkv, *diff_g_q, *diff_g_k, *diff_lambda, *diff_g_sub, *diff_w_o;
  const float *swa_w_qkv, *swa_g_q, *swa_g_k, *swa_sink, *swa_w_o;
  const float *peer_w_q, *peer_keys, *peer_u, *peer_v;
  float* out; unsigned char* ws;
  int single, phase;
};

__device__ __forceinline__ int opaque_tid() { int t = threadIdx.x; asm volatile("" : "+v"(t)); return t; }
__device__ __forceinline__ int otid(int wv) { int w = wv; asm volatile("" : "+s"(w)); unsigned m = ~0u; asm volatile("" : "+s"(m)); const int l = (int)__builtin_amdgcn_mbcnt_hi(m, __builtin_amdgcn_mbcnt_lo(m, 0u)); return (w << 6) | l; }
__device__ __forceinline__ unsigned pk2(float lo, float hi) { f32x2_t v = {lo, hi}; bf16x2_t b = __builtin_convertvector(v, bf16x2_t); return __builtin_bit_cast(unsigned, b); }
__device__ __forceinline__ unsigned pk4_fp8(float a, float b, float c, float d) { int w = 0; w = __builtin_amdgcn_cvt_pk_fp8_f32(a, b, w, false); w = __builtin_amdgcn_cvt_pk_fp8_f32(c, d, w, true); return (unsigned)w; }
__device__ __forceinline__ float bf_lo(unsigned u) { return __uint_as_float(u << 16); }
__device__ __forceinline__ float bf_hi(unsigned u) { return __uint_as_float(u & 0xffff0000u); }
__device__ __forceinline__ float wave_sum(float v) {
#pragma unroll
  for (int o = 32; o >= 1; o >>= 1) v += __shfl_xor(v, o);
  return v;
}
__device__ __forceinline__ float dot2bf(unsigned a, unsigned b, float c) { return __builtin_amdgcn_fdot2_f32_bf16(__builtin_bit_cast(bf16x2_t, a), __builtin_bit_cast(bf16x2_t, b), c, false); }
__device__ __forceinline__ int crow(int r, int hi) { return (r & 3) + 8 * (r >> 2) + 4 * hi; }
__device__ __forceinline__ unsigned f2ord(float f) { unsigned u = __float_as_uint(f); return (u & 0x80000000u) ? ~u : (u | 0x80000000u); }
__device__ __forceinline__ float ord2f(unsigned o) { return __uint_as_float((o & 0x80000000u) ? (o & 0x7fffffffu) : ~o); }
__device__ __forceinline__ bf16_t* xrow_ptr(bf16_t* xl, bf16_t* xc, int r) {
  const int b = r / TPB, s = r - b * TPB;
  return (s < SEQ) ? xl + (size_t)(b * SEQ + s) * D : xc + (size_t)(b * NCTX + (s - SEQ)) * D;
}
__device__ __forceinline__ const float* xsrc_ptr(const float* sl, const float* sc, int r) {
  const int b = r / TPB, s = r - b * TPB;
  return (s < SEQ) ? sl + (size_t)(b * SEQ + s) * D : sc + (size_t)(b * NCTX + (s - SEQ)) * D;
}
template <bool F8>
__device__ __forceinline__ void tr_job(LAS unsigned char* lds, const float* __restrict__ W, void* __restrict__ Wt_, int K, int N, int Npad, int& rot) {
  LAS float* tile = (LAS float*)lds;
  const int nnb = Npad / 64, nit = (K / 64) * nnb, tid = opaque_tid();
  const int vb = ((int)blockIdx.x - rot % (int)gridDim.x + (int)gridDim.x) % (int)gridDim.x;
  rot += (nit + 3) / 4;
  for (int it0 = vb * 4; it0 < nit; it0 += gridDim.x * 4) {
    f32x4 v[4][2];
#pragma unroll
    for (int q = 0; q < 4; ++q) {
      const int it = it0 + q, kb = it / nnb, nb = it - kb * nnb, k0 = kb * 64, n0 = nb * 64;
#pragma unroll
      for (int i = 0; i < 2; ++i) {
        const int idx = tid + i * 512, kk = idx >> 4, nc = (idx & 15) * 4;
        v[q][i] = (f32x4){0.f, 0.f, 0.f, 0.f};
        if (it < nit && n0 + nc < N) v[q][i] = *(const f32x4*)(W + (size_t)(k0 + kk) * N + n0 + nc);
      }
    }
#pragma unroll
    for (int q = 0; q < 4; ++q)
#pragma unroll
      for (int i = 0; i < 2; ++i) {
        const int idx = tid + i * 512, kk = idx >> 4, nc = (idx & 15) * 4; LAS float* t = tile + q * (64 * 65) + kk * 65 + nc;
        t[0] = v[q][i].x; t[1] = v[q][i].y; t[2] = v[q][i].z; t[3] = v[q][i].w;
      }
    __syncthreads();
#pragma unroll
    for (int q = 0; q < 4; ++q) {
      const int it = it0 + q;
      if (it < nit) {
        const int kb = it / nnb, nb = it - kb * nnb, k0 = kb * 64, n0 = nb * 64;
        const int n = tid >> 3, kc = tid & 7;
        float f[8];
#pragma unroll
        for (int j = 0; j < 8; ++j) f[j] = tile[q * (64 * 65) + (kc * 8 + j) * 65 + n];
        if (F8) *(u32x2*)((unsigned char*)Wt_ + (size_t)(n0 + n) * K + k0 + kc * 8) = (u32x2){pk4_fp8(f[0] * WSC, f[1] * WSC, f[2] * WSC, f[3] * WSC), pk4_fp8(f[4] * WSC, f[5] * WSC, f[6] * WSC, f[7] * WSC)};
        else *(u32x4*)((bf16_t*)Wt_ + (size_t)(n0 + n) * K + k0 + kc * 8) = (u32x4){pk2(f[0], f[1]), pk2(f[2], f[3]), pk2(f[4], f[5]), pk2(f[6], f[7])};
      }
    }
    __syncthreads();
  }
}
__device__ __forceinline__ void cvt_job(const float* __restrict__ src, bf16_t* __restrict__ dst, size_t n8) {
  for (size_t i = (size_t)blockIdx.x * NTHREADS + threadIdx.x; i < n8; i += (size_t)gridDim.x * NTHREADS) {
    const f32x4 a = ((const f32x4*)src)[2 * i], b = ((const f32x4*)src)[2 * i + 1];
    ((u32x4*)dst)[i] = (u32x4){pk2(a.x, a.y), pk2(a.z, a.w), pk2(b.x, b.y), pk2(b.z, b.w)};
  }
}
__device__ __forceinline__ unsigned q4pack(f32x4 a, f32x4 b, float sc) {
  const float v[8] = {a.x, a.y, a.z, a.w, b.x, b.y, b.z, b.w}; unsigned w = 0u;
#pragma unroll
  for (int j = 0; j < 8; ++j) { int q = (int)rintf(v[j] * sc); q = min(7, max(-8, q)); w |= ((unsigned)q & 15u) << (4 * j); }
  return w;
}
__device__ __forceinline__ void conv_rows(const float* __restrict__ usrc, const float* __restrict__ vsrc, unsigned char* __restrict__ udst, unsigned char* __restrict__ vdst, float su, float sv, int r0, int r1, int tid) {
  for (int rb = r0 + (tid >> 6); rb < r1; rb += 4 * NWAVES) {
    const int c = (tid & 63);
    f32x4 a[4], b[4], cc[4], d[4];
#pragma unroll
    for (int k = 0; k < 4; ++k) { const int r = min(rb + k * NWAVES, r1 - 1); const bool isv = r >= 16384; const int rr = isv ? r - 16384 : r;
      const f32x4* sp = (const f32x4*)((isv ? vsrc : usrc) + (size_t)rr * 1024) + c * 4;
      a[k] = sp[0]; b[k] = sp[1]; cc[k] = sp[2]; d[k] = sp[3]; }
#pragma unroll
    for (int k = 0; k < 4; ++k) { const int r = rb + k * NWAVES; if (r < r1) { const bool isv = r >= 16384; const int rr = isv ? r - 16384 : r;
      u32x2 o;
      if (isv) {
        unsigned w0 = 0u, w1 = 0u;
        w0 = __builtin_amdgcn_cvt_scalef32_pk_fp4_f32(w0, a[k].x * sv, a[k].y * sv, 1.0f, 0); w0 = __builtin_amdgcn_cvt_scalef32_pk_fp4_f32(w0, a[k].z * sv, a[k].w * sv, 1.0f, 1);
        w0 = __builtin_amdgcn_cvt_scalef32_pk_fp4_f32(w0, b[k].x * sv, b[k].y * sv, 1.0f, 2); w0 = __builtin_amdgcn_cvt_scalef32_pk_fp4_f32(w0, b[k].z * sv, b[k].w * sv, 1.0f, 3);
        w1 = __builtin_amdgcn_cvt_scalef32_pk_fp4_f32(w1, cc[k].x * sv, cc[k].y * sv, 1.0f, 0); w1 = __builtin_amdgcn_cvt_scalef32_pk_fp4_f32(w1, cc[k].z * sv, cc[k].w * sv, 1.0f, 1);
        w1 = __builtin_amdgcn_cvt_scalef32_pk_fp4_f32(w1, d[k].x * sv, d[k].y * sv, 1.0f, 2); w1 = __builtin_amdgcn_cvt_scalef32_pk_fp4_f32(w1, d[k].z * sv, d[k].w * sv, 1.0f, 3);
        o = (u32x2){w0, w1};
      } else o = (u32x2){q4pack(a[k], b[k], su), q4pack(cc[k], d[k], su)};
      *(u32x2*)((isv ? vdst : udst) + (size_t)rr * 512 + c * 8) = o; } }
  }
}
__device__ __forceinline__ void ada_job(LAS unsigned char* lds, const Params& p, float* __restrict__ modp) {
  LAS float* s = (LAS float*)lds;
  const int tid = opaque_tid();
  for (int u = blockIdx.x; u < 768; u += gridDim.x) {
    const int l = u / 192, r = u - l * 192, cc = r >> 6, kc = r & 63;
    __syncthreads();
    if (tid < 144) { const int bi = tid >> 4, k = tid & 15; const float c = (bi < 8) ? p.c[bi * D + kc * 16 + k] : p.c_ctx[kc * 16 + k]; s[tid] = c / (1.f + __expf(-c)); }
    __syncthreads();
    f32x4 acc[9];
#pragma unroll
    for (int bi = 0; bi < 9; ++bi) acc[bi] = (f32x4){0.f, 0.f, 0.f, 0.f};
    const float* w = p.ada_w + ((size_t)l * D + kc * 16) * 6144 + cc * 2048 + tid * 4;
#pragma unroll
    for (int h = 0; h < 2; ++h) {
      f32x4 wv[8];
#pragma unroll
      for (int k = 0; k < 8; ++k) wv[k] = *(const f32x4*)(w + (size_t)(h * 8 + k) * 6144);
#pragma unroll
      for (int k = 0; k < 8; ++k)
#pragma unroll
        for (int bi = 0; bi < 9; ++bi) acc[bi] += s[bi * 16 + h * 8 + k] * wv[k];
    }
#pragma unroll
    for (int bi = 0; bi < 9; ++bi) *(f32x4*)(modp + (((size_t)kc * 4 + l) * 9 + bi) * 6144 + cc * 2048 + tid * 4) = acc[bi];
  }
}

__device__ __forceinline__ void norm_phase(const float* sl, const float* sc_, bf16_t* xl, bf16_t* xc, bool src_f32, const float* __restrict__ g, const float* __restrict__ modl, int which, unsigned char* __restrict__ H, bool out_f8, bool skip_ctx, int wv) {
  const int tid_ = otid(wv); const int lane = tid_ & 63, wid = tid_ >> 6;
  for (int r = blockIdx.x * NWAVES + wid; r < M; r += gridDim.x * NWAVES) {
    const int b = r / TPB, s = r - b * TPB; const bool isctx = s >= SEQ;
    if (skip_ctx && isctx) continue;
    const int bi = isctx ? 8 : b;
    const float* sh = modl + (size_t)(bi * 6 + which) * D; const float* sc = sh + D;
    f32x4 v[4]; float ss = 0.f;
    if (src_f32) {
      const float* xr = xsrc_ptr(sl, sc_, r);
#pragma unroll
      for (int j = 0; j < 4; ++j) v[j] = ((const f32x4*)xr)[lane + 64 * j];
    } else {
      const bf16_t* xr = xrow_ptr(xl, xc, r);
#pragma unroll
      for (int j = 0; j < 4; ++j) { const u32x2 w = ((const u32x2*)xr)[lane + 64 * j]; v[j] = (f32x4){bf_lo(w.x), bf_hi(w.x), bf_lo(w.y), bf_hi(w.y)}; }
    }
#pragma unroll
    for (int j = 0; j < 4; ++j) ss += v[j].x * v[j].x + v[j].y * v[j].y + v[j].z * v[j].z + v[j].w * v[j].w;
    ss = wave_sum(ss);
    const float rstd = rsqrtf(ss * (1.f / D) + EPS);
#pragma unroll
    for (int j = 0; j < 4; ++j) {
      const int c4 = lane + 64 * j;
      const f32x4 g4 = ((const f32x4*)g)[c4], s4 = ((const f32x4*)sc)[c4], h4 = ((const f32x4*)sh)[c4];
      const f32x4 y = v[j] * rstd * g4 * (1.f + s4) + h4;
      if (out_f8) *(unsigned*)(H + (size_t)r * D + c4 * 4) = pk4_fp8(y.x * ASC, y.y * ASC, y.z * ASC, y.w * ASC);
      else *(u32x2*)((bf16_t*)H + (size_t)r * D + c4 * 4) = (u32x2){pk2(y.x, y.y), pk2(y.z, y.w)};
    }
  }
}
__device__ __forceinline__ void latnorm_phase(const bf16_t* __restrict__ LAT, const float* __restrict__ gcq, const float* __restrict__ gckv, unsigned char* __restrict__ CQN, bf16_t* __restrict__ CKVN, int wv) {
  const int tid_ = otid(wv); const int lane = tid_ & 63, wid = tid_ >> 6;
  for (int r = blockIdx.x * NWAVES + wid; r < M; r += gridDim.x * NWAVES) {
    const bf16_t* lr = LAT + (size_t)r * 1280;
    float q[12], kv[4]; float sq = 0.f, sk = 0.f;
#pragma unroll
    for (int j = 0; j < 3; ++j) { const u32x2 w = *(const u32x2*)(lr + lane * 4 + 256 * j); q[4 * j] = bf_lo(w.x); q[4 * j + 1] = bf_hi(w.x); q[4 * j + 2] = bf_lo(w.y); q[4 * j + 3] = bf_hi(w.y); }
    { const u32x2 w = *(const u32x2*)(lr + 768 + lane * 4); kv[0] = bf_lo(w.x); kv[1] = bf_hi(w.x); kv[2] = bf_lo(w.y); kv[3] = bf_hi(w.y); }
#pragma unroll
    for (int j = 0; j < 12; ++j) sq += q[j] * q[j];
#pragma unroll
    for (int j = 0; j < 4; ++j) sk += kv[j] * kv[j];
    sq = wave_sum(sq); sk = wave_sum(sk);
    const float rq = rsqrtf(sq * (1.f / 768.f) + EPS), rk = rsqrtf(sk * (1.f / 256.f) + EPS);
#pragma unroll
    for (int j = 0; j < 3; ++j) { const int c = lane * 4 + 256 * j; const f32x4 g4 = *(const f32x4*)(gcq + c);
      *(unsigned*)(CQN + (size_t)r * 768 + c) = pk4_fp8(q[4 * j] * rq * g4.x * ASC, q[4 * j + 1] * rq * g4.y * ASC, q[4 * j + 2] * rq * g4.z * ASC, q[4 * j + 3] * rq * g4.w * ASC); }
    { const int c = lane * 4; const f32x4 g4 = *(const f32x4*)(gckv + c);
      *(u32x2*)(CKVN + (size_t)r * 256 + c) = (u32x2){pk2(kv[0] * rk * g4.x, kv[1] * rk * g4.y), pk2(kv[2] * rk * g4.z, kv[3] * rk * g4.w)}; }
  }
}

constexpr int G_AS = 144;
constexpr int G_ATILE = 256 * G_AS, G_BTILE = 128 * G_AS, G_STAGE = G_ATILE + G_BTILE;
struct EpiFp8T { unsigned char* C; int ldc;
  __device__ __forceinline__ void operator()(int row, int col, f32x4 v) const { const unsigned w = pk4_fp8(v.x * WSC, v.y * WSC, v.z * WSC, v.w * WSC);
    C[(size_t)(col + 0) * ldc + row] = (unsigned char)(w & 255u); C[(size_t)(col + 1) * ldc + row] = (unsigned char)((w >> 8) & 255u); C[(size_t)(col + 2) * ldc + row] = (unsigned char)((w >> 16) & 255u); C[(size_t)(col + 3) * ldc + row] = (unsigned char)(w >> 24); } };
struct EpiBf16T { bf16_t* C; int ldc;
  __device__ __forceinline__ void operator()(int row, int col, f32x4 v) const {
    C[(size_t)(col + 0) * ldc + row] = (bf16_t)(pk2(v.x, 0.f) & 0xffffu); C[(size_t)(col + 1) * ldc + row] = (bf16_t)(pk2(v.y, 0.f) & 0xffffu);
    C[(size_t)(col + 2) * ldc + row] = (bf16_t)(pk2(v.z, 0.f) & 0xffffu); C[(size_t)(col + 3) * ldc + row] = (bf16_t)(pk2(v.w, 0.f) & 0xffffu); } };
template <class Epi>
__device__ __forceinline__ void gemm_phase(LAS unsigned char* lds, const bf16_t* __restrict__ A, int lda, const bf16_t* __restrict__ Bt, int ldb,
                                           int Mrows, int N, int K, bool skip_ctx_tiles, const Epi epi, int ustart, int ustride) {
  const int tid = opaque_tid(), lane = tid & 63, wid = tid >> 6, wr = wid >> 1, wc = wid & 1, fr = lane & 15, fq = lane >> 4;
  const int nN = N / 128, nU = (Mrows / 256) * nN, nt = K / 64;
  const int lrow = tid >> 3, lkc = tid & 7;
  for (int u = ustart; u < nU; u += ustride) {
    const int pm = u / nN, pn = u - pm * nN;
    if (skip_ctx_tiles && (pm % 9) == 8) continue;
    const bf16_t* Ag = A + (size_t)(pm * 256 + lrow) * lda + lkc * 8;
    const bf16_t* Bg = Bt + (size_t)(pn * 128 + lrow) * ldb + lkc * 8;
    f32x4 acc[4][4];
#pragma unroll
    for (int m = 0; m < 4; ++m)
#pragma unroll
      for (int n = 0; n < 4; ++n) acc[m][n] = (f32x4){0.f, 0.f, 0.f, 0.f};
    u32x4 ra[4], rb[2];
#pragma unroll
    for (int i = 0; i < 4; ++i) ra[i] = *(const u32x4*)(Ag + (size_t)(64 * i) * lda);
#pragma unroll
    for (int i = 0; i < 2; ++i) rb[i] = *(const u32x4*)(Bg + (size_t)(64 * i) * ldb);
    {
      LAS unsigned char* sa = lds + lrow * G_AS + lkc * 16; LAS unsigned char* sb = lds + G_ATILE + lrow * G_AS + lkc * 16;
#pragma unroll
      for (int i = 0; i < 4; ++i) *(LAS u32x4*)(sa + i * 64 * G_AS) = ra[i];
#pragma unroll
      for (int i = 0; i < 2; ++i) *(LAS u32x4*)(sb + i * 64 * G_AS) = rb[i];
    }
    __syncthreads();
    for (int t = 0; t < nt; ++t) {
      const bool more = (t + 1 < nt);
      if (more) {
#pragma unroll
        for (int i = 0; i < 4; ++i) ra[i] = *(const u32x4*)(Ag + (size_t)(64 * i) * lda + (t + 1) * 64);
#pragma unroll
        for (int i = 0; i < 2; ++i) rb[i] = *(const u32x4*)(Bg + (size_t)(64 * i) * ldb + (t + 1) * 64);
      }
      const LAS unsigned char* st = lds + (t & 1) * G_STAGE;
      const LAS unsigned char* pa = st + (wr * 64 + fr) * G_AS + fq * 16;
      const LAS unsigned char* pb = st + G_ATILE + (wc * 64 + fr) * G_AS + fq * 16;
#pragma unroll
      for (int ks = 0; ks < 2; ++ks) {
        bf16x8 af[4], bfr[4];
#pragma unroll
        for (int m = 0; m < 4; ++m) af[m] = *(const LAS bf16x8*)(pa + m * 16 * G_AS + ks * 64);
#pragma unroll
        for (int n = 0; n < 4; ++n) bfr[n] = *(const LAS bf16x8*)(pb + n * 16 * G_AS + ks * 64);
#pragma unroll
        for (int m = 0; m < 4; ++m)
#pragma unroll
          for (int n = 0; n < 4; ++n) acc[m][n] = __builtin_amdgcn_mfma_f32_16x16x32_bf16(bfr[n], af[m], acc[m][n], 0, 0, 0);
      }
      if (more) {
        LAS unsigned char* sa = lds + ((t + 1) & 1) * G_STAGE + lrow * G_AS + lkc * 16; LAS unsigned char* sb = sa + G_ATILE;
#pragma unroll
        for (int i = 0; i < 4; ++i) *(LAS u32x4*)(sa + i * 64 * G_AS) = ra[i];
#pragma unroll
        for (int i = 0; i < 2; ++i) *(LAS u32x4*)(sb + i * 64 * G_AS) = rb[i];
      }
      __syncthreads();
    }
#pragma unroll
    for (int m = 0; m < 4; ++m)
#pragma unroll
      for (int n = 0; n < 4; ++n) epi(pm * 256 + wr * 64 + m * 16 + fr, pn * 128 + wc * 64 + n * 16 + fq * 4, acc[m][n]);
  }
}

namespace pg8 {
#define PG8_LAS __attribute__((address_space(3)))
typedef unsigned short bf16_t;
typedef short bf16x8 __attribute__((ext_vector_type(8)));
typedef float f32x4 __attribute__((ext_vector_type(4)));
typedef unsigned u32x4 __attribute__((ext_vector_type(4)));
constexpr int BM = 256, BK = 64, HALF = 128, HTB = HALF * BK * 2  , STAGE_BYTES = 8 * HTB, NXCD = 8, WGM = 8;

__host__ __device__ __forceinline__ int lds_byte(int r, int c) { const int st = (r >> 4) * 2 + (c >> 5), rr = r & 15, cc = c & 31, ob = rr * 64 + cc * 2; return st * 1024 + (ob ^ (((ob >> 9) & 1) << 5)); }
__host__ __device__ __forceinline__ void stage_rc(int b, int& R, int& C) { const int st = b / 1024, sb = b % 1024, swz = sb ^ (((sb >> 9) & 1) << 5); R = (st >> 1) * 16 + swz / 64; C = (st & 1) * 32 + (swz % 64) / 2; }
__host__ __device__ __forceinline__ int perm32(int rho) { const int n = rho >> 4, i = rho & 15; return 8 * (i >> 2) + 4 * n + (i & 3); }

struct Unit { int pm, pn; };
struct Gemm { const bf16_t* A; const bf16_t* Bt; int M, N, K; };

struct StaticOrder {
    int nM, nN, nwg, G, c;
    __host__ __device__ void init(int M, int N, int G_, int c_) { nM = M / BM; nN = N / BM; nwg = nM * nN; G = G_; c = c_; }
    __host__ __device__ bool next(int i, Unit& u) const {
        const long L = (long)i * G + c; if (L >= nwg) return false;
        int wgid = (int)L; { const int q = nwg / NXCD, r = nwg % NXCD, xcd = wgid % NXCD, off = wgid / NXCD; wgid = (xcd < r ? xcd * (q + 1) : r * (q + 1) + (xcd - r) * q) + off; }
        const int nig = WGM * nN, gid = wgid / nig, fm = gid * WGM, gsz = (nM - fm) < WGM ? (nM - fm) : WGM;
        u.pm = fm + ((wgid % nig) % gsz); u.pn = (wgid % nig) / gsz; return true;
    }
    __device__ __forceinline__ void a_ready(const Unit&) const {}
    __device__ __forceinline__ void done(const Unit&) const {}
};
struct LatentOrder {
    StaticOrder base; bool skip;
    __host__ __device__ void init(int M_, int N_, int G_, int c_, bool skip_) { skip = skip_; base.init(skip_ ? (M_ / 9) * 8 : M_, N_, G_, c_); }
    __host__ __device__ bool next(int i, Unit& u) const { if (!base.next(i, u)) return false; if (skip) u.pm += u.pm >> 3; return true; }
    __device__ __forceinline__ void a_ready(const Unit&) const {}
    __device__ __forceinline__ void done(const Unit&) const {}
};
struct EpiBf16P { static constexpr bool PERM = true, AFTER_DRAIN = false; bf16_t* O; int ldc; float sc;
  __device__ __forceinline__ void operator()(const f32x4 (&acc)[2][2][4][2], const Unit& u, int wr, int wc, int fr, int fq) const {
    const int row0 = u.pm * BM + wr * 64 + fr, col0 = u.pn * BM + wc * 32 + 8 * fq;
#pragma unroll
    for (int ai = 0; ai < 2; ++ai)
#pragma unroll
      for (int m = 0; m < 4; ++m) { bf16_t* rowp = O + (size_t)(row0 + ai * HALF + m * 16) * ldc + col0;
#pragma unroll
        for (int bj = 0; bj < 2; ++bj) { const f32x4 v0 = acc[ai][bj][m][0] * sc, v1 = acc[ai][bj][m][1] * sc;
          *(u32x4*)(rowp + bj * HALF) = (u32x4){pk2(v0[0], v0[1]), pk2(v0[2], v0[3]), pk2(v1[0], v1[1]), pk2(v1[2], v1[3])}; } }
  } };
struct EpiResidN { static constexpr bool PERM = false, AFTER_DRAIN = false; const float* sl; const float* sc; bool src_f32; bf16_t* xl; bf16_t* xc; const float* modl; int which; bool live; float osc;
  __device__ __forceinline__ void operator()(const f32x4 (&acc)[2][2][4][2], const Unit& u, int wr, int wc, int fr, int fq) const {
    if (!live) return;
    const int row0 = u.pm * BM + wr * 64 + fr, col0 = u.pn * BM + wc * 32 + 4 * fq;
    const int b = (u.pm * BM) / TPB, s0 = u.pm * BM - b * TPB; const int bi = (s0 >= SEQ) ? 8 : b;
    const float* gp = modl + (size_t)(bi * 6 + which) * D + col0;
#pragma unroll
    for (int bj = 0; bj < 2; ++bj)
#pragma unroll
      for (int n = 0; n < 2; ++n) { const f32x4 gt = *(const f32x4*)(gp + bj * HALF + n * 16) * osc;
#pragma unroll
        for (int ai = 0; ai < 2; ++ai)
#pragma unroll
          for (int m = 0; m < 4; ++m) { const int rr = row0 + ai * HALF + m * 16, cc = col0 + bj * HALF + n * 16;
            bf16_t* xp = xrow_ptr(xl, xc, rr) + cc; f32x4 xv;
            if (src_f32) xv = *(const f32x4*)(xsrc_ptr(sl, sc, rr) + cc);
            else { const u32x2 w = *(const u32x2*)xp; xv = (f32x4){bf_lo(w.x), bf_hi(w.x), bf_lo(w.y), bf_hi(w.y)}; }
            xv += gt * acc[ai][bj][m][n]; *(u32x2*)xp = (u32x2){pk2(xv.x, xv.y), pk2(xv.z, xv.w)}; } }
  } };
template <class Epi, class Sched, bool ALIGN_EPI = false, bool SP2 = false, bool FP8 = false>
__device__ __forceinline__ void gemm_phase(PG8_LAS unsigned char* lds, const Gemm g, const Sched& S, const Epi& E, int wv) {
    const int tid = otid(wv), wid = __builtin_amdgcn_readfirstlane(tid >> 6), lane = tid & 63, wr = wid >> 2, wc = wid & 3, fr = lane & 15, fq = lane >> 4;
    const int K = g.K, nt = K / BK;
    unsigned voffA[2], voffB[2];
#pragma unroll
    for (int i = 0; i < 2; ++i) { int R, C; stage_rc(tid * 16 + i * 8192, R, C); const int Rb = Epi::PERM ? ((R & ~31) + perm32(R & 31)) : R;
        voffA[i] = (unsigned)(R * K + C) * 2u; voffB[i] = (unsigned)(Rb * K + C) * 2u; }
    const size_t kstep = (size_t)(BK * 2);
    const size_t hstep = (size_t)HALF * K * 2;
    const size_t tstep = 2 * hstep;
    const unsigned ldsw = (unsigned)wid * 1024u;
    const int aoff = lds_byte(wr * 64 + fr, fq * 8), boff = lds_byte(wc * 32 + fr, fq * 8);
#define PG8_SA(b, h) (((b) * 2 + (h)) * HTB)
#define PG8_SB(b, h) ((4 + (b) * 2 + (h)) * HTB)
#define PG8_STAGE(bufoff, gbase, voff) do { _Pragma("unroll") for (int _i = 0; _i < 2; ++_i) \
        __builtin_amdgcn_global_load_lds((const unsigned*)((const char*)(gbase) + (voff)[_i]), (PG8_LAS unsigned*)(lds + (bufoff) + ldsw + _i * 8192), 16, 0, 0); } while (0)
#define PG8_LDA(dst, b, h) do { _Pragma("unroll") for (int m = 0; m < 4; ++m) _Pragma("unroll") for (int k = 0; k < 2; ++k) dst[m][k] = *(const PG8_LAS bf16x8*)(lds + PG8_SA(b, h) + aoff + m * 2048 + k * 1024); } while (0)
#define PG8_LDB(dst, b, h) do { _Pragma("unroll") for (int n = 0; n < 2; ++n) _Pragma("unroll") for (int k = 0; k < 2; ++k) dst[n][k] = *(const PG8_LAS bf16x8*)(lds + PG8_SB(b, h) + boff + n * 2048 + k * 1024); } while (0)
#define PG8_MMA(ai, bj, At, Bt) do { __builtin_amdgcn_s_setprio(1); _Pragma("unroll") for (int m = 0; m < 4; ++m) _Pragma("unroll") for (int n = 0; n < 2; ++n) _Pragma("unroll") for (int k = 0; k < 2; ++k) { \
        if constexpr (FP8) { const long2_t a2_ = __builtin_bit_cast(long2_t, At[m][k]), b2_ = __builtin_bit_cast(long2_t, Bt[n][k]); \
          acc[ai][bj][m][n] = __builtin_amdgcn_mfma_f32_16x16x32_fp8_fp8(b2_[0], a2_[0], acc[ai][bj][m][n], 0, 0, 0); \
          acc[ai][bj][m][n] = __builtin_amdgcn_mfma_f32_16x16x32_fp8_fp8(b2_[1], a2_[1], acc[ai][bj][m][n], 0, 0, 0); } \
        else acc[ai][bj][m][n] = __builtin_amdgcn_mfma_f32_16x16x32_bf16(Bt[n][k], At[m][k], acc[ai][bj][m][n], 0, 0, 0); } __builtin_amdgcn_s_setprio(0); } while (0)
#define PG8_WAIT_V(n) asm volatile("s_waitcnt vmcnt(" #n ")" ::: "memory")
#define PG8_WAIT_L(n) asm volatile("s_waitcnt lgkmcnt(" #n ")" ::: "memory")
#define PG8_BAR __builtin_amdgcn_s_barrier()
#define PG8_SCHED __builtin_amdgcn_sched_barrier(0)
    Unit cur, nxt; int ui = 0;
    if (!S.next(0, cur)) return;
    f32x4 acc[2][2][4][2];
#pragma unroll
    for (int a = 0; a < 2; ++a)
#pragma unroll
        for (int b = 0; b < 2; ++b)
#pragma unroll
            for (int m = 0; m < 4; ++m)
#pragma unroll
                for (int n = 0; n < 2; ++n) acc[a][b][m][n] = (f32x4){0.f, 0.f, 0.f, 0.f};
    bf16x8 At[4][2], B0[2][2], B1[2][2];
    const char* cA = (const char*)g.A + (size_t)cur.pm * tstep; const char* cB = (const char*)g.Bt + (size_t)cur.pn * tstep;
    S.a_ready(cur);
    if constexpr (SP2) {
        PG8_STAGE(PG8_SB(0, 0), cB, voffB); PG8_STAGE(PG8_SB(0, 1), cB + hstep, voffB); PG8_STAGE(PG8_SA(0, 0), cA, voffA); PG8_STAGE(PG8_SA(0, 1), cA + hstep, voffA);
        if (wr == 1) PG8_BAR;
        PG8_WAIT_V(2); PG8_BAR;
        PG8_STAGE(PG8_SB(1, 0), cB + kstep, voffB); PG8_STAGE(PG8_SA(1, 0), cA + kstep, voffA); PG8_STAGE(PG8_SB(1, 1), cB + hstep + kstep, voffB);
        PG8_WAIT_V(6); PG8_BAR;
    } else {
        PG8_STAGE(PG8_SB(0, 0), cB, voffB); PG8_STAGE(PG8_SA(0, 0), cA, voffA); PG8_STAGE(PG8_SB(0, 1), cB + hstep, voffB); PG8_STAGE(PG8_SA(0, 1), cA + hstep, voffA);
        if (wr == 1) PG8_BAR;
        PG8_WAIT_V(4); PG8_BAR;
        PG8_STAGE(PG8_SB(1, 0), cB + kstep, voffB); PG8_STAGE(PG8_SA(1, 0), cA + kstep, voffA); PG8_STAGE(PG8_SB(1, 1), cB + hstep + kstep, voffB);
        PG8_WAIT_V(6); PG8_BAR;
    }
    for (;;) {
        const bool has_next = S.next(ui + 1, nxt);
        const char* nA = has_next ? (const char*)g.A + (size_t)nxt.pm * tstep : cA; const char* nB = has_next ? (const char*)g.Bt + (size_t)nxt.pn * tstep : cB;
        for (int t = 0; t < nt; t += 2) {
            const bool last = (t == nt - 2);
            const char* a1 = cA + (size_t)(t + 1) * kstep;
            const char* a2 = last ? nA : cA + (size_t)(t + 2) * kstep; const char* b2 = last ? nB : cB + (size_t)(t + 2) * kstep;
            const char* a3 = a2 + kstep; const char* b3 = b2 + kstep;
            if (last && has_next) S.a_ready(nxt);
            if constexpr (SP2) {
            PG8_LDB(B0, 0, 0); PG8_LDB(B1, 0, 1); PG8_SCHED; PG8_LDA(At, 0, 0); PG8_STAGE(PG8_SA(1, 1), a1 + hstep, voffA);
            PG8_WAIT_V(8); PG8_WAIT_L(0); PG8_BAR; PG8_MMA(0, 0, At, B0); PG8_MMA(0, 1, At, B1); PG8_BAR; PG8_SCHED;
            PG8_LDA(At, 0, 1); PG8_STAGE(PG8_SB(0, 0), b2, voffB); PG8_STAGE(PG8_SB(0, 1), b2 + hstep, voffB); PG8_STAGE(PG8_SA(0, 0), a2, voffA);
            PG8_WAIT_V(8); PG8_WAIT_L(0); PG8_BAR; PG8_MMA(1, 0, At, B0); PG8_MMA(1, 1, At, B1); PG8_BAR; PG8_SCHED;
            PG8_LDB(B0, 1, 0); PG8_LDB(B1, 1, 1); PG8_SCHED; PG8_LDA(At, 1, 0); PG8_STAGE(PG8_SA(0, 1), a2 + hstep, voffA);
            PG8_WAIT_V(8); PG8_WAIT_L(0); PG8_BAR; PG8_MMA(0, 0, At, B0); PG8_MMA(0, 1, At, B1); PG8_BAR; PG8_SCHED;
            PG8_LDA(At, 1, 1); PG8_STAGE(PG8_SB(1, 0), b3, voffB); PG8_STAGE(PG8_SB(1, 1), b3 + hstep, voffB); PG8_STAGE(PG8_SA(1, 0), a3, voffA);
            PG8_WAIT_V(8); PG8_WAIT_L(0); PG8_BAR; PG8_MMA(1, 0, At, B0); PG8_MMA(1, 1, At, B1); PG8_BAR; PG8_SCHED;
            } else {
            PG8_LDB(B0, 0, 0); PG8_SCHED; PG8_LDA(At, 0, 0); PG8_STAGE(PG8_SA(1, 1), a1 + hstep, voffA);
            PG8_WAIT_L(8); PG8_BAR; PG8_WAIT_L(0); PG8_MMA(0, 0, At, B0); PG8_BAR; PG8_SCHED;
            PG8_LDB(B1, 0, 1); PG8_STAGE(PG8_SB(0, 0), b2, voffB);
            PG8_BAR; PG8_WAIT_L(0); PG8_MMA(0, 1, At, B1); PG8_BAR;
            PG8_LDA(At, 0, 1); PG8_STAGE(PG8_SA(0, 0), a2, voffA);
            PG8_BAR; PG8_WAIT_L(0); PG8_MMA(1, 0, At, B0); PG8_BAR; PG8_SCHED;
            PG8_STAGE(PG8_SB(0, 1), b2 + hstep, voffB);
            PG8_WAIT_V(6); PG8_BAR; PG8_MMA(1, 1, At, B1); PG8_BAR;
            PG8_LDB(B0, 1, 0); PG8_SCHED; PG8_LDA(At, 1, 0); PG8_STAGE(PG8_SA(0, 1), a2 + hstep, voffA);
            PG8_WAIT_L(8); PG8_BAR; PG8_WAIT_L(0); PG8_MMA(0, 0, At, B0); PG8_BAR; PG8_SCHED;
            PG8_LDB(B1, 1, 1); PG8_STAGE(PG8_SB(1, 0), b3, voffB);
            PG8_BAR; PG8_WAIT_L(0); PG8_MMA(0, 1, At, B1); PG8_BAR;
            PG8_LDA(At, 1, 1); PG8_STAGE(PG8_SA(1, 0), a3, voffA);
            PG8_BAR; PG8_WAIT_L(0); PG8_MMA(1, 0, At, B0); PG8_BAR; PG8_SCHED;
            PG8_STAGE(PG8_SB(1, 1), b3 + hstep, voffB);
            PG8_WAIT_V(6); PG8_BAR; PG8_MMA(1, 1, At, B1); PG8_BAR;
            }
        }
        if constexpr (ALIGN_EPI) { if (wr == 0) PG8_BAR; }
        if constexpr (!Epi::AFTER_DRAIN) { E(acc, cur, wr, wc, fr, fq); S.done(cur); }
        if (!has_next) break;
#pragma unroll
        for (int a = 0; a < 2; ++a)
#pragma unroll
            for (int b = 0; b < 2; ++b)
#pragma unroll
                for (int m = 0; m < 4; ++m)
#pragma unroll
                    for (int n = 0; n < 2; ++n) acc[a][b][m][n] = (f32x4){0.f, 0.f, 0.f, 0.f};
        cur = nxt; cA = nA; cB = nB; ++ui;
        if constexpr (ALIGN_EPI) { if (wr == 1) PG8_BAR; }
    }
    PG8_WAIT_V(0);
    if constexpr (!ALIGN_EPI) { if (wr == 0) PG8_BAR; }
    PG8_BAR;
    if constexpr (Epi::AFTER_DRAIN) { E.fused(acc, cur, wr, wc, fr, fq, lds, wid, lane); S.done(cur); }
#undef PG8_SA
#undef PG8_SB
#undef PG8_STAGE
#undef PG8_LDA
#undef PG8_LDB
#undef PG8_MMA
#undef PG8_WAIT_V
#undef PG8_WAIT_L
#undef PG8_BAR
#undef PG8_SCHED
}
}
#define UNPACK8(W, V, O) do { V[O + 0] = bf_lo(W.x); V[O + 1] = bf_hi(W.x); V[O + 2] = bf_lo(W.y); V[O + 3] = bf_hi(W.y); V[O + 4] = bf_lo(W.z); V[O + 5] = bf_hi(W.z); V[O + 6] = bf_lo(W.w); V[O + 7] = bf_hi(W.w); } while (0)
#define PACK8(V, O, SC) (u32x4){pk2(V[O] * SC, V[O + 1] * SC), pk2(V[O + 2] * SC, V[O + 3] * SC), pk2(V[O + 4] * SC, V[O + 5] * SC), pk2(V[O + 6] * SC, V[O + 7] * SC)}
__device__ __forceinline__ void headnorm96(const bf16_t* srcA, const bf16_t* srcB, bf16_t* dst, const float* __restrict__ g, float outscale, bool rope, int rowpos, int colpos,
                                           const float* __restrict__ tab8, int j) {
  const u32x4 w0 = *(const u32x4*)(srcA + j * 8), w1 = *(const u32x4*)(srcA + 32 + j * 8), w2 = *(const u32x4*)(srcB + j * 8);
  float v[24];
  UNPACK8(w0, v, 0); UNPACK8(w1, v, 8); UNPACK8(w2, v, 16);
  float ss = 0.f;
#pragma unroll
  for (int e = 0; e < 24; ++e) ss += v[e] * v[e];
  ss += __shfl_xor(ss, 1); ss += __shfl_xor(ss, 2);
  const float rstd = rsqrtf(ss * (1.f / 96.f) + EPS);
#pragma unroll
  for (int e = 0; e < 8; ++e) { v[e] *= rstd * g[j * 8 + e]; v[8 + e] *= rstd * g[32 + j * 8 + e]; v[16 + e] *= rstd * g[64 + j * 8 + e]; }
  const int pos = (j < 2) ? rowpos : colpos;
#pragma unroll
  for (int e = 0; e < 8; ++e) {
    const float own = v[16 + e], oth = __shfl_xor(own, 1);
    const f32x2_t cs = *(const f32x2_t*)(tab8 + (pos * 8 + e) * 2);
    const float res = (j & 1) ? (oth * cs.y + own * cs.x) : (own * cs.x - oth * cs.y);
    if (rope) v[16 + e] = res;
  }
  *(u32x4*)(dst + j * 8) = PACK8(v, 0, outscale); *(u32x4*)(dst + 32 + j * 8) = PACK8(v, 8, outscale); *(u32x4*)(dst + 64 + j * 8) = PACK8(v, 16, outscale);
}
__device__ __forceinline__ void headnorm64(const bf16_t* q, bf16_t* qd, const float* __restrict__ g, float outscale, bool rope, int rowpos, int colpos, const float* __restrict__ tab16, int j) {
  const u32x4 w0 = *(const u32x4*)(q + j * 8), w1 = *(const u32x4*)(q + 32 + j * 8);
  float v[16];
  UNPACK8(w0, v, 0); UNPACK8(w1, v, 8);
  float ss = 0.f;
#pragma unroll
  for (int e = 0; e < 16; ++e) ss += v[e] * v[e];
  ss += __shfl_xor(ss, 1); ss += __shfl_xor(ss, 2);
  const float rstd = rsqrtf(ss * (1.f / 64.f) + EPS);
#pragma unroll
  for (int e = 0; e < 8; ++e) { v[e] *= rstd * g[j * 8 + e]; v[8 + e] *= rstd * g[32 + j * 8 + e]; }
#pragma unroll
  for (int e = 0; e < 8; ++e) {
    const int i = (j & 1) * 8 + e;
    const float own0 = v[e], oth0 = __shfl_xor(own0, 2), own1 = v[8 + e], oth1 = __shfl_xor(own1, 2);
    const f32x2_t cr = *(const f32x2_t*)(tab16 + (rowpos * 16 + i) * 2), cc = *(const f32x2_t*)(tab16 + (colpos * 16 + i) * 2);
    const float r0 = (j >> 1) ? (oth0 * cr.y + own0 * cr.x) : (own0 * cr.x - oth0 * cr.y);
    const float r1 = (j >> 1) ? (oth1 * cc.y + own1 * cc.x) : (own1 * cc.x - oth1 * cc.y);
    if (rope) { v[e] = r0; v[8 + e] = r1; }
  }
  *(u32x4*)(qd + j * 8) = PACK8(v, 0, outscale); *(u32x4*)(qd + 32 + j * 8) = PACK8(v, 8, outscale);
}

template <int DQK, int DV, int NS, bool WINDOW>
__device__ __forceinline__ void attn_unit(LAS unsigned char* lds, const bf16_t* __restrict__ Qb, int qsoff, int ldq, const bf16_t* __restrict__ Kb, int ksoff, int ldk,
                                          const bf16_t* __restrict__ Vb, int ldv, int q0, int ta0, int ta1, int tb0, int tb1, bool has_sink, float sink_l2, float kmax,
                                          unsigned char* __restrict__ Ob, int ldo, float lam, const float* __restrict__ gsub, int wv) {
  constexpr int KS = DQK * 2 + 16, KTB = 64 * KS, VS = (DV == 64) ? 192 : 320, VOFF = NS * KTB, VTB = 64 * VS, STG = VOFF + VTB;
  constexpr int KCR = DQK / 8, KCH = 64 * KCR, VCR = DV / 8, VCH = 64 * VCR, NCH = NS * KCH + VCH, NI = (NCH + NTHREADS - 1) / NTHREADS;
  constexpr int NDB = DV / 32, NKS = DQK / 16;
  static_assert(3 * STG <= LDS_BYTES - 16 && (NS == 1 || 4 * DV * 32 * 4 <= 3 * STG), "LDS");
  const int tid = otid(wv), lane = tid & 63, wid = tid >> 6, l31 = lane & 31, hi = lane >> 5;
  const int grp = wid >> 2;
  const int qsub = (NS == 1) ? wid : (wid & 3), stream = (NS == 1) ? 0 : grp;
  const int qrow = q0 + qsub * 32 + l31;
  bf16x8 qf[NKS];
  float qn2 = 0.f;
#pragma unroll
  for (int ks = 0; ks < NKS; ++ks) {
    const u32x4 w = *(const u32x4*)(Qb + (size_t)stream * qsoff + (size_t)qrow * ldq + ks * 16 + hi * 8);
    qf[ks] = __builtin_bit_cast(bf16x8, w);
    const float a0 = bf_lo(w.x), a1 = bf_hi(w.x), a2 = bf_lo(w.y), a3 = bf_hi(w.y), a4 = bf_lo(w.z), a5 = bf_hi(w.z), a6 = bf_lo(w.w), a7 = bf_hi(w.w);
    qn2 += a0 * a0 + a1 * a1 + a2 * a2 + a3 * a3 + a4 * a4 + a5 * a5 + a6 * a6 + a7 * a7;
  }
  qn2 += __shfl_xor(qn2, 32);
  const float negmb = -(sqrtf(qn2) * kmax);
  f32x16 negmv;
  if (DV == 64) {
#pragma unroll
    for (int r = 0; r < 16; ++r) negmv[r] = negmb;
    asm volatile("" : "+v"(negmv));
  }
  f32x16 o[NDB];
#pragma unroll
  for (int db = 0; db < NDB; ++db)
#pragma unroll
    for (int r = 0; r < 16; ++r) o[db][r] = 0.f;
  float lrun = 0.f;
  const int n1 = ta1 - ta0, ntl = n1 + (tb1 - tb0);
  u32x4 st[NI];
  f32x16 p0, p1;
  const LAS unsigned char* klb = lds + stream * KTB + l31 * KS + hi * 16;
  const LAS unsigned char* vlb = lds + VOFF + (4 * hi + ((lane & 15) >> 2)) * VS + (16 * ((lane >> 4) & 1) + 4 * (lane & 3)) * 2;
#define ATT_TILE(i_) (((i_) < n1) ? ta0 + (i_) : tb0 + ((i_) - n1))
#define ATT_LOAD(T_) do { const int t__ = (T_); _Pragma("unroll") for (int ii = 0; ii < NI; ++ii) { const int c = tid + ii * NTHREADS; if (c < NCH) { \
      if (c < NS * KCH) { const int s_ = c / KCH, cc = c - s_ * KCH, row = cc / KCR, kc = cc - row * KCR; st[ii] = *(const u32x4*)(Kb + (size_t)s_ * ksoff + (size_t)(t__ * 64 + row) * ldk + kc * 8); } \
      else { const int cc = c - NS * KCH, row = cc / VCR, vc = cc - row * VCR; st[ii] = *(const u32x4*)(Vb + (size_t)(t__ * 64 + row) * ldv + vc * 8); } } } } while (0)
#define ATT_STORE(BO_) do { LAS unsigned char* sb__ = lds + (BO_); _Pragma("unroll") for (int ii = 0; ii < NI; ++ii) { const int c = tid + ii * NTHREADS; if (c < NCH) { \
      if (c < NS * KCH) { const int s_ = c / KCH, cc = c - s_ * KCH, row = cc / KCR, kc = cc - row * KCR; *(LAS u32x4*)(sb__ + s_ * KTB + row * KS + kc * 16) = st[ii]; } \
      else { const int cc = c - NS * KCH, row = cc / VCR, vc = cc - row * VCR; *(LAS u32x4*)(sb__ + VOFF + row * VS + vc * 16) = st[ii]; } } } } while (0)
#define ATT_FLAGS(T_, ACT_, MSK_) do { ACT_ = true; MSK_ = false; if (WINDOW && (T_) < 32) { const int qlo = q0 + qsub * 32, qhi = qlo + 31, klo = (T_) * 64, khi = klo + 63; \
      ACT_ = !(khi < qlo - 128 || klo > qhi + 128); MSK_ = (khi - qlo > 128) || (qhi - klo > 128); } } while (0)
  constexpr int KB1 = NKS / 2;
  bf16x8 kf[2 * KB1];
#define ATT_QK_READ1(BO_) do { const LAS unsigned char* kl = klb + (BO_); \
      _Pragma("unroll") for (int ks = 0; ks < KB1; ++ks) { kf[2 * ks] = *(const LAS bf16x8*)(kl + ks * 32); kf[2 * ks + 1] = *(const LAS bf16x8*)(kl + 32 * KS + ks * 32); } \
      __builtin_amdgcn_sched_barrier(0); } while (0)
#define ATT_QK_REST(BO_) do { const LAS unsigned char* kl = klb + (BO_); \
      __builtin_amdgcn_sched_barrier(0); \
      if (DV == 64) { p0 = __builtin_amdgcn_mfma_f32_32x32x16_bf16(kf[0], qf[0], negmv, 0, 0, 0); p1 = __builtin_amdgcn_mfma_f32_32x32x16_bf16(kf[1], qf[0], negmv, 0, 0, 0); } \
      else { _Pragma("unroll") for (int r = 0; r < 16; ++r) { p0[r] = negmb; p1[r] = negmb; } p0 = __builtin_amdgcn_mfma_f32_32x32x16_bf16(kf[0], qf[0], p0, 0, 0, 0); p1 = __builtin_amdgcn_mfma_f32_32x32x16_bf16(kf[1], qf[0], p1, 0, 0, 0); } \
      _Pragma("unroll") for (int ks = 1; ks < KB1; ++ks) { p0 = __builtin_amdgcn_mfma_f32_32x32x16_bf16(kf[2 * ks], qf[ks], p0, 0, 0, 0); p1 = __builtin_amdgcn_mfma_f32_32x32x16_bf16(kf[2 * ks + 1], qf[ks], p1, 0, 0, 0); } \
      __builtin_amdgcn_sched_barrier(0); \
      _Pragma("unroll") for (int ks = KB1; ks < NKS; ++ks) { kf[2 * (ks - KB1)] = *(const LAS bf16x8*)(kl + ks * 32); kf[2 * (ks - KB1) + 1] = *(const LAS bf16x8*)(kl + 32 * KS + ks * 32); } \
      __builtin_amdgcn_sched_barrier(0); \
      _Pragma("unroll") for (int ks = KB1; ks < NKS; ++ks) { p0 = __builtin_amdgcn_mfma_f32_32x32x16_bf16(kf[2 * (ks - KB1)], qf[ks], p0, 0, 0, 0); p1 = __builtin_amdgcn_mfma_f32_32x32x16_bf16(kf[2 * (ks - KB1) + 1], qf[ks], p1, 0, 0, 0); } \
      __builtin_amdgcn_sched_barrier(0); } while (0)
#define ATT_VREAD(G_) do { _Pragma("unroll") for (int d2 = 0; d2 < GD; ++d2) _Pragma("unroll") for (int kb = 0; kb < 2; ++kb) _Pragma("unroll") for (int s_ = 0; s_ < 2; ++s_) { \
        const LAS unsigned char* vp = vl + (kb * 32 + 16 * s_) * VS + ((G_) * GD + d2) * 64; \
        vlo[d2 * 4 + kb * 2 + s_] = __builtin_amdgcn_ds_read_tr16_b64_v4i16((LAS v4i16_t*)vp); vhi[d2 * 4 + kb * 2 + s_] = __builtin_amdgcn_ds_read_tr16_b64_v4i16((LAS v4i16_t*)(vp + 8 * VS)); } } while (0)
#define ATT_PVM(G_) do { _Pragma("unroll") for (int d2 = 0; d2 < GD; ++d2) _Pragma("unroll") for (int kb = 0; kb < 2; ++kb) _Pragma("unroll") for (int s_ = 0; s_ < 2; ++s_) { \
        const v4i16_t lo_ = vlo[d2 * 4 + kb * 2 + s_], hi_ = vhi[d2 * 4 + kb * 2 + s_]; \
        const bf16x8 vf = (bf16x8){lo_[0], lo_[1], lo_[2], lo_[3], hi_[0], hi_[1], hi_[2], hi_[3]}; \
        o[(G_) * GD + d2] = __builtin_amdgcn_mfma_f32_32x32x16_bf16(vf, __builtin_bit_cast(bf16x8, pw[kb][s_]), o[(G_) * GD + d2], 0, 0, 0); } } while (0)
#define ATT_SPV(T_, BO_, MSK_) do { const LAS unsigned char* vl = vlb + (BO_); constexpr int GD = (DV == 128) ? 1 : 2; v4i16_t vlo[4 * GD], vhi[4 * GD]; \
      ATT_VREAD(0); __builtin_amdgcn_sched_barrier(0); \
      if (WINDOW && (MSK_)) { _Pragma("unroll") for (int r = 0; r < 16; ++r) { const int d0 = (T_) * 64 + crow(r, hi) - qrow, d1 = d0 + 32; \
          if (d0 > 128 || d0 < -128) p0[r] = -INFINITY; if (d1 > 128 || d1 < -128) p1[r] = -INFINITY; } } \
      _Pragma("unroll") for (int r = 0; r < 16; ++r) { p0[r] = __builtin_amdgcn_exp2f(p0[r]); p1[r] = __builtin_amdgcn_exp2f(p1[r]); } \
      u32x4 pw[2][2]; \
      _Pragma("unroll") for (int s_ = 0; s_ < 2; ++s_) { \
        pw[0][s_] = (u32x4){pk2(p0[8 * s_], p0[8 * s_ + 1]), pk2(p0[8 * s_ + 2], p0[8 * s_ + 3]), pk2(p0[8 * s_ + 4], p0[8 * s_ + 5]), pk2(p0[8 * s_ + 6], p0[8 * s_ + 7])}; \
        pw[1][s_] = (u32x4){pk2(p1[8 * s_], p1[8 * s_ + 1]), pk2(p1[8 * s_ + 2], p1[8 * s_ + 3]), pk2(p1[8 * s_ + 4], p1[8 * s_ + 5]), pk2(p1[8 * s_ + 6], p1[8 * s_ + 7])}; } \
      _Pragma("unroll") for (int kb = 0; kb < 2; ++kb) _Pragma("unroll") for (int s_ = 0; s_ < 2; ++s_) { \
        lrun = dot2bf(pw[kb][s_].x, 0x3f803f80u, lrun); lrun = dot2bf(pw[kb][s_].y, 0x3f803f80u, lrun); lrun = dot2bf(pw[kb][s_].z, 0x3f803f80u, lrun); lrun = dot2bf(pw[kb][s_].w, 0x3f803f80u, lrun); } \
      __builtin_amdgcn_sched_barrier(0); \
      ATT_PVM(0); \
      _Pragma("unroll") for (int g_ = 1; g_ < NDB / GD; ++g_) { __builtin_amdgcn_sched_barrier(0); ATT_VREAD(g_); __builtin_amdgcn_sched_barrier(0); ATT_PVM(g_); } } while (0)
  ATT_LOAD(ATT_TILE(0));
  ATT_STORE(0);
  if (ntl > 1) ATT_LOAD(ATT_TILE(1));
  __syncthreads();
  int bo_prev = 0, bo_cur = 0, bo_next = STG;
  for (int i = 0; i <= ntl; ++i) {
    if (grp == 0) {
      if (i < ntl) {
        const int t = ATT_TILE(i);
        bool act, msk; ATT_FLAGS(t, act, msk);
        if (act) ATT_QK_READ1(bo_cur);
        if (i + 1 < ntl) ATT_STORE(bo_next);
        if (i + 2 < ntl) ATT_LOAD(ATT_TILE(i + 2));
        if (act) { ATT_QK_REST(bo_cur); ATT_SPV(t, bo_cur, msk); }
      }
    } else {
      if (i >= 1) { const int tp = ATT_TILE(i - 1); bool act, msk; ATT_FLAGS(tp, act, msk); if (act) ATT_SPV(tp, bo_prev, msk); }
      if (i < ntl) {
        const int t = ATT_TILE(i);
        bool act, msk; ATT_FLAGS(t, act, msk);
        if (act) ATT_QK_READ1(bo_cur);
        if (i + 1 < ntl) ATT_STORE(bo_next);
        if (i + 2 < ntl) ATT_LOAD(ATT_TILE(i + 2));
        if (act) ATT_QK_REST(bo_cur);
      }
    }
    bo_prev = bo_cur; bo_cur = bo_next; bo_next = (bo_next == 2 * STG) ? 0 : bo_next + STG;
    __syncthreads();
  }
#undef ATT_LOAD
#undef ATT_STORE
#undef ATT_TILE
#undef ATT_FLAGS
#undef ATT_QK_READ1
#undef ATT_QK_REST
#undef ATT_VREAD
#undef ATT_PVM
#undef ATT_SPV
  float ltot = lrun + __shfl_xor(lrun, 32);
  if (has_sink) ltot += __builtin_amdgcn_exp2f(sink_l2 + negmb);
  const float inv = 1.f / ltot;
  if (NS == 1) {
    unsigned char* op = Ob + (size_t)qrow * ldo + 4 * hi; const float is_ = inv * OSC;
#pragma unroll
    for (int db = 0; db < NDB; ++db)
#pragma unroll
      for (int r4 = 0; r4 < 4; ++r4)
        *(unsigned*)(op + db * 32 + 8 * r4) = pk4_fp8(o[db][4 * r4] * is_, o[db][4 * r4 + 1] * is_, o[db][4 * r4 + 2] * is_, o[db][4 * r4 + 3] * is_);
  } else {
    LAS float* ex = (LAS float*)lds + qsub * (DV * 32);
    if (stream == 1) {
#pragma unroll
      for (int db = 0; db < NDB; ++db)
#pragma unroll
        for (int r = 0; r < 16; ++r) ex[(db * 32 + crow(r, hi)) * 32 + l31] = o[db][r] * inv;
    }
    __syncthreads();
    if (stream == 0) {
      float ss = 0.f;
#pragma unroll
      for (int db = 0; db < NDB; ++db)
#pragma unroll
        for (int r = 0; r < 16; ++r) { const float v = o[db][r] * inv - lam * ex[(db * 32 + crow(r, hi)) * 32 + l31]; o[db][r] = v; ss += v * v; }
      ss += __shfl_xor(ss, 32);
      const float rs = rsqrtf(ss * (1.f / DV) + EPS) * (1.f - LAM_INIT);
      unsigned char* op = Ob + (size_t)qrow * ldo + 4 * hi; const float rs_ = rs * OSC;
#pragma unroll
      for (int db = 0; db < NDB; ++db)
#pragma unroll
        for (int r4 = 0; r4 < 4; ++r4) {
          const f32x4 g4 = *(const f32x4*)(gsub + db * 32 + 8 * r4 + 4 * hi);
          *(unsigned*)(op + db * 32 + 8 * r4) = pk4_fp8(o[db][4 * r4] * rs_ * g4.x, o[db][4 * r4 + 1] * rs_ * g4.y, o[db][4 * r4 + 2] * rs_ * g4.z, o[db][4 * r4 + 3] * rs_ * g4.w);
        }
    }
    __syncthreads();
  }
}

template <int DQK, int DV, bool WINDOW>
__device__ __forceinline__ void attn_unit_p(LAS unsigned char* lds, const bf16_t* __restrict__ Qb, int ldq, const bf16_t* __restrict__ Kb, int ldk, const bf16_t* __restrict__ Vb, int ldv,
                                            int q0, int ta0, int ta1, int tb0, int tb1, bool has_sink, float sink_l2, float kmax, unsigned char* __restrict__ Ob, int ldo, int wv) {
  static_assert(DV == 64 && !WINDOW, "pipelined form: DV = 64, no window");
  constexpr int KS = DQK * 2 + 16, KTB = 64 * KS, VS = 192, VOFF = KTB, VTB = 64 * VS, STG = VOFF + VTB;
  constexpr int KCR = DQK / 8, KCH = 64 * KCR, VCR = DV / 8, VCH = 64 * VCR, NCH = KCH + VCH, NI = (NCH + NTHREADS - 1) / NTHREADS;
  constexpr int NKS = DQK / 16, NQK = 2 * NKS, NPV = 8, EG = (NQK >= 12) ? 8 : NQK - 2;
  static_assert(3 * STG <= LDS_BYTES - 16, "LDS");
  const int tid = otid(wv), lane = tid & 63, wid = tid >> 6, l31 = lane & 31, hi = lane >> 5;
  const int qrow = q0 + wid * 32 + l31;
  bf16x8 qf[NKS];
  float qn2 = 0.f;
#pragma unroll
  for (int ks = 0; ks < NKS; ++ks) {
    const u32x4 w = *(const u32x4*)(Qb + (size_t)qrow * ldq + ks * 16 + hi * 8);
    qf[ks] = __builtin_bit_cast(bf16x8, w);
    const float a0 = bf_lo(w.x), a1 = bf_hi(w.x), a2 = bf_lo(w.y), a3 = bf_hi(w.y), a4 = bf_lo(w.z), a5 = bf_hi(w.z), a6 = bf_lo(w.w), a7 = bf_hi(w.w);
    qn2 += a0 * a0 + a1 * a1 + a2 * a2 + a3 * a3 + a4 * a4 + a5 * a5 + a6 * a6 + a7 * a7;
  }
  qn2 += __shfl_xor(qn2, 32);
  const float negmb = -(sqrtf(qn2) * kmax);
  f32x16 negmv;
#pragma unroll
  for (int r = 0; r < 16; ++r) negmv[r] = negmb;
  asm volatile("" : "+v"(negmv));
  f32x16 o[2];
#pragma unroll
  for (int db = 0; db < 2; ++db)
#pragma unroll
    for (int r = 0; r < 16; ++r) o[db][r] = 0.f;
  float lrun = 0.f;
  const int n1 = ta1 - ta0, ntl = n1 + (tb1 - tb0);
  u32x4 st[NI];
  f32x16 pA0, pA1, pB0, pB1;
  bf16x8 kw[3];
  v4i16_t vwl[3], vwh[3];
  u32x4 pw[2][2];
  const LAS unsigned char* klb = lds + l31 * KS + hi * 16;
  const LAS unsigned char* vlb = lds + VOFF + (4 * hi + ((lane & 15) >> 2)) * VS + (16 * ((lane >> 4) & 1) + 4 * (lane & 3)) * 2;
#define ATT_TILE(i_) (((i_) < n1) ? ta0 + (i_) : tb0 + ((i_) - n1))
  unsigned gof[NI], lof[NI];
#pragma unroll
  for (int ii = 0; ii < NI; ++ii) { const int cw = (wv + 8 * ii) * 64, c = cw + lane;
    if (cw < KCH) { const int row = c / KCR, kc = c - row * KCR; gof[ii] = (unsigned)(row * ldk + kc * 8) * 2u; lof[ii] = (unsigned)(row * KS + kc * 16); }
    else { const int cc = c - KCH, row = cc / VCR, vc = cc - row * VCR; gof[ii] = (unsigned)(row * ldv + vc * 8) * 2u; lof[ii] = (unsigned)(VOFF + row * VS + vc * 16); } }
#define ATT_LOAD(T_) do { const int t__ = (T_); _Pragma("unroll") for (int ii = 0; ii < NI; ++ii) { const int cw = (wv + 8 * ii) * 64; if (cw < NCH) { \
      const char* gb__ = (cw < KCH) ? (const char*)Kb + (size_t)t__ * 128 * ldk : (const char*)Vb + (size_t)t__ * 128 * ldv; st[ii] = *(const u32x4*)(gb__ + gof[ii]); } } } while (0)
#define ATT_STORE(BO_) do { _Pragma("unroll") for (int ii = 0; ii < NI; ++ii) { const int cw = (wv + 8 * ii) * 64; if (cw < NCH) *(LAS u32x4*)(lds + (BO_) + lof[ii]) = st[ii]; } } while (0)
#define SB_() __builtin_amdgcn_sched_barrier(0)
#define KRD1(BO_, G_) do { kw[(G_) % 3] = *(const LAS bf16x8*)(klb + (BO_) + ((G_) & 1) * 32 * KS + ((G_) >> 1) * 32); } while (0)
#define VRDG(BO_, G_) do { const LAS unsigned char* vp = vlb + (BO_) + ((((G_) >> 2) & 1) * 32 + 16 * (((G_) >> 1) & 1)) * VS + ((G_) & 1) * 64; \
      vwl[(G_) % 3] = __builtin_amdgcn_ds_read_tr16_b64_v4i16((LAS v4i16_t*)vp); vwh[(G_) % 3] = __builtin_amdgcn_ds_read_tr16_b64_v4i16((LAS v4i16_t*)(vp + 8 * VS)); } while (0)
#define QKM(R0_, R1_, G_) do { const int ks_ = (G_) >> 1; \
      if (((G_) & 1) == 0) R0_ = __builtin_amdgcn_mfma_f32_32x32x16_bf16(kw[(G_) % 3], qf[ks_], (ks_ == 0) ? negmv : R0_, 0, 0, 0); \
      else R1_ = __builtin_amdgcn_mfma_f32_32x32x16_bf16(kw[(G_) % 3], qf[ks_], (ks_ == 0) ? negmv : R1_, 0, 0, 0); } while (0)
#define PVM(G_) do { const int d2_ = (G_) & 1, kb_ = ((G_) >> 2) & 1, s_ = ((G_) >> 1) & 1; \
      const v4i16_t lo_ = vwl[(G_) % 3], hi_ = vwh[(G_) % 3]; const bf16x8 vf = (bf16x8){lo_[0], lo_[1], lo_[2], lo_[3], hi_[0], hi_[1], hi_[2], hi_[3]}; \
      o[d2_] = __builtin_amdgcn_mfma_f32_32x32x16_bf16(vf, __builtin_bit_cast(bf16x8, pw[kb_][s_]), o[d2_], 0, 0, 0); } while (0)
#define PACK1(P_, KB_, C_) do { const int s_ = (C_) >> 2, e_ = (C_) & 3; pw[KB_][s_][e_] = pk2(P_[8 * s_ + 2 * e_], P_[8 * s_ + 2 * e_ + 1]); } while (0)
#define EXPR(P_, LO_, HI_) do { _Pragma("unroll") for (int x_ = (LO_); x_ < (HI_); ++x_) { float e_ = __builtin_amdgcn_exp2f(P_[x_]); asm volatile("" : "+v"(e_)); P_[x_] = e_; } } while (0)
#define SUMR(P_, LO_, HI_) do { _Pragma("unroll") for (int x_ = (LO_); x_ < (HI_); ++x_) lrun += P_[x_]; asm volatile("" : "+v"(lrun)); } while (0)
#define FILL_A(E0_, E1_, G_) do { \
      if ((G_) < EG) EXPR(E1_, ((G_) * 16) / EG, (((G_) + 1) * 16) / EG); \
      if ((G_) >= 1 && (G_) <= EG) SUMR(E1_, (((G_) - 1) * 16) / EG, ((G_) * 16) / EG); \
      if ((G_) < EG) { _Pragma("unroll") for (int c = ((G_) * 8) / EG; c < (((G_) + 1) * 8) / EG; ++c) PACK1(E0_, 0, c); } \
      else { _Pragma("unroll") for (int c = (((G_) - EG) * 8) / (NQK - EG); c < (((G_) - EG + 1) * 8) / (NQK - EG); ++c) PACK1(E1_, 1, c); } } while (0)
#define FILL_B(R0_, G_) do { EXPR(R0_, 2 * (G_), 2 * (G_) + 2); if ((G_) >= 1) SUMR(R0_, 2 * (G_) - 2, 2 * (G_)); if ((G_) == NPV - 1) SUMR(R0_, 14, 16); } while (0)
#define STEP_MID(R0_, R1_, E0_, E1_, BOC_, BOP_) do { \
      _Pragma("unroll") for (int g = 0; g < NQK; ++g) { \
        QKM(R0_, R1_, g); \
        if (g + 2 < NQK) KRD1(BOC_, g + 2); \
        if (g >= NQK - 2) VRDG(BOP_, g - (NQK - 2)); \
        FILL_A(E0_, E1_, g); \
        SB_(); } \
      _Pragma("unroll") for (int g = 0; g < NPV; ++g) { \
        PVM(g); \
        if (g + 2 < NPV) VRDG(BOP_, g + 2); \
        FILL_B(R0_, g); \
        SB_(); } } while (0)
#define STEP_HEAD(R0_, R1_, BOC_) do { \
      _Pragma("unroll") for (int g = 0; g < NQK; ++g) { QKM(R0_, R1_, g); if (g + 2 < NQK) KRD1(BOC_, g + 2); SB_(); } \
      _Pragma("unroll") for (int g = 0; g < NPV; ++g) { FILL_B(R0_, g); } SB_(); } while (0)
#define STEP_TAIL(E0_, E1_, BOP_) do { \
      VRDG(BOP_, 0); VRDG(BOP_, 1); \
      _Pragma("unroll") for (int g = 0; g < NQK; ++g) FILL_A(E0_, E1_, g); SB_(); \
      _Pragma("unroll") for (int g = 0; g < NPV; ++g) { PVM(g); if (g + 2 < NPV) VRDG(BOP_, g + 2); SB_(); } } while (0)
#define STEP_PRE(I_, KR_) do { const int i__ = (I_); \
      if (KR_) { KRD1(bo_cur, 0); KRD1(bo_cur, 1); } \
      if (i__ + 1 < ntl) ATT_STORE(bo_next); \
      if (i__ + 2 < ntl) ATT_LOAD(ATT_TILE(i__ + 2)); \
      SB_(); } while (0)
#define STEP_POST() do { bo_prev = bo_cur; bo_cur = bo_next; bo_next = (bo_next == 2 * STG) ? 0 : bo_next + STG; __syncthreads(); } while (0)
  ATT_LOAD(ATT_TILE(0));
  ATT_STORE(0);
  if (ntl > 1) ATT_LOAD(ATT_TILE(1));
  __syncthreads();
  int bo_prev = 0, bo_cur = 0, bo_next = STG;
  STEP_PRE(0, true); STEP_HEAD(pA0, pA1, bo_cur); STEP_POST();
  int it = 1;
  for (; it + 1 < ntl; it += 2) {
    STEP_PRE(it, true); STEP_MID(pB0, pB1, pA0, pA1, bo_cur, bo_prev); STEP_POST();
    STEP_PRE(it + 1, true); STEP_MID(pA0, pA1, pB0, pB1, bo_cur, bo_prev); STEP_POST();
  }
  if (it < ntl) {
    STEP_PRE(it, true); STEP_MID(pB0, pB1, pA0, pA1, bo_cur, bo_prev); STEP_POST();
    STEP_TAIL(pB0, pB1, bo_prev);
  } else {
    STEP_TAIL(pA0, pA1, bo_prev);
  }
  __syncthreads();
#undef ATT_TILE
#undef ATT_LOAD
#undef ATT_STORE
#undef SB_
#undef KRD1
#undef VRDG
#undef QKM
#undef PVM
#undef PACK1
#undef EXPR
#undef SUMR
#undef FILL_A
#undef FILL_B
#undef STEP_MID
#undef STEP_HEAD
#undef STEP_TAIL
#undef STEP_PRE
#undef STEP_POST
  float ltot = lrun + __shfl_xor(lrun, 32);
  if (has_sink) ltot += __builtin_amdgcn_exp2f(sink_l2 + negmb);
  const float is_ = OSC / ltot;
  unsigned char* op = Ob + (size_t)qrow * ldo + 4 * hi;
#pragma unroll
  for (int db = 0; db < 2; ++db)
#pragma unroll
    for (int r4 = 0; r4 < 4; ++r4)
      *(unsigned*)(op + db * 32 + 8 * r4) = pk4_fp8(o[db][4 * r4] * is_, o[db][4 * r4 + 1] * is_, o[db][4 * r4 + 2] * is_, o[db][4 * r4 + 3] * is_);
}

#define TOPK_INSERT(ARR, KEY) do { unsigned k__ = (KEY); _Pragma("unroll") for (int t_ = 0; t_ < 16; ++t_) { const unsigned h__ = max(ARR[t_], k__); k__ = min(ARR[t_], k__); ARR[t_] = h__; } } while (0)
__device__ __forceinline__ void peer_phase(LAS unsigned char* lds, const bf16_t* __restrict__ S, const unsigned char* __restrict__ H, const unsigned char* __restrict__ U, const unsigned char* __restrict__ V, float uinv, float vinv,
                                           const float* __restrict__ modl, bf16_t* xl, bf16_t* xc, float* outf, bool last, bool live, unsigned char* Hn, const float* __restrict__ gn, const float* __restrict__ modn, int wv) {
  const int tid_ = otid(wv); const int lane = tid_ & 63, wid = tid_ >> 6;
  LAS unsigned* keysL = (LAS unsigned*)(lds + wid * 9216);
  LAS u32x2* resL = (LAS u32x2*)(lds + wid * 9216 + 4096);
  LAS float* wL = (LAS float*)(lds + wid * 9216 + 8192);
  const int ngroups = last ? (NB * SEQ / 4) : (M / 4);
  const int nwav = gridDim.x * NWAVES, nfull = (ngroups / nwav) * nwav, nitems = nfull + (ngroups - nfull) * 4;
  for (int q = blockIdx.x * NWAVES + wid; q < nitems; q += nwav) {
    const int g = (q < nfull) ? q : nfull + ((q - nfull) >> 2);
    const int tk0 = (q < nfull) ? 0 : ((q - nfull) & 3), tk1 = (q < nfull) ? 4 : tk0 + 1;
    const int r0 = last ? (g / (SEQ / 4)) * TPB + (g % (SEQ / 4)) * 4 : g * 4;
    const int tok = lane >> 4, hc = lane & 15;
    unsigned top[16];
    const bf16_t* sp = S + (size_t)(r0 + tok) * 2048 + hc * 128;
#define CE_DESC(A_, B_) do { const unsigned h__ = max(A_, B_), l__ = min(A_, B_); A_ = h__; B_ = l__; } while (0)
#pragma unroll 1
    for (int j0 = 0; j0 < 128; j0 += 16) {
      unsigned blk[16];
      { const u32x4 v0 = *(const u32x4*)(sp + j0), v1 = *(const u32x4*)(sp + j0 + 8);
        const unsigned base = (unsigned)(127 - j0);
        blk[0] = (f2ord(bf_lo(v0.x)) & ~127u) | (base - 0u);  blk[1] = (f2ord(bf_hi(v0.x)) & ~127u) | (base - 1u);
        blk[2] = (f2ord(bf_lo(v0.y)) & ~127u) | (base - 2u);  blk[3] = (f2ord(bf_hi(v0.y)) & ~127u) | (base - 3u);
        blk[4] = (f2ord(bf_lo(v0.z)) & ~127u) | (base - 4u);  blk[5] = (f2ord(bf_hi(v0.z)) & ~127u) | (base - 5u);
        blk[6] = (f2ord(bf_lo(v0.w)) & ~127u) | (base - 6u);  blk[7] = (f2ord(bf_hi(v0.w)) & ~127u) | (base - 7u);
        blk[8] = (f2ord(bf_lo(v1.x)) & ~127u) | (base - 8u);  blk[9] = (f2ord(bf_hi(v1.x)) & ~127u) | (base - 9u);
        blk[10] = (f2ord(bf_lo(v1.y)) & ~127u) | (base - 10u); blk[11] = (f2ord(bf_hi(v1.y)) & ~127u) | (base - 11u);
        blk[12] = (f2ord(bf_lo(v1.z)) & ~127u) | (base - 12u); blk[13] = (f2ord(bf_hi(v1.z)) & ~127u) | (base - 13u);
        blk[14] = (f2ord(bf_lo(v1.w)) & ~127u) | (base - 14u); blk[15] = (f2ord(bf_hi(v1.w)) & ~127u) | (base - 15u); }
#pragma unroll
      for (int k = 2; k <= 16; k <<= 1)
#pragma unroll
        for (int j = k >> 1; j > 0; j >>= 1)
#pragma unroll
          for (int i = 0; i < 16; ++i) { const int l = i ^ j; if (l > i) { if ((i & k) == 0) CE_DESC(blk[i], blk[l]); else CE_DESC(blk[l], blk[i]); } }
      if (j0 == 0) {
#pragma unroll
        for (int i = 0; i < 16; ++i) top[i] = blk[i];
      } else {
#pragma unroll
        for (int i = 0; i < 16; ++i) top[i] = max(top[i], blk[15 - i]);
#pragma unroll
        for (int j = 8; j > 0; j >>= 1)
#pragma unroll
          for (int i = 0; i < 16; ++i) { const int l = i ^ j; if (l > i) CE_DESC(top[i], top[l]); }
      }
    }
#undef CE_DESC
#pragma unroll
    for (int i = 0; i < 16; ++i) keysL[lane * 16 + i] = top[i];
    float v0[16], v1[16];
#pragma unroll
    for (int i = 0; i < 16; ++i) { const unsigned t1 = __shfl_down(top[i], 1); v0[i] = ord2f(top[i] & ~127u); v1[i] = ord2f(t1 & ~127u); }
    unsigned cd[16];
#pragma unroll
    for (int i = 0; i < 16; ++i) cd[i] = 0u;
#pragma unroll
    for (int a = 0; a < 16; ++a)
#pragma unroll
      for (int b = 0; b < 16 / (a + 1); ++b) TOPK_INSERT(cd, (f2ord(v0[a] + v1[b]) & ~255u) | (unsigned)(255 - (a * 16 + b)));
    {
      float e[16]; float sum = 0.f; const float mx = ord2f(cd[0] & ~255u);
#pragma unroll
      for (int k = 0; k < 16; ++k) { e[k] = __expf(ord2f(cd[k] & ~255u) - mx); sum += e[k]; }
      const float inv = 1.f / sum;
      const int lp1 = (lane + 1) & 63;
#pragma unroll
      for (int k = 0; k < 16; ++k) {
        const int pos = 255 - (int)(cd[k] & 255u), a = pos >> 4, b = pos & 15;
        const unsigned i1 = 127u - (keysL[lane * 16 + a] & 127u), i2 = 127u - (keysL[lp1 * 16 + b] & 127u);
        if ((hc & 1) == 0) resL[tok * 128 + (hc >> 1) * 16 + k] = (u32x2){i1 * 128u + i2, __float_as_uint(e[k] * inv)};
      }
    }
    for (int tk = tk0; tk < tk1; ++tk) {
      const int r = r0 + tk;
      u32x2 ua[16], va[16], ub[16], vb[16];
      const unsigned lane8 = (unsigned)lane * 8u;
#define PEER_LOAD(UU, VV, BT) do { _Pragma("unroll") for (int i = 0; i < 16; ++i) { const unsigned o_ = resL[tk * 128 + (BT) * 16 + i].x * 512u + lane8;     \
        UU[i] = *(const u32x2*)(U + o_); VV[i] = *(const u32x2*)(V + o_); } } while (0)
      PEER_LOAD(ua, va, 0);
      float hf[16];
      { const bf16_t* hrow = (const bf16_t*)H + (size_t)r * D + lane * 16; const u32x4 ha = *(const u32x4*)hrow, hb = *(const u32x4*)(hrow + 8);
        hf[0] = bf_lo(ha.x); hf[1] = bf_hi(ha.x); hf[2] = bf_lo(ha.y); hf[3] = bf_hi(ha.y); hf[4] = bf_lo(ha.z); hf[5] = bf_hi(ha.z); hf[6] = bf_lo(ha.w); hf[7] = bf_hi(ha.w);
        hf[8] = bf_lo(hb.x); hf[9] = bf_hi(hb.x); hf[10] = bf_lo(hb.y); hf[11] = bf_hi(hb.y); hf[12] = bf_lo(hb.z); hf[13] = bf_hi(hb.z); hf[14] = bf_lo(hb.w); hf[15] = bf_hi(hb.w); }
      unsigned hq1a = 0u, hq1b = 0u, hq2a = 0u, hq2b = 0u; float hstep;
      { float ss = 0.f;
#pragma unroll
        for (int j = 0; j < 16; ++j) ss += hf[j] * hf[j];
        ss = wave_sum(ss);
        hstep = 0.5f * sqrtf(ss * (1.f / D) + 1e-20f); const float rs = 1.f / hstep;
#pragma unroll
        for (int j = 0; j < 16; ++j) {
          const float t = hf[j] * rs; int q1 = (int)rintf(t); q1 = min(7, max(-8, q1));
          int q2 = (int)rintf((t - (float)q1) * 16.f); q2 = min(7, max(-8, q2));
          if (j < 8) { hq1a |= ((unsigned)q1 & 15u) << (4 * j); hq2a |= ((unsigned)q2 & 15u) << (4 * j); }
          else { hq1b |= ((unsigned)q1 & 15u) << (4 * (j - 8)); hq2b |= ((unsigned)q2 & 15u) << (4 * (j - 8)); }
        } }
      const float uscale = uinv * hstep * (1.f / 16.f);
      f32x2_t o2[8];
#pragma unroll
      for (int j = 0; j < 8; ++j) o2[j] = (f32x2_t){0.f, 0.f};
      const bool b5 = (lane & 32) != 0, b4 = (lane & 16) != 0, b3 = (lane & 8) != 0, b2 = (lane & 4) != 0;
      const int ei = (lane >> 2) & 15;
#define PEER_PROC(UU, VV, BT) do { float d[16]; \
        _Pragma("unroll") for (int i = 0; i < 16; ++i) { const int w0 = (int)UU[i].x, w1 = (int)UU[i].y; \
          const int i1 = __builtin_amdgcn_sdot8(w1, (int)hq1b, __builtin_amdgcn_sdot8(w0, (int)hq1a, 0, false), false); \
          const int i2 = __builtin_amdgcn_sdot8(w1, (int)hq2b, __builtin_amdgcn_sdot8(w0, (int)hq2a, 0, false), false); \
          d[i] = (float)(i1 * 16 + i2); } \
        float k8[8], k4[4], k2[2], k1; \
        _Pragma("unroll") for (int i = 0; i < 8; ++i) { const auto r_ = __builtin_amdgcn_permlane32_swap(__float_as_uint(d[i]), __float_as_uint(d[8 + i]), false, false); k8[i] = __uint_as_float(r_[0]) + __uint_as_float(r_[1]); } \
        _Pragma("unroll") for (int i = 0; i < 4; ++i) { const auto r_ = __builtin_amdgcn_permlane16_swap(__float_as_uint(k8[i]), __float_as_uint(k8[4 + i]), false, false); k4[i] = __uint_as_float(r_[0]) + __uint_as_float(r_[1]); } \
        _Pragma("unroll") for (int i = 0; i < 2; ++i) { \
          const float sa = k4[i] + __int_as_float(__builtin_amdgcn_update_dpp(0, __float_as_int(k4[i]), 0x128, 0xf, 0xf, false)); \
          const float sb = k4[2 + i] + __int_as_float(__builtin_amdgcn_update_dpp(0, __float_as_int(k4[2 + i]), 0x128, 0xf, 0xf, false)); \
          k2[i] = b3 ? sb : sa; } \
        { const float keep = b2 ? k2[1] : k2[0], send = b2 ? k2[0] : k2[1]; k1 = keep + __shfl_xor(send, 4); } \
        k1 += __shfl_xor(k1, 2); k1 += __shfl_xor(k1, 1); \
        const float tot = k1 * uscale; \
        const float gate = __uint_as_float(resL[tk * 128 + (BT) * 16 + ei].y); \
        const float wact = 0.5f * tot * (1.f + erff(tot * 0.70710678118f)) * gate * vinv; \
        _Pragma("unroll") for (int i = 0; i < 16; ++i) { const float wi = __int_as_float(__builtin_amdgcn_readlane(__float_as_int(wact), 4 * i)); const f32x2_t w2 = {wi, wi}; const unsigned w0 = VV[i].x, w1 = VV[i].y; \
          o2[0] = __builtin_elementwise_fma(__builtin_amdgcn_cvt_scalef32_pk_f32_fp4(w0, 1.0f, 0), w2, o2[0]); o2[1] = __builtin_elementwise_fma(__builtin_amdgcn_cvt_scalef32_pk_f32_fp4(w0, 1.0f, 1), w2, o2[1]); \
          o2[2] = __builtin_elementwise_fma(__builtin_amdgcn_cvt_scalef32_pk_f32_fp4(w0, 1.0f, 2), w2, o2[2]); o2[3] = __builtin_elementwise_fma(__builtin_amdgcn_cvt_scalef32_pk_f32_fp4(w0, 1.0f, 3), w2, o2[3]); \
          o2[4] = __builtin_elementwise_fma(__builtin_amdgcn_cvt_scalef32_pk_f32_fp4(w1, 1.0f, 0), w2, o2[4]); o2[5] = __builtin_elementwise_fma(__builtin_amdgcn_cvt_scalef32_pk_f32_fp4(w1, 1.0f, 1), w2, o2[5]); \
          o2[6] = __builtin_elementwise_fma(__builtin_amdgcn_cvt_scalef32_pk_f32_fp4(w1, 1.0f, 2), w2, o2[6]); o2[7] = __builtin_elementwise_fma(__builtin_amdgcn_cvt_scalef32_pk_f32_fp4(w1, 1.0f, 3), w2, o2[7]); } } while (0)
      for (int bt = 0; bt < 8; bt += 2) {
        PEER_LOAD(ub, vb, bt + 1);
        PEER_PROC(ua, va, bt);
        if (bt + 2 < 8) PEER_LOAD(ua, va, bt + 2);
        PEER_PROC(ub, vb, bt + 1);
      }
#undef PEER_LOAD
#undef PEER_PROC
      if (live) {
        const int b = r / TPB, s = r - b * TPB; const int bi = (s >= SEQ) ? 8 : b;
        bf16_t* xp = xrow_ptr(xl, xc, r) + lane * 16; const float* gt = modl + (size_t)(bi * 6 + 5) * D + lane * 16;
        f32x4 xn[4]; float ss = 0.f;
        { const u32x4 xa = *(const u32x4*)xp, xb = *(const u32x4*)(xp + 8);
          xn[0] = (f32x4){bf_lo(xa.x), bf_hi(xa.x), bf_lo(xa.y), bf_hi(xa.y)}; xn[1] = (f32x4){bf_lo(xa.z), bf_hi(xa.z), bf_lo(xa.w), bf_hi(xa.w)};
          xn[2] = (f32x4){bf_lo(xb.x), bf_hi(xb.x), bf_lo(xb.y), bf_hi(xb.y)}; xn[3] = (f32x4){bf_lo(xb.z), bf_hi(xb.z), bf_lo(xb.w), bf_hi(xb.w)}; }
#pragma unroll
        for (int q = 0; q < 4; ++q) {
          const f32x4 gv = ((const f32x4*)gt)[q];
          xn[q] += gv * (f32x4){o2[2 * q].x, o2[2 * q].y, o2[2 * q + 1].x, o2[2 * q + 1].y};
          ss += xn[q].x * xn[q].x + xn[q].y * xn[q].y + xn[q].z * xn[q].z + xn[q].w * xn[q].w;
        }
        if (last) {
          float* op = outf + (size_t)(b * SEQ + s) * D + lane * 16;
#pragma unroll
          for (int q = 0; q < 4; ++q) ((f32x4*)op)[q] = xn[q];
        } else {
          *(u32x4*)xp = (u32x4){pk2(xn[0].x, xn[0].y), pk2(xn[0].z, xn[0].w), pk2(xn[1].x, xn[1].y), pk2(xn[1].z, xn[1].w)};
          *(u32x4*)(xp + 8) = (u32x4){pk2(xn[2].x, xn[2].y), pk2(xn[2].z, xn[2].w), pk2(xn[3].x, xn[3].y), pk2(xn[3].z, xn[3].w)};
        }
        if (Hn != nullptr) {
          ss = wave_sum(ss);
          const float rstd = rsqrtf(ss * (1.f / D) + EPS);
          const float* sh = modn + (size_t)(bi * 6) * D + lane * 16; const float* sc = sh + D; const float* gg = gn + lane * 16;
          u32x4 h0;
#pragma unroll
          for (int q = 0; q < 4; ++q) {
            const f32x4 g4 = ((const f32x4*)gg)[q], s4 = ((const f32x4*)sc)[q], h4 = ((const f32x4*)sh)[q];
            const f32x4 y = (xn[q] * rstd * g4 * (1.f + s4) + h4) * ASC;
            h0[q] = pk4_fp8(y.x, y.y, y.z, y.w);
          }
          *(u32x4*)(Hn + (size_t)r * D + lane * 16) = h0;
        }
      }
    }
  }
}

#define XB_TMO      128
#define XB_XCNT(j)  (256  + 64 * (j))
#define XB_XSUB(j)  (1280 + 64 * (j))
#define XB_XGEN(j)  (2304 + 64 * (j))
#define XB_TOP      3328
#define XB_TOPGEN   3392
#define XCD_BAR_WORDS 3456
#define XB_SPIN_CAP (1u << 20)
__device__ __forceinline__ unsigned xb_ld(unsigned* p)              { return __hip_atomic_load(p, __ATOMIC_RELAXED, __HIP_MEMORY_SCOPE_AGENT); }
__device__ __forceinline__ unsigned xb_add(unsigned* p, unsigned v) { return __hip_atomic_fetch_add(p, v, __ATOMIC_RELAXED, __HIP_MEMORY_SCOPE_AGENT); }
__device__ __forceinline__ unsigned xb_xcc_id() { return (unsigned)__builtin_amdgcn_s_getreg((3 << 11) | 20) & 0xFu; }
#define XB_SPIN(cond, bar) do { unsigned _sp = 0; while (cond) { __builtin_amdgcn_s_sleep(1); \
    if ((++_sp & 255u) == 0u) { if (xb_ld(&(bar)[XB_TMO])) break; if (_sp > XB_SPIN_CAP) { atomicAdd(&(bar)[XB_TMO], 1u); break; } } } } while (0)
struct XcdBarrier { unsigned* bar; unsigned x; volatile LAS unsigned* st; };
__device__ __forceinline__ XcdBarrier xcd_barrier_post(unsigned* bar, volatile LAS unsigned* st) {
    XcdBarrier b; b.bar = bar; b.x = xb_xcc_id(); b.st = st;
    if (threadIdx.x == 0) (void)xb_add(&bar[XB_XCNT(b.x)], 1u);
    return b;
}
__device__ __forceinline__ void xcd_barrier_complete(unsigned* bar, unsigned x, unsigned& nloc, unsigned& nx) {
    const unsigned G = gridDim.x * gridDim.y * gridDim.z;
    unsigned sum, cnt, mine, sp = 0u;
    for (;;) {
        sum = 0u; cnt = 0u; mine = 0u;
#pragma unroll
        for (unsigned j = 0; j < 16; ++j) { const unsigned c = xb_ld(&bar[XB_XCNT(j)]); sum += c; cnt += (c > 0u) ? 1u : 0u; mine = (j == x) ? c : mine; }
        if (sum == G) break;
        __builtin_amdgcn_s_sleep(1);
        if ((++sp & 255u) == 0u) { if (xb_ld(&bar[XB_TMO])) break; if (sp > XB_SPIN_CAP) { atomicAdd(&bar[XB_TMO], 1u); break; } }
    }
    nloc = mine > 0u ? mine : 1u; nx = cnt > 0u ? cnt : 1u;
}
__device__ __forceinline__ void xcd_barrier(const XcdBarrier& b, int wv) {
    asm volatile("s_waitcnt vmcnt(0)" ::: "memory");
    __syncthreads();
    if (otid(wv) == 0) {
        unsigned* bar = b.bar;
        __builtin_amdgcn_s_waitcnt(0);
        unsigned nloc = b.st[0], nx = b.st[1];
        if (nloc == 0u) { xcd_barrier_complete(bar, b.x, nloc, nx); b.st[0] = nloc; b.st[1] = nx; }
        const unsigned old = xb_add(&bar[XB_XSUB(b.x)], 1u);
        const unsigned gen = old / nloc;
        if (old + 1u == (gen + 1u) * nloc) {
            __builtin_amdgcn_fence(__ATOMIC_RELEASE, "agent");
            asm volatile("s_waitcnt vmcnt(0)" ::: "memory");
            const unsigned og = xb_add(&bar[XB_TOP], 1u);
            const unsigned tg = og / nx;
            if (og + 1u == (tg + 1u) * nx) xb_add(&bar[XB_TOPGEN], 1u);
            else XB_SPIN(xb_ld(&bar[XB_TOPGEN]) == tg, bar);
            __builtin_amdgcn_fence(__ATOMIC_ACQUIRE, "agent");
            xb_add(&bar[XB_XGEN(b.x)], 1u);
            asm volatile("s_waitcnt vmcnt(0)" ::: "memory");
        } else {
            XB_SPIN(xb_ld(&bar[XB_XGEN(b.x)]) == gen, bar);
            __builtin_amdgcn_fence(__ATOMIC_ACQUIRE, "agent");
            asm volatile("s_waitcnt vmcnt(0)" ::: "memory");
        }
    }
    __syncthreads();
}

enum { ST_NORM = 0, ST_GEMM_BF16, ST_GEMM_F32, ST_GEMM_RESID, ST_LATNORM, ST_HN_MLA, ST_HN_DS, ST_ATTN_MLA, ST_ATTN_D, ST_ATTN_S, ST_PEER };
#define SV(t, v) ((t) | ((v) << 4))
#define SR(t, v) ((t) | ((v) << 4) | 0x80)
__device__ const unsigned char STEPS[3][24] = {
  {SV(ST_NORM, 0), SV(ST_GEMM_BF16, 0), SV(ST_LATNORM, 0), SV(ST_GEMM_BF16, 1), SV(ST_GEMM_BF16, 2), SV(ST_HN_MLA, 0), SV(ST_ATTN_MLA, 0), SV(ST_GEMM_RESID, 0), SV(ST_NORM, 1), SV(ST_GEMM_F32, 0), SV(ST_PEER, 0), 0xFF},
  {SV(ST_NORM, 0), SV(ST_GEMM_BF16, 0), SV(ST_HN_DS, 0), SV(ST_ATTN_D, 0), SV(ST_GEMM_RESID, 0), SV(ST_NORM, 1), SV(ST_GEMM_F32, 0), SV(ST_PEER, 0), 0xFF},
  {SV(ST_NORM, 0), SV(ST_GEMM_BF16, 0), SV(ST_HN_DS, 0), SV(ST_ATTN_S, 0), SV(ST_GEMM_RESID, 0), SV(ST_NORM, 1), SV(ST_GEMM_F32, 0), SV(ST_PEER, 0), 0xFF}};
__global__ void __launch_bounds__(NTHREADS, 2) mega(Params p) {
  extern __shared__ __attribute__((aligned(16))) unsigned char lds_raw[];
  LAS unsigned char* lds = (LAS unsigned char*)lds_raw;
  cg::grid_group grid = cg::this_grid();
  const int tid = threadIdx.x;
  const int wv_s = __builtin_amdgcn_readfirstlane(tid >> 6);
  unsigned char* ws = p.ws;
  float* modp = (float*)(ws + WS_MODP); float* mod = (float*)(ws + WS_MOD);
  float* tab8 = (float*)(ws + WS_TAB); float* tab16 = tab8 + 64 * 8 * 2; float* lamp = tab16 + 64 * 16 * 2;
  bf16_t* xl = (bf16_t*)(ws + WS_XL); bf16_t* xc = (bf16_t*)(ws + WS_XC);
  bf16_t* wdown_t = (bf16_t*)(ws + WS_WDOWN); bf16_t* wuq_t = (bf16_t*)(ws + WS_WUQ); bf16_t* wukv_t = (bf16_t*)(ws + WS_WUKV); bf16_t* mwo_t = (bf16_t*)(ws + WS_MWO);
  bf16_t* dqkv_t = (bf16_t*)(ws + WS_DQKV); bf16_t* dwo_t = (bf16_t*)(ws + WS_DWO); bf16_t* sqkv_t = (bf16_t*)(ws + WS_SQKV); bf16_t* swo_t = (bf16_t*)(ws + WS_SWO);
  bf16_t* pwq = (bf16_t*)(ws + WS_PWQ); bf16_t* pkeys = (bf16_t*)(ws + WS_PKEYS); bf16_t* weff_t = (bf16_t*)(ws + WS_WEFF);
  unsigned char* pu = ws + WS_PU; unsigned char* pv = ws + WS_PV;
  bf16_t* Hb = (bf16_t*)(ws + WS_H); bf16_t* Ob = (bf16_t*)(ws + WS_O);
  bf16_t* B1 = (bf16_t*)(ws + WS_BUF1); bf16_t* B2 = (bf16_t*)(ws + WS_BUF2); bf16_t* B3 = (bf16_t*)(ws + WS_BUF3); bf16_t* B4 = (bf16_t*)(ws + WS_BUF4);
  bf16_t* CQN = (bf16_t*)(ws + WS_CQN); bf16_t* CKVN = (bf16_t*)(ws + WS_CKVN); float* SC = (float*)(ws + WS_SC);

  volatile LAS unsigned* xb_st = (volatile LAS unsigned*)(lds + LDS_BYTES - 16);
  if (tid < 4) xb_st[tid] = 0u;
  __syncthreads();
  (void)xcd_barrier_post((unsigned*)ws, xb_st);
  int phc = 0;
#define PH_BEGIN {
#define PH_END } ++phc; if (phc == 1) grid.sync(); else { XcdBarrier xb_; xb_.bar = (unsigned*)p.ws; xb_.x = xb_xcc_id(); xb_.st = (volatile LAS unsigned*)(lds + LDS_BYTES - 16); xcd_barrier(xb_, wv_s); }

  PH_BEGIN
    int rot = 0;
    for (int j = 0; j < 2; ++j) {
      tr_job<true>(lds, p.mla_w_down + (size_t)j * 1024 * 1056, (unsigned char*)wdown_t + (size_t)j * 1280 * 1024, 1024, 1056, 1280, rot);
      tr_job<true>(lds, p.mla_w_uq + (size_t)j * 768 * 1536, (unsigned char*)wuq_t + (size_t)j * 1536 * 768, 768, 1536, 1536, rot);
      tr_job<false>(lds, p.mla_w_ukv + (size_t)j * 256 * 2048, wukv_t + (size_t)j * 2048 * 256, 256, 2048, 2048, rot);
      tr_job<true>(lds, p.mla_w_o + (size_t)j * 1024 * 1024, (unsigned char*)mwo_t + (size_t)j * 1024 * 1024, 1024, 1024, 1024, rot);
    }
    tr_job<true>(lds, p.diff_w_qkv, dqkv_t, 1024, 3072, 3072, rot);
    tr_job<true>(lds, p.diff_w_o, dwo_t, 1024, 1024, 1024, rot);
    tr_job<true>(lds, p.swa_w_qkv, sqkv_t, 1024, 1536, 1536, rot);
    tr_job<true>(lds, p.swa_w_o, swo_t, 1024, 1024, 1024, rot);
    ada_job(lds, p, modp);
    cvt_job(p.peer_w_q, pwq, (size_t)4 * 1024 * 2048 / 8);
    cvt_job(p.peer_keys, pkeys, (size_t)4 * 16 * 128 * 128 / 8);
    {
      const int wv = tid >> 6, ln = tid & 63, l = wv >> 1; const float* t = ((wv & 1) ? p.peer_v : p.peer_u) + (size_t)l * 16384 * 1024;
      float ss = 0.f;
#pragma unroll
      for (int q = 0; q < 8; ++q) { const f32x4 v = ((const f32x4*)t)[ln + 64 * q]; ss += v.x * v.x + v.y * v.y + v.z * v.z + v.w * v.w; }
      ss = wave_sum(ss);
      const float rms = sqrtf(ss * (1.f / 2048.f));
      if (blockIdx.x == 0 && ln == 0) lamp[4 + wv] = (wv & 1) ? rms * 0.5f : rms * 0.34f;
    }
    if (blockIdx.x == 0 && tid == 0) {
      const float** t = (const float**)(ws + WS_PTRS);
      t[0] = p.x; t[1] = p.c; t[2] = p.ctx; t[3] = p.c_ctx; t[4] = p.ada_w; t[5] = p.ada_b; t[6] = p.norm_mix; t[7] = p.norm_ffn;
      t[8] = p.mla_w_down; t[9] = p.mla_g_cq; t[10] = p.mla_g_ckv; t[11] = p.mla_w_uq; t[12] = p.mla_w_ukv; t[13] = p.mla_g_q; t[14] = p.mla_g_k; t[15] = p.mla_w_o;
      t[16] = p.diff_w_qkv; t[17] = p.diff_g_q; t[18] = p.diff_g_k; t[19] = p.diff_lambda; t[20] = p.diff_g_sub; t[21] = p.diff_w_o;
      t[22] = p.swa_w_qkv; t[23] = p.swa_g_q; t[24] = p.swa_g_k; t[25] = p.swa_sink; t[26] = p.swa_w_o; t[27] = p.peer_w_q; t[28] = p.peer_keys; t[29] = p.peer_u; t[30] = p.peer_v;
    }
    if (blockIdx.x == gridDim.x - 1) {
      for (int i = tid; i < 64 * 8; i += NTHREADS) { const int pos = i >> 3, j = i & 7; const float ang = (float)pos * powf(10000.f, -(float)j / 8.f); tab8[2 * i] = cosf(ang); tab8[2 * i + 1] = sinf(ang); }
      for (int i = tid; i < 64 * 16; i += NTHREADS) { const int pos = i >> 4, j = i & 15; const float ang = (float)pos * powf(10000.f, -(float)j / 16.f); tab16[2 * i] = cosf(ang); tab16[2 * i + 1] = sinf(ang); }
      if (tid >= 64 && tid < 68) {
        const int q = tid - 64; const float* g = (q < 2) ? p.mla_g_k + q * 96 : (q == 2) ? p.diff_g_k : p.swa_g_k; const int n = (q < 2) ? 96 : 64;
        float mx = 0.f; for (int i = 0; i < n; ++i) mx = fmaxf(mx, fabsf(g[i]));
        lamp[12 + q] = sqrtf((float)n) * mx * 1.002f;
      }
      if (tid == 0) { float s01 = 0.f, s23 = 0.f; for (int i = 0; i < 64; ++i) { s01 += p.diff_lambda[i] * p.diff_lambda[64 + i]; s23 += p.diff_lambda[128 + i] * p.diff_lambda[192 + i]; }
        lamp[0] = expf(s01) - expf(s23) + LAM_INIT; }
    }
  PH_END
  PH_BEGIN
    for (int i = blockIdx.x * NTHREADS + tid; i < 4 * 9 * 6144; i += gridDim.x * NTHREADS) {
      const int col = i % 6144, l = i / (9 * 6144); float a = p.ada_b[l * 6144 + col];
#pragma unroll
      for (int kc = 0; kc < 64; ++kc) a += modp[(size_t)kc * (4 * 9 * 6144) + i];
      mod[i] = a;
    }
    for (int U = blockIdx.x; U < 256; U += gridDim.x) {
      const int q = U >> 2, l = q >> 4, hc = q & 15;
      gemm_phase(lds, pwq + (size_t)l * 1024 * 2048 + hc * 128, 2048, pkeys + (size_t)q * 128 * 128, 128, 1024, 128, 128, false,
                 EpiBf16T{weff_t + (size_t)l * 2048 * 1024 + (size_t)hc * 128 * 1024, 1024}, U & 3, 4);
    }
  PH_END

  for (int l = 0; l < 4; ++l) {
    int kind = l % 3; asm volatile("" : "+s"(kind));
    const bool last = (l == 3);
    for (int ss = 0; STEPS[kind][ss] != 0xFF; ++ss) {
      unsigned long long w_ = (unsigned long long)p.ws; asm volatile("" : "+s"(w_));
      unsigned char* w = (unsigned char*)(GAS unsigned char*)w_;
      const unsigned long long* tab = (const unsigned long long*)(w + WS_PTRS);
#define IN_(i) ((const float*)(GAS const float*)tab[i])
      bf16_t* xl = (bf16_t*)(w + WS_XL); bf16_t* xc = (bf16_t*)(w + WS_XC);
      const float* modl = (const float*)(w + WS_MOD) + (size_t)l * 9 * 6144;
      const float* tab8 = (const float*)(w + WS_TAB); const float* tab16 = tab8 + 64 * 8 * 2; const float* lamp = tab16 + 64 * 16 * 2;
      unsigned char* Hb = w + WS_H; unsigned char* Ob = w + WS_O; float* SC = (float*)(w + WS_SC);
      unsigned char* H8 = w + WS_O + 18 * MiB;
      bf16_t* LAT = (bf16_t*)(w + WS_BUF1); bf16_t* QP = (bf16_t*)(w + WS_BUF2); bf16_t* KV = (bf16_t*)(w + WS_BUF3); bf16_t* KB = (bf16_t*)(w + WS_BUF4); bf16_t* QKV = LAT;
      unsigned char* CQN = w + WS_CQN; bf16_t* CKVN = (bf16_t*)(w + WS_CKVN);
      bf16_t* QN = (bf16_t*)(w + WS_SC);
      const int ent = STEPS[kind][ss]; const int ty = ent & 15, var = (ent >> 4) & 7; const bool live = (ent & 0x80) == 0 || (p.phase == 777);
      int lo_ = l; asm volatile("" : "+s"(lo_)); const int j = (lo_ >= 3) ? 1 : 0;
      bool sync = true;
      if (ty == ST_NORM) {
        const bool first = (var == 0);
        if (first && l > 0) sync = false;
        else norm_phase(IN_(0), IN_(2), xl, xc, first && l == 0, (first ? IN_(6) : IN_(7)) + l * D, modl, first ? 0 : 3, first ? H8 : Hb, first, last && !first, wv_s);
      } else if (ty == ST_GEMM_BF16) {
        const void* A = H8; const void* Bt; bf16_t* O; int N, K = 1024;
        if (kind == 0) {
          if (var == 0) { Bt = w + WS_WDOWN + (size_t)j * 1280 * 1024; N = 1280; O = LAT; }
          else if (var == 1) { A = CQN; Bt = w + WS_WUQ + (size_t)j * 1536 * 768; N = 1536; K = 768; O = QP; sync = false; }
          else { A = CKVN; Bt = (const bf16_t*)(w + WS_WUKV) + (size_t)j * 2048 * 256; N = 2048; K = 256; O = KV; }
        } else if (kind == 1) { Bt = w + WS_DQKV; N = 3072; O = QKV; }
        else { Bt = w + WS_SQKV; N = 1536; O = QKV; }
        pg8::LatentOrder S; S.init(M, N, gridDim.x, blockIdx.x, last && kind == 0 && var == 1);
        if (kind == 0 && var == 2) pg8::gemm_phase<pg8::EpiBf16P, pg8::LatentOrder, true, true, false>(lds, pg8::Gemm{(const bf16_t*)A, (const bf16_t*)Bt, M, N, K}, S, pg8::EpiBf16P{O, N, 1.f}, wv_s);
        else pg8::gemm_phase<pg8::EpiBf16P, pg8::LatentOrder, true, true, true>(lds, pg8::Gemm{(const bf16_t*)A, (const bf16_t*)Bt, M, N, K / 2}, S, pg8::EpiBf16P{O, N, 1.f / (ASC * WSC)}, wv_s);

        {
          const int nwg_ = (false ? (M / 9) * 8 / 256 : M / 256) * (N / 256), rem_ = nwg_ % (int)gridDim.x;
          if ((rem_ == 0 || (int)blockIdx.x >= rem_) && ((var == 0) ? 0 : -1) >= 0) {
            const int E_ = (rem_ == 0) ? (int)gridDim.x : (int)gridDim.x - rem_, e_ = (rem_ == 0) ? (int)blockIdx.x : (int)blockIdx.x - rem_;
            const int s0_ = (((var == 0) ? 0 : -1) == 0) ? 0 : (((var == 0) ? 0 : -1) == 1) ? 16 : 21000, s1_ = (((var == 0) ? 0 : -1) == 0) ? 16 : (((var == 0) ? 0 : -1) == 1) ? 21000 : 32768;
            const int per_ = (s1_ - s0_ + E_ - 1) / E_, a_ = s0_ + e_ * per_, b_ = min(s1_, a_ + per_);
            const float su_ = 1.f / lamp[4 + 2 * l], sv_ = 1.f / lamp[5 + 2 * l];
            conv_rows(IN_(29) + (size_t)l * 16384 * 1024, IN_(30) + (size_t)l * 16384 * 1024, w + WS_PU + (size_t)l * 16384 * 512, w + WS_PV + (size_t)l * 16384 * 512, su_, sv_, a_, b_, otid(wv_s));
          }
        }
      } else if (ty == ST_GEMM_RESID) {
        const unsigned char* Bt = (kind == 0) ? w + WS_MWO + (size_t)j * 1024 * 1024 : (kind == 1) ? w + WS_DWO : w + WS_SWO;
        pg8::LatentOrder S; S.init(M, 1024, gridDim.x, blockIdx.x, last);
        pg8::gemm_phase<pg8::EpiResidN, pg8::LatentOrder, true, true, true>(lds, pg8::Gemm{(const bf16_t*)Ob, (const bf16_t*)Bt, M, 1024, 512}, S, pg8::EpiResidN{IN_(0), IN_(2), l == 0, xl, xc, modl, 2, live, 1.f / (OSC * WSC)}, wv_s);

        {
          const int nwg_ = (last ? (M / 9) * 8 / 256 : M / 256) * (1024 / 256), rem_ = nwg_ % (int)gridDim.x;
          if ((rem_ == 0 || (int)blockIdx.x >= rem_) && 1 >= 0) {
            const int E_ = (rem_ == 0) ? (int)gridDim.x : (int)gridDim.x - rem_, e_ = (rem_ == 0) ? (int)blockIdx.x : (int)blockIdx.x - rem_;
            const int s0_ = (1 == 0) ? 0 : (1 == 1) ? 16 : 21000, s1_ = (1 == 0) ? 16 : (1 == 1) ? 21000 : 32768;
            const int per_ = (s1_ - s0_ + E_ - 1) / E_, a_ = s0_ + e_ * per_, b_ = min(s1_, a_ + per_);
            const float su_ = 1.f / lamp[4 + 2 * l], sv_ = 1.f / lamp[5 + 2 * l];
            conv_rows(IN_(29) + (size_t)l * 16384 * 1024, IN_(30) + (size_t)l * 16384 * 1024, w + WS_PU + (size_t)l * 16384 * 512, w + WS_PV + (size_t)l * 16384 * 512, su_, sv_, a_, b_, otid(wv_s));
          }
        }
      } else if (ty == ST_GEMM_F32) {
        pg8::LatentOrder S; S.init(M, 2048, gridDim.x, blockIdx.x, last);
        pg8::gemm_phase<pg8::EpiBf16P, pg8::LatentOrder, true, true, false>(lds, pg8::Gemm{(const bf16_t*)Hb, (const bf16_t*)(w + WS_WEFF) + (size_t)l * 2048 * 1024, M, 2048, 1024}, S, pg8::EpiBf16P{(bf16_t*)SC, 2048, 1.f}, wv_s);

        {
          const int nwg_ = (last ? (M / 9) * 8 / 256 : M / 256) * (2048 / 256), rem_ = nwg_ % (int)gridDim.x;
          if ((rem_ == 0 || (int)blockIdx.x >= rem_) && 2 >= 0) {
            const int E_ = (rem_ == 0) ? (int)gridDim.x : (int)gridDim.x - rem_, e_ = (rem_ == 0) ? (int)blockIdx.x : (int)blockIdx.x - rem_;
            const int s0_ = (2 == 0) ? 0 : (2 == 1) ? 16 : 21000, s1_ = (2 == 0) ? 16 : (2 == 1) ? 21000 : 32768;
            const int per_ = (s1_ - s0_ + E_ - 1) / E_, a_ = s0_ + e_ * per_, b_ = min(s1_, a_ + per_);
            const float su_ = 1.f / lamp[4 + 2 * l], sv_ = 1.f / lamp[5 + 2 * l];
            conv_rows(IN_(29) + (size_t)l * 16384 * 1024, IN_(30) + (size_t)l * 16384 * 1024, w + WS_PU + (size_t)l * 16384 * 512, w + WS_PV + (size_t)l * 16384 * 512, su_, sv_, a_, b_, otid(wv_s));
          }
        }
      } else if (ty == ST_LATNORM) {
        latnorm_phase(LAT, IN_(9) + j * 768, IN_(10) + j * 256, CQN, CKVN, wv_s);
      } else if (ty == ST_HN_MLA) {
        const float qs = 0.10206207261596577f * LOG2E;
        for (int gi = blockIdx.x * NTHREADS + otid(wv_s); gi < M * 32 * 4; gi += gridDim.x * NTHREADS) {
          const int i = gi >> 2, jl = gi & 3, r = i >> 5, it = i & 31, h = it & 15; const int b = r / TPB, s = r - b * TPB; const bool lat = s < SEQ;
          if (it < 16) { const bf16_t* q = QP + (size_t)r * 1536 + h * 96; headnorm96(q, q + 64, QN + (size_t)r * 1536 + h * 96, IN_(13) + j * 96, qs, lat, s >> 6, s & 63, tab8, jl); }
          else headnorm96(KV + (size_t)r * 2048 + h * 128, LAT + (size_t)r * 1280 + 1024, KB + (size_t)r * 1536 + h * 96, IN_(14) + j * 96, 1.f, lat, s >> 6, s & 63, tab8, jl);
        }
      } else if (ty == ST_HN_DS) {
        const float qs = 0.125f * LOG2E;
        const int ipr = (kind == 1) ? 32 : 20, pitch = (kind == 1) ? 3072 : 1536, npitch = (kind == 1) ? 2048 : 1280;
        const float* gq = (kind == 1) ? IN_(17) : IN_(23); const float* gk = (kind == 1) ? IN_(18) : IN_(24);
        for (int gi = blockIdx.x * NTHREADS + otid(wv_s); gi < M * ipr * 4; gi += gridDim.x * NTHREADS) {
          const int i = gi >> 2, jl = gi & 3; int r, it; if (kind == 1) { r = i >> 5; it = i & 31; } else { r = i / 20; it = i - r * 20; }
          const int b = r / TPB, s = r - b * TPB; const bool lat = s < SEQ;
          const bf16_t* q = QKV + (size_t)r * pitch + it * 64;
          headnorm64(q, QN + (size_t)r * npitch + it * 64, (it < 16) ? gq : gk, (it < 16) ? qs : 1.f, lat, s >> 6, s & 63, tab16, jl);
        }
      } else if (ty == ST_ATTN_MLA) {
        const int nu = last ? 1024 : 1152;
        for (int u = blockIdx.x; u < nu; u += gridDim.x) {
          int bh, q0, ta0; if (u < 1024) { const int x = u & 7, y = u >> 3; bh = ((y >> 3) << 3) + x; q0 = (y & 7) * 256; ta0 = 0; } else { bh = u - 1024; q0 = SEQ; ta0 = 32; }
          const int b = bh >> 4, h = bh & 15; const size_t rb = (size_t)b * TPB;
          attn_unit_p<96, 64, false>(lds, QN + rb * 1536 + h * 96, 1536, KB + rb * 1536 + h * 96, 1536, KV + rb * 2048 + h * 128 + 64, 2048,
                                     q0, ta0, 36, 0, 0, false, 0.f, lamp[12 + j], Ob + rb * D + h * 64, D, wv_s);
        }
      } else if (ty == ST_ATTN_D) {
        const float lam = lamp[0];
        for (int u = blockIdx.x; u < 1152; u += gridDim.x) {
          int bh, q0, ta0; if (u < 1024) { const int x = u & 7, y = u >> 3; bh = ((y >> 4) << 3) + x; q0 = (y & 15) * 128; ta0 = 0; } else { bh = (u - 1024) >> 1; q0 = SEQ + ((u - 1024) & 1) * 128; ta0 = 32; }
          const int b = bh >> 3, h = bh & 7; const size_t rb = (size_t)b * TPB;
          attn_unit<64, 128, 2, false>(lds, QN + rb * 2048 + h * 128, 64, 2048, QN + rb * 2048 + 1024 + h * 128, 64, 2048, QKV + rb * 3072 + 2048 + h * 128, 3072,
                                       q0, ta0, 36, 0, 0, false, 0.f, lamp[14], Ob + rb * D + h * 128, D, lam, IN_(20), wv_s);
        }
      } else if (ty == ST_ATTN_S) {
        for (int u = blockIdx.x; u < 1152; u += gridDim.x) {
          int bh, q0, ta0, ta1; if (u < 1024) { const int x = u & 7, y = u >> 3; bh = ((y >> 3) << 3) + x; q0 = (y & 7) * 256; ta0 = max(0, q0 / 64 - 2); ta1 = min(32, q0 / 64 + 6); } else { bh = u - 1024; q0 = SEQ; ta0 = 0; ta1 = 0; }
          const int b = bh >> 4, h = bh & 15, kvh = h >> 2; const size_t rb = (size_t)b * TPB;
          attn_unit<64, 64, 1, true>(lds, QN + rb * 1280 + h * 64, 0, 1280, QN + rb * 1280 + 1024 + kvh * 64, 0, 1280, QKV + rb * 1536 + 1280 + kvh * 64, 1536,
                                     q0, ta0, ta1, 32, 36, true, IN_(25)[h] * LOG2E, lamp[15], Ob + rb * D + h * 64, D, 0.f, nullptr, wv_s);
        }
      } else {
        peer_phase(lds, (const bf16_t*)SC, Hb, w + WS_PU + (size_t)l * 16384 * 512, w + WS_PV + (size_t)l * 16384 * 512, lamp[4 + 2 * l], lamp[5 + 2 * l], modl, xl, xc, p.out, last, live, last ? nullptr : H8, IN_(6) + (l + 1) * D, modl + 9 * 6144, wv_s);
      }
#undef IN_
      if (sync) { XcdBarrier xb_; xb_.bar = (unsigned*)p.ws; xb_.x = xb_xcc_id(); xb_.st = (volatile LAS unsigned*)(lds + LDS_BYTES - 16); xcd_barrier(xb_, wv_s); }
    }
  }
#undef PH_BEGIN
#undef PH_END
}

extern "C" void kernel_launch(void* const* d_in, const int* in_sizes, int n_in, void* d_out, int out_size, void* d_ws, size_t ws_size, hipStream_t stream) {
  static int grid_blocks = 0;
  if (grid_blocks == 0) {
    int dev = 0, cus = 0, per_cu = 0;
    if (n_in != 31 || out_size != NB * SEQ * D || ws_size < WS_TOTAL) { fprintf(stderr, "kernel_launch: unexpected shapes (n_in %d out %d ws %zu)\n", n_in, out_size, ws_size); grid_blocks = -1; return; }
    (void)hipGetDevice(&dev);
    (void)hipDeviceGetAttribute(&cus, hipDeviceAttributeMultiprocessorCount, dev);
    (void)hipFuncSetAttribute((const void*)mega, hipFuncAttributeMaxDynamicSharedMemorySize, LDS_BYTES);
    (void)hipOccupancyMaxActiveBlocksPerMultiprocessor(&per_cu, (const void*)mega, NTHREADS, LDS_BYTES);
    if (per_cu < 1) { fprintf(stderr, "kernel_launch: occupancy query says %d blocks/CU\n", per_cu); per_cu = 1; }
    grid_blocks = cus;
  }
  if (grid_blocks < 0) return;
  (void)hipMemsetAsync(d_ws, 0, 16384, stream);
  Params p{};
  const float** f = (const float**)&p;
  for (int i = 0; i < 31; ++i) f[i] = (const float*)d_in[i];
  p.out = (float*)d_out; p.ws = (unsigned char*)d_ws;
  p.single = 1; p.phase = 0;
  void* args[] = {&p};
  hipError_t e = hipLaunchCooperativeKernel((const void*)mega, dim3(grid_blocks), dim3(NTHREADS), args, LDS_BYTES, stream);
  if (e != hipSuccess) fprintf(stderr, "cooperative launch failed: %s (grid %d)\n", hipGetErrorString(e), grid_blocks);
}
```

```cpp
#include <hip/hip_runtime.h>
#include <hip/hip_cooperative_groups.h>
#include <cstdio>
#include <cstdint>
namespace cg = cooperative_groups;

#define LAS __attribute__((address_space(3)))
#define GAS __attribute__((address_space(1)))
typedef unsigned short bf16_t;
typedef short bf16x8 __attribute__((ext_vector_type(8)));
typedef short v4i16_t __attribute__((ext_vector_type(4)));
typedef float f32x4 __attribute__((ext_vector_type(4)));
typedef float f32x16 __attribute__((ext_vector_type(16)));
typedef unsigned u32x4 __attribute__((ext_vector_type(4)));
typedef unsigned u32x2 __attribute__((ext_vector_type(2)));
typedef long long2_t __attribute__((ext_vector_type(2)));
typedef float f32x2_t __attribute__((ext_vector_type(2)));
typedef __bf16 bf16x2_t __attribute__((ext_vector_type(2)));

constexpr int D = 1024, NB = 8, SEQ = 2048, NCTX = 256, TPB = SEQ + NCTX  , M = NB * TPB  ;
constexpr int NTHREADS = 512, NWAVES = 8;
constexpr float EPS = 1e-6f;
constexpr float LOG2E = 1.4426950408889634f;
constexpr float LAM_INIT = 0.35550907f;
constexpr float ASC = 8.f, WSC = 64.f, OSC = 64.f;
constexpr size_t MiB = 1u << 20;
constexpr size_t WS_PTRS = 32768;
constexpr size_t WS_MODP = 352 * MiB  , WS_MOD = 8 * MiB, WS_TAB = 9 * MiB, WS_XC = 10 * MiB;
constexpr size_t WS_WDOWN = 18 * MiB, WS_WUQ = 23 * MiB, WS_WUKV = 28 * MiB, WS_MWO = 30 * MiB, WS_DQKV = 34 * MiB, WS_DWO = 40 * MiB;
constexpr size_t WS_SQKV = 42 * MiB, WS_SWO = 45 * MiB, WS_PWQ = 47 * MiB, WS_PKEYS = 63 * MiB, WS_WEFF = 65 * MiB;
constexpr size_t WS_PU = 96 * MiB, WS_PV = 224 * MiB, WS_H = 352 * MiB, WS_O = 388 * MiB, WS_BUF1 = 424 * MiB, WS_BUF2 = 532 * MiB;
constexpr size_t WS_BUF3 = 586 * MiB, WS_BUF4 = 658 * MiB, WS_CQN = 712 * MiB, WS_CKVN = 739 * MiB, WS_SC = 748 * MiB, WS_END = 892 * MiB;
constexpr size_t WS_XL = 896 * MiB, WS_TOTAL = 928 * MiB;
constexpr int LDS_BYTES = 147456;


struct Params {
  const float *x, *c, *ctx, *c_ctx, *ada_w, *ada_b, *norm_mix, *norm_ffn;
  const float *mla_w_down, *mla_g_cq, *mla_g_ckv, *mla_w_uq, *mla_w_ukv, *mla_g_q, *mla_g_k, *mla_w_o;
  const float *diff_w_qkv, *diff_g_q, *diff_g_k, *diff_lambda, *diff_g_sub, *diff_w_o;
  const float *swa_w_qkv, *swa_g_q, *swa_g_k, *swa_sink, *swa_w_o;
  const float *peer_w_q, *peer_keys, *peer_u, *peer_v;
  float* out; unsigned char* ws;
  int single, phase;
};

__device__ __forceinline__ int opaque_tid() { int t = threadIdx.x; asm volatile("" : "+v"(t)); return t; }
__device__ __forceinline__ int otid(int wv) { int w = wv; asm volatile("" : "+s"(w)); unsigned m = ~0u; asm volatile("" : "+s"(m)); const int l = (int)__builtin_amdgcn_mbcnt_hi(m, __builtin_amdgcn_mbcnt_lo(m, 0u)); return (w << 6) | l; }
__device__ __forceinline__ unsigned pk2(float lo, float hi) { f32x2_t v = {lo, hi}; bf16x2_t b = __builtin_convertvector(v, bf16x2_t); return __builtin_bit_cast(unsigned, b); }
__device__ __forceinline__ unsigned pk4_fp8(float a, float b, float c, float d) { int w = 0; w = __builtin_amdgcn_cvt_pk_fp8_f32(a, b, w, false); w = __builtin_amdgcn_cvt_pk_fp8_f32(c, d, w, true); return (unsigned)w; }
__device__ __forceinline__ float bf_lo(unsigned u) { return __uint_as_float(u << 16); }
__device__ __forceinline__ float bf_hi(unsigned u) { return __uint_as_float(u & 0xffff0000u); }
__device__ __forceinline__ float wave_sum(float v) {
#pragma unroll
  for (int o = 32; o >= 1; o >>= 1) v += __shfl_xor(v, o);
  return v;
}
__device__ __forceinline__ float dot2bf(unsigned a, unsigned b, float c) { return __builtin_amdgcn_fdot2_f32_bf16(__builtin_bit_cast(bf16x2_t, a), __builtin_bit_cast(bf16x2_t, b), c, false); }
__device__ __forceinline__ int crow(int r, int hi) { return (r & 3) + 8 * (r >> 2) + 4 * hi; }
__device__ __forceinline__ unsigned f2ord(float f) { unsigned u = __float_as_uint(f); return (u & 0x80000000u) ? ~u : (u | 0x80000000u); }
__device__ __forceinline__ float ord2f(unsigned o) { return __uint_as_float((o & 0x80000000u) ? (o & 0x7fffffffu) : ~o); }
__device__ __forceinline__ bf16_t* xrow_ptr(bf16_t* xl, bf16_t* xc, int r) {
  const int b = r / TPB, s = r - b * TPB;
  return (s < SEQ) ? xl + (size_t)(b * SEQ + s) * D : xc + (size_t)(b * NCTX + (s - SEQ)) * D;
}
__device__ __forceinline__ const float* xsrc_ptr(const float* sl, const float* sc, int r) {
  const int b = r / TPB, s = r - b * TPB;
  return (s < SEQ) ? sl + (size_t)(b * SEQ + s) * D : sc + (size_t)(b * NCTX + (s - SEQ)) * D;
}
template <bool F8>
__device__ __forceinline__ void tr_job(LAS unsigned char* lds, const float* __restrict__ W, void* __restrict__ Wt_, int K, int N, int Npad, int& rot) {
  LAS float* tile = (LAS float*)lds;
  const int nnb = Npad / 64, nit = (K / 64) * nnb, tid = opaque_tid();
  const int vb = ((int)blockIdx.x - rot % (int)gridDim.x + (int)gridDim.x) % (int)gridDim.x;
  rot += (nit + 3) / 4;
  for (int it0 = vb * 4; it0 < nit; it0 += gridDim.x * 4) {
    f32x4 v[4][2];
#pragma unroll
    for (int q = 0; q < 4; ++q) {
      const int it = it0 + q, kb = it / nnb, nb = it - kb * nnb, k0 = kb * 64, n0 = nb * 64;
#pragma unroll
      for (int i = 0; i < 2; ++i) {
        const int idx = tid + i * 512, kk = idx >> 4, nc = (idx & 15) * 4;
        v[q][i] = (f32x4){0.f, 0.f, 0.f, 0.f};
        if (it < nit && n0 + nc < N) v[q][i] = *(const f32x4*)(W + (size_t)(k0 + kk) * N + n0 + nc);
      }
    }
#pragma unroll
    for (int q = 0; q < 4; ++q)
#pragma unroll
      for (int i = 0; i < 2; ++i) {
        const int idx = tid + i * 512, kk = idx >> 4, nc = (idx & 15) * 4; LAS float* t = tile + q * (64 * 65) + kk * 65 + nc;
        t[0] = v[q][i].x; t[1] = v[q][i].y; t[2] = v[q][i].z; t[3] = v[q][i].w;
      }
    __syncthreads();
#pragma unroll
    for (int q = 0; q < 4; ++q) {
      const int it = it0 + q;
      if (it < nit) {
        const int kb = it / nnb, nb = it - kb * nnb, k0 = kb * 64, n0 = nb * 64;
        const int n = tid >> 3, kc = tid & 7;
        float f[8];
#pragma unroll
        for (int j = 0; j < 8; ++j) f[j] = tile[q * (64 * 65) + (kc * 8 + j) * 65 + n];
        if (F8) *(u32x2*)((unsigned char*)Wt_ + (size_t)(n0 + n) * K + k0 + kc * 8) = (u32x2){pk4_fp8(f[0] * WSC, f[1] * WSC, f[2] * WSC, f[3] * WSC), pk4_fp8(f[4] * WSC, f[5] * WSC, f[6] * WSC, f[7] * WSC)};
        else *(u32x4*)((bf16_t*)Wt_ + (size_t)(n0 + n) * K + k0 + kc * 8) = (u32x4){pk2(f[0], f[1]), pk2(f[2], f[3]), pk2(f[4], f[5]), pk2(f[6], f[7])};
      }
    }
    __syncthreads();
  }
}
__device__ __forceinline__ void cvt_job(const float* __restrict__ src, bf16_t* __restrict__ dst, size_t n8) {
  for (size_t i = (size_t)blockIdx.x * NTHREADS + threadIdx.x; i < n8; i += (size_t)gridDim.x * NTHREADS) {
    const f32x4 a = ((const f32x4*)src)[2 * i], b = ((const f32x4*)src)[2 * i + 1];
    ((u32x4*)dst)[i] = (u32x4){pk2(a.x, a.y), pk2(a.z, a.w), pk2(b.x, b.y), pk2(b.z, b.w)};
  }
}
__device__ __forceinline__ unsigned q4pack(f32x4 a, f32x4 b, float sc) {
  const float v[8] = {a.x, a.y, a.z, a.w, b.x, b.y, b.z, b.w}; unsigned w = 0u;
#pragma unroll
  for (int j = 0; j < 8; ++j) { int q = (int)rintf(v[j] * sc); q = min(7, max(-8, q)); w |= ((unsigned)q & 15u) << (4 * j); }
  return w;
}
__device__ __forceinline__ void conv_rows(const float* __restrict__ usrc, const float* __restrict__ vsrc, unsigned char* __restrict__ udst, unsigned char* __restrict__ vdst, float su, float sv, int r0, int r1, int tid) {
  for (int rb = r0 + (tid >> 6); rb < r1; rb += 4 * NWAVES) {
    const int c = (tid & 63);
    f32x4 a[4], b[4], cc[4], d[4];
#pragma unroll
    for (int k = 0; k < 4; ++k) { const int r = min(rb + k * NWAVES, r1 - 1); const bool isv = r >= 16384; const int rr = isv ? r - 16384 : r;
      const f32x4* sp = (const f32x4*)((isv ? vsrc : usrc) + (size_t)rr * 1024) + c * 4;
      a[k] = sp[0]; b[k] = sp[1]; cc[k] = sp[2]; d[k] = sp[3]; }
#pragma unroll
    for (int k = 0; k < 4; ++k) { const int r = rb + k * NWAVES; if (r < r1) { const bool isv = r >= 16384; const int rr = isv ? r - 16384 : r;
      u32x2 o;
      if (isv) {
        unsigned w0 = 0u, w1 = 0u;
        w0 = __builtin_amdgcn_cvt_scalef32_pk_fp4_f32(w0, a[k].x * sv, a[k].y * sv, 1.0f, 0); w0 = __builtin_amdgcn_cvt_scalef32_pk_fp4_f32(w0, a[k].z * sv, a[k].w * sv, 1.0f, 1);
        w0 = __builtin_amdgcn_cvt_scalef32_pk_fp4_f32(w0, b[k].x * sv, b[k].y * sv, 1.0f, 2); w0 = __builtin_amdgcn_cvt_scalef32_pk_fp4_f32(w0, b[k].z * sv, b[k].w * sv, 1.0f, 3);
        w1 = __builtin_amdgcn_cvt_scalef32_pk_fp4_f32(w1, cc[k].x * sv, cc[k].y * sv, 1.0f, 0); w1 = __builtin_amdgcn_cvt_scalef32_pk_fp4_f32(w1, cc[k].z * sv, cc[k].w * sv, 1.0f, 1);
        w1 = __builtin_amdgcn_cvt_scalef32_pk_fp4_f32(w1, d[k].x * sv, d[k].y * sv, 1.0f, 2); w1 = __builtin_amdgcn_cvt_scalef32_pk_fp4_f32(w1, d[k].z * sv, d[k].w * sv, 1.0f, 3);
        o = (u32x2){w0, w1};
      } else o = (u32x2){q4pack(a[k], b[k], su), q4pack(cc[k], d[k], su)};
      *(u32x2*)((isv ? vdst : udst) + (size_t)rr * 512 + c * 8) = o; } }
  }
}
__device__ __forceinline__ void ada_job(LAS unsigned char* lds, const Params& p, float* __restrict__ modp) {
  LAS float* s = (LAS float*)lds;
  const int tid = opaque_tid();
  for (int u = blockIdx.x; u < 768; u += gridDim.x) {
    const int l = u / 192, r = u - l * 192, cc = r >> 6, kc = r & 63;
    __syncthreads();
    if (tid < 144) { const int bi = tid >> 4, k = tid & 15; const float c = (bi < 8) ? p.c[bi * D + kc * 16 + k] : p.c_ctx[kc * 16 + k]; s[tid] = c / (1.f + __expf(-c)); }
    __syncthreads();
    f32x4 acc[9];
#pragma unroll
    for (int bi = 0; bi < 9; ++bi) acc[bi] = (f32x4){0.f, 0.f, 0.f, 0.f};
    const float* w = p.ada_w + ((size_t)l * D + kc * 16) * 6144 + cc * 2048 + tid * 4;
#pragma unroll
    for (int h = 0; h < 2; ++h) {
      f32x4 wv[8];
#pragma unroll
      for (int k = 0; k < 8; ++k) wv[k] = *(const f32x4*)(w + (size_t)(h * 8 + k) * 6144);
#pragma unroll
      for (int k = 0; k < 8; ++k)
#pragma unroll
        for (int bi = 0; bi < 9; ++bi) acc[bi] += s[bi * 16 + h * 8 + k] * wv[k];
    }
#pragma unroll
    for (int bi = 0; bi < 9; ++bi) *(f32x4*)(modp + (((size_t)kc * 4 + l) * 9 + bi) * 6144 + cc * 2048 + tid * 4) = acc[bi];
  }
}

__device__ __forceinline__ void norm_phase(const float* sl, const float* sc_, bf16_t* xl, bf16_t* xc, bool src_f32, const float* __restrict__ g, const float* __restrict__ modl, int which, unsigned char* __restrict__ H, bool out_f8, bool skip_ctx, int wv) {
  const int tid_ = otid(wv); const int lane = tid_ & 63, wid = tid_ >> 6;
  for (int r = blockIdx.x * NWAVES + wid; r < M; r += gridDim.x * NWAVES) {
    const int b = r / TPB, s = r - b * TPB; const bool isctx = s >= SEQ;
    if (skip_ctx && isctx) continue;
    const int bi = isctx ? 8 : b;
    const float* sh = modl + (size_t)(bi * 6 + which) * D; const float* sc = sh + D;
    f32x4 v[4]; float ss = 0.f;
    if (src_f32) {
      const float* xr = xsrc_ptr(sl, sc_, r);
#pragma unroll
      for (int j = 0; j < 4; ++j) v[j] = ((const f32x4*)xr)[lane + 64 * j];
    } else {
      const bf16_t* xr = xrow_ptr(xl, xc, r);
#pragma unroll
      for (int j = 0; j < 4; ++j) { const u32x2 w = ((const u32x2*)xr)[lane + 64 * j]; v[j] = (f32x4){bf_lo(w.x), bf_hi(w.x), bf_lo(w.y), bf_hi(w.y)}; }
    }
#pragma unroll
    for (int j = 0; j < 4; ++j) ss += v[j].x * v[j].x + v[j].y * v[j].y + v[j].z * v[j].z + v[j].w * v[j].w;
    ss = wave_sum(ss);
    const float rstd = rsqrtf(ss * (1.f / D) + EPS);
#pragma unroll
    for (int j = 0; j < 4; ++j) {
      const int c4 = lane + 64 * j;
      const f32x4 g4 = ((const f32x4*)g)[c4], s4 = ((const f32x4*)sc)[c4], h4 = ((const f32x4*)sh)[c4];
      const f32x4 y = v[j] * rstd * g4 * (1.f + s4) + h4;
      if (out_f8) *(unsigned*)(H + (size_t)r * D + c4 * 4) = pk4_fp8(y.x * ASC, y.y * ASC, y.z * ASC, y.w * ASC);
      else *(u32x2*)((bf16_t*)H + (size_t)r * D + c4 * 4) = (u32x2){pk2(y.x, y.y), pk2(y.z, y.w)};
    }
  }
}
__device__ __forceinline__ void latnorm_phase(const bf16_t* __restrict__ LAT, const float* __restrict__ gcq, const float* __restrict__ gckv, unsigned char* __restrict__ CQN, bf16_t* __restrict__ CKVN, int wv) {
  const int tid_ = otid(wv); const int lane = tid_ & 63, wid = tid_ >> 6;
  for (int r = blockIdx.x * NWAVES + wid; r < M; r += gridDim.x * NWAVES) {
    const bf16_t* lr = LAT + (size_t)r * 1280;
    float q[12], kv[4]; float sq = 0.f, sk = 0.f;
#pragma unroll
    for (int j = 0; j < 3; ++j) { const u32x2 w = *(const u32x2*)(lr + lane * 4 + 256 * j); q[4 * j] = bf_lo(w.x); q[4 * j + 1] = bf_hi(w.x); q[4 * j + 2] = bf_lo(w.y); q[4 * j + 3] = bf_hi(w.y); }
    { const u32x2 w = *(const u32x2*)(lr + 768 + lane * 4); kv[0] = bf_lo(w.x); kv[1] = bf_hi(w.x); kv[2] = bf_lo(w.y); kv[3] = bf_hi(w.y); }
#pragma unroll
    for (int j = 0; j < 12; ++j) sq += q[j] * q[j];
#pragma unroll
    for (int j = 0; j < 4; ++j) sk += kv[j] * kv[j];
    sq = wave_sum(sq); sk = wave_sum(sk);
    const float rq = rsqrtf(sq * (1.f / 768.f) + EPS), rk = rsqrtf(sk * (1.f / 256.f) + EPS);
#pragma unroll
    for (int j = 0; j < 3; ++j) { const int c = lane * 4 + 256 * j; const f32x4 g4 = *(const f32x4*)(gcq + c);
      *(unsigned*)(CQN + (size_t)r * 768 + c) = pk4_fp8(q[4 * j] * rq * g4.x * ASC, q[4 * j + 1] * rq * g4.y * ASC, q[4 * j + 2] * rq * g4.z * ASC, q[4 * j + 3] * rq * g4.w * ASC); }
    { const int c = lane * 4; const f32x4 g4 = *(const f32x4*)(gckv + c);
      *(u32x2*)(CKVN + (size_t)r * 256 + c) = (u32x2){pk2(kv[0] * rk * g4.x, kv[1] * rk * g4.y), pk2(kv[2] * rk * g4.z, kv[3] * rk * g4.w)}; }
  }
}

constexpr int G_AS = 144;
constexpr int G_ATILE = 256 * G_AS, G_BTILE = 128 * G_AS, G_STAGE = G_ATILE + G_BTILE;
struct EpiFp8T { unsigned char* C; int ldc;
  __device__ __forceinline__ void operator()(int row, int col, f32x4 v) const { const unsigned w = pk4_fp8(v.x * WSC, v.y * WSC, v.z * WSC, v.w * WSC);
    C[(size_t)(col + 0) * ldc + row] = (unsigned char)(w & 255u); C[(size_t)(col + 1) * ldc + row] = (unsigned char)((w >> 8) & 255u); C[(size_t)(col + 2) * ldc + row] = (unsigned char)((w >> 16) & 255u); C[(size_t)(col + 3) * ldc + row] = (unsigned char)(w >> 24); } };
struct EpiBf16T { bf16_t* C; int ldc;
  __device__ __forceinline__ void operator()(int row, int col, f32x4 v) const {
    C[(size_t)(col + 0) * ldc + row] = (bf16_t)(pk2(v.x, 0.f) & 0xffffu); C[(size_t)(col + 1) * ldc + row] = (bf16_t)(pk2(v.y, 0.f) & 0xffffu);
    C[(size_t)(col + 2) * ldc + row] = (bf16_t)(pk2(v.z, 0.f) & 0xffffu); C[(size_t)(col + 3) * ldc + row] = (bf16_t)(pk2(v.w, 0.f) & 0xffffu); } };
template <class Epi>
__device__ __forceinline__ void gemm_phase(LAS unsigned char* lds, const bf16_t* __restrict__ A, int lda, const bf16_t* __restrict__ Bt, int ldb,
                                           int Mrows, int N, int K, bool skip_ctx_tiles, const Epi epi, int ustart, int ustride) {
  const int tid = opaque_tid(), lane = tid & 63, wid = tid >> 6, wr = wid >> 1, wc = wid & 1, fr = lane & 15, fq = lane >> 4;
  const int nN = N / 128, nU = (Mrows / 256) * nN, nt = K / 64;
  const int lrow = tid >> 3, lkc = tid & 7;
  for (int u = ustart; u < nU; u += ustride) {
    const int pm = u / nN, pn = u - pm * nN;
    if (skip_ctx_tiles && (pm % 9) == 8) continue;
    const bf16_t* Ag = A + (size_t)(pm * 256 + lrow) * lda + lkc * 8;
    const bf16_t* Bg = Bt + (size_t)(pn * 128 + lrow) * ldb + lkc * 8;
    f32x4 acc[4][4];
#pragma unroll
    for (int m = 0; m < 4; ++m)
#pragma unroll
      for (int n = 0; n < 4; ++n) acc[m][n] = (f32x4){0.f, 0.f, 0.f, 0.f};
    u32x4 ra[4], rb[2];
#pragma unroll
    for (int i = 0; i < 4; ++i) ra[i] = *(const u32x4*)(Ag + (size_t)(64 * i) * lda);
#pragma unroll
    for (int i = 0; i < 2; ++i) rb[i] = *(const u32x4*)(Bg + (size_t)(64 * i) * ldb);
    {
      LAS unsigned char* sa = lds + lrow * G_AS + lkc * 16; LAS unsigned char* sb = lds + G_ATILE + lrow * G_AS + lkc * 16;
#pragma unroll
      for (int i = 0; i < 4; ++i) *(LAS u32x4*)(sa + i * 64 * G_AS) = ra[i];
#pragma unroll
      for (int i = 0; i < 2; ++i) *(LAS u32x4*)(sb + i * 64 * G_AS) = rb[i];
    }
    __syncthreads();
    for (int t = 0; t < nt; ++t) {
      const bool more = (t + 1 < nt);
      if (more) {
#pragma unroll
        for (int i = 0; i < 4; ++i) ra[i] = *(const u32x4*)(Ag + (size_t)(64 * i) * lda + (t + 1) * 64);
#pragma unroll
        for (int i = 0; i < 2; ++i) rb[i] = *(const u32x4*)(Bg + (size_t)(64 * i) * ldb + (t + 1) * 64);
      }
      const LAS unsigned char* st = lds + (t & 1) * G_STAGE;
      const LAS unsigned char* pa = st + (wr * 64 + fr) * G_AS + fq * 16;
      const LAS unsigned char* pb = st + G_ATILE + (wc * 64 + fr) * G_AS + fq * 16;
#pragma unroll
      for (int ks = 0; ks < 2; ++ks) {
        bf16x8 af[4], bfr[4];
#pragma unroll
        for (int m = 0; m < 4; ++m) af[m] = *(const LAS bf16x8*)(pa + m * 16 * G_AS + ks * 64);
#pragma unroll
        for (int n = 0; n < 4; ++n) bfr[n] = *(const LAS bf16x8*)(pb + n * 16 * G_AS + ks * 64);
#pragma unroll
        for (int m = 0; m < 4; ++m)
#pragma unroll
          for (int n = 0; n < 4; ++n) acc[m][n] = __builtin_amdgcn_mfma_f32_16x16x32_bf16(bfr[n], af[m], acc[m][n], 0, 0, 0);
      }
      if (more) {
        LAS unsigned char* sa = lds + ((t + 1) & 1) * G_STAGE + lrow * G_AS + lkc * 16; LAS unsigned char* sb = sa + G_ATILE;
#pragma unroll
        for (int i = 0; i < 4; ++i) *(LAS u32x4*)(sa + i * 64 * G_AS) = ra[i];
#pragma unroll
        for (int i = 0; i < 2; ++i) *(LAS u32x4*)(sb + i * 64 * G_AS) = rb[i];
      }
      __syncthreads();
    }
#pragma unroll
    for (int m = 0; m < 4; ++m)
#pragma unroll
      for (int n = 0; n < 4; ++n) epi(pm * 256 + wr * 64 + m * 16 + fr, pn * 128 + wc * 64 + n * 16 + fq * 4, acc[m][n]);
  }
}

namespace pg8 {
#define PG8_LAS __attribute__((address_space(3)))
typedef unsigned short bf16_t;
typedef short bf16x8 __attribute__((ext_vector_type(8)));
typedef int pg8_v8i __attribute__((ext_vector_type(8)));
typedef float f32x4 __attribute__((ext_vector_type(4)));
typedef unsigned u32x4 __attribute__((ext_vector_type(4)));
constexpr int BM = 256, BK = 64, HALF = 128, HTB = HALF * BK * 2  , STAGE_BYTES = 8 * HTB, NXCD = 8, WGM = 8;

__host__ __device__ __forceinline__ int lds_byte(int r, int c) { const int st = (r >> 4) * 2 + (c >> 5), rr = r & 15, cc = c & 31, ob = rr * 64 + cc * 2; return st * 1024 + (ob ^ (((ob >> 9) & 1) << 5)); }
__host__ __device__ __forceinline__ void stage_rc(int b, int& R, int& C) { const int st = b / 1024, sb = b % 1024, swz = sb ^ (((sb >> 9) & 1) << 5); R = (st >> 1) * 16 + swz / 64; C = (st & 1) * 32 + (swz % 64) / 2; }
__host__ __device__ __forceinline__ int perm32(int rho) { const int n = rho >> 4, i = rho & 15; return 8 * (i >> 2) + 4 * n + (i & 3); }

struct Unit { int pm, pn; };
struct Gemm { const bf16_t* A; const bf16_t* Bt; int M, N, K; };

struct StaticOrder {
    int nM, nN, nwg, G, c;
    __host__ __device__ void init(int M, int N, int G_, int c_) { nM = M / BM; nN = N / BM; nwg = nM * nN; G = G_; c = c_; }
    __host__ __device__ bool next(int i, Unit& u) const {
        const long L = (long)i * G + c; if (L >= nwg) return false;
        int wgid = (int)L; { const int q = nwg / NXCD, r = nwg % NXCD, xcd = wgid % NXCD, off = wgid / NXCD; wgid = (xcd < r ? xcd * (q + 1) : r * (q + 1) + (xcd - r) * q) + off; }
        const int nig = WGM * nN, gid = wgid / nig, fm = gid * WGM, gsz = (nM - fm) < WGM ? (nM - fm) : WGM;
        u.pm = fm + ((wgid % nig) % gsz); u.pn = (wgid % nig) / gsz; return true;
    }
    __device__ __forceinline__ void a_ready(const Unit&) const {}
    __device__ __forceinline__ void done(const Unit&) const {}
};
struct LatentOrder {
    StaticOrder base; bool skip;
    __host__ __device__ void init(int M_, int N_, int G_, int c_, bool skip_) { skip = skip_; base.init(skip_ ? (M_ / 9) * 8 : M_, N_, G_, c_); }
    __host__ __device__ bool next(int i, Unit& u) const { if (!base.next(i, u)) return false; if (skip) u.pm += u.pm >> 3; return true; }
    __device__ __forceinline__ void a_ready(const Unit&) const {}
    __device__ __forceinline__ void done(const Unit&) const {}
};
struct EpiBf16P { static constexpr bool PERM = true, AFTER_DRAIN = false; bf16_t* O; int ldc; float sc;
  __device__ __forceinline__ void operator()(const f32x4 (&acc)[2][2][4][2], const Unit& u, int wr, int wc, int fr, int fq) const {
    const int row0 = u.pm * BM + wr * 64 + fr, col0 = u.pn * BM + wc * 32 + 8 * fq;
#pragma unroll
    for (int ai = 0; ai < 2; ++ai)
#pragma unroll
      for (int m = 0; m < 4; ++m) { bf16_t* rowp = O + (size_t)(row0 + ai * HALF + m * 16) * ldc + col0;
#pragma unroll
        for (int bj = 0; bj < 2; ++bj) { const f32x4 v0 = acc[ai][bj][m][0] * sc, v1 = acc[ai][bj][m][1] * sc;
          *(u32x4*)(rowp + bj * HALF) = (u32x4){pk2(v0[0], v0[1]), pk2(v0[2], v0[3]), pk2(v1[0], v1[1]), pk2(v1[2], v1[3])}; } }
  } };
struct EpiResidN { static constexpr bool PERM = false, AFTER_DRAIN = false; const float* sl; const float* sc; bool src_f32; bf16_t* xl; bf16_t* xc; const float* modl; int which; bool live; float osc;
  __device__ __forceinline__ void operator()(const f32x4 (&acc)[2][2][4][2], const Unit& u, int wr, int wc, int fr, int fq) const {
    if (!live) return;
    const int row0 = u.pm * BM + wr * 64 + fr, col0 = u.pn * BM + wc * 32 + 4 * fq;
    const int b = (u.pm * BM) / TPB, s0 = u.pm * BM - b * TPB; const int bi = (s0 >= SEQ) ? 8 : b;
    const float* gp = modl + (size_t)(bi * 6 + which) * D + col0;
#pragma unroll
    for (int bj = 0; bj < 2; ++bj)
#pragma unroll
      for (int n = 0; n < 2; ++n) { const f32x4 gt = *(const f32x4*)(gp + bj * HALF + n * 16) * osc;
#pragma unroll
        for (int ai = 0; ai < 2; ++ai)
#pragma unroll
          for (int m = 0; m < 4; ++m) { const int rr = row0 + ai * HALF + m * 16, cc = col0 + bj * HALF + n * 16;
            bf16_t* xp = xrow_ptr(xl, xc, rr) + cc; f32x4 xv;
            if (src_f32) xv = *(const f32x4*)(xsrc_ptr(sl, sc, rr) + cc);
            else { const u32x2 w = *(const u32x2*)xp; xv = (f32x4){bf_lo(w.x), bf_hi(w.x), bf_lo(w.y), bf_hi(w.y)}; }
            xv += gt * acc[ai][bj][m][n]; *(u32x2*)xp = (u32x2){pk2(xv.x, xv.y), pk2(xv.z, xv.w)}; } }
  } };
template <class Epi, class Sched, bool ALIGN_EPI = false, bool SP2 = false, bool FP8 = false>
__device__ __forceinline__ void gemm_phase(PG8_LAS unsigned char* lds, const Gemm g, const Sched& S, const Epi& E, int wv) {
    const int tid = otid(wv), wid = __builtin_amdgcn_readfirstlane(tid >> 6), lane = tid & 63, wr = wid >> 2, wc = wid & 3, fr = lane & 15, fq = lane >> 4;
    const int K = g.K, nt = K / BK;
    unsigned voffA[2], voffB[2];
#pragma unroll
    for (int i = 0; i < 2; ++i) { int R, C; stage_rc(tid * 16 + i * 8192, R, C); const int Rb = Epi::PERM ? ((R & ~31) + perm32(R & 31)) : R;
        voffA[i] = (unsigned)(R * K + C) * 2u; voffB[i] = (unsigned)(Rb * K + C) * 2u; }
    const size_t kstep = (size_t)(BK * 2);
    const size_t hstep = (size_t)HALF * K * 2;
    const size_t tstep = 2 * hstep;
    const unsigned ldsw = (unsigned)wid * 1024u;
    const int aoff = lds_byte(wr * 64 + fr, fq * 8), boff = lds_byte(wc * 32 + fr, fq * 8);
#define PG8_SA(b, h) (((b) * 2 + (h)) * HTB)
#define PG8_SB(b, h) ((4 + (b) * 2 + (h)) * HTB)
#define PG8_STAGE(bufoff, gbase, voff) do { _Pragma("unroll") for (int _i = 0; _i < 2; ++_i) \
        __builtin_amdgcn_global_load_lds((const unsigned*)((const char*)(gbase) + (voff)[_i]), (PG8_LAS unsigned*)(lds + (bufoff) + ldsw + _i * 8192), 16, 0, 0); } while (0)
#define PG8_LDA(dst, b, h) do { _Pragma("unroll") for (int m = 0; m < 4; ++m) { _Pragma("unroll") for (int k = 0; k < 2; ++k) dst[m][k] = *(const PG8_LAS bf16x8*)(lds + PG8_SA(b, h) + aoff + m * 2048 + k * 1024); \
        if constexpr (FP8) dst##8[m] = __builtin_bit_cast(pg8_v8i, __builtin_shufflevector(dst[m][0], dst[m][1], 0, 1, 2, 3, 4, 5, 6, 7, 8, 9, 10, 11, 12, 13, 14, 15)); } } while (0)
#define PG8_LDB(dst, b, h) do { _Pragma("unroll") for (int n = 0; n < 2; ++n) { _Pragma("unroll") for (int k = 0; k < 2; ++k) dst[n][k] = *(const PG8_LAS bf16x8*)(lds + PG8_SB(b, h) + boff + n * 2048 + k * 1024); \
        if constexpr (FP8) dst##8[n] = __builtin_bit_cast(pg8_v8i, __builtin_shufflevector(dst[n][0], dst[n][1], 0, 1, 2, 3, 4, 5, 6, 7, 8, 9, 10, 11, 12, 13, 14, 15)); } } while (0)
#define PG8_MMA(ai, bj, At, Bt) do { __builtin_amdgcn_s_setprio(1); _Pragma("unroll") for (int m = 0; m < 4; ++m) _Pragma("unroll") for (int n = 0; n < 2; ++n) { \
        if constexpr (FP8) {     \
          acc[ai][bj][m][n] = __builtin_amdgcn_mfma_scale_f32_16x16x128_f8f6f4(Bt##8[n], At##8[m], acc[ai][bj][m][n], 0, 0, 0, 127, 0, 127); asm volatile("" : "+v"(acc[ai][bj][m][n])); } \
        else { _Pragma("unroll") for (int k = 0; k < 2; ++k) acc[ai][bj][m][n] = __builtin_amdgcn_mfma_f32_16x16x32_bf16(Bt[n][k], At[m][k], acc[ai][bj][m][n], 0, 0, 0); } } __builtin_amdgcn_s_setprio(0); } while (0)
#define PG8_WAIT_V(n) asm volatile("s_waitcnt vmcnt(" #n ")" ::: "memory")
#define PG8_WAIT_L(n) asm volatile("s_waitcnt lgkmcnt(" #n ")" ::: "memory")
#define PG8_BAR __builtin_amdgcn_s_barrier()
#define PG8_SCHED __builtin_amdgcn_sched_barrier(0)
    Unit cur, nxt; int ui = 0;
    if (!S.next(0, cur)) return;
    f32x4 acc[2][2][4][2];
#pragma unroll
    for (int a = 0; a < 2; ++a)
#pragma unroll
        for (int b = 0; b < 2; ++b)
#pragma unroll
            for (int m = 0; m < 4; ++m)
#pragma unroll
                for (int n = 0; n < 2; ++n) acc[a][b][m][n] = (f32x4){0.f, 0.f, 0.f, 0.f};
    bf16x8 At[4][2], B0[2][2], B1[2][2];
    pg8_v8i At8[4], B08[2], B18[2];
    const char* cA = (const char*)g.A + (size_t)cur.pm * tstep; const char* cB = (const char*)g.Bt + (size_t)cur.pn * tstep;
    S.a_ready(cur);
    if constexpr (SP2) {
        PG8_STAGE(PG8_SB(0, 0), cB, voffB); PG8_STAGE(PG8_SB(0, 1), cB + hstep, voffB); PG8_STAGE(PG8_SA(0, 0), cA, voffA); PG8_STAGE(PG8_SA(0, 1), cA + hstep, voffA);
        if (wr == 1) PG8_BAR;
        PG8_WAIT_V(2); PG8_BAR;
        PG8_STAGE(PG8_SB(1, 0), cB + kstep, voffB); PG8_STAGE(PG8_SA(1, 0), cA + kstep, voffA); PG8_STAGE(PG8_SB(1, 1), cB + hstep + kstep, voffB);
        PG8_WAIT_V(6); PG8_BAR;
    } else {
        PG8_STAGE(PG8_SB(0, 0), cB, voffB); PG8_STAGE(PG8_SA(0, 0), cA, voffA); PG8_STAGE(PG8_SB(0, 1), cB + hstep, voffB); PG8_STAGE(PG8_SA(0, 1), cA + hstep, voffA);
        if (wr == 1) PG8_BAR;
        PG8_WAIT_V(4); PG8_BAR;
        PG8_STAGE(PG8_SB(1, 0), cB + kstep, voffB); PG8_STAGE(PG8_SA(1, 0), cA + kstep, voffA); PG8_STAGE(PG8_SB(1, 1), cB + hstep + kstep, voffB);
        PG8_WAIT_V(6); PG8_BAR;
    }
    for (;;) {
        const bool has_next = S.next(ui + 1, nxt);
        const char* nA = has_next ? (const char*)g.A + (size_t)nxt.pm * tstep : cA; const char* nB = has_next ? (const char*)g.Bt + (size_t)nxt.pn * tstep : cB;
        for (int t = 0; t < nt; t += 2) {
            const bool last = (t == nt - 2);
            const char* a1 = cA + (size_t)(t + 1) * kstep;
            const char* a2 = last ? nA : cA + (size_t)(t + 2) * kstep; const char* b2 = last ? nB : cB + (size_t)(t + 2) * kstep;
            const char* a3 = a2 + kstep; const char* b3 = b2 + kstep;
            if (last && has_next) S.a_ready(nxt);
            if constexpr (SP2) {
            PG8_LDB(B0, 0, 0); PG8_LDB(B1, 0, 1); PG8_SCHED; PG8_LDA(At, 0, 0); PG8_STAGE(PG8_SA(1, 1), a1 + hstep, voffA);
            PG8_WAIT_V(8); PG8_WAIT_L(0); PG8_BAR; PG8_MMA(0, 0, At, B0); PG8_MMA(0, 1, At, B1); PG8_BAR; PG8_SCHED;
            PG8_LDA(At, 0, 1); PG8_STAGE(PG8_SB(0, 0), b2, voffB); PG8_STAGE(PG8_SB(0, 1), b2 + hstep, voffB); PG8_STAGE(PG8_SA(0, 0), a2, voffA);
            PG8_WAIT_V(8); PG8_WAIT_L(0); PG8_BAR; PG8_MMA(1, 0, At, B0); PG8_MMA(1, 1, At, B1); PG8_BAR; PG8_SCHED;
            PG8_LDB(B0, 1, 0); PG8_LDB(B1, 1, 1); PG8_SCHED; PG8_LDA(At, 1, 0); PG8_STAGE(PG8_SA(0, 1), a2 + hstep, voffA);
            PG8_WAIT_V(8); PG8_WAIT_L(0); PG8_BAR; PG8_MMA(0, 0, At, B0); PG8_MMA(0, 1, At, B1); PG8_BAR; PG8_SCHED;
            PG8_LDA(At, 1, 1); PG8_STAGE(PG8_SB(1, 0), b3, voffB); PG8_STAGE(PG8_SB(1, 1), b3 + hstep, voffB); PG8_STAGE(PG8_SA(1, 0), a3, voffA);
            PG8_WAIT_V(8); PG8_WAIT_L(0); PG8_BAR; PG8_MMA(1, 0, At, B0); PG8_MMA(1, 1, At, B1); PG8_BAR; PG8_SCHED;
            } else {
            PG8_LDB(B0, 0, 0); PG8_SCHED; PG8_LDA(At, 0, 0); PG8_STAGE(PG8_SA(1, 1), a1 + hstep, voffA);
            PG8_WAIT_L(8); PG8_BAR; PG8_WAIT_L(0); PG8_MMA(0, 0, At, B0); PG8_BAR; PG8_SCHED;
            PG8_LDB(B1, 0, 1); PG8_STAGE(PG8_SB(0, 0), b2, voffB);
            PG8_BAR; PG8_WAIT_L(0); PG8_MMA(0, 1, At, B1); PG8_BAR;
            PG8_LDA(At, 0, 1); PG8_STAGE(PG8_SA(0, 0), a2, voffA);
            PG8_BAR; PG8_WAIT_L(0); PG8_MMA(1, 0, At, B0); PG8_BAR; PG8_SCHED;
            PG8_STAGE(PG8_SB(0, 1), b2 + hstep, voffB);
            PG8_WAIT_V(6); PG8_BAR; PG8_MMA(1, 1, At, B1); PG8_BAR;
            PG8_LDB(B0, 1, 0); PG8_SCHED; PG8_LDA(At, 1, 0); PG8_STAGE(PG8_SA(0, 1), a2 + hstep, voffA);
            PG8_WAIT_L(8); PG8_BAR; PG8_WAIT_L(0); PG8_MMA(0, 0, At, B0); PG8_BAR; PG8_SCHED;
            PG8_LDB(B1, 1, 1); PG8_STAGE(PG8_SB(1, 0), b3, voffB);
            PG8_BAR; PG8_WAIT_L(0); PG8_MMA(0, 1, At, B1); PG8_BAR;
            PG8_LDA(At, 1, 1); PG8_STAGE(PG8_SA(1, 0), a3, voffA);
            PG8_BAR; PG8_WAIT_L(0); PG8_MMA(1, 0, At, B0); PG8_BAR; PG8_SCHED;
            PG8_STAGE(PG8_SB(1, 1), b3 + hstep, voffB);
            PG8_WAIT_V(6); PG8_BAR; PG8_MMA(1, 1, At, B1); PG8_BAR;
            }
        }
        if constexpr (ALIGN_EPI) { if (wr == 0) PG8_BAR; }
        if constexpr (!Epi::AFTER_DRAIN) { E(acc, cur, wr, wc, fr, fq); S.done(cur); }
        if (!has_next) break;
#pragma unroll
        for (int a = 0; a < 2; ++a)
#pragma unroll
            for (int b = 0; b < 2; ++b)
#pragma unroll
                for (int m = 0; m < 4; ++m)
#pragma unroll
                    for (int n = 0; n < 2; ++n) acc[a][b][m][n] = (f32x4){0.f, 0.f, 0.f, 0.f};
        cur = nxt; cA = nA; cB = nB; ++ui;
        if constexpr (ALIGN_EPI) { if (wr == 1) PG8_BAR; }
    }
    PG8_WAIT_V(0);
    if constexpr (!ALIGN_EPI) { if (wr == 0) PG8_BAR; }
    PG8_BAR;
    if constexpr (Epi::AFTER_DRAIN) { E.fused(acc, cur, wr, wc, fr, fq, lds, wid, lane); S.done(cur); }
#undef PG8_SA
#undef PG8_SB
#undef PG8_STAGE
#undef PG8_LDA
#undef PG8_LDB
#undef PG8_MMA
#undef PG8_WAIT_V
#undef PG8_WAIT_L
#undef PG8_BAR
#undef PG8_SCHED
}
}
#define UNPACK8(W, V, O) do { V[O + 0] = bf_lo(W.x); V[O + 1] = bf_hi(W.x); V[O + 2] = bf_lo(W.y); V[O + 3] = bf_hi(W.y); V[O + 4] = bf_lo(W.z); V[O + 5] = bf_hi(W.z); V[O + 6] = bf_lo(W.w); V[O + 7] = bf_hi(W.w); } while (0)
#define PACK8(V, O, SC) (u32x4){pk2(V[O] * SC, V[O + 1] * SC), pk2(V[O + 2] * SC, V[O + 3] * SC), pk2(V[O + 4] * SC, V[O + 5] * SC), pk2(V[O + 6] * SC, V[O + 7] * SC)}
__device__ __forceinline__ void headnorm96(const bf16_t* srcA, const bf16_t* srcB, bf16_t* dst, const float* __restrict__ g, float outscale, bool rope, int rowpos, int colpos,
                                           const float* __restrict__ tab8, int j) {
  const u32x4 w0 = *(const u32x4*)(srcA + j * 8), w1 = *(const u32x4*)(srcA + 32 + j * 8), w2 = *(const u32x4*)(srcB + j * 8);
  float v[24];
  UNPACK8(w0, v, 0); UNPACK8(w1, v, 8); UNPACK8(w2, v, 16);
  float ss = 0.f;
#pragma unroll
  for (int e = 0; e < 24; ++e) ss += v[e] * v[e];
  ss += __shfl_xor(ss, 1); ss += __shfl_xor(ss, 2);
  const float rstd = rsqrtf(ss * (1.f / 96.f) + EPS);
#pragma unroll
  for (int e = 0; e < 8; ++e) { v[e] *= rstd * g[j * 8 + e]; v[8 + e] *= rstd * g[32 + j * 8 + e]; v[16 + e] *= rstd * g[64 + j * 8 + e]; }
  const int pos = (j < 2) ? rowpos : colpos;
#pragma unroll
  for (int e = 0; e < 8; ++e) {
    const float own = v[16 + e], oth = __shfl_xor(own, 1);
    const f32x2_t cs = *(const f32x2_t*)(tab8 + (pos * 8 + e) * 2);
    const float res = (j & 1) ? (oth * cs.y + own * cs.x) : (own * cs.x - oth * cs.y);
    if (rope) v[16 + e] = res;
  }
  *(u32x4*)(dst + j * 8) = PACK8(v, 0, outscale); *(u32x4*)(dst + 32 + j * 8) = PACK8(v, 8, outscale); *(u32x4*)(dst + 64 + j * 8) = PACK8(v, 16, outscale);
}
__device__ __forceinline__ void headnorm64(const bf16_t* q, bf16_t* qd, const float* __restrict__ g, float outscale, bool rope, int rowpos, int colpos, const float* __restrict__ tab16, int j) {
  const u32x4 w0 = *(const u32x4*)(q + j * 8), w1 = *(const u32x4*)(q + 32 + j * 8);
  float v[16];
  UNPACK8(w0, v, 0); UNPACK8(w1, v, 8);
  float ss = 0.f;
#pragma unroll
  for (int e = 0; e < 16; ++e) ss += v[e] * v[e];
  ss += __shfl_xor(ss, 1); ss += __shfl_xor(ss, 2);
  const float rstd = rsqrtf(ss * (1.f / 64.f) + EPS);
#pragma unroll
  for (int e = 0; e < 8; ++e) { v[e] *= rstd * g[j * 8 + e]; v[8 + e] *= rstd * g[32 + j * 8 + e]; }
#pragma unroll
  for (int e = 0; e < 8; ++e) {
    const int i = (j & 1) * 8 + e;
    const float own0 = v[e], oth0 = __shfl_xor(own0, 2), own1 = v[8 + e], oth1 = __shfl_xor(own1, 2);
    const f32x2_t cr = *(const f32x2_t*)(tab16 + (rowpos * 16 + i) * 2), cc = *(const f32x2_t*)(tab16 + (colpos * 16 + i) * 2);
    const float r0 = (j >> 1) ? (oth0 * cr.y + own0 * cr.x) : (own0 * cr.x - oth0 * cr.y);
    const float r1 = (j >> 1) ? (oth1 * cc.y + own1 * cc.x) : (own1 * cc.x - oth1 * cc.y);
    if (rope) { v[e] = r0; v[8 + e] = r1; }
  }
  *(u32x4*)(qd + j * 8) = PACK8(v, 0, outscale); *(u32x4*)(qd + 32 + j * 8) = PACK8(v, 8, outscale);
}

template <int DQK, int DV, int NS, bool WINDOW>
__device__ __forceinline__ void attn_unit(LAS unsigned char* lds, const bf16_t* __restrict__ Qb, int qsoff, int ldq, const bf16_t* __restrict__ Kb, int ksoff, int ldk,
                                          const bf16_t* __restrict__ Vb, int ldv, int q0, int ta0, int ta1, int tb0, int tb1, bool has_sink, float sink_l2, float kmax,
                                          unsigned char* __restrict__ Ob, int ldo, float lam, const float* __restrict__ gsub, int wv) {
  constexpr int KS = DQK * 2 + 16, KTB = 64 * KS, VS = (DV == 64) ? 192 : 320, VOFF = NS * KTB, VTB = 64 * VS, STG = VOFF + VTB;
  constexpr int KCR = DQK / 8, KCH = 64 * KCR, VCR = DV / 8, VCH = 64 * VCR, NCH = NS * KCH + VCH, NI = (NCH + NTHREADS - 1) / NTHREADS;
  constexpr int NDB = DV / 32, NKS = DQK / 16;
  static_assert(3 * STG <= LDS_BYTES - 16 && (NS == 1 || 4 * DV * 32 * 4 <= 3 * STG), "LDS");
  const int tid = otid(wv), lane = tid & 63, wid = tid >> 6, l31 = lane & 31, hi = lane >> 5;
  const int grp = wid >> 2;
  const int qsub = (NS == 1) ? wid : (wid & 3), stream = (NS == 1) ? 0 : grp;
  const int qrow = q0 + qsub * 32 + l31;
  bf16x8 qf[NKS];
  float qn2 = 0.f;
#pragma unroll
  for (int ks = 0; ks < NKS; ++ks) {
    const u32x4 w = *(const u32x4*)(Qb + (size_t)stream * qsoff + (size_t)qrow * ldq + ks * 16 + hi * 8);
    qf[ks] = __builtin_bit_cast(bf16x8, w);
    const float a0 = bf_lo(w.x), a1 = bf_hi(w.x), a2 = bf_lo(w.y), a3 = bf_hi(w.y), a4 = bf_lo(w.z), a5 = bf_hi(w.z), a6 = bf_lo(w.w), a7 = bf_hi(w.w);
    qn2 += a0 * a0 + a1 * a1 + a2 * a2 + a3 * a3 + a4 * a4 + a5 * a5 + a6 * a6 + a7 * a7;
  }
  qn2 += __shfl_xor(qn2, 32);
  const float negmb = -(sqrtf(qn2) * kmax);
  f32x16 negmv;
  if (DV == 64) {
#pragma unroll
    for (int r = 0; r < 16; ++r) negmv[r] = negmb;
    asm volatile("" : "+v"(negmv));
  }
  f32x16 o[NDB];
#pragma unroll
  for (int db = 0; db < NDB; ++db)
#pragma unroll
    for (int r = 0; r < 16; ++r) o[db][r] = 0.f;
  float lrun = 0.f;
  const int n1 = ta1 - ta0, ntl = n1 + (tb1 - tb0);
  u32x4 st[NI];
  f32x16 p0, p1;
  const LAS unsigned char* klb = lds + stream * KTB + l31 * KS + hi * 16;
  const LAS unsigned char* vlb = lds + VOFF + (4 * hi + ((lane & 15) >> 2)) * VS + (16 * ((lane >> 4) & 1) + 4 * (lane & 3)) * 2;
#define ATT_TILE(i_) (((i_) < n1) ? ta0 + (i_) : tb0 + ((i_) - n1))
#define ATT_LOAD(T_) do { const int t__ = (T_); _Pragma("unroll") for (int ii = 0; ii < NI; ++ii) { const int c = tid + ii * NTHREADS; if (c < NCH) { \
      if (c < NS * KCH) { const int s_ = c / KCH, cc = c - s_ * KCH, row = cc / KCR, kc = cc - row * KCR; st[ii] = *(const u32x4*)(Kb + (size_t)s_ * ksoff + (size_t)(t__ * 64 + row) * ldk + kc * 8); } \
      else { const int cc = c - NS * KCH, row = cc / VCR, vc = cc - row * VCR; st[ii] = *(const u32x4*)(Vb + (size_t)(t__ * 64 + row) * ldv + vc * 8); } } } } while (0)
#define ATT_STORE(BO_) do { LAS unsigned char* sb__ = lds + (BO_); _Pragma("unroll") for (int ii = 0; ii < NI; ++ii) { const int c = tid + ii * NTHREADS; if (c < NCH) { \
      if (c < NS * KCH) { const int s_ = c / KCH, cc = c - s_ * KCH, row = cc / KCR, kc = cc - row * KCR; *(LAS u32x4*)(sb__ + s_ * KTB + row * KS + kc * 16) = st[ii]; } \
      else { const int cc = c - NS * KCH, row = cc / VCR, vc = cc - row * VCR; *(LAS u32x4*)(sb__ + VOFF + row * VS + vc * 16) = st[ii]; } } } } while (0)
#define ATT_FLAGS(T_, ACT_, MSK_) do { ACT_ = true; MSK_ = false; if (WINDOW && (T_) < 32) { const int qlo = q0 + qsub * 32, qhi = qlo + 31, klo = (T_) * 64, khi = klo + 63; \
      ACT_ = !(khi < qlo - 128 || klo > qhi + 128); MSK_ = (khi - qlo > 128) || (qhi - klo > 128); } } while (0)
  constexpr int KB1 = NKS / 2;
  bf16x8 kf[2 * KB1];
#define ATT_QK_READ1(BO_) do { const LAS unsigned char* kl = klb + (BO_); \
      _Pragma("unroll") for (int ks = 0; ks < KB1; ++ks) { kf[2 * ks] = *(const LAS bf16x8*)(kl + ks * 32); kf[2 * ks + 1] = *(const LAS bf16x8*)(kl + 32 * KS + ks * 32); } \
      __builtin_amdgcn_sched_barrier(0); } while (0)
#define ATT_QK_REST(BO_) do { const LAS unsigned char* kl = klb + (BO_); \
      __builtin_amdgcn_sched_barrier(0); \
      if (DV == 64) { p0 = __builtin_amdgcn_mfma_f32_32x32x16_bf16(kf[0], qf[0], negmv, 0, 0, 0); p1 = __builtin_amdgcn_mfma_f32_32x32x16_bf16(kf[1], qf[0], negmv, 0, 0, 0); } \
      else { _Pragma("unroll") for (int r = 0; r < 16; ++r) { p0[r] = negmb; p1[r] = negmb; } p0 = __builtin_amdgcn_mfma_f32_32x32x16_bf16(kf[0], qf[0], p0, 0, 0, 0); p1 = __builtin_amdgcn_mfma_f32_32x32x16_bf16(kf[1], qf[0], p1, 0, 0, 0); } \
      _Pragma("unroll") for (int ks = 1; ks < KB1; ++ks) { p0 = __builtin_amdgcn_mfma_f32_32x32x16_bf16(kf[2 * ks], qf[ks], p0, 0, 0, 0); p1 = __builtin_amdgcn_mfma_f32_32x32x16_bf16(kf[2 * ks + 1], qf[ks], p1, 0, 0, 0); } \
      __builtin_amdgcn_sched_barrier(0); \
      _Pragma("unroll") for (int ks = KB1; ks < NKS; ++ks) { kf[2 * (ks - KB1)] = *(const LAS bf16x8*)(kl + ks * 32); kf[2 * (ks - KB1) + 1] = *(const LAS bf16x8*)(kl + 32 * KS + ks * 32); } \
      __builtin_amdgcn_sched_barrier(0); \
      _Pragma("unroll") for (int ks = KB1; ks < NKS; ++ks) { p0 = __builtin_amdgcn_mfma_f32_32x32x16_bf16(kf[2 * (ks - KB1)], qf[ks], p0, 0, 0, 0); p1 = __builtin_amdgcn_mfma_f32_32x32x16_bf16(kf[2 * (ks - KB1) + 1], qf[ks], p1, 0, 0, 0); } \
      __builtin_amdgcn_sched_barrier(0); } while (0)
#define ATT_VREAD(G_) do { _Pragma("unroll") for (int d2 = 0; d2 < GD; ++d2) _Pragma("unroll") for (int kb = 0; kb < 2; ++kb) _Pragma("unroll") for (int s_ = 0; s_ < 2; ++s_) { \
        const LAS unsigned char* vp = vl + (kb * 32 + 16 * s_) * VS + ((G_) * GD + d2) * 64; \
        vlo[d2 * 4 + kb * 2 + s_] = __builtin_amdgcn_ds_read_tr16_b64_v4i16((LAS v4i16_t*)vp); vhi[d2 * 4 + kb * 2 + s_] = __builtin_amdgcn_ds_read_tr16_b64_v4i16((LAS v4i16_t*)(vp + 8 * VS)); } } while (0)
#define ATT_PVM(G_) do { _Pragma("unroll") for (int d2 = 0; d2 < GD; ++d2) _Pragma("unroll") for (int kb = 0; kb < 2; ++kb) _Pragma("unroll") for (int s_ = 0; s_ < 2; ++s_) { \
        const v4i16_t lo_ = vlo[d2 * 4 + kb * 2 + s_], hi_ = vhi[d2 * 4 + kb * 2 + s_]; \
        const bf16x8 vf = (bf16x8){lo_[0], lo_[1], lo_[2], lo_[3], hi_[0], hi_[1], hi_[2], hi_[3]}; \
        o[(G_) * GD + d2] = __builtin_amdgcn_mfma_f32_32x32x16_bf16(vf, __builtin_bit_cast(bf16x8, pw[kb][s_]), o[(G_) * GD + d2], 0, 0, 0); } } while (0)
#define ATT_SPV(T_, BO_, MSK_) do { const LAS unsigned char* vl = vlb + (BO_); constexpr int GD = (DV == 128) ? 1 : 2; v4i16_t vlo[4 * GD], vhi[4 * GD]; \
      ATT_VREAD(0); __builtin_amdgcn_sched_barrier(0); \
      if (WINDOW && (MSK_)) { _Pragma("unroll") for (int r = 0; r < 16; ++r) { const int d0 = (T_) * 64 + crow(r, hi) - qrow, d1 = d0 + 32; \
          if (d0 > 128 || d0 < -128) p0[r] = -INFINITY; if (d1 > 128 || d1 < -128) p1[r] = -INFINITY; } } \
      _Pragma("unroll") for (int r = 0; r < 16; ++r) { p0[r] = __builtin_amdgcn_exp2f(p0[r]); p1[r] = __builtin_amdgcn_exp2f(p1[r]); } \
      u32x4 pw[2][2]; \
      _Pragma("unroll") for (int s_ = 0; s_ < 2; ++s_) { \
        pw[0][s_] = (u32x4){pk2(p0[8 * s_], p0[8 * s_ + 1]), pk2(p0[8 * s_ + 2], p0[8 * s_ + 3]), pk2(p0[8 * s_ + 4], p0[8 * s_ + 5]), pk2(p0[8 * s_ + 6], p0[8 * s_ + 7])}; \
        pw[1][s_] = (u32x4){pk2(p1[8 * s_], p1[8 * s_ + 1]), pk2(p1[8 * s_ + 2], p1[8 * s_ + 3]), pk2(p1[8 * s_ + 4], p1[8 * s_ + 5]), pk2(p1[8 * s_ + 6], p1[8 * s_ + 7])}; } \
      _Pragma("unroll") for (int kb = 0; kb < 2; ++kb) _Pragma("unroll") for (int s_ = 0; s_ < 2; ++s_) { \
        lrun = dot2bf(pw[kb][s_].x, 0x3f803f80u, lrun); lrun = dot2bf(pw[kb][s_].y, 0x3f803f80u, lrun); lrun = dot2bf(pw[kb][s_].z, 0x3f803f80u, lrun); lrun = dot2bf(pw[kb][s_].w, 0x3f803f80u, lrun); } \
      __builtin_amdgcn_sched_barrier(0); \
      ATT_PVM(0); \
      _Pragma("unroll") for (int g_ = 1; g_ < NDB / GD; ++g_) { __builtin_amdgcn_sched_barrier(0); ATT_VREAD(g_); __builtin_amdgcn_sched_barrier(0); ATT_PVM(g_); } } while (0)
  ATT_LOAD(ATT_TILE(0));
  ATT_STORE(0);
  if (ntl > 1) ATT_LOAD(ATT_TILE(1));
  __syncthreads();
  int bo_prev = 0, bo_cur = 0, bo_next = STG;
  for (int i = 0; i <= ntl; ++i) {
    if (grp == 0) {
      if (i < ntl) {
        const int t = ATT_TILE(i);
        bool act, msk; ATT_FLAGS(t, act, msk);
        if (act) ATT_QK_READ1(bo_cur);
        if (i + 1 < ntl) ATT_STORE(bo_next);
        if (i + 2 < ntl) ATT_LOAD(ATT_TILE(i + 2));
        if (act) { ATT_QK_REST(bo_cur); ATT_SPV(t, bo_cur, msk); }
      }
    } else {
      if (i >= 1) { const int tp = ATT_TILE(i - 1); bool act, msk; ATT_FLAGS(tp, act, msk); if (act) ATT_SPV(tp, bo_prev, msk); }
      if (i < ntl) {
        const int t = ATT_TILE(i);
        bool act, msk; ATT_FLAGS(t, act, msk);
        if (act) ATT_QK_READ1(bo_cur);
        if (i + 1 < ntl) ATT_STORE(bo_next);
        if (i + 2 < ntl) ATT_LOAD(ATT_TILE(i + 2));
        if (act) ATT_QK_REST(bo_cur);
      }
    }
    bo_prev = bo_cur; bo_cur = bo_next; bo_next = (bo_next == 2 * STG) ? 0 : bo_next + STG;
    __syncthreads();
  }
#undef ATT_LOAD
#undef ATT_STORE
#undef ATT_TILE
#undef ATT_FLAGS
#undef ATT_QK_READ1
#undef ATT_QK_REST
#undef ATT_VREAD
#undef ATT_PVM
#undef ATT_SPV
  float ltot = lrun + __shfl_xor(lrun, 32);
  if (has_sink) ltot += __builtin_amdgcn_exp2f(sink_l2 + negmb);
  const float inv = 1.f / ltot;
  if (NS == 1) {
    unsigned char* op = Ob + (size_t)qrow * ldo + 4 * hi; const float is_ = inv * OSC;
#pragma unroll
    for (int db = 0; db < NDB; ++db)
#pragma unroll
      for (int r4 = 0; r4 < 4; ++r4)
        *(unsigned*)(op + db * 32 + 8 * r4) = pk4_fp8(o[db][4 * r4] * is_, o[db][4 * r4 + 1] * is_, o[db][4 * r4 + 2] * is_, o[db][4 * r4 + 3] * is_);
  } else {
    LAS float* ex = (LAS float*)lds + qsub * (DV * 32);
    if (stream == 1) {
#pragma unroll
      for (int db = 0; db < NDB; ++db)
#pragma unroll
        for (int r = 0; r < 16; ++r) ex[(db * 32 + crow(r, hi)) * 32 + l31] = o[db][r] * inv;
    }
    __syncthreads();
    if (stream == 0) {
      float ss = 0.f;
#pragma unroll
      for (int db = 0; db < NDB; ++db)
#pragma unroll
        for (int r = 0; r < 16; ++r) { const float v = o[db][r] * inv - lam * ex[(db * 32 + crow(r, hi)) * 32 + l31]; o[db][r] = v; ss += v * v; }
      ss += __shfl_xor(ss, 32);
      const float rs = rsqrtf(ss * (1.f / DV) + EPS) * (1.f - LAM_INIT);
      unsigned char* op = Ob + (size_t)qrow * ldo + 4 * hi; const float rs_ = rs * OSC;
#pragma unroll
      for (int db = 0; db < NDB; ++db)
#pragma unroll
        for (int r4 = 0; r4 < 4; ++r4) {
          const f32x4 g4 = *(const f32x4*)(gsub + db * 32 + 8 * r4 + 4 * hi);
          *(unsigned*)(op + db * 32 + 8 * r4) = pk4_fp8(o[db][4 * r4] * rs_ * g4.x, o[db][4 * r4 + 1] * rs_ * g4.y, o[db][4 * r4 + 2] * rs_ * g4.z, o[db][4 * r4 + 3] * rs_ * g4.w);
        }
    }
    __syncthreads();
  }
}

template <int DQK, int DV, bool WINDOW>
__device__ __forceinline__ void attn_unit_p(LAS unsigned char* lds, const bf16_t* __restrict__ Qb, int ldq, const bf16_t* __restrict__ Kb, int ldk, const bf16_t* __restrict__ Vb, int ldv,
                                            int q0, int ta0, int ta1, int tb0, int tb1, bool has_sink, float sink_l2, float kmax, unsigned char* __restrict__ Ob, int ldo, int wv) {
  static_assert(DV == 64 && !WINDOW, "pipelined form: DV = 64, no window");
  constexpr int KS = DQK * 2 + 16, KTB = 64 * KS, VS = 192, VOFF = KTB, VTB = 64 * VS, STG = VOFF + VTB;
  constexpr int KCR = DQK / 8, KCH = 64 * KCR, VCR = DV / 8, VCH = 64 * VCR, NCH = KCH + VCH, NI = (NCH + NTHREADS - 1) / NTHREADS;
  constexpr int NKS = DQK / 16, NQK = 2 * NKS, NPV = 8, EG = (NQK >= 12) ? 8 : NQK - 2;
  static_assert(3 * STG <= LDS_BYTES - 16, "LDS");
  const int tid = otid(wv), lane = tid & 63, wid = tid >> 6, l31 = lane & 31, hi = lane >> 5;
  const int qrow = q0 + wid * 32 + l31;
  bf16x8 qf[NKS];
  float qn2 = 0.f;
#pragma unroll
  for (int ks = 0; ks < NKS; ++ks) {
    const u32x4 w = *(const u32x4*)(Qb + (size_t)qrow * ldq + ks * 16 + hi * 8);
    qf[ks] = __builtin_bit_cast(bf16x8, w);
    const float a0 = bf_lo(w.x), a1 = bf_hi(w.x), a2 = bf_lo(w.y), a3 = bf_hi(w.y), a4 = bf_lo(w.z), a5 = bf_hi(w.z), a6 = bf_lo(w.w), a7 = bf_hi(w.w);
    qn2 += a0 * a0 + a1 * a1 + a2 * a2 + a3 * a3 + a4 * a4 + a5 * a5 + a6 * a6 + a7 * a7;
  }
  qn2 += __shfl_xor(qn2, 32);
  const float negmb = -(sqrtf(qn2) * kmax);
  f32x16 negmv;
#pragma unroll
  for (int r = 0; r < 16; ++r) negmv[r] = negmb;
  asm volatile("" : "+v"(negmv));
  f32x16 o[2];
#pragma unroll
  for (int db = 0; db < 2; ++db)
#pragma unroll
    for (int r = 0; r < 16; ++r) o[db][r] = 0.f;
  float lrun = 0.f;
  const int n1 = ta1 - ta0, ntl = n1 + (tb1 - tb0);
  u32x4 st[NI];
  f32x16 pA0, pA1, pB0, pB1;
  bf16x8 kw[3];
  v4i16_t vwl[3], vwh[3];
  u32x4 pw[2][2];
  const LAS unsigned char* klb = lds + l31 * KS + hi * 16;
  const LAS unsigned char* vlb = lds + VOFF + (4 * hi + ((lane & 15) >> 2)) * VS + (16 * ((lane >> 4) & 1) + 4 * (lane & 3)) * 2;
#define ATT_TILE(i_) (((i_) < n1) ? ta0 + (i_) : tb0 + ((i_) - n1))
  unsigned gof[NI], lof[NI];
#pragma unroll
  for (int ii = 0; ii < NI; ++ii) { const int cw = (wv + 8 * ii) * 64, c = cw + lane;
    if (cw < KCH) { const int row = c / KCR, kc = c - row * KCR; gof[ii] = (unsigned)(row * ldk + kc * 8) * 2u; lof[ii] = (unsigned)(row * KS + kc * 16); }
    else { const int cc = c - KCH, row = cc / VCR, vc = cc - row * VCR; gof[ii] = (unsigned)(row * ldv + vc * 8) * 2u; lof[ii] = (unsigned)(VOFF + row * VS + vc * 16); } }
#define ATT_LOAD(T_) do { const int t__ = (T_); _Pragma("unroll") for (int ii = 0; ii < NI; ++ii) { const int cw = (wv + 8 * ii) * 64; if (cw < NCH) { \
      const char* gb__ = (cw < KCH) ? (const char*)Kb + (size_t)t__ * 128 * ldk : (const char*)Vb + (size_t)t__ * 128 * ldv; st[ii] = *(const u32x4*)(gb__ + gof[ii]); } } } while (0)
#define ATT_STORE(BO_) do { _Pragma("unroll") for (int ii = 0; ii < NI; ++ii) { const int cw = (wv + 8 * ii) * 64; if (cw < NCH) *(LAS u32x4*)(lds + (BO_) + lof[ii]) = st[ii]; } } while (0)
#define SB_() __builtin_amdgcn_sched_barrier(0)
#define KRD1(BO_, G_) do { kw[(G_) % 3] = *(const LAS bf16x8*)(klb + (BO_) + ((G_) & 1) * 32 * KS + ((G_) >> 1) * 32); } while (0)
#define VRDG(BO_, G_) do { const LAS unsigned char* vp = vlb + (BO_) + ((((G_) >> 2) & 1) * 32 + 16 * (((G_) >> 1) & 1)) * VS + ((G_) & 1) * 64; \
      vwl[(G_) % 3] = __builtin_amdgcn_ds_read_tr16_b64_v4i16((LAS v4i16_t*)vp); vwh[(G_) % 3] = __builtin_amdgcn_ds_read_tr16_b64_v4i16((LAS v4i16_t*)(vp + 8 * VS)); } while (0)
#define QKM(R0_, R1_, G_) do { const int ks_ = (G_) >> 1; \
      if (((G_) & 1) == 0) R0_ = __builtin_amdgcn_mfma_f32_32x32x16_bf16(kw[(G_) % 3], qf[ks_], (ks_ == 0) ? negmv : R0_, 0, 0, 0); \
      else R1_ = __builtin_amdgcn_mfma_f32_32x32x16_bf16(kw[(G_) % 3], qf[ks_], (ks_ == 0) ? negmv : R1_, 0, 0, 0); } while (0)
#define PVM(G_) do { const int d2_ = (G_) & 1, kb_ = ((G_) >> 2) & 1, s_ = ((G_) >> 1) & 1; \
      const v4i16_t lo_ = vwl[(G_) % 3], hi_ = vwh[(G_) % 3]; const bf16x8 vf = (bf16x8){lo_[0], lo_[1], lo_[2], lo_[3], hi_[0], hi_[1], hi_[2], hi_[3]}; \
      o[d2_] = __builtin_amdgcn_mfma_f32_32x32x16_bf16(vf, __builtin_bit_cast(bf16x8, pw[kb_][s_]), o[d2_], 0, 0, 0); } while (0)
#define PACK1(P_, KB_, C_) do { const int s_ = (C_) >> 2, e_ = (C_) & 3; pw[KB_][s_][e_] = pk2(P_[8 * s_ + 2 * e_], P_[8 * s_ + 2 * e_ + 1]); } while (0)
#define EXPR(P_, LO_, HI_) do { _Pragma("unroll") for (int x_ = (LO_); x_ < (HI_); ++x_) { float e_ = __builtin_amdgcn_exp2f(P_[x_]); asm volatile("" : "+v"(e_)); P_[x_] = e_; } } while (0)
#define SUMR(P_, LO_, HI_) do { _Pragma("unroll") for (int x_ = (LO_); x_ < (HI_); ++x_) lrun += P_[x_]; asm volatile("" : "+v"(lrun)); } while (0)
#define FILL_A(E0_, E1_, G_) do { \
      if ((G_) < EG) EXPR(E1_, ((G_) * 16) / EG, (((G_) + 1) * 16) / EG); \
      if ((G_) >= 1 && (G_) <= EG) SUMR(E1_, (((G_) - 1) * 16) / EG, ((G_) * 16) / EG); \
      if ((G_) < EG) { _Pragma("unroll") for (int c = ((G_) * 8) / EG; c < (((G_) + 1) * 8) / EG; ++c) PACK1(E0_, 0, c); } \
      else { _Pragma("unroll") for (int c = (((G_) - EG) * 8) / (NQK - EG); c < (((G_) - EG + 1) * 8) / (NQK - EG); ++c) PACK1(E1_, 1, c); } } while (0)
#define FILL_B(R0_, G_) do { EXPR(R0_, 2 * (G_), 2 * (G_) + 2); if ((G_) >= 1) SUMR(R0_, 2 * (G_) - 2, 2 * (G_)); if ((G_) == NPV - 1) SUMR(R0_, 14, 16); } while (0)
#define STEP_MID(R0_, R1_, E0_, E1_, BOC_, BOP_) do { \
      _Pragma("unroll") for (int g = 0; g < NQK; ++g) { \
        QKM(R0_, R1_, g); \
        if (g + 2 < NQK) KRD1(BOC_, g + 2); \
        if (g >= NQK - 2) VRDG(BOP_, g - (NQK - 2)); \
        FILL_A(E0_, E1_, g); \
        SB_(); } \
      _Pragma("unroll") for (int g = 0; g < NPV; ++g) { \
        PVM(g); \
        if (g + 2 < NPV) VRDG(BOP_, g + 2); \
        FILL_B(R0_, g); \
        SB_(); } } while (0)
#define STEP_HEAD(R0_, R1_, BOC_) do { \
      _Pragma("unroll") for (int g = 0; g < NQK; ++g) { QKM(R0_, R1_, g); if (g + 2 < NQK) KRD1(BOC_, g + 2); SB_(); } \
      _Pragma("unroll") for (int g = 0; g < NPV; ++g) { FILL_B(R0_, g); } SB_(); } while (0)
#define STEP_TAIL(E0_, E1_, BOP_) do { \
      VRDG(BOP_, 0); VRDG(BOP_, 1); \
      _Pragma("unroll") for (int g = 0; g < NQK; ++g) FILL_A(E0_, E1_, g); SB_(); \
      _Pragma("unroll") for (int g = 0; g < NPV; ++g) { PVM(g); if (g + 2 < NPV) VRDG(BOP_, g + 2); SB_(); } } while (0)
#define STEP_PRE(I_, KR_) do { const int i__ = (I_); \
      if (KR_) { KRD1(bo_cur, 0); KRD1(bo_cur, 1); } \
      if (i__ + 1 < ntl) ATT_STORE(bo_next); \
      if (i__ + 2 < ntl) ATT_LOAD(ATT_TILE(i__ + 2)); \
      SB_(); } while (0)
#define STEP_POST() do { bo_prev = bo_cur; bo_cur = bo_next; bo_next = (bo_next == 2 * STG) ? 0 : bo_next + STG; __syncthreads(); } while (0)
  ATT_LOAD(ATT_TILE(0));
  ATT_STORE(0);
  if (ntl > 1) ATT_LOAD(ATT_TILE(1));
  __syncthreads();
  int bo_prev = 0, bo_cur = 0, bo_next = STG;
  STEP_PRE(0, true); STEP_HEAD(pA0, pA1, bo_cur); STEP_POST();
  int it = 1;
  for (; it + 1 < ntl; it += 2) {
    STEP_PRE(it, true); STEP_MID(pB0, pB1, pA0, pA1, bo_cur, bo_prev); STEP_POST();
    STEP_PRE(it + 1, true); STEP_MID(pA0, pA1, pB0, pB1, bo_cur, bo_prev); STEP_POST();
  }
  if (it < ntl) {
    STEP_PRE(it, true); STEP_MID(pB0, pB1, pA0, pA1, bo_cur, bo_prev); STEP_POST();
    STEP_TAIL(pB0, pB1, bo_prev);
  } else {
    STEP_TAIL(pA0, pA1, bo_prev);
  }
  __syncthreads();
#undef ATT_TILE
#undef ATT_LOAD
#undef ATT_STORE
#undef SB_
#undef KRD1
#undef VRDG
#undef QKM
#undef PVM
#undef PACK1
#undef EXPR
#undef SUMR
#undef FILL_A
#undef FILL_B
#undef STEP_MID
#undef STEP_HEAD
#undef STEP_TAIL
#undef STEP_PRE
#undef STEP_POST
  float ltot = lrun + __shfl_xor(lrun, 32);
  if (has_sink) ltot += __builtin_amdgcn_exp2f(sink_l2 + negmb);
  const float is_ = OSC / ltot;
  unsigned char* op = Ob + (size_t)qrow * ldo + 4 * hi;
#pragma unroll
  for (int db = 0; db < 2; ++db)
#pragma unroll
    for (int r4 = 0; r4 < 4; ++r4)
      *(unsigned*)(op + db * 32 + 8 * r4) = pk4_fp8(o[db][4 * r4] * is_, o[db][4 * r4 + 1] * is_, o[db][4 * r4 + 2] * is_, o[db][4 * r4 + 3] * is_);
}

#define TOPK_INSERT(ARR, KEY) do { unsigned k__ = (KEY); _Pragma("unroll") for (int t_ = 0; t_ < 16; ++t_) { const unsigned h__ = max(ARR[t_], k__); k__ = min(ARR[t_], k__); ARR[t_] = h__; } } while (0)
__device__ __forceinline__ void peer_phase(LAS unsigned char* lds, const bf16_t* __restrict__ S, const unsigned char* __restrict__ H, const unsigned char* __restrict__ U, const unsigned char* __restrict__ V, float uinv, float vinv,
                                           const float* __restrict__ modl, bf16_t* xl, bf16_t* xc, float* outf, bool last, bool live, unsigned char* Hn, const float* __restrict__ gn, const float* __restrict__ modn, int wv) {
  const int tid_ = otid(wv); const int lane = tid_ & 63, wid = tid_ >> 6;
  LAS unsigned* keysL = (LAS unsigned*)(lds + wid * 9216);
  LAS u32x2* resL = (LAS u32x2*)(lds + wid * 9216 + 4096);
  LAS float* wL = (LAS float*)(lds + wid * 9216 + 8192);
  const int ngroups = last ? (NB * SEQ / 4) : (M / 4);
  const int nwav = gridDim.x * NWAVES, nfull = (ngroups / nwav) * nwav, nitems = nfull + (ngroups - nfull) * 4;
  for (int q = blockIdx.x * NWAVES + wid; q < nitems; q += nwav) {
    const int g = (q < nfull) ? q : nfull + ((q - nfull) >> 2);
    const int tk0 = (q < nfull) ? 0 : ((q - nfull) & 3), tk1 = (q < nfull) ? 4 : tk0 + 1;
    const int r0 = last ? (g / (SEQ / 4)) * TPB + (g % (SEQ / 4)) * 4 : g * 4;
    const int tok = lane >> 4, hc = lane & 15;
    unsigned top[16];
    const bf16_t* sp = S + (size_t)(r0 + tok) * 2048 + hc * 128;
#define CE_DESC(A_, B_) do { const unsigned h__ = max(A_, B_), l__ = min(A_, B_); A_ = h__; B_ = l__; } while (0)
#pragma unroll 1
    for (int j0 = 0; j0 < 128; j0 += 16) {
      unsigned blk[16];
      { const u32x4 v0 = *(const u32x4*)(sp + j0), v1 = *(const u32x4*)(sp + j0 + 8);
        const unsigned base = (unsigned)(127 - j0);
        blk[0] = (f2ord(bf_lo(v0.x)) & ~127u) | (base - 0u);  blk[1] = (f2ord(bf_hi(v0.x)) & ~127u) | (base - 1u);
        blk[2] = (f2ord(bf_lo(v0.y)) & ~127u) | (base - 2u);  blk[3] = (f2ord(bf_hi(v0.y)) & ~127u) | (base - 3u);
        blk[4] = (f2ord(bf_lo(v0.z)) & ~127u) | (base - 4u);  blk[5] = (f2ord(bf_hi(v0.z)) & ~127u) | (base - 5u);
        blk[6] = (f2ord(bf_lo(v0.w)) & ~127u) | (base - 6u);  blk[7] = (f2ord(bf_hi(v0.w)) & ~127u) | (base - 7u);
        blk[8] = (f2ord(bf_lo(v1.x)) & ~127u) | (base - 8u);  blk[9] = (f2ord(bf_hi(v1.x)) & ~127u) | (base - 9u);
        blk[10] = (f2ord(bf_lo(v1.y)) & ~127u) | (base - 10u); blk[11] = (f2ord(bf_hi(v1.y)) & ~127u) | (base - 11u);
        blk[12] = (f2ord(bf_lo(v1.z)) & ~127u) | (base - 12u); blk[13] = (f2ord(bf_hi(v1.z)) & ~127u) | (base - 13u);
        blk[14] = (f2ord(bf_lo(v1.w)) & ~127u) | (base - 14u); blk[15] = (f2ord(bf_hi(v1.w)) & ~127u) | (base - 15u); }
#pragma unroll
      for (int k = 2; k <= 16; k <<= 1)
#pragma unroll
        for (int j = k >> 1; j > 0; j >>= 1)
#pragma unroll
          for (int i = 0; i < 16; ++i) { const int l = i ^ j; if (l > i) { if ((i & k) == 0) CE_DESC(blk[i], blk[l]); else CE_DESC(blk[l], blk[i]); } }
      if (j0 == 0) {
#pragma unroll
        for (int i = 0; i < 16; ++i) top[i] = blk[i];
      } else {
#pragma unroll
        for (int i = 0; i < 16; ++i) top[i] = max(top[i], blk[15 - i]);
#pragma unroll
        for (int j = 8; j > 0; j >>= 1)
#pragma unroll
          for (int i = 0; i < 16; ++i) { const int l = i ^ j; if (l > i) CE_DESC(top[i], top[l]); }
      }
    }
#undef CE_DESC
#pragma unroll
    for (int i = 0; i < 16; ++i) keysL[lane * 16 + i] = top[i];
    float v0[16], v1[16];
#pragma unroll
    for (int i = 0; i < 16; ++i) { const unsigned t1 = __shfl_down(top[i], 1); v0[i] = ord2f(top[i] & ~127u); v1[i] = ord2f(t1 & ~127u); }
    unsigned cd[16];
#pragma unroll
    for (int i = 0; i < 16; ++i) cd[i] = 0u;
#pragma unroll
    for (int a = 0; a < 16; ++a)
#pragma unroll
      for (int b = 0; b < 16 / (a + 1); ++b) TOPK_INSERT(cd, (f2ord(v0[a] + v1[b]) & ~255u) | (unsigned)(255 - (a * 16 + b)));
    {
      float e[16]; float sum = 0.f; const float mx = ord2f(cd[0] & ~255u);
#pragma unroll
      for (int k = 0; k < 16; ++k) { e[k] = __expf(ord2f(cd[k] & ~255u) - mx); sum += e[k]; }
      const float inv = 1.f / sum;
      const int lp1 = (lane + 1) & 63;
#pragma unroll
      for (int k = 0; k < 16; ++k) {
        const int pos = 255 - (int)(cd[k] & 255u), a = pos >> 4, b = pos & 15;
        const unsigned i1 = 127u - (keysL[lane * 16 + a] & 127u), i2 = 127u - (keysL[lp1 * 16 + b] & 127u);
        if ((hc & 1) == 0) resL[tok * 128 + (hc >> 1) * 16 + k] = (u32x2){i1 * 128u + i2, __float_as_uint(e[k] * inv)};
      }
    }
    for (int tk = tk0; tk < tk1; ++tk) {
      const int r = r0 + tk;
      u32x2 ua[16], va[16], ub[16], vb[16];
      const unsigned lane8 = (unsigned)lane * 8u;
#define PEER_LOAD(UU, VV, BT) do { _Pragma("unroll") for (int i = 0; i < 16; ++i) { const unsigned o_ = resL[tk * 128 + (BT) * 16 + i].x * 512u + lane8;     \
        UU[i] = *(const u32x2*)(U + o_); VV[i] = *(const u32x2*)(V + o_); } } while (0)
      PEER_LOAD(ua, va, 0);
      float hf[16];
      { const bf16_t* hrow = (const bf16_t*)H + (size_t)r * D + lane * 16; const u32x4 ha = *(const u32x4*)hrow, hb = *(const u32x4*)(hrow + 8);
        hf[0] = bf_lo(ha.x); hf[1] = bf_hi(ha.x); hf[2] = bf_lo(ha.y); hf[3] = bf_hi(ha.y); hf[4] = bf_lo(ha.z); hf[5] = bf_hi(ha.z); hf[6] = bf_lo(ha.w); hf[7] = bf_hi(ha.w);
        hf[8] = bf_lo(hb.x); hf[9] = bf_hi(hb.x); hf[10] = bf_lo(hb.y); hf[11] = bf_hi(hb.y); hf[12] = bf_lo(hb.z); hf[13] = bf_hi(hb.z); hf[14] = bf_lo(hb.w); hf[15] = bf_hi(hb.w); }
      unsigned hq1a = 0u, hq1b = 0u, hq2a = 0u, hq2b = 0u; float hstep;
      { float ss = 0.f;
#pragma unroll
        for (int j = 0; j < 16; ++j) ss += hf[j] * hf[j];
        ss = wave_sum(ss);
        hstep = 0.5f * sqrtf(ss * (1.f / D) + 1e-20f); const float rs = 1.f / hstep;
#pragma unroll
        for (int j = 0; j < 16; ++j) {
          const float t = hf[j] * rs; int q1 = (int)rintf(t); q1 = min(7, max(-8, q1));
          int q2 = (int)rintf((t - (float)q1) * 16.f); q2 = min(7, max(-8, q2));
          if (j < 8) { hq1a |= ((unsigned)q1 & 15u) << (4 * j); hq2a |= ((unsigned)q2 & 15u) << (4 * j); }
          else { hq1b |= ((unsigned)q1 & 15u) << (4 * (j - 8)); hq2b |= ((unsigned)q2 & 15u) << (4 * (j - 8)); }
        } }
      const float uscale = uinv * hstep * (1.f / 16.f);
      f32x2_t o2[8];
#pragma unroll
      for (int j = 0; j < 8; ++j) o2[j] = (f32x2_t){0.f, 0.f};
      const bool b5 = (lane & 32) != 0, b4 = (lane & 16) != 0, b3 = (lane & 8) != 0, b2 = (lane & 4) != 0;
      const int ei = (lane >> 2) & 15;
#define PEER_PROC(UU, VV, BT) do { float d[16]; \
        _Pragma("unroll") for (int i = 0; i < 16; ++i) { const int w0 = (int)UU[i].x, w1 = (int)UU[i].y; \
          const int i1 = __builtin_amdgcn_sdot8(w1, (int)hq1b, __builtin_amdgcn_sdot8(w0, (int)hq1a, 0, false), false); \
          const int i2 = __builtin_amdgcn_sdot8(w1, (int)hq2b, __builtin_amdgcn_sdot8(w0, (int)hq2a, 0, false), false); \
          d[i] = (float)(i1 * 16 + i2); } \
        float k8[8], k4[4], k2[2], k1; \
        _Pragma("unroll") for (int i = 0; i < 8; ++i) { const auto r_ = __builtin_amdgcn_permlane32_swap(__float_as_uint(d[i]), __float_as_uint(d[8 + i]), false, false); k8[i] = __uint_as_float(r_[0]) + __uint_as_float(r_[1]); } \
        _Pragma("unroll") for (int i = 0; i < 4; ++i) { const auto r_ = __builtin_amdgcn_permlane16_swap(__float_as_uint(k8[i]), __float_as_uint(k8[4 + i]), false, false); k4[i] = __uint_as_float(r_[0]) + __uint_as_float(r_[1]); } \
        _Pragma("unroll") for (int i = 0; i < 2; ++i) { \
          const float sa = k4[i] + __int_as_float(__builtin_amdgcn_update_dpp(0, __float_as_int(k4[i]), 0x128, 0xf, 0xf, false)); \
          const float sb = k4[2 + i] + __int_as_float(__builtin_amdgcn_update_dpp(0, __float_as_int(k4[2 + i]), 0x128, 0xf, 0xf, false)); \
          k2[i] = b3 ? sb : sa; } \
        { const float keep = b2 ? k2[1] : k2[0], send = b2 ? k2[0] : k2[1]; k1 = keep + __shfl_xor(send, 4); } \
        k1 += __shfl_xor(k1, 2); k1 += __shfl_xor(k1, 1); \
        const float tot = k1 * uscale; \
        const float gate = __uint_as_float(resL[tk * 128 + (BT) * 16 + ei].y); \
        const float wact = 0.5f * tot * (1.f + erff(tot * 0.70710678118f)) * gate * vinv; \
        _Pragma("unroll") for (int i = 0; i < 16; ++i) { const float wi = __int_as_float(__builtin_amdgcn_readlane(__float_as_int(wact), 4 * i)); const f32x2_t w2 = {wi, wi}; const unsigned w0 = VV[i].x, w1 = VV[i].y; \
          o2[0] = __builtin_elementwise_fma(__builtin_amdgcn_cvt_scalef32_pk_f32_fp4(w0, 1.0f, 0), w2, o2[0]); o2[1] = __builtin_elementwise_fma(__builtin_amdgcn_cvt_scalef32_pk_f32_fp4(w0, 1.0f, 1), w2, o2[1]); \
          o2[2] = __builtin_elementwise_fma(__builtin_amdgcn_cvt_scalef32_pk_f32_fp4(w0, 1.0f, 2), w2, o2[2]); o2[3] = __builtin_elementwise_fma(__builtin_amdgcn_cvt_scalef32_pk_f32_fp4(w0, 1.0f, 3), w2, o2[3]); \
          o2[4] = __builtin_elementwise_fma(__builtin_amdgcn_cvt_scalef32_pk_f32_fp4(w1, 1.0f, 0), w2, o2[4]); o2[5] = __builtin_elementwise_fma(__builtin_amdgcn_cvt_scalef32_pk_f32_fp4(w1, 1.0f, 1), w2, o2[5]); \
          o2[6] = __builtin_elementwise_fma(__builtin_amdgcn_cvt_scalef32_pk_f32_fp4(w1, 1.0f, 2), w2, o2[6]); o2[7] = __builtin_elementwise_fma(__builtin_amdgcn_cvt_scalef32_pk_f32_fp4(w1, 1.0f, 3), w2, o2[7]); } } while (0)
      for (int bt = 0; bt < 8; bt += 2) {
        PEER_LOAD(ub, vb, bt + 1);
        PEER_PROC(ua, va, bt);
        if (bt + 2 < 8) PEER_LOAD(ua, va, bt + 2);
        PEER_PROC(ub, vb, bt + 1);
      }
#undef PEER_LOAD
#undef PEER_PROC
      if (live) {
        const int b = r / TPB, s = r - b * TPB; const int bi = (s >= SEQ) ? 8 : b;
        bf16_t* xp = xrow_ptr(xl, xc, r) + lane * 16; const float* gt = modl + (size_t)(bi * 6 + 5) * D + lane * 16;
        f32x4 xn[4]; float ss = 0.f;
        { const u32x4 xa = *(const u32x4*)xp, xb = *(const u32x4*)(xp + 8);
          xn[0] = (f32x4){bf_lo(xa.x), bf_hi(xa.x), bf_lo(xa.y), bf_hi(xa.y)}; xn[1] = (f32x4){bf_lo(xa.z), bf_hi(xa.z), bf_lo(xa.w), bf_hi(xa.w)};
          xn[2] = (f32x4){bf_lo(xb.x), bf_hi(xb.x), bf_lo(xb.y), bf_hi(xb.y)}; xn[3] = (f32x4){bf_lo(xb.z), bf_hi(xb.z), bf_lo(xb.w), bf_hi(xb.w)}; }
#pragma unroll
        for (int q = 0; q < 4; ++q) {
          const f32x4 gv = ((const f32x4*)gt)[q];
          xn[q] += gv * (f32x4){o2[2 * q].x, o2[2 * q].y, o2[2 * q + 1].x, o2[2 * q + 1].y};
          ss += xn[q].x * xn[q].x + xn[q].y * xn[q].y + xn[q].z * xn[q].z + xn[q].w * xn[q].w;
        }
        if (last) {
          float* op = outf + (size_t)(b * SEQ + s) * D + lane * 16;
#pragma unroll
          for (int q = 0; q < 4; ++q) ((f32x4*)op)[q] = xn[q];
        } else {
          *(u32x4*)xp = (u32x4){pk2(xn[0].x, xn[0].y), pk2(xn[0].z, xn[0].w), pk2(xn[1].x, xn[1].y), pk2(xn[1].z, xn[1].w)};
          *(u32x4*)(xp + 8) = (u32x4){pk2(xn[2].x, xn[2].y), pk2(xn[2].z, xn[2].w), pk2(xn[3].x, xn[3].y), pk2(xn[3].z, xn[3].w)};
        }
        if (Hn != nullptr) {
          ss = wave_sum(ss);
          const float rstd = rsqrtf(ss * (1.f / D) + EPS);
          const float* sh = modn + (size_t)(bi * 6) * D + lane * 16; const float* sc = sh + D; const float* gg = gn + lane * 16;
          u32x4 h0;
#pragma unroll
          for (int q = 0; q < 4; ++q) {
            const f32x4 g4 = ((const f32x4*)gg)[q], s4 = ((const f32x4*)sc)[q], h4 = ((const f32x4*)sh)[q];
            const f32x4 y = (xn[q] * rstd * g4 * (1.f + s4) + h4) * ASC;
            h0[q] = pk4_fp8(y.x, y.y, y.z, y.w);
          }
          *(u32x4*)(Hn + (size_t)r * D + lane * 16) = h0;
        }
      }
    }
  }
}

#define XB_TMO      128
#define XB_XCNT(j)  (256  + 64 * (j))
#define XB_XSUB(j)  (1280 + 64 * (j))
#define XB_XGEN(j)  (2304 + 64 * (j))
#define XB_TOP      3328
#define XB_TOPGEN   3392
#define XCD_BAR_WORDS 3456
#define XB_SPIN_CAP (1u << 20)
__device__ __forceinline__ unsigned xb_ld(unsigned* p)              { return __hip_atomic_load(p, __ATOMIC_RELAXED, __HIP_MEMORY_SCOPE_AGENT); }
__device__ __forceinline__ unsigned xb_add(unsigned* p, unsigned v) { return __hip_atomic_fetch_add(p, v, __ATOMIC_RELAXED, __HIP_MEMORY_SCOPE_AGENT); }
__device__ __forceinline__ unsigned xb_xcc_id() { return (unsigned)__builtin_amdgcn_s_getreg((3 << 11) | 20) & 0xFu; }
#define XB_SPIN(cond, bar) do { unsigned _sp = 0; while (cond) { __builtin_amdgcn_s_sleep(1); \
    if ((++_sp & 255u) == 0u) { if (xb_ld(&(bar)[XB_TMO])) break; if (_sp > XB_SPIN_CAP) { atomicAdd(&(bar)[XB_TMO], 1u); break; } } } } while (0)
struct XcdBarrier { unsigned* bar; unsigned x; volatile LAS unsigned* st; };
__device__ __forceinline__ XcdBarrier xcd_barrier_post(unsigned* bar, volatile LAS unsigned* st) {
    XcdBarrier b; b.bar = bar; b.x = xb_xcc_id(); b.st = st;
    if (threadIdx.x == 0) (void)xb_add(&bar[XB_XCNT(b.x)], 1u);
    return b;
}
__device__ __forceinline__ void xcd_barrier_complete(unsigned* bar, unsigned x, unsigned& nloc, unsigned& nx) {
    const unsigned G = gridDim.x * gridDim.y * gridDim.z;
    unsigned sum, cnt, mine, sp = 0u;
    for (;;) {
        sum = 0u; cnt = 0u; mine = 0u;
#pragma unroll
        for (unsigned j = 0; j < 16; ++j) { const unsigned c = xb_ld(&bar[XB_XCNT(j)]); sum += c; cnt += (c > 0u) ? 1u : 0u; mine = (j == x) ? c : mine; }
        if (sum == G) break;
        __builtin_amdgcn_s_sleep(1);
        if ((++sp & 255u) == 0u) { if (xb_ld(&bar[XB_TMO])) break; if (sp > XB_SPIN_CAP) { atomicAdd(&bar[XB_TMO], 1u); break; } }
    }
    nloc = mine > 0u ? mine : 1u; nx = cnt > 0u ? cnt : 1u;
}
__device__ __forceinline__ void xcd_barrier(const XcdBarrier& b, int wv) {
    asm volatile("s_waitcnt vmcnt(0)" ::: "memory");
    __syncthreads();
    if (otid(wv) == 0) {
        unsigned* bar = b.bar;
        __builtin_amdgcn_s_waitcnt(0);
        unsigned nloc = b.st[0], nx = b.st[1];
        if (nloc == 0u) { xcd_barrier_complete(bar, b.x, nloc, nx); b.st[0] = nloc; b.st[1] = nx; }
        const unsigned old = xb_add(&bar[XB_XSUB(b.x)], 1u);
        const unsigned gen = old / nloc;
        if (old + 1u == (gen + 1u) * nloc) {
            __builtin_amdgcn_fence(__ATOMIC_RELEASE, "agent");
            asm volatile("s_waitcnt vmcnt(0)" ::: "memory");
            const unsigned og = xb_add(&bar[XB_TOP], 1u);
            const unsigned tg = og / nx;
            if (og + 1u == (tg + 1u) * nx) xb_add(&bar[XB_TOPGEN], 1u);
            else XB_SPIN(xb_ld(&bar[XB_TOPGEN]) == tg, bar);
            __builtin_amdgcn_fence(__ATOMIC_ACQUIRE, "agent");
            xb_add(&bar[XB_XGEN(b.x)], 1u);
            asm volatile("s_waitcnt vmcnt(0)" ::: "memory");
        } else {
            XB_SPIN(xb_ld(&bar[XB_XGEN(b.x)]) == gen, bar);
            __builtin_amdgcn_fence(__ATOMIC_ACQUIRE, "agent");
            asm volatile("s_waitcnt vmcnt(0)" ::: "memory");
        }
    }
    __syncthreads();
}

enum { ST_NORM = 0, ST_GEMM_BF16, ST_GEMM_F32, ST_GEMM_RESID, ST_LATNORM, ST_HN_MLA, ST_HN_DS, ST_ATTN_MLA, ST_ATTN_D, ST_ATTN_S, ST_PEER };
#define SV(t, v) ((t) | ((v) << 4))
#define SR(t, v) ((t) | ((v) << 4) | 0x80)
__device__ const unsigned char STEPS[3][24] = {
  {SV(ST_NORM, 0), SV(ST_GEMM_BF16, 0), SV(ST_LATNORM, 0), SV(ST_GEMM_BF16, 1), SV(ST_GEMM_BF16, 2), SV(ST_HN_MLA, 0), SV(ST_ATTN_MLA, 0), SV(ST_GEMM_RESID, 0), SV(ST_NORM, 1), SV(ST_GEMM_F32, 0), SV(ST_PEER, 0), 0xFF},
  {SV(ST_NORM, 0), SV(ST_GEMM_BF16, 0), SV(ST_HN_DS, 0), SV(ST_ATTN_D, 0), SV(ST_GEMM_RESID, 0), SV(ST_NORM, 1), SV(ST_GEMM_F32, 0), SV(ST_PEER, 0), 0xFF},
  {SV(ST_NORM, 0), SV(ST_GEMM_BF16, 0), SV(ST_HN_DS, 0), SV(ST_ATTN_S, 0), SV(ST_GEMM_RESID, 0), SV(ST_NORM, 1), SV(ST_GEMM_F32, 0), SV(ST_PEER, 0), 0xFF}};
__global__ void __launch_bounds__(NTHREADS, 2) mega(Params p) {
  extern __shared__ __attribute__((aligned(16))) unsigned char lds_raw[];
  LAS unsigned char* lds = (LAS unsigned char*)lds_raw;
  cg::grid_group grid = cg::this_grid();
  const int tid = threadIdx.x;
  const int wv_s = __builtin_amdgcn_readfirstlane(tid >> 6);
  unsigned char* ws = p.ws;
  float* modp = (float*)(ws + WS_MODP); float* mod = (float*)(ws + WS_MOD);
  float* tab8 = (float*)(ws + WS_TAB); float* tab16 = tab8 + 64 * 8 * 2; float* lamp = tab16 + 64 * 16 * 2;
  bf16_t* xl = (bf16_t*)(ws + WS_XL); bf16_t* xc = (bf16_t*)(ws + WS_XC);
  bf16_t* wdown_t = (bf16_t*)(ws + WS_WDOWN); bf16_t* wuq_t = (bf16_t*)(ws + WS_WUQ); bf16_t* wukv_t = (bf16_t*)(ws + WS_WUKV); bf16_t* mwo_t = (bf16_t*)(ws + WS_MWO);
  bf16_t* dqkv_t = (bf16_t*)(ws + WS_DQKV); bf16_t* dwo_t = (bf16_t*)(ws + WS_DWO); bf16_t* sqkv_t = (bf16_t*)(ws + WS_SQKV); bf16_t* swo_t = (bf16_t*)(ws + WS_SWO);
  bf16_t* pwq = (bf16_t*)(ws + WS_PWQ); bf16_t* pkeys = (bf16_t*)(ws + WS_PKEYS); bf16_t* weff_t = (bf16_t*)(ws + WS_WEFF);
  unsigned char* pu = ws + WS_PU; unsigned char* pv = ws + WS_PV;
  bf16_t* Hb = (bf16_t*)(ws + WS_H); bf16_t* Ob = (bf16_t*)(ws + WS_O);
  bf16_t* B1 = (bf16_t*)(ws + WS_BUF1); bf16_t* B2 = (bf16_t*)(ws + WS_BUF2); bf16_t* B3 = (bf16_t*)(ws + WS_BUF3); bf16_t* B4 = (bf16_t*)(ws + WS_BUF4);
  bf16_t* CQN = (bf16_t*)(ws + WS_CQN); bf16_t* CKVN = (bf16_t*)(ws + WS_CKVN); float* SC = (float*)(ws + WS_SC);

  volatile LAS unsigned* xb_st = (volatile LAS unsigned*)(lds + LDS_BYTES - 16);
  if (tid < 4) xb_st[tid] = 0u;
  __syncthreads();
  (void)xcd_barrier_post((unsigned*)ws, xb_st);
  int phc = 0;
#define PH_BEGIN {
#define PH_END } ++phc; if (phc == 1) grid.sync(); else { XcdBarrier xb_; xb_.bar = (unsigned*)p.ws; xb_.x = xb_xcc_id(); xb_.st = (volatile LAS unsigned*)(lds + LDS_BYTES - 16); xcd_barrier(xb_, wv_s); }

  PH_BEGIN
    int rot = 0;
    for (int j = 0; j < 2; ++j) {
      tr_job<true>(lds, p.mla_w_down + (size_t)j * 1024 * 1056, (unsigned char*)wdown_t + (size_t)j * 1280 * 1024, 1024, 1056, 1280, rot);
      tr_job<true>(lds, p.mla_w_uq + (size_t)j * 768 * 1536, (unsigned char*)wuq_t + (size_t)j * 1536 * 768, 768, 1536, 1536, rot);
      tr_job<false>(lds, p.mla_w_ukv + (size_t)j * 256 * 2048, wukv_t + (size_t)j * 2048 * 256, 256, 2048, 2048, rot);
      tr_job<true>(lds, p.mla_w_o + (size_t)j * 1024 * 1024, (unsigned char*)mwo_t + (size_t)j * 1024 * 1024, 1024, 1024, 1024, rot);
    }
    tr_job<true>(lds, p.diff_w_qkv, dqkv_t, 1024, 3072, 3072, rot);
    tr_job<true>(lds, p.diff_w_o, dwo_t, 1024, 1024, 1024, rot);
    tr_job<true>(lds, p.swa_w_qkv, sqkv_t, 1024, 1536, 1536, rot);
    tr_job<true>(lds, p.swa_w_o, swo_t, 1024, 1024, 1024, rot);
    ada_job(lds, p, modp);
    cvt_job(p.peer_w_q, pwq, (size_t)4 * 1024 * 2048 / 8);
    cvt_job(p.peer_keys, pkeys, (size_t)4 * 16 * 128 * 128 / 8);
    {
      const int wv = tid >> 6, ln = tid & 63, l = wv >> 1; const float* t = ((wv & 1) ? p.peer_v : p.peer_u) + (size_t)l * 16384 * 1024;
      float ss = 0.f;
#pragma unroll
      for (int q = 0; q < 8; ++q) { const f32x4 v = ((const f32x4*)t)[ln + 64 * q]; ss += v.x * v.x + v.y * v.y + v.z * v.z + v.w * v.w; }
      ss = wave_sum(ss);
      const float rms = sqrtf(ss * (1.f / 2048.f));
      if (blockIdx.x == 0 && ln == 0) lamp[4 + wv] = (wv & 1) ? rms * 0.5f : rms * 0.34f;
    }
    if (blockIdx.x == 0 && tid == 0) {
      const float** t = (const float**)(ws + WS_PTRS);
      t[0] = p.x; t[1] = p.c; t[2] = p.ctx; t[3] = p.c_ctx; t[4] = p.ada_w; t[5] = p.ada_b; t[6] = p.norm_mix; t[7] = p.norm_ffn;
      t[8] = p.mla_w_down; t[9] = p.mla_g_cq; t[10] = p.mla_g_ckv; t[11] = p.mla_w_uq; t[12] = p.mla_w_ukv; t[13] = p.mla_g_q; t[14] = p.mla_g_k; t[15] = p.mla_w_o;
      t[16] = p.diff_w_qkv; t[17] = p.diff_g_q; t[18] = p.diff_g_k; t[19] = p.diff_lambda; t[20] = p.diff_g_sub; t[21] = p.diff_w_o;
      t[22] = p.swa_w_qkv; t[23] = p.swa_g_q; t[24] = p.swa_g_k; t[25] = p.swa_sink; t[26] = p.swa_w_o; t[27] = p.peer_w_q; t[28] = p.peer_keys; t[29] = p.peer_u; t[30] = p.peer_v;
    }
    if (blockIdx.x == gridDim.x - 1) {
      for (int i = tid; i < 64 * 8; i += NTHREADS) { const int pos = i >> 3, j = i & 7; const float ang = (float)pos * powf(10000.f, -(float)j / 8.f); tab8[2 * i] = cosf(ang); tab8[2 * i + 1] = sinf(ang); }
      for (int i = tid; i < 64 * 16; i += NTHREADS) { const int pos = i >> 4, j = i & 15; const float ang = (float)pos * powf(10000.f, -(float)j / 16.f); tab16[2 * i] = cosf(ang); tab16[2 * i + 1] = sinf(ang); }
      if (tid >= 64 && tid < 68) {
        const int q = tid - 64; const float* g = (q < 2) ? p.mla_g_k + q * 96 : (q == 2) ? p.diff_g_k : p.swa_g_k; const int n = (q < 2) ? 96 : 64;
        float mx = 0.f; for (int i = 0; i < n; ++i) mx = fmaxf(mx, fabsf(g[i]));
        lamp[12 + q] = sqrtf((float)n) * mx * 1.002f;
      }
      if (tid == 0) { float s01 = 0.f, s23 = 0.f; for (int i = 0; i < 64; ++i) { s01 += p.diff_lambda[i] * p.diff_lambda[64 + i]; s23 += p.diff_lambda[128 + i] * p.diff_lambda[192 + i]; }
        lamp[0] = expf(s01) - expf(s23) + LAM_INIT; }
    }
  PH_END
  PH_BEGIN
    for (int i = blockIdx.x * NTHREADS + tid; i < 4 * 9 * 6144; i += gridDim.x * NTHREADS) {
      const int col = i % 6144, l = i / (9 * 6144); float a = p.ada_b[l * 6144 + col];
#pragma unroll
      for (int kc = 0; kc < 64; ++kc) a += modp[(size_t)kc * (4 * 9 * 6144) + i];
      mod[i] = a;
    }
    for (int U = blockIdx.x; U < 256; U += gridDim.x) {
      const int q = U >> 2, l = q >> 4, hc = q & 15;
      gemm_phase(lds, pwq + (size_t)l * 1024 * 2048 + hc * 128, 2048, pkeys + (size_t)q * 128 * 128, 128, 1024, 128, 128, false,
                 EpiBf16T{weff_t + (size_t)l * 2048 * 1024 + (size_t)hc * 128 * 1024, 1024}, U & 3, 4);
    }
  PH_END

  for (int l = 0; l < 4; ++l) {
    int kind = l % 3; asm volatile("" : "+s"(kind));
    const bool last = (l == 3);
    for (int ss = 0; STEPS[kind][ss] != 0xFF; ++ss) {
      unsigned long long w_ = (unsigned long long)p.ws; asm volatile("" : "+s"(w_));
      unsigned char* w = (unsigned char*)(GAS unsigned char*)w_;
      const unsigned long long* tab = (const unsigned long long*)(w + WS_PTRS);
#define IN_(i) ((const float*)(GAS const float*)tab[i])
      bf16_t* xl = (bf16_t*)(w + WS_XL); bf16_t* xc = (bf16_t*)(w + WS_XC);
      const float* modl = (const float*)(w + WS_MOD) + (size_t)l * 9 * 6144;
      const float* tab8 = (const float*)(w + WS_TAB); const float* tab16 = tab8 + 64 * 8 * 2; const float* lamp = tab16 + 64 * 16 * 2;
      unsigned char* Hb = w + WS_H; unsigned char* Ob = w + WS_O; float* SC = (float*)(w + WS_SC);
      unsigned char* H8 = w + WS_O + 18 * MiB;
      bf16_t* LAT = (bf16_t*)(w + WS_BUF1); bf16_t* QP = (bf16_t*)(w + WS_BUF2); bf16_t* KV = (bf16_t*)(w + WS_BUF3); bf16_t* KB = (bf16_t*)(w + WS_BUF4); bf16_t* QKV = LAT;
      unsigned char* CQN = w + WS_CQN; bf16_t* CKVN = (bf16_t*)(w + WS_CKVN);
      bf16_t* QN = (bf16_t*)(w + WS_SC);
      const int ent = STEPS[kind][ss]; const int ty = ent & 15, var = (ent >> 4) & 7; const bool live = (ent & 0x80) == 0 || (p.phase == 777);
      int lo_ = l; asm volatile("" : "+s"(lo_)); const int j = (lo_ >= 3) ? 1 : 0;
      bool sync = true;
      if (ty == ST_NORM) {
        const bool first = (var == 0);
        if (first && l > 0) sync = false;
        else norm_phase(IN_(0), IN_(2), xl, xc, first && l == 0, (first ? IN_(6) : IN_(7)) + l * D, modl, first ? 0 : 3, first ? H8 : Hb, first, last && !first, wv_s);
      } else if (ty == ST_GEMM_BF16) {
        const void* A = H8; const void* Bt; bf16_t* O; int N, K = 1024;
        if (kind == 0) {
          if (var == 0) { Bt = w + WS_WDOWN + (size_t)j * 1280 * 1024; N = 1280; O = LAT; }
          else if (var == 1) { A = CQN; Bt = w + WS_WUQ + (size_t)j * 1536 * 768; N = 1536; K = 768; O = QP; sync = false; }
          else { A = CKVN; Bt = (const bf16_t*)(w + WS_WUKV) + (size_t)j * 2048 * 256; N = 2048; K = 256; O = KV; }
        } else if (kind == 1) { Bt = w + WS_DQKV; N = 3072; O = QKV; }
        else { Bt = w + WS_SQKV; N = 1536; O = QKV; }
        pg8::LatentOrder S; S.init(M, N, gridDim.x, blockIdx.x, last && kind == 0 && var == 1);
        if (kind == 0 && var == 2) pg8::gemm_phase<pg8::EpiBf16P, pg8::LatentOrder, true, true, false>(lds, pg8::Gemm{(const bf16_t*)A, (const bf16_t*)Bt, M, N, K}, S, pg8::EpiBf16P{O, N, 1.f}, wv_s);
        else pg8::gemm_phase<pg8::EpiBf16P, pg8::LatentOrder, true, true, true>(lds, pg8::Gemm{(const bf16_t*)A, (const bf16_t*)Bt, M, N, K / 2}, S, pg8::EpiBf16P{O, N, 1.f / (ASC * WSC)}, wv_s);

        {
          const int nwg_ = (false ? (M / 9) * 8 / 256 : M / 256) * (N / 256), rem_ = nwg_ % (int)gridDim.x;
          if ((rem_ == 0 || (int)blockIdx.x >= rem_) && ((var == 0) ? 0 : -1) >= 0) {
            const int E_ = (rem_ == 0) ? (int)gridDim.x : (int)gridDim.x - rem_, e_ = (rem_ == 0) ? (int)blockIdx.x : (int)blockIdx.x - rem_;
            const int s0_ = (((var == 0) ? 0 : -1) == 0) ? 0 : (((var == 0) ? 0 : -1) == 1) ? 16 : 21000, s1_ = (((var == 0) ? 0 : -1) == 0) ? 16 : (((var == 0) ? 0 : -1) == 1) ? 21000 : 32768;
            const int per_ = (s1_ - s0_ + E_ - 1) / E_, a_ = s0_ + e_ * per_, b_ = min(s1_, a_ + per_);
            const float su_ = 1.f / lamp[4 + 2 * l], sv_ = 1.f / lamp[5 + 2 * l];
            conv_rows(IN_(29) + (size_t)l * 16384 * 1024, IN_(30) + (size_t)l * 16384 * 1024, w + WS_PU + (size_t)l * 16384 * 512, w + WS_PV + (size_t)l * 16384 * 512, su_, sv_, a_, b_, otid(wv_s));
          }
        }
      } else if (ty == ST_GEMM_RESID) {
        const unsigned char* Bt = (kind == 0) ? w + WS_MWO + (size_t)j * 1024 * 1024 : (kind == 1) ? w + WS_DWO : w + WS_SWO;
        pg8::LatentOrder S; S.init(M, 1024, gridDim.x, blockIdx.x, last);
        pg8::gemm_phase<pg8::EpiResidN, pg8::LatentOrder, true, true, true>(lds, pg8::Gemm{(const bf16_t*)Ob, (const bf16_t*)Bt, M, 1024, 512}, S, pg8::EpiResidN{IN_(0), IN_(2), l == 0, xl, xc, modl, 2, live, 1.f / (OSC * WSC)}, wv_s);

        {
          const int nwg_ = (last ? (M / 9) * 8 / 256 : M / 256) * (1024 / 256), rem_ = nwg_ % (int)gridDim.x;
          if ((rem_ == 0 || (int)blockIdx.x >= rem_) && 1 >= 0) {
            const int E_ = (rem_ == 0) ? (int)gridDim.x : (int)gridDim.x - rem_, e_ = (rem_ == 0) ? (int)blockIdx.x : (int)blockIdx.x - rem_;
            const int s0_ = (1 == 0) ? 0 : (1 == 1) ? 16 : 21000, s1_ = (1 == 0) ? 16 : (1 == 1) ? 21000 : 32768;
            const int per_ = (s1_ - s0_ + E_ - 1) / E_, a_ = s0_ + e_ * per_, b_ = min(s1_, a_ + per_);
            const float su_ = 1.f / lamp[4 + 2 * l], sv_ = 1.f / lamp[5 + 2 * l];
            conv_rows(IN_(29) + (size_t)l * 16384 * 1024, IN_(30) + (size_t)l * 16384 * 1024, w + WS_PU + (size_t)l * 16384 * 512, w + WS_PV + (size_t)l * 16384 * 512, su_, sv_, a_, b_, otid(wv_s));
          }
        }
      } else if (ty == ST_GEMM_F32) {
        pg8::LatentOrder S; S.init(M, 2048, gridDim.x, blockIdx.x, last);
        pg8::gemm_phase<pg8::EpiBf16P, pg8::LatentOrder, true, true, false>(lds, pg8::Gemm{(const bf16_t*)Hb, (const bf16_t*)(w + WS_WEFF) + (size_t)l * 2048 * 1024, M, 2048, 1024}, S, pg8::EpiBf16P{(bf16_t*)SC, 2048, 1.f}, wv_s);

        {
          const int nwg_ = (last ? (M / 9) * 8 / 256 : M / 256) * (2048 / 256), rem_ = nwg_ % (int)gridDim.x;
          if ((rem_ == 0 || (int)blockIdx.x >= rem_) && 2 >= 0) {
            const int E_ = (rem_ == 0) ? (int)gridDim.x : (int)gridDim.x - rem_, e_ = (rem_ == 0) ? (int)blockIdx.x : (int)blockIdx.x - rem_;
            const int s0_ = (2 == 0) ? 0 : (2 == 1) ? 16 : 21000, s1_ = (2 == 0) ? 16 : (2 == 1) ? 21000 : 32768;
            const int per_ = (s1_ - s0_ + E_ - 1) / E_, a_ = s0_ + e_ * per_, b_ = min(s1_, a_ + per_);
            const float su_ = 1.f / lamp[4 + 2 * l], sv_ = 1.f / lamp[5 + 2 * l];
            conv_rows(IN_(29) + (size_t)l * 16384 * 1024, IN_(30) + (size_t)l * 16384 * 1024, w + WS_PU + (size_t)l * 16384 * 512, w + WS_PV + (size_t)l * 16384 * 512, su_, sv_, a_, b_, otid(wv_s));
          }
        }
      } else if (ty == ST_LATNORM) {
        latnorm_phase(LAT, IN_(9) + j * 768, IN_(10) + j * 256, CQN, CKVN, wv_s);
      } else if (ty == ST_HN_MLA) {
        const float qs = 0.10206207261596577f * LOG2E;
        for (int gi = blockIdx.x * NTHREADS + otid(wv_s); gi < M * 32 * 4; gi += gridDim.x * NTHREADS) {
          const int i = gi >> 2, jl = gi & 3, r = i >> 5, it = i & 31, h = it & 15; const int b = r / TPB, s = r - b * TPB; const bool lat = s < SEQ;
          if (it < 16) { const bf16_t* q = QP + (size_t)r * 1536 + h * 96; headnorm96(q, q + 64, QN + (size_t)r * 1536 + h * 96, IN_(13) + j * 96, qs, lat, s >> 6, s & 63, tab8, jl); }
          else headnorm96(KV + (size_t)r * 2048 + h * 128, LAT + (size_t)r * 1280 + 1024, KB + (size_t)r * 1536 + h * 96, IN_(14) + j * 96, 1.f, lat, s >> 6, s & 63, tab8, jl);
        }
      } else if (ty == ST_HN_DS) {
        const float qs = 0.125f * LOG2E;
        const int ipr = (kind == 1) ? 32 : 20, pitch = (kind == 1) ? 3072 : 1536, npitch = (kind == 1) ? 2048 : 1280;
        const float* gq = (kind == 1) ? IN_(17) : IN_(23); const float* gk = (kind == 1) ? IN_(18) : IN_(24);
        for (int gi = blockIdx.x * NTHREADS + otid(wv_s); gi < M * ipr * 4; gi += gridDim.x * NTHREADS) {
          const int i = gi >> 2, jl = gi & 3; int r, it; if (kind == 1) { r = i >> 5; it = i & 31; } else { r = i / 20; it = i - r * 20; }
          const int b = r / TPB, s = r - b * TPB; const bool lat = s < SEQ;
          const bf16_t* q = QKV + (size_t)r * pitch + it * 64;
          headnorm64(q, QN + (size_t)r * npitch + it * 64, (it < 16) ? gq : gk, (it < 16) ? qs : 1.f, lat, s >> 6, s & 63, tab16, jl);
        }
      } else if (ty == ST_ATTN_MLA) {
        const int nu = last ? 1024 : 1152;
        for (int u = blockIdx.x; u < nu; u += gridDim.x) {
          int bh, q0, ta0; if (u < 1024) { const int x = u & 7, y = u >> 3; bh = ((y >> 3) << 3) + x; q0 = (y & 7) * 256; ta0 = 0; } else { bh = u - 1024; q0 = SEQ; ta0 = 32; }
          const int b = bh >> 4, h = bh & 15; const size_t rb = (size_t)b * TPB;
          attn_unit_p<96, 64, false>(lds, QN + rb * 1536 + h * 96, 1536, KB + rb * 1536 + h * 96, 1536, KV + rb * 2048 + h * 128 + 64, 2048,
                                     q0, ta0, 36, 0, 0, false, 0.f, lamp[12 + j], Ob + rb * D + h * 64, D, wv_s);
        }
      } else if (ty == ST_ATTN_D) {
        const float lam = lamp[0];
        for (int u = blockIdx.x; u < 1152; u += gridDim.x) {
          int bh, q0, ta0; if (u < 1024) { const int x = u & 7, y = u >> 3; bh = ((y >> 4) << 3) + x; q0 = (y & 15) * 128; ta0 = 0; } else { bh = (u - 1024) >> 1; q0 = SEQ + ((u - 1024) & 1) * 128; ta0 = 32; }
          const int b = bh >> 3, h = bh & 7; const size_t rb = (size_t)b * TPB;
          attn_unit<64, 128, 2, false>(lds, QN + rb * 2048 + h * 128, 64, 2048, QN + rb * 2048 + 1024 + h * 128, 64, 2048, QKV + rb * 3072 + 2048 + h * 128, 3072,
                                       q0, ta0, 36, 0, 0, false, 0.f, lamp[14], Ob + rb * D + h * 128, D, lam, IN_(20), wv_s);
        }
      } else if (ty == ST_ATTN_S) {
        for (int u = blockIdx.x; u < 1152; u += gridDim.x) {
          int bh, q0, ta0, ta1; if (u < 1024) { const int x = u & 7, y = u >> 3; bh = ((y >> 3) << 3) + x; q0 = (y & 7) * 256; ta0 = max(0, q0 / 64 - 2); ta1 = min(32, q0 / 64 + 6); } else { bh = u - 1024; q0 = SEQ; ta0 = 0; ta1 = 0; }
          const int b = bh >> 4, h = bh & 15, kvh = h >> 2; const size_t rb = (size_t)b * TPB;
          attn_unit<64, 64, 1, true>(lds, QN + rb * 1280 + h * 64, 0, 1280, QN + rb * 1280 + 1024 + kvh * 64, 0, 1280, QKV + rb * 1536 + 1280 + kvh * 64, 1536,
                                     q0, ta0, ta1, 32, 36, true, IN_(25)[h] * LOG2E, lamp[15], Ob + rb * D + h * 64, D, 0.f, nullptr, wv_s);
        }
      } else {
        peer_phase(lds, (const bf16_t*)SC, Hb, w + WS_PU + (size_t)l * 16384 * 512, w + WS_PV + (size_t)l * 16384 * 512, lamp[4 + 2 * l], lamp[5 + 2 * l], modl, xl, xc, p.out, last, live, last ? nullptr : H8, IN_(6) + (l + 1) * D, modl + 9 * 6144, wv_s);
      }
#undef IN_
      if (sync) { XcdBarrier xb_; xb_.bar = (unsigned*)p.ws; xb_.x = xb_xcc_id(); xb_.st = (volatile LAS unsigned*)(lds + LDS_BYTES - 16); xcd_barrier(xb_, wv_s); }
    }
  }
#undef PH_BEGIN
#undef PH_END
}

extern "C" void kernel_launch(void* const* d_in, const int* in_sizes, int n_in, void* d_out, int out_size, void* d_ws, size_t ws_size, hipStream_t stream) {
  static int grid_blocks = 0;
  if (grid_blocks == 0) {
    int dev = 0, cus = 0, per_cu = 0;
    if (n_in != 31 || out_size != NB * SEQ * D || ws_size < WS_TOTAL) { fprintf(stderr, "kernel_launch: unexpected shapes (n_in %d out %d ws %zu)\n", n_in, out_size, ws_size); grid_blocks = -1; return; }
    (void)hipGetDevice(&dev);
    (void)hipDeviceGetAttribute(&cus, hipDeviceAttributeMultiprocessorCount, dev);
    (void)hipFuncSetAttribute((const void*)mega, hipFuncAttributeMaxDynamicSharedMemorySize, LDS_BYTES);
    (void)hipOccupancyMaxActiveBlocksPerMultiprocessor(&per_cu, (const void*)mega, NTHREADS, LDS_BYTES);
    if (per_cu < 1) { fprintf(stderr, "kernel_launch: occupancy query says %d blocks/CU\n", per_cu); per_cu = 1; }
    grid_blocks = cus;
  }
  if (grid_blocks < 0) return;
  (void)hipMemsetAsync(d_ws, 0, 16384, stream);
  Params p{};
  const float** f = (const float**)&p;
  for (int i = 0; i < 31; ++i) f[i] = (const float*)d_in[i];
  p.out = (float*)d_out; p.ws = (unsigned char*)d_ws;
  p.single = 1; p.phase = 0;
  void* args[] = {&p};
  hipError_t e = hipLaunchCooperativeKernel((const void*)mega, dim3(grid_blocks), dim3(NTHREADS), args, LDS_BYTES, stream);
  if (e != hipSuccess) fprintf(stderr, "cooperative launch failed: %s (grid %d)\n", hipGetErrorString(e), grid_blocks);
}
```

```cpp
#include <hip/hip_runtime.h>
#include <hip/hip_cooperative_groups.h>
#include <cstdio>
#include <cstdint>
namespace cg = cooperative_groups;

#define LAS __attribute__((address_space(3)))
#define GAS __attribute__((address_space(1)))
typedef unsigned short bf16_t;
typedef short bf16x8 __attribute__((ext_vector_type(8)));
typedef short v4i16_t __attribute__((ext_vector_type(4)));
typedef float f32x4 __attribute__((ext_vector_type(4)));
typedef float f32x16 __attribute__((ext_vector_type(16)));
typedef unsigned u32x4 __attribute__((ext_vector_type(4)));
typedef unsigned u32x2 __attribute__((ext_vector_type(2)));
typedef long long2_t __attribute__((ext_vector_type(2)));
typedef float f32x2_t __attribute__((ext_vector_type(2)));
typedef __bf16 bf16x2_t __attribute__((ext_vector_type(2)));

constexpr int D = 1024, NB = 8, SEQ = 2048, NCTX = 256, TPB = SEQ + NCTX  , M = NB * TPB  ;
constexpr int NTHREADS = 512, NWAVES = 8;
constexpr float EPS = 1e-6f;
constexpr float LOG2E = 1.4426950408889634f;
constexpr float LAM_INIT = 0.35550907f;
constexpr float ASC = 8.f, WSC = 64.f, OSC = 64.f;
constexpr size_t MiB = 1u << 20;
constexpr size_t WS_PTRS = 32768;
constexpr size_t WS_MODP = 352 * MiB  , WS_MOD = 8 * MiB, WS_TAB = 9 * MiB, WS_XC = 10 * MiB;
constexpr size_t WS_WDOWN = 18 * MiB, WS_WUQ = 23 * MiB, WS_WUKV = 28 * MiB, WS_MWO = 30 * MiB, WS_DQKV = 34 * MiB, WS_DWO = 40 * MiB;
constexpr size_t WS_SQKV = 42 * MiB, WS_SWO = 45 * MiB, WS_PWQ = 47 * MiB, WS_PKEYS = 63 * MiB, WS_WEFF = 65 * MiB;
constexpr size_t WS_PU = 96 * MiB, WS_PV = 224 * MiB, WS_H = 352 * MiB, WS_O = 388 * MiB, WS_BUF1 = 424 * MiB, WS_BUF2 = 532 * MiB;
constexpr size_t WS_BUF3 = 586 * MiB, WS_BUF4 = 658 * MiB, WS_CQN = 712 * MiB, WS_CKVN = 739 * MiB, WS_SC = 748 * MiB, WS_END = 892 * MiB;
constexpr size_t WS_XL = 896 * MiB, WS_TOTAL = 928 * MiB;
constexpr int LDS_BYTES = 147456;


struct Params {
  const float *x, *c, *ctx, *c_ctx, *ada_w, *ada_b, *norm_mix, *norm_ffn;
  const float *mla_w_down, *mla_g_cq, *mla_g_ckv, *mla_w_uq, *mla_w_ukv, *mla_g_q, *mla_g_k, *mla_w_o;
  const float *diff_w_qkv, *diff_g_q, *diff_g_k, *diff_lambda, *diff_g_sub, *diff_w_o;
  const float *swa_w_qkv, *swa_g_q, *swa_g_k, *swa_sink, *swa_w_o;
  const float *peer_w_q, *peer_keys, *peer_u, *peer_v;
  float* out; unsigned char* ws;
  int single, phase;
};

__device__ __forceinline__ int opaque_tid() { int t = threadIdx.x; asm volatile("" : "+v"(t)); return t; }
__device__ __forceinline__ int otid(int wv) { int w = wv; asm volatile("" : "+s"(w)); unsigned m = ~0u; asm volatile("" : "+s"(m)); const int l = (int)__builtin_amdgcn_mbcnt_hi(m, __builtin_amdgcn_mbcnt_lo(m, 0u)); return (w << 6) | l; }
__device__ __forceinline__ unsigned pk2(float lo, float hi) { f32x2_t v = {lo, hi}; bf16x2_t b = __builtin_convertvector(v, bf16x2_t); return __builtin_bit_cast(unsigned, b); }
__device__ __forceinline__ unsigned pk4_fp8(float a, float b, float c, float d) { int w = 0; w = __builtin_amdgcn_cvt_pk_fp8_f32(a, b, w, false); w = __builtin_amdgcn_cvt_pk_fp8_f32(c, d, w, true); return (unsigned)w; }
__device__ __forceinline__ float bf_lo(unsigned u) { return __uint_as_float(u << 16); }
__device__ __forceinline__ float bf_hi(unsigned u) { return __uint_as_float(u & 0xffff0000u); }
__device__ __forceinline__ float wave_sum(float v) {
#pragma unroll
  for (int o = 32; o >= 1; o >>= 1) v += __shfl_xor(v, o);
  return v;
}
__device__ __forceinline__ float dot2bf(unsigned a, unsigned b, float c) { return __builtin_amdgcn_fdot2_f32_bf16(__builtin_bit_cast(bf16x2_t, a), __builtin_bit_cast(bf16x2_t, b), c, false); }
__device__ __forceinline__ int crow(int r, int hi) { return (r & 3) + 8 * (r >> 2) + 4 * hi; }
__device__ __forceinline__ unsigned f2ord(float f) { const unsigned u = __float_as_uint(f); return u ^ ((unsigned)((int)u >> 31) | 0x80000000u); }
__device__ __forceinline__ float ord2f(unsigned o) { return __uint_as_float((o & 0x80000000u) ? (o & 0x7fffffffu) : ~o); }
__device__ __forceinline__ bf16_t* xrow_ptr(bf16_t* xl, bf16_t* xc, int r) {
  const int b = r / TPB, s = r - b * TPB;
  return (s < SEQ) ? xl + (size_t)(b * SEQ + s) * D : xc + (size_t)(b * NCTX + (s - SEQ)) * D;
}
__device__ __forceinline__ const float* xsrc_ptr(const float* sl, const float* sc, int r) {
  const int b = r / TPB, s = r - b * TPB;
  return (s < SEQ) ? sl + (size_t)(b * SEQ + s) * D : sc + (size_t)(b * NCTX + (s - SEQ)) * D;
}
template <bool F8>
__device__ __forceinline__ void tr_job(LAS unsigned char* lds, const float* __restrict__ W, void* __restrict__ Wt_, int K, int N, int Npad, int& rot) {
  LAS float* tile = (LAS float*)lds;
  const int nnb = Npad / 64, nit = (K / 64) * nnb, tid = opaque_tid();
  const int vb = ((int)blockIdx.x - rot % (int)gridDim.x + (int)gridDim.x) % (int)gridDim.x;
  rot += (nit + 3) / 4;
  for (int it0 = vb * 4; it0 < nit; it0 += gridDim.x * 4) {
    f32x4 v[4][2];
#pragma unroll
    for (int q = 0; q < 4; ++q) {
      const int it = it0 + q, kb = it / nnb, nb = it - kb * nnb, k0 = kb * 64, n0 = nb * 64;
#pragma unroll
      for (int i = 0; i < 2; ++i) {
        const int idx = tid + i * 512, kk = idx >> 4, nc = (idx & 15) * 4;
        v[q][i] = (f32x4){0.f, 0.f, 0.f, 0.f};
        if (it < nit && n0 + nc < N) v[q][i] = *(const f32x4*)(W + (size_t)(k0 + kk) * N + n0 + nc);
      }
    }
#pragma unroll
    for (int q = 0; q < 4; ++q)
#pragma unroll
      for (int i = 0; i < 2; ++i) {
        const int idx = tid + i * 512, kk = idx >> 4, nc = (idx & 15) * 4; LAS float* t = tile + q * (64 * 65) + kk * 65 + nc;
        t[0] = v[q][i].x; t[1] = v[q][i].y; t[2] = v[q][i].z; t[3] = v[q][i].w;
      }
    __syncthreads();
#pragma unroll
    for (int q = 0; q < 4; ++q) {
      const int it = it0 + q;
      if (it < nit) {
        const int kb = it / nnb, nb = it - kb * nnb, k0 = kb * 64, n0 = nb * 64;
        const int n = tid >> 3, kc = tid & 7;
        float f[8];
#pragma unroll
        for (int j = 0; j < 8; ++j) f[j] = tile[q * (64 * 65) + (kc * 8 + j) * 65 + n];
        if (F8) *(u32x2*)((unsigned char*)Wt_ + (size_t)(n0 + n) * K + k0 + kc * 8) = (u32x2){pk4_fp8(f[0] * WSC, f[1] * WSC, f[2] * WSC, f[3] * WSC), pk4_fp8(f[4] * WSC, f[5] * WSC, f[6] * WSC, f[7] * WSC)};
        else *(u32x4*)((bf16_t*)Wt_ + (size_t)(n0 + n) * K + k0 + kc * 8) = (u32x4){pk2(f[0], f[1]), pk2(f[2], f[3]), pk2(f[4], f[5]), pk2(f[6], f[7])};
      }
    }
    __syncthreads();
  }
}
__device__ __forceinline__ void cvt_job(const float* __restrict__ src, bf16_t* __restrict__ dst, size_t n8) {
  for (size_t i = (size_t)blockIdx.x * NTHREADS + threadIdx.x; i < n8; i += (size_t)gridDim.x * NTHREADS) {
    const f32x4 a = ((const f32x4*)src)[2 * i], b = ((const f32x4*)src)[2 * i + 1];
    ((u32x4*)dst)[i] = (u32x4){pk2(a.x, a.y), pk2(a.z, a.w), pk2(b.x, b.y), pk2(b.z, b.w)};
  }
}
__device__ __forceinline__ unsigned q4pack(f32x4 a, f32x4 b, float sc) {
  const float v[8] = {a.x, a.y, a.z, a.w, b.x, b.y, b.z, b.w}; unsigned w = 0u;
#pragma unroll
  for (int j = 0; j < 8; ++j) { int q = (int)rintf(v[j] * sc); q = min(7, max(-8, q)); w |= ((unsigned)q & 15u) << (4 * j); }
  return w;
}
__device__ __forceinline__ void conv_rows(const float* __restrict__ usrc, const float* __restrict__ vsrc, unsigned char* __restrict__ udst, unsigned char* __restrict__ vdst, float su, float sv, int r0, int r1, int tid) {
  for (int rb = r0 + (tid >> 6); rb < r1; rb += 4 * NWAVES) {
    const int c = (tid & 63);
    f32x4 a[4], b[4], cc[4], d[4];
#pragma unroll
    for (int k = 0; k < 4; ++k) { const int r = min(rb + k * NWAVES, r1 - 1); const bool isv = r >= 16384; const int rr = isv ? r - 16384 : r;
      const f32x4* sp = (const f32x4*)((isv ? vsrc : usrc) + (size_t)rr * 1024) + c * 4;
      a[k] = sp[0]; b[k] = sp[1]; cc[k] = sp[2]; d[k] = sp[3]; }
#pragma unroll
    for (int k = 0; k < 4; ++k) { const int r = rb + k * NWAVES; if (r < r1) { const bool isv = r >= 16384; const int rr = isv ? r - 16384 : r;
      u32x2 o;
      if (isv) {
        unsigned w0 = 0u, w1 = 0u;
        w0 = __builtin_amdgcn_cvt_scalef32_pk_fp4_f32(w0, a[k].x * sv, a[k].y * sv, 1.0f, 0); w0 = __builtin_amdgcn_cvt_scalef32_pk_fp4_f32(w0, a[k].z * sv, a[k].w * sv, 1.0f, 1);
        w0 = __builtin_amdgcn_cvt_scalef32_pk_fp4_f32(w0, b[k].x * sv, b[k].y * sv, 1.0f, 2); w0 = __builtin_amdgcn_cvt_scalef32_pk_fp4_f32(w0, b[k].z * sv, b[k].w * sv, 1.0f, 3);
        w1 = __builtin_amdgcn_cvt_scalef32_pk_fp4_f32(w1, cc[k].x * sv, cc[k].y * sv, 1.0f, 0); w1 = __builtin_amdgcn_cvt_scalef32_pk_fp4_f32(w1, cc[k].z * sv, cc[k].w * sv, 1.0f, 1);
        w1 = __builtin_amdgcn_cvt_scalef32_pk_fp4_f32(w1, d[k].x * sv, d[k].y * sv, 1.0f, 2); w1 = __builtin_amdgcn_cvt_scalef32_pk_fp4_f32(w1, d[k].z * sv, d[k].w * sv, 1.0f, 3);
        o = (u32x2){w0, w1};
      } else o = (u32x2){q4pack(a[k], b[k], su), q4pack(cc[k], d[k], su)};
      *(u32x2*)((isv ? vdst : udst) + (size_t)rr * 512 + c * 8) = o; } }
  }
}
__device__ __forceinline__ void ada_job(LAS unsigned char* lds, const Params& p, float* __restrict__ modp) {
  LAS float* s = (LAS float*)lds;
  const int tid = opaque_tid();
  for (int u = blockIdx.x; u < 768; u += gridDim.x) {
    const int l = u / 192, r = u - l * 192, cc = r >> 6, kc = r & 63;
    __syncthreads();
    if (tid < 144) { const int bi = tid >> 4, k = tid & 15; const float c = (bi < 8) ? p.c[bi * D + kc * 16 + k] : p.c_ctx[kc * 16 + k]; s[tid] = c / (1.f + __expf(-c)); }
    __syncthreads();
    f32x4 acc[9];
#pragma unroll
    for (int bi = 0; bi < 9; ++bi) acc[bi] = (f32x4){0.f, 0.f, 0.f, 0.f};
    const float* w = p.ada_w + ((size_t)l * D + kc * 16) * 6144 + cc * 2048 + tid * 4;
#pragma unroll
    for (int h = 0; h < 2; ++h) {
      f32x4 wv[8];
#pragma unroll
      for (int k = 0; k < 8; ++k) wv[k] = *(const f32x4*)(w + (size_t)(h * 8 + k) * 6144);
#pragma unroll
      for (int k = 0; k < 8; ++k)
#pragma unroll
        for (int bi = 0; bi < 9; ++bi) acc[bi] += s[bi * 16 + h * 8 + k] * wv[k];
    }
#pragma unroll
    for (int bi = 0; bi < 9; ++bi) *(f32x4*)(modp + (((size_t)kc * 4 + l) * 9 + bi) * 6144 + cc * 2048 + tid * 4) = acc[bi];
  }
}

__device__ __forceinline__ void norm_phase(const float* sl, const float* sc_, bf16_t* xl, bf16_t* xc, bool src_f32, const float* __restrict__ g, const float* __restrict__ modl, int which, unsigned char* __restrict__ H, bool out_f8, bool skip_ctx, unsigned char* __restrict__ HI, float* __restrict__ HS, int wv) {
  const int tid_ = otid(wv); const int lane = tid_ & 63, wid = tid_ >> 6;
  const int nwav_ = gridDim.x * NWAVES, rpw_ = (M + nwav_ - 1) / nwav_, wg_ = blockIdx.x * NWAVES + wid;
  int cur_bi = -1; f32x4 gs4[4], h4r[4];
#pragma unroll
  for (int j = 0; j < 4; ++j) { gs4[j] = (f32x4){0.f, 0.f, 0.f, 0.f}; h4r[j] = gs4[j]; }
  for (int r = wg_ * rpw_; r < min(M, (wg_ + 1) * rpw_); ++r) {
    const int b = r / TPB, s = r - b * TPB; const bool isctx = s >= SEQ;
    if (skip_ctx && isctx) continue;
    const int bi = isctx ? 8 : b;
    if (bi != cur_bi) { cur_bi = bi; const float* sh = modl + (size_t)(bi * 6 + which) * D + lane * 16; const float* sc = sh + D; const float* gl = g + lane * 16;
#pragma unroll
      for (int j = 0; j < 4; ++j) { const f32x4 g4 = ((const f32x4*)gl)[j], s4 = ((const f32x4*)sc)[j]; gs4[j] = g4 * (1.f + s4); h4r[j] = ((const f32x4*)sh)[j]; } }
    f32x4 v[4]; float ss = 0.f;
    if (src_f32) {
      const float* xr = xsrc_ptr(sl, sc_, r) + lane * 16;
#pragma unroll
      for (int j = 0; j < 4; ++j) v[j] = ((const f32x4*)xr)[j];
    } else {
      const bf16_t* xr = xrow_ptr(xl, xc, r) + lane * 16; const u32x4 wa = *(const u32x4*)xr, wb = *(const u32x4*)(xr + 8);
      v[0] = (f32x4){bf_lo(wa.x), bf_hi(wa.x), bf_lo(wa.y), bf_hi(wa.y)}; v[1] = (f32x4){bf_lo(wa.z), bf_hi(wa.z), bf_lo(wa.w), bf_hi(wa.w)};
      v[2] = (f32x4){bf_lo(wb.x), bf_hi(wb.x), bf_lo(wb.y), bf_hi(wb.y)}; v[3] = (f32x4){bf_lo(wb.z), bf_hi(wb.z), bf_lo(wb.w), bf_hi(wb.w)};
    }
#pragma unroll
    for (int j = 0; j < 4; ++j) ss += v[j].x * v[j].x + v[j].y * v[j].y + v[j].z * v[j].z + v[j].w * v[j].w;
    ss = wave_sum(ss);
    const float rstd = rsqrtf(ss * (1.f / D) + EPS);
    float amax = 0.f, s2 = 0.f;
#pragma unroll
    for (int j = 0; j < 4; ++j) {
      const f32x4 y = v[j] * rstd * gs4[j] + h4r[j];
      v[j] = y; amax = fmaxf(amax, fmaxf(fmaxf(fabsf(y.x), fabsf(y.y)), fmaxf(fabsf(y.z), fabsf(y.w)))); s2 += y.x * y.x + y.y * y.y + y.z * y.z + y.w * y.w;
    }
    if (out_f8) {
      *(u32x4*)(H + (size_t)r * D + lane * 16) = (u32x4){pk4_fp8(v[0].x * ASC, v[0].y * ASC, v[0].z * ASC, v[0].w * ASC), pk4_fp8(v[1].x * ASC, v[1].y * ASC, v[1].z * ASC, v[1].w * ASC),
                                                           pk4_fp8(v[2].x * ASC, v[2].y * ASC, v[2].z * ASC, v[2].w * ASC), pk4_fp8(v[3].x * ASC, v[3].y * ASC, v[3].z * ASC, v[3].w * ASC)};
    } else {
      s2 = wave_sum(s2);
      const float hstep = 0.5f * sqrtf(s2 * (1.f / D) + 1e-20f), rs = 1.f / hstep;
      unsigned hq1a = 0u, hq1b = 0u, hq2a = 0u, hq2b = 0u;
#pragma unroll
      for (int j = 0; j < 16; ++j) {
        const float t = v[j >> 2][j & 3] * rs; int q1 = (int)rintf(t); q1 = min(7, max(-8, q1));
        int q2 = (int)rintf((t - (float)q1) * 16.f); q2 = min(7, max(-8, q2));
        if (j < 8) { hq1a |= ((unsigned)q1 & 15u) << (4 * j); hq2a |= ((unsigned)q2 & 15u) << (4 * j); }
        else { hq1b |= ((unsigned)q1 & 15u) << (4 * (j - 8)); hq2b |= ((unsigned)q2 & 15u) << (4 * (j - 8)); }
      }
      *(u32x4*)(H + (size_t)r * D + lane * 16) = (u32x4){hq1a, hq1b, hq2a, hq2b};
      if (lane == 0) HS[M + r] = hstep;
    }
    if (HI != nullptr) {
#pragma unroll
      for (int o = 32; o >= 1; o >>= 1) amax = fmaxf(amax, __shfl_xor(amax, o));
      amax = fmaxf(amax, 1e-20f);
      const float qs = 127.f / amax;
      unsigned ow[4];
#pragma unroll
      for (int j = 0; j < 4; ++j) { const int q0 = (int)rintf(v[j].x * qs), q1 = (int)rintf(v[j].y * qs), q2 = (int)rintf(v[j].z * qs), q3 = (int)rintf(v[j].w * qs);
        ow[j] = (unsigned)(q0 & 255) | ((unsigned)(q1 & 255) << 8) | ((unsigned)(q2 & 255) << 16) | ((unsigned)(q3 & 255) << 24); }
      *(u32x4*)(HI + (size_t)r * D + lane * 16) = (u32x4){ow[0], ow[1], ow[2], ow[3]};
      if (lane == 0) HS[r] = amax * (1.f / 127.f);
    }
  }
}
__device__ __forceinline__ void latnorm_phase(const bf16_t* __restrict__ LAT, const float* __restrict__ gcq, const float* __restrict__ gckv, unsigned char* __restrict__ CQN, bf16_t* __restrict__ CKVN, int wv) {
  const int tid_ = otid(wv); const int lane = tid_ & 63, wid = tid_ >> 6;
  for (int r = blockIdx.x * NWAVES + wid; r < M; r += gridDim.x * NWAVES) {
    const bf16_t* lr = LAT + (size_t)r * 1280;
    float q[12], kv[4]; float sq = 0.f, sk = 0.f;
#pragma unroll
    for (int j = 0; j < 3; ++j) { const u32x2 w = *(const u32x2*)(lr + lane * 4 + 256 * j); q[4 * j] = bf_lo(w.x); q[4 * j + 1] = bf_hi(w.x); q[4 * j + 2] = bf_lo(w.y); q[4 * j + 3] = bf_hi(w.y); }
    { const u32x2 w = *(const u32x2*)(lr + 768 + lane * 4); kv[0] = bf_lo(w.x); kv[1] = bf_hi(w.x); kv[2] = bf_lo(w.y); kv[3] = bf_hi(w.y); }
#pragma unroll
    for (int j = 0; j < 12; ++j) sq += q[j] * q[j];
#pragma unroll
    for (int j = 0; j < 4; ++j) sk += kv[j] * kv[j];
    sq = wave_sum(sq); sk = wave_sum(sk);
    const float rq = rsqrtf(sq * (1.f / 768.f) + EPS), rk = rsqrtf(sk * (1.f / 256.f) + EPS);
#pragma unroll
    for (int j = 0; j < 3; ++j) { const int c = lane * 4 + 256 * j; const f32x4 g4 = *(const f32x4*)(gcq + c);
      *(unsigned*)(CQN + (size_t)r * 768 + c) = pk4_fp8(q[4 * j] * rq * g4.x * ASC, q[4 * j + 1] * rq * g4.y * ASC, q[4 * j + 2] * rq * g4.z * ASC, q[4 * j + 3] * rq * g4.w * ASC); }
    { const int c = lane * 4; const f32x4 g4 = *(const f32x4*)(gckv + c);
      *(u32x2*)(CKVN + (size_t)r * 256 + c) = (u32x2){pk2(kv[0] * rk * g4.x, kv[1] * rk * g4.y), pk2(kv[2] * rk * g4.z, kv[3] * rk * g4.w)}; }
  }
}

constexpr int G_AS = 144;
constexpr int G_ATILE = 256 * G_AS, G_BTILE = 128 * G_AS, G_STAGE = G_ATILE + G_BTILE;
struct EpiFp8T { unsigned char* C; int ldc;
  __device__ __forceinline__ void operator()(int row, int col, f32x4 v) const { const unsigned w = pk4_fp8(v.x * WSC, v.y * WSC, v.z * WSC, v.w * WSC);
    C[(size_t)(col + 0) * ldc + row] = (unsigned char)(w & 255u); C[(size_t)(col + 1) * ldc + row] = (unsigned char)((w >> 8) & 255u); C[(size_t)(col + 2) * ldc + row] = (unsigned char)((w >> 16) & 255u); C[(size_t)(col + 3) * ldc + row] = (unsigned char)(w >> 24); } };
struct EpiBf16T { bf16_t* C; int ldc;
  __device__ __forceinline__ void operator()(int row, int col, f32x4 v) const {
    C[(size_t)(col + 0) * ldc + row] = (bf16_t)(pk2(v.x, 0.f) & 0xffffu); C[(size_t)(col + 1) * ldc + row] = (bf16_t)(pk2(v.y, 0.f) & 0xffffu);
    C[(size_t)(col + 2) * ldc + row] = (bf16_t)(pk2(v.z, 0.f) & 0xffffu); C[(size_t)(col + 3) * ldc + row] = (bf16_t)(pk2(v.w, 0.f) & 0xffffu); } };
template <class Epi>
__device__ __forceinline__ void gemm_phase(LAS unsigned char* lds, const bf16_t* __restrict__ A, int lda, const bf16_t* __restrict__ Bt, int ldb,
                                           int Mrows, int N, int K, bool skip_ctx_tiles, const Epi epi, int ustart, int ustride) {
  const int tid = opaque_tid(), lane = tid & 63, wid = tid >> 6, wr = wid >> 1, wc = wid & 1, fr = lane & 15, fq = lane >> 4;
  const int nN = N / 128, nU = (Mrows / 256) * nN, nt = K / 64;
  const int lrow = tid >> 3, lkc = tid & 7;
  for (int u = ustart; u < nU; u += ustride) {
    const int pm = u / nN, pn = u - pm * nN;
    if (skip_ctx_tiles && (pm % 9) == 8) continue;
    const bf16_t* Ag = A + (size_t)(pm * 256 + lrow) * lda + lkc * 8;
    const bf16_t* Bg = Bt + (size_t)(pn * 128 + lrow) * ldb + lkc * 8;
    f32x4 acc[4][4];
#pragma unroll
    for (int m = 0; m < 4; ++m)
#pragma unroll
      for (int n = 0; n < 4; ++n) acc[m][n] = (f32x4){0.f, 0.f, 0.f, 0.f};
    u32x4 ra[4], rb[2];
#pragma unroll
    for (int i = 0; i < 4; ++i) ra[i] = *(const u32x4*)(Ag + (size_t)(64 * i) * lda);
#pragma unroll
    for (int i = 0; i < 2; ++i) rb[i] = *(const u32x4*)(Bg + (size_t)(64 * i) * ldb);
    {
      LAS unsigned char* sa = lds + lrow * G_AS + lkc * 16; LAS unsigned char* sb = lds + G_ATILE + lrow * G_AS + lkc * 16;
#pragma unroll
      for (int i = 0; i < 4; ++i) *(LAS u32x4*)(sa + i * 64 * G_AS) = ra[i];
#pragma unroll
      for (int i = 0; i < 2; ++i) *(LAS u32x4*)(sb + i * 64 * G_AS) = rb[i];
    }
    __syncthreads();
    for (int t = 0; t < nt; ++t) {
      const bool more = (t + 1 < nt);
      if (more) {
#pragma unroll
        for (int i = 0; i < 4; ++i) ra[i] = *(const u32x4*)(Ag + (size_t)(64 * i) * lda + (t + 1) * 64);
#pragma unroll
        for (int i = 0; i < 2; ++i) rb[i] = *(const u32x4*)(Bg + (size_t)(64 * i) * ldb + (t + 1) * 64);
      }
      const LAS unsigned char* st = lds + (t & 1) * G_STAGE;
      const LAS unsigned char* pa = st + (wr * 64 + fr) * G_AS + fq * 16;
      const LAS unsigned char* pb = st + G_ATILE + (wc * 64 + fr) * G_AS + fq * 16;
#pragma unroll
      for (int ks = 0; ks < 2; ++ks) {
        bf16x8 af[4], bfr[4];
#pragma unroll
        for (int m = 0; m < 4; ++m) af[m] = *(const LAS bf16x8*)(pa + m * 16 * G_AS + ks * 64);
#pragma unroll
        for (int n = 0; n < 4; ++n) bfr[n] = *(const LAS bf16x8*)(pb + n * 16 * G_AS + ks * 64);
#pragma unroll
        for (int m = 0; m < 4; ++m)
#pragma unroll
          for (int n = 0; n < 4; ++n) acc[m][n] = __builtin_amdgcn_mfma_f32_16x16x32_bf16(bfr[n], af[m], acc[m][n], 0, 0, 0);
      }
      if (more) {
        LAS unsigned char* sa = lds + ((t + 1) & 1) * G_STAGE + lrow * G_AS + lkc * 16; LAS unsigned char* sb = sa + G_ATILE;
#pragma unroll
        for (int i = 0; i < 4; ++i) *(LAS u32x4*)(sa + i * 64 * G_AS) = ra[i];
#pragma unroll
        for (int i = 0; i < 2; ++i) *(LAS u32x4*)(sb + i * 64 * G_AS) = rb[i];
      }
      __syncthreads();
    }
#pragma unroll
    for (int m = 0; m < 4; ++m)
#pragma unroll
      for (int n = 0; n < 4; ++n) epi(pm * 256 + wr * 64 + m * 16 + fr, pn * 128 + wc * 64 + n * 16 + fq * 4, acc[m][n]);
  }
}

namespace pg8 {
#define PG8_LAS __attribute__((address_space(3)))
typedef unsigned short bf16_t;
typedef short bf16x8 __attribute__((ext_vector_type(8)));
typedef int pg8_v8i __attribute__((ext_vector_type(8)));
typedef int pg8_v4i __attribute__((ext_vector_type(4)));
typedef float f32x4 __attribute__((ext_vector_type(4)));
typedef unsigned u32x4 __attribute__((ext_vector_type(4)));
constexpr int BM = 256, BK = 64, HALF = 128, HTB = HALF * BK * 2  , STAGE_BYTES = 8 * HTB, NXCD = 8, WGM = 8;

__host__ __device__ __forceinline__ int lds_byte(int r, int c) { const int st = (r >> 4) * 2 + (c >> 5), rr = r & 15, cc = c & 31, ob = rr * 64 + cc * 2; return st * 1024 + (ob ^ (((ob >> 9) & 1) << 5)); }
__host__ __device__ __forceinline__ void stage_rc(int b, int& R, int& C) { const int st = b / 1024, sb = b % 1024, swz = sb ^ (((sb >> 9) & 1) << 5); R = (st >> 1) * 16 + swz / 64; C = (st & 1) * 32 + (swz % 64) / 2; }
__host__ __device__ __forceinline__ int perm32(int rho) { const int n = rho >> 4, i = rho & 15; return 8 * (i >> 2) + 4 * n + (i & 3); }

struct Unit { int pm, pn; };
struct Gemm { const bf16_t* A; const bf16_t* Bt; int M, N, K; };

struct StaticOrder {
    int nM, nN, nwg, G, c;
    __host__ __device__ void init(int M, int N, int G_, int c_) { nM = M / BM; nN = N / BM; nwg = nM * nN; G = G_; c = c_; }
    __host__ __device__ bool next(int i, Unit& u) const {
        const long L = (long)i * G + c; if (L >= nwg) return false;
        int wgid = (int)L; { const int q = nwg / NXCD, r = nwg % NXCD, xcd = wgid % NXCD, off = wgid / NXCD; wgid = (xcd < r ? xcd * (q + 1) : r * (q + 1) + (xcd - r) * q) + off; }
        const int nig = WGM * nN, gid = wgid / nig, fm = gid * WGM, gsz = (nM - fm) < WGM ? (nM - fm) : WGM;
        u.pm = fm + ((wgid % nig) % gsz); u.pn = (wgid % nig) / gsz; return true;
    }
    __device__ __forceinline__ void a_ready(const Unit&) const {}
    __device__ __forceinline__ void done(const Unit&) const {}
};
struct LatentOrder {
    StaticOrder base; bool skip;
    __host__ __device__ void init(int M_, int N_, int G_, int c_, bool skip_) { skip = skip_; base.init(skip_ ? (M_ / 9) * 8 : M_, N_, G_, c_); }
    __host__ __device__ bool next(int i, Unit& u) const { if (!base.next(i, u)) return false; if (skip) u.pm += u.pm >> 3; return true; }
    __device__ __forceinline__ void a_ready(const Unit&) const {}
    __device__ __forceinline__ void done(const Unit&) const {}
};
struct EpiBf16P { static constexpr bool PERM = true, AFTER_DRAIN = false; bf16_t* O; int ldc; float sc;
  __device__ __forceinline__ void operator()(const f32x4 (&acc)[2][2][4][2], const Unit& u, int wr, int wc, int fr, int fq) const {
    const int row0 = u.pm * BM + wr * 64 + fr, col0 = u.pn * BM + wc * 32 + 8 * fq;
#pragma unroll
    for (int ai = 0; ai < 2; ++ai)
#pragma unroll
      for (int m = 0; m < 4; ++m) { bf16_t* rowp = O + (size_t)(row0 + ai * HALF + m * 16) * ldc + col0;
#pragma unroll
        for (int bj = 0; bj < 2; ++bj) { const f32x4 v0 = acc[ai][bj][m][0] * sc, v1 = acc[ai][bj][m][1] * sc;
          *(u32x4*)(rowp + bj * HALF) = (u32x4){pk2(v0[0], v0[1]), pk2(v0[2], v0[3]), pk2(v1[0], v1[1]), pk2(v1[2], v1[3])}; } }
  } };
struct EpiI8 { static constexpr bool PERM = true, AFTER_DRAIN = false; bf16_t* O; int ldc; const float* sa; const float* sb;
  __device__ __forceinline__ void operator()(const f32x4 (&acc)[2][2][4][2], const Unit& u, int wr, int wc, int fr, int fq) const {
    const int row0 = u.pm * BM + wr * 64 + fr, col0 = u.pn * BM + wc * 32 + 8 * fq;
    f32x4 cs[2][2];
#pragma unroll
    for (int bj = 0; bj < 2; ++bj) { cs[bj][0] = *(const f32x4*)(sb + col0 + bj * HALF); cs[bj][1] = *(const f32x4*)(sb + col0 + bj * HALF + 4); }
#pragma unroll
    for (int ai = 0; ai < 2; ++ai)
#pragma unroll
      for (int m = 0; m < 4; ++m) { const int r = row0 + ai * HALF + m * 16; const float ra = sa[r]; bf16_t* rowp = O + (size_t)r * ldc + col0;
#pragma unroll
        for (int bj = 0; bj < 2; ++bj) { const pg8_v4i a0 = __builtin_bit_cast(pg8_v4i, acc[ai][bj][m][0]), a1 = __builtin_bit_cast(pg8_v4i, acc[ai][bj][m][1]);
          const f32x4 v0 = (f32x4){(float)a0[0], (float)a0[1], (float)a0[2], (float)a0[3]} * cs[bj][0] * ra, v1 = (f32x4){(float)a1[0], (float)a1[1], (float)a1[2], (float)a1[3]} * cs[bj][1] * ra;
          *(u32x4*)(rowp + bj * HALF) = (u32x4){pk2(v0[0], v0[1]), pk2(v0[2], v0[3]), pk2(v1[0], v1[1]), pk2(v1[2], v1[3])}; } }
  } };
struct EpiResidN { static constexpr bool PERM = true, AFTER_DRAIN = false; const float* sl; const float* sc; bool src_f32; bf16_t* xl; bf16_t* xc; const float* modl; int which; bool live; float osc;
  __device__ __forceinline__ void operator()(const f32x4 (&acc)[2][2][4][2], const Unit& u, int wr, int wc, int fr, int fq) const {
    if (!live) return;
    const int row0 = u.pm * BM + wr * 64 + fr, col0 = u.pn * BM + wc * 32 + 8 * fq;
    const int b = (u.pm * BM) / TPB, s0 = u.pm * BM - b * TPB; const int bi = (s0 >= SEQ) ? 8 : b;
    const float* gp = modl + (size_t)(bi * 6 + which) * D + col0;
#pragma unroll
    for (int bj = 0; bj < 2; ++bj) { const f32x4 g0 = *(const f32x4*)(gp + bj * HALF) * osc, g1 = *(const f32x4*)(gp + bj * HALF + 4) * osc;
#pragma unroll
      for (int ai = 0; ai < 2; ++ai)
#pragma unroll
        for (int m = 0; m < 4; ++m) { const int rr = row0 + ai * HALF + m * 16, cc = col0 + bj * HALF;
          bf16_t* xp = xrow_ptr(xl, xc, rr) + cc; f32x4 x0, x1;
          if (src_f32) { const float* sp_ = xsrc_ptr(sl, sc, rr) + cc; x0 = *(const f32x4*)sp_; x1 = *(const f32x4*)(sp_ + 4); }
          else { const u32x4 w = *(const u32x4*)xp; x0 = (f32x4){bf_lo(w.x), bf_hi(w.x), bf_lo(w.y), bf_hi(w.y)}; x1 = (f32x4){bf_lo(w.z), bf_hi(w.z), bf_lo(w.w), bf_hi(w.w)}; }
          x0 += g0 * acc[ai][bj][m][0]; x1 += g1 * acc[ai][bj][m][1];
          *(u32x4*)xp = (u32x4){pk2(x0.x, x0.y), pk2(x0.z, x0.w), pk2(x1.x, x1.y), pk2(x1.z, x1.w)}; } }
  } };
template <class Epi, class Sched, bool ALIGN_EPI = false, bool SP2 = false, bool FP8 = false, bool I8 = false>
__device__ __forceinline__ void gemm_phase(PG8_LAS unsigned char* lds, const Gemm g, const Sched& S, const Epi& E, int wv) {
    const int tid = otid(wv), wid = __builtin_amdgcn_readfirstlane(tid >> 6), lane = tid & 63, wr = wid >> 2, wc = wid & 3, fr = lane & 15, fq = lane >> 4;
    const int K = g.K, nt = K / BK;
    unsigned voffA[2], voffB[2];
#pragma unroll
    for (int i = 0; i < 2; ++i) { int R, C; stage_rc(tid * 16 + i * 8192, R, C); const int Rb = Epi::PERM ? ((R & ~31) + perm32(R & 31)) : R;
        voffA[i] = (unsigned)(R * K + C) * 2u; voffB[i] = (unsigned)(Rb * K + C) * 2u; }
    const size_t kstep = (size_t)(BK * 2);
    const size_t hstep = (size_t)HALF * K * 2;
    const size_t tstep = 2 * hstep;
    const unsigned ldsw = (unsigned)wid * 1024u;
    const int aoff = lds_byte(wr * 64 + fr, fq * 8), boff = lds_byte(wc * 32 + fr, fq * 8);
#define PG8_SA(b, h) (((b) * 2 + (h)) * HTB)
#define PG8_SB(b, h) ((4 + (b) * 2 + (h)) * HTB)
#define PG8_STAGE(bufoff, gbase, voff) do { _Pragma("unroll") for (int _i = 0; _i < 2; ++_i) \
        __builtin_amdgcn_global_load_lds((const unsigned*)((const char*)(gbase) + (voff)[_i]), (PG8_LAS unsigned*)(lds + (bufoff) + ldsw + _i * 8192), 16, 0, 0); } while (0)
#define PG8_LDA(dst, b, h) do { _Pragma("unroll") for (int m = 0; m < 4; ++m) { _Pragma("unroll") for (int k = 0; k < 2; ++k) dst[m][k] = *(const PG8_LAS bf16x8*)(lds + PG8_SA(b, h) + aoff + m * 2048 + k * 1024); \
        if constexpr (FP8) dst##8[m] = __builtin_bit_cast(pg8_v8i, __builtin_shufflevector(dst[m][0], dst[m][1], 0, 1, 2, 3, 4, 5, 6, 7, 8, 9, 10, 11, 12, 13, 14, 15)); } } while (0)
#define PG8_LDB(dst, b, h) do { _Pragma("unroll") for (int n = 0; n < 2; ++n) { _Pragma("unroll") for (int k = 0; k < 2; ++k) dst[n][k] = *(const PG8_LAS bf16x8*)(lds + PG8_SB(b, h) + boff + n * 2048 + k * 1024); \
        if constexpr (FP8) dst##8[n] = __builtin_bit_cast(pg8_v8i, __builtin_shufflevector(dst[n][0], dst[n][1], 0, 1, 2, 3, 4, 5, 6, 7, 8, 9, 10, 11, 12, 13, 14, 15)); } } while (0)
#define PG8_MMA(ai, bj, At, Bt) do { __builtin_amdgcn_s_setprio(1); _Pragma("unroll") for (int m = 0; m < 4; ++m) _Pragma("unroll") for (int n = 0; n < 2; ++n) { \
        if constexpr (FP8) {     \
          acc[ai][bj][m][n] = __builtin_amdgcn_mfma_scale_f32_16x16x128_f8f6f4(Bt##8[n], At##8[m], acc[ai][bj][m][n], 0, 0, 0, 127, 0, 127); asm volatile("" : "+v"(acc[ai][bj][m][n])); } \
        else if constexpr (I8) {     \
          _Pragma("unroll") for (int k = 0; k < 2; ++k) acc[ai][bj][m][n] = __builtin_bit_cast(f32x4, __builtin_amdgcn_mfma_i32_16x16x64_i8(__builtin_bit_cast(pg8_v4i, Bt[n][k]), __builtin_bit_cast(pg8_v4i, At[m][k]), __builtin_bit_cast(pg8_v4i, acc[ai][bj][m][n]), 0, 0, 0)); \
          asm volatile("" : "+v"(acc[ai][bj][m][n])); } \
        else { _Pragma("unroll") for (int k = 0; k < 2; ++k) acc[ai][bj][m][n] = __builtin_amdgcn_mfma_f32_16x16x32_bf16(Bt[n][k], At[m][k], acc[ai][bj][m][n], 0, 0, 0); } } __builtin_amdgcn_s_setprio(0); } while (0)
#define PG8_WAIT_V(n) asm volatile("s_waitcnt vmcnt(" #n ")" ::: "memory")
#define PG8_WAIT_L(n) asm volatile("s_waitcnt lgkmcnt(" #n ")" ::: "memory")
#define PG8_BAR __builtin_amdgcn_s_barrier()
#define PG8_SCHED __builtin_amdgcn_sched_barrier(0)
    Unit cur, nxt; int ui = 0;
    if (!S.next(0, cur)) return;
    f32x4 acc[2][2][4][2];
#pragma unroll
    for (int a = 0; a < 2; ++a)
#pragma unroll
        for (int b = 0; b < 2; ++b)
#pragma unroll
            for (int m = 0; m < 4; ++m)
#pragma unroll
                for (int n = 0; n < 2; ++n) acc[a][b][m][n] = (f32x4){0.f, 0.f, 0.f, 0.f};
    bf16x8 At[4][2], B0[2][2], B1[2][2];
    pg8_v8i At8[4], B08[2], B18[2];
    const char* cA = (const char*)g.A + (size_t)cur.pm * tstep; const char* cB = (const char*)g.Bt + (size_t)cur.pn * tstep;
    S.a_ready(cur);
    if constexpr (SP2) {
        PG8_STAGE(PG8_SB(0, 0), cB, voffB); PG8_STAGE(PG8_SB(0, 1), cB + hstep, voffB); PG8_STAGE(PG8_SA(0, 0), cA, voffA); PG8_STAGE(PG8_SA(0, 1), cA + hstep, voffA);
        if (wr == 1) PG8_BAR;
        PG8_WAIT_V(2); PG8_BAR;
        PG8_STAGE(PG8_SB(1, 0), cB + kstep, voffB); PG8_STAGE(PG8_SA(1, 0), cA + kstep, voffA); PG8_STAGE(PG8_SB(1, 1), cB + hstep + kstep, voffB);
        PG8_WAIT_V(6); PG8_BAR;
    } else {
        PG8_STAGE(PG8_SB(0, 0), cB, voffB); PG8_STAGE(PG8_SA(0, 0), cA, voffA); PG8_STAGE(PG8_SB(0, 1), cB + hstep, voffB); PG8_STAGE(PG8_SA(0, 1), cA + hstep, voffA);
        if (wr == 1) PG8_BAR;
        PG8_WAIT_V(4); PG8_BAR;
        PG8_STAGE(PG8_SB(1, 0), cB + kstep, voffB); PG8_STAGE(PG8_SA(1, 0), cA + kstep, voffA); PG8_STAGE(PG8_SB(1, 1), cB + hstep + kstep, voffB);
        PG8_WAIT_V(6); PG8_BAR;
    }
    for (;;) {
        const bool has_next = S.next(ui + 1, nxt);
        const char* nA = has_next ? (const char*)g.A + (size_t)nxt.pm * tstep : cA; const char* nB = has_next ? (const char*)g.Bt + (size_t)nxt.pn * tstep : cB;
        for (int t = 0; t < nt; t += 2) {
            const bool last = (t == nt - 2);
            const char* a1 = cA + (size_t)(t + 1) * kstep;
            const char* a2 = last ? nA : cA + (size_t)(t + 2) * kstep; const char* b2 = last ? nB : cB + (size_t)(t + 2) * kstep;
            const char* a3 = a2 + kstep; const char* b3 = b2 + kstep;
            if (last && has_next) S.a_ready(nxt);
            if constexpr (SP2) {
            PG8_LDB(B0, 0, 0); PG8_LDB(B1, 0, 1); PG8_SCHED; PG8_LDA(At, 0, 0); PG8_STAGE(PG8_SA(1, 1), a1 + hstep, voffA);
            PG8_WAIT_V(8); PG8_WAIT_L(0); PG8_BAR; PG8_MMA(0, 0, At, B0); PG8_MMA(0, 1, At, B1); PG8_BAR; PG8_SCHED;
            PG8_LDA(At, 0, 1); PG8_STAGE(PG8_SB(0, 0), b2, voffB); PG8_STAGE(PG8_SB(0, 1), b2 + hstep, voffB); PG8_STAGE(PG8_SA(0, 0), a2, voffA);
            PG8_WAIT_V(8); PG8_WAIT_L(0); PG8_BAR; PG8_MMA(1, 0, At, B0); PG8_MMA(1, 1, At, B1); PG8_BAR; PG8_SCHED;
            PG8_LDB(B0, 1, 0); PG8_LDB(B1, 1, 1); PG8_SCHED; PG8_LDA(At, 1, 0); PG8_STAGE(PG8_SA(0, 1), a2 + hstep, voffA);
            PG8_WAIT_V(8); PG8_WAIT_L(0); PG8_BAR; PG8_MMA(0, 0, At, B0); PG8_MMA(0, 1, At, B1); PG8_BAR; PG8_SCHED;
            PG8_LDA(At, 1, 1); PG8_STAGE(PG8_SB(1, 0), b3, voffB); PG8_STAGE(PG8_SB(1, 1), b3 + hstep, voffB); PG8_STAGE(PG8_SA(1, 0), a3, voffA);
            PG8_WAIT_V(8); PG8_WAIT_L(0); PG8_BAR; PG8_MMA(1, 0, At, B0); PG8_MMA(1, 1, At, B1); PG8_BAR; PG8_SCHED;
            } else {
            PG8_LDB(B0, 0, 0); PG8_SCHED; PG8_LDA(At, 0, 0); PG8_STAGE(PG8_SA(1, 1), a1 + hstep, voffA);
            PG8_WAIT_L(8); PG8_BAR; PG8_WAIT_L(0); PG8_MMA(0, 0, At, B0); PG8_BAR; PG8_SCHED;
            PG8_LDB(B1, 0, 1); PG8_STAGE(PG8_SB(0, 0), b2, voffB);
            PG8_BAR; PG8_WAIT_L(0); PG8_MMA(0, 1, At, B1); PG8_BAR;
            PG8_LDA(At, 0, 1); PG8_STAGE(PG8_SA(0, 0), a2, voffA);
            PG8_BAR; PG8_WAIT_L(0); PG8_MMA(1, 0, At, B0); PG8_BAR; PG8_SCHED;
            PG8_STAGE(PG8_SB(0, 1), b2 + hstep, voffB);
            PG8_WAIT_V(6); PG8_BAR; PG8_MMA(1, 1, At, B1); PG8_BAR;
            PG8_LDB(B0, 1, 0); PG8_SCHED; PG8_LDA(At, 1, 0); PG8_STAGE(PG8_SA(0, 1), a2 + hstep, voffA);
            PG8_WAIT_L(8); PG8_BAR; PG8_WAIT_L(0); PG8_MMA(0, 0, At, B0); PG8_BAR; PG8_SCHED;
            PG8_LDB(B1, 1, 1); PG8_STAGE(PG8_SB(1, 0), b3, voffB);
            PG8_BAR; PG8_WAIT_L(0); PG8_MMA(0, 1, At, B1); PG8_BAR;
            PG8_LDA(At, 1, 1); PG8_STAGE(PG8_SA(1, 0), a3, voffA);
            PG8_BAR; PG8_WAIT_L(0); PG8_MMA(1, 0, At, B0); PG8_BAR; PG8_SCHED;
            PG8_STAGE(PG8_SB(1, 1), b3 + hstep, voffB);
            PG8_WAIT_V(6); PG8_BAR; PG8_MMA(1, 1, At, B1); PG8_BAR;
            }
        }
        if constexpr (ALIGN_EPI) { if (wr == 0) PG8_BAR; }
        if constexpr (!Epi::AFTER_DRAIN) { E(acc, cur, wr, wc, fr, fq); S.done(cur); }
        if (!has_next) break;
#pragma unroll
        for (int a = 0; a < 2; ++a)
#pragma unroll
            for (int b = 0; b < 2; ++b)
#pragma unroll
                for (int m = 0; m < 4; ++m)
#pragma unroll
                    for (int n = 0; n < 2; ++n) acc[a][b][m][n] = (f32x4){0.f, 0.f, 0.f, 0.f};
        cur = nxt; cA = nA; cB = nB; ++ui;
        if constexpr (ALIGN_EPI) { if (wr == 1) PG8_BAR; }
    }
    PG8_WAIT_V(0);
    if constexpr (!ALIGN_EPI) { if (wr == 0) PG8_BAR; }
    PG8_BAR;
    if constexpr (Epi::AFTER_DRAIN) { E.fused(acc, cur, wr, wc, fr, fq, lds, wid, lane); S.done(cur); }
#undef PG8_SA
#undef PG8_SB
#undef PG8_STAGE
#undef PG8_LDA
#undef PG8_LDB
#undef PG8_MMA
#undef PG8_WAIT_V
#undef PG8_WAIT_L
#undef PG8_BAR
#undef PG8_SCHED
}
}
#define UNPACK8(W, V, O) do { V[O + 0] = bf_lo(W.x); V[O + 1] = bf_hi(W.x); V[O + 2] = bf_lo(W.y); V[O + 3] = bf_hi(W.y); V[O + 4] = bf_lo(W.z); V[O + 5] = bf_hi(W.z); V[O + 6] = bf_lo(W.w); V[O + 7] = bf_hi(W.w); } while (0)
#define PACK8(V, O, SC) (u32x4){pk2(V[O] * SC, V[O + 1] * SC), pk2(V[O + 2] * SC, V[O + 3] * SC), pk2(V[O + 4] * SC, V[O + 5] * SC), pk2(V[O + 6] * SC, V[O + 7] * SC)}
__device__ __forceinline__ void headnorm96(const bf16_t* srcA, const bf16_t* srcB, bf16_t* dst, const float* __restrict__ g, float outscale, bool rope, int rowpos, int colpos,
                                           const float* __restrict__ tab8, int j) {
  const u32x4 w0 = *(const u32x4*)(srcA + j * 8), w1 = *(const u32x4*)(srcA + 32 + j * 8), w2 = *(const u32x4*)(srcB + j * 8);
  float v[24];
  UNPACK8(w0, v, 0); UNPACK8(w1, v, 8); UNPACK8(w2, v, 16);
  float ss = 0.f;
#pragma unroll
  for (int e = 0; e < 24; ++e) ss += v[e] * v[e];
  ss += __shfl_xor(ss, 1); ss += __shfl_xor(ss, 2);
  const float rstd = rsqrtf(ss * (1.f / 96.f) + EPS);
#pragma unroll
  for (int e = 0; e < 8; ++e) { v[e] *= rstd * g[j * 8 + e]; v[8 + e] *= rstd * g[32 + j * 8 + e]; v[16 + e] *= rstd * g[64 + j * 8 + e]; }
  const int pos = (j < 2) ? rowpos : colpos;
#pragma unroll
  for (int e = 0; e < 8; ++e) {
    const float own = v[16 + e], oth = __shfl_xor(own, 1);
    const f32x2_t cs = *(const f32x2_t*)(tab8 + (pos * 8 + e) * 2);
    const float res = (j & 1) ? (oth * cs.y + own * cs.x) : (own * cs.x - oth * cs.y);
    if (rope) v[16 + e] = res;
  }
  *(u32x4*)(dst + j * 8) = PACK8(v, 0, outscale); *(u32x4*)(dst + 32 + j * 8) = PACK8(v, 8, outscale); *(u32x4*)(dst + 64 + j * 8) = PACK8(v, 16, outscale);
}
__device__ __forceinline__ void headnorm64(const bf16_t* q, bf16_t* qd, const float* __restrict__ g, float outscale, bool rope, int rowpos, int colpos, const float* __restrict__ tab16, int j) {
  const u32x4 w0 = *(const u32x4*)(q + j * 8), w1 = *(const u32x4*)(q + 32 + j * 8);
  float v[16];
  UNPACK8(w0, v, 0); UNPACK8(w1, v, 8);
  float ss = 0.f;
#pragma unroll
  for (int e = 0; e < 16; ++e) ss += v[e] * v[e];
  ss += __shfl_xor(ss, 1); ss += __shfl_xor(ss, 2);
  const float rstd = rsqrtf(ss * (1.f / 64.f) + EPS);
#pragma unroll
  for (int e = 0; e < 8; ++e) { v[e] *= rstd * g[j * 8 + e]; v[8 + e] *= rstd * g[32 + j * 8 + e]; }
#pragma unroll
  for (int e = 0; e < 8; ++e) {
    const int i = (j & 1) * 8 + e;
    const float own0 = v[e], oth0 = __shfl_xor(own0, 2), own1 = v[8 + e], oth1 = __shfl_xor(own1, 2);
    const f32x2_t cr = *(const f32x2_t*)(tab16 + (rowpos * 16 + i) * 2), cc = *(const f32x2_t*)(tab16 + (colpos * 16 + i) * 2);
    const float r0 = (j >> 1) ? (oth0 * cr.y + own0 * cr.x) : (own0 * cr.x - oth0 * cr.y);
    const float r1 = (j >> 1) ? (oth1 * cc.y + own1 * cc.x) : (own1 * cc.x - oth1 * cc.y);
    if (rope) { v[e] = r0; v[8 + e] = r1; }
  }
  *(u32x4*)(qd + j * 8) = PACK8(v, 0, outscale); *(u32x4*)(qd + 32 + j * 8) = PACK8(v, 8, outscale);
}

template <int DQK, int DV, int NS, bool WINDOW>
__device__ __forceinline__ void attn_unit(LAS unsigned char* lds, const bf16_t* __restrict__ Qb, int qsoff, int ldq, const bf16_t* __restrict__ Kb, int ksoff, int ldk,
                                          const bf16_t* __restrict__ Vb, int ldv, int q0, int ta0, int ta1, int tb0, int tb1, bool has_sink, float sink_l2, float kmax,
                                          unsigned char* __restrict__ Ob, int ldo, float lam, const float* __restrict__ gsub, int wv) {
  constexpr int KS = DQK * 2 + 16, KTB = 64 * KS, VS = (DV == 64) ? 192 : 320, VOFF = NS * KTB, VTB = 64 * VS, STG = VOFF + VTB;
  constexpr int KCR = DQK / 8, KCH = 64 * KCR, VCR = DV / 8, VCH = 64 * VCR, NCH = NS * KCH + VCH, NI = (NCH + NTHREADS - 1) / NTHREADS;
  constexpr int NDB = DV / 32, NKS = DQK / 16;
  static_assert(3 * STG <= LDS_BYTES - 16 && (NS == 1 || 4 * DV * 32 * 4 <= 3 * STG), "LDS");
  const int tid = otid(wv), lane = tid & 63, wid = tid >> 6, l31 = lane & 31, hi = lane >> 5;
  const int grp = wid >> 2;
  const int qsub = (NS == 1) ? wid : (wid & 3), stream = (NS == 1) ? 0 : grp;
  const int qrow = q0 + qsub * 32 + l31;
  bf16x8 qf[NKS];
  float qn2 = 0.f;
#pragma unroll
  for (int ks = 0; ks < NKS; ++ks) {
    const u32x4 w = *(const u32x4*)(Qb + (size_t)stream * qsoff + (size_t)qrow * ldq + ks * 16 + hi * 8);
    qf[ks] = __builtin_bit_cast(bf16x8, w);
    const float a0 = bf_lo(w.x), a1 = bf_hi(w.x), a2 = bf_lo(w.y), a3 = bf_hi(w.y), a4 = bf_lo(w.z), a5 = bf_hi(w.z), a6 = bf_lo(w.w), a7 = bf_hi(w.w);
    qn2 += a0 * a0 + a1 * a1 + a2 * a2 + a3 * a3 + a4 * a4 + a5 * a5 + a6 * a6 + a7 * a7;
  }
  qn2 += __shfl_xor(qn2, 32);
  const float negmb = -(sqrtf(qn2) * kmax);
  f32x16 negmv;
  if (DV == 64) {
#pragma unroll
    for (int r = 0; r < 16; ++r) negmv[r] = negmb;
    asm volatile("" : "+v"(negmv));
  }
  f32x16 o[NDB];
#pragma unroll
  for (int db = 0; db < NDB; ++db)
#pragma unroll
    for (int r = 0; r < 16; ++r) o[db][r] = 0.f;
  float lrun = 0.f;
  const int n1 = ta1 - ta0, ntl = n1 + (tb1 - tb0);
  u32x4 st[NI];
  f32x16 p0, p1;
  const LAS unsigned char* klb = lds + stream * KTB + l31 * KS + hi * 16;
  const LAS unsigned char* vlb = lds + VOFF + (4 * hi + ((lane & 15) >> 2)) * VS + (16 * ((lane >> 4) & 1) + 4 * (lane & 3)) * 2;
#define ATT_TILE(i_) (((i_) < n1) ? ta0 + (i_) : tb0 + ((i_) - n1))
  constexpr bool ALIGNED = ((NS * KCH) % NTHREADS == 0) && (NCH % NTHREADS == 0);
#define ATT_LOAD(T_) do { const int t__ = (T_); \
      if constexpr (ALIGNED) { unsigned tq__ = (unsigned)tid; asm volatile("" : "+v"(tq__)); \
        const unsigned kofs__ = (__umul24(tq__ / (unsigned)KCR, (unsigned)ldk) + (tq__ % (unsigned)KCR) * 8u) * 2u, vofs__ = (__umul24(tq__ / (unsigned)VCR, (unsigned)ldv) + (tq__ % (unsigned)VCR) * 8u) * 2u;     \
        _Pragma("unroll") for (int ii = 0; ii < NI; ++ii) { \
          if (ii * NTHREADS < NS * KCH) { const int cK = ii * NTHREADS, s_ = cK / KCH, rb_ = (cK % KCH) / KCR; \
            st[ii] = *(const u32x4*)((const char*)(Kb + (size_t)s_ * ksoff + (size_t)(t__ * 64 + rb_) * ldk) + kofs__); } \
          else { const int rb_ = (ii * NTHREADS - NS * KCH) / VCR; const unsigned vt__ = (unsigned)(t__ * 64 + rb_) * (unsigned)ldv * 2u;     \
            st[ii] = *(const u32x4*)((const char*)Vb + (vt__ + vofs__)); } } } \
      else { \
      _Pragma("unroll") for (int ii = 0; ii < NI; ++ii) { const int c = tid + ii * NTHREADS; if (c < NCH) { \
      if (c < NS * KCH) { const int s_ = c / KCH, cc = c - s_ * KCH, row = cc / KCR, kc = cc - row * KCR; st[ii] = *(const u32x4*)(Kb + (size_t)s_ * ksoff + (size_t)(t__ * 64 + row) * ldk + kc * 8); } \
      else { const int cc = c - NS * KCH, row = cc / VCR, vc = cc - row * VCR; st[ii] = *(const u32x4*)(Vb + (size_t)(t__ * 64 + row) * ldv + vc * 8); } } } } } while (0)
#define ATT_STORE(BO_) do { LAS unsigned char* sb__ = lds + (BO_); \
      if constexpr (ALIGNED) { unsigned tq__ = (unsigned)tid; asm volatile("" : "+v"(tq__)); \
        const unsigned kl__ = __umul24(tq__ / (unsigned)KCR, (unsigned)KS) + (tq__ % (unsigned)KCR) * 16u, vl__ = __umul24(tq__ / (unsigned)VCR, (unsigned)VS) + (tq__ % (unsigned)VCR) * 16u; \
        _Pragma("unroll") for (int ii = 0; ii < NI; ++ii) { \
          if (ii * NTHREADS < NS * KCH) { const int cK = ii * NTHREADS, s_ = cK / KCH, rb_ = (cK % KCH) / KCR; *(LAS u32x4*)(sb__ + s_ * KTB + rb_ * KS + kl__) = st[ii]; } \
          else { const int rb_ = (ii * NTHREADS - NS * KCH) / VCR; *(LAS u32x4*)(sb__ + VOFF + rb_ * VS + vl__) = st[ii]; } } } \
      else { \
      _Pragma("unroll") for (int ii = 0; ii < NI; ++ii) { const int c = tid + ii * NTHREADS; if (c < NCH) { \
      if (c < NS * KCH) { const int s_ = c / KCH, cc = c - s_ * KCH, row = cc / KCR, kc = cc - row * KCR; *(LAS u32x4*)(sb__ + s_ * KTB + row * KS + kc * 16) = st[ii]; } \
      else { const int cc = c - NS * KCH, row = cc / VCR, vc = cc - row * VCR; *(LAS u32x4*)(sb__ + VOFF + row * VS + vc * 16) = st[ii]; } } } } } while (0)
#define ATT_FLAGS(T_, ACT_, MSK_) do { ACT_ = true; MSK_ = false; if (WINDOW && (T_) < 32) { const int qlo = q0 + qsub * 32, qhi = qlo + 31, klo = (T_) * 64, khi = klo + 63; \
      ACT_ = !(khi < qlo - 128 || klo > qhi + 128); MSK_ = (khi - qlo > 128) || (qhi - klo > 128); } } while (0)
  constexpr int KB1 = NKS / 2;
  bf16x8 kf[2 * KB1];
#define ATT_QK_READ1(BO_) do { const LAS unsigned char* kl = klb + (BO_); \
      _Pragma("unroll") for (int ks = 0; ks < KB1; ++ks) { kf[2 * ks] = *(const LAS bf16x8*)(kl + ks * 32); kf[2 * ks + 1] = *(const LAS bf16x8*)(kl + 32 * KS + ks * 32); } \
      __builtin_amdgcn_sched_barrier(0); } while (0)
#define ATT_QK_REST(BO_) do { const LAS unsigned char* kl = klb + (BO_); \
      __builtin_amdgcn_sched_barrier(0); \
      if (DV == 64) { p0 = __builtin_amdgcn_mfma_f32_32x32x16_bf16(kf[0], qf[0], negmv, 0, 0, 0); p1 = __builtin_amdgcn_mfma_f32_32x32x16_bf16(kf[1], qf[0], negmv, 0, 0, 0); } \
      else { _Pragma("unroll") for (int r = 0; r < 16; ++r) { p0[r] = negmb; p1[r] = negmb; } p0 = __builtin_amdgcn_mfma_f32_32x32x16_bf16(kf[0], qf[0], p0, 0, 0, 0); p1 = __builtin_amdgcn_mfma_f32_32x32x16_bf16(kf[1], qf[0], p1, 0, 0, 0); } \
      _Pragma("unroll") for (int ks = 1; ks < KB1; ++ks) { p0 = __builtin_amdgcn_mfma_f32_32x32x16_bf16(kf[2 * ks], qf[ks], p0, 0, 0, 0); p1 = __builtin_amdgcn_mfma_f32_32x32x16_bf16(kf[2 * ks + 1], qf[ks], p1, 0, 0, 0); } \
      __builtin_amdgcn_sched_barrier(0); \
      _Pragma("unroll") for (int ks = KB1; ks < NKS; ++ks) { kf[2 * (ks - KB1)] = *(const LAS bf16x8*)(kl + ks * 32); kf[2 * (ks - KB1) + 1] = *(const LAS bf16x8*)(kl + 32 * KS + ks * 32); } \
      __builtin_amdgcn_sched_barrier(0); \
      _Pragma("unroll") for (int ks = KB1; ks < NKS; ++ks) { p0 = __builtin_amdgcn_mfma_f32_32x32x16_bf16(kf[2 * (ks - KB1)], qf[ks], p0, 0, 0, 0); p1 = __builtin_amdgcn_mfma_f32_32x32x16_bf16(kf[2 * (ks - KB1) + 1], qf[ks], p1, 0, 0, 0); } \
      __builtin_amdgcn_sched_barrier(0); } while (0)
#define ATT_VREAD_(VLO_, VHI_, G_) do { _Pragma("unroll") for (int d2 = 0; d2 < GD; ++d2) _Pragma("unroll") for (int kb = 0; kb < 2; ++kb) _Pragma("unroll") for (int s_ = 0; s_ < 2; ++s_) { \
        const LAS unsigned char* vp = vl + (kb * 32 + 16 * s_) * VS + ((G_) * GD + d2) * 64; \
        VLO_[d2 * 4 + kb * 2 + s_] = __builtin_amdgcn_ds_read_tr16_b64_v4i16((LAS v4i16_t*)vp); VHI_[d2 * 4 + kb * 2 + s_] = __builtin_amdgcn_ds_read_tr16_b64_v4i16((LAS v4i16_t*)(vp + 8 * VS)); } } while (0)
#define ATT_PVM_(VLO_, VHI_, G_) do { _Pragma("unroll") for (int d2 = 0; d2 < GD; ++d2) _Pragma("unroll") for (int kb = 0; kb < 2; ++kb) _Pragma("unroll") for (int s_ = 0; s_ < 2; ++s_) { \
        const v4i16_t lo_ = VLO_[d2 * 4 + kb * 2 + s_], hi_ = VHI_[d2 * 4 + kb * 2 + s_]; \
        const bf16x8 vf = (bf16x8){lo_[0], lo_[1], lo_[2], lo_[3], hi_[0], hi_[1], hi_[2], hi_[3]}; \
        o[(G_) * GD + d2] = __builtin_amdgcn_mfma_f32_32x32x16_bf16(vf, __builtin_bit_cast(bf16x8, pw[kb][s_]), o[(G_) * GD + d2], 0, 0, 0); } } while (0)
#define ATT_VREAD(G_) ATT_VREAD_(vlo, vhi, G_)
#define ATT_PVM(G_) ATT_PVM_(vlo, vhi, G_)
#define ATT_SPV(T_, BO_, MSK_) do { const LAS unsigned char* vl = vlb + (BO_); constexpr int GD = (DV == 128) ? 1 : 2; v4i16_t vlo[4 * GD], vhi[4 * GD]; \
      ATT_VREAD(0); __builtin_amdgcn_sched_barrier(0); \
      if (WINDOW && (MSK_)) { _Pragma("unroll") for (int r = 0; r < 16; ++r) { const int d0 = (T_) * 64 + crow(r, hi) - qrow, d1 = d0 + 32; \
          if (d0 > 128 || d0 < -128) p0[r] = -INFINITY; if (d1 > 128 || d1 < -128) p1[r] = -INFINITY; } } \
      _Pragma("unroll") for (int r = 0; r < 16; ++r) { p0[r] = __builtin_amdgcn_exp2f(p0[r]); p1[r] = __builtin_amdgcn_exp2f(p1[r]); } \
      u32x4 pw[2][2]; \
      _Pragma("unroll") for (int s_ = 0; s_ < 2; ++s_) { \
        pw[0][s_] = (u32x4){pk2(p0[8 * s_], p0[8 * s_ + 1]), pk2(p0[8 * s_ + 2], p0[8 * s_ + 3]), pk2(p0[8 * s_ + 4], p0[8 * s_ + 5]), pk2(p0[8 * s_ + 6], p0[8 * s_ + 7])}; \
        pw[1][s_] = (u32x4){pk2(p1[8 * s_], p1[8 * s_ + 1]), pk2(p1[8 * s_ + 2], p1[8 * s_ + 3]), pk2(p1[8 * s_ + 4], p1[8 * s_ + 5]), pk2(p1[8 * s_ + 6], p1[8 * s_ + 7])}; } \
      _Pragma("unroll") for (int kb = 0; kb < 2; ++kb) _Pragma("unroll") for (int s_ = 0; s_ < 2; ++s_) { \
        lrun = dot2bf(pw[kb][s_].x, 0x3f803f80u, lrun); lrun = dot2bf(pw[kb][s_].y, 0x3f803f80u, lrun); lrun = dot2bf(pw[kb][s_].z, 0x3f803f80u, lrun); lrun = dot2bf(pw[kb][s_].w, 0x3f803f80u, lrun); } \
      __builtin_amdgcn_sched_barrier(0); \
      if constexpr (DV == 128) {     \
        v4i16_t vlo2[4], vhi2[4]; \
        ATT_VREAD_(vlo2, vhi2, 1); __builtin_amdgcn_sched_barrier(0); ATT_PVM_(vlo, vhi, 0); __builtin_amdgcn_sched_barrier(0); \
        ATT_VREAD_(vlo, vhi, 2); __builtin_amdgcn_sched_barrier(0); ATT_PVM_(vlo2, vhi2, 1); __builtin_amdgcn_sched_barrier(0); \
        ATT_VREAD_(vlo2, vhi2, 3); __builtin_amdgcn_sched_barrier(0); ATT_PVM_(vlo, vhi, 2); __builtin_amdgcn_sched_barrier(0); ATT_PVM_(vlo2, vhi2, 3); \
      } else { \
      ATT_PVM(0); \
      _Pragma("unroll") for (int g_ = 1; g_ < NDB / GD; ++g_) { __builtin_amdgcn_sched_barrier(0); ATT_VREAD(g_); __builtin_amdgcn_sched_barrier(0); ATT_PVM(g_); } } } while (0)
  ATT_LOAD(ATT_TILE(0));
  ATT_STORE(0);
  if (ntl > 1) ATT_LOAD(ATT_TILE(1));
  __syncthreads();
  int bo_prev = 0, bo_cur = 0, bo_next = STG;
  for (int i = 0; i <= ntl; ++i) {
    if (grp == 0) {
      if (i < ntl) {
        const int t = ATT_TILE(i);
        bool act, msk; ATT_FLAGS(t, act, msk);
        if (act) ATT_QK_READ1(bo_cur);
        if (i + 1 < ntl) ATT_STORE(bo_next);
        if (i + 2 < ntl) ATT_LOAD(ATT_TILE(i + 2));
        if (act) { ATT_QK_REST(bo_cur); ATT_SPV(t, bo_cur, msk); }
      }
    } else {
      if (i >= 1) { const int tp = ATT_TILE(i - 1); bool act, msk; ATT_FLAGS(tp, act, msk); if (act) ATT_SPV(tp, bo_prev, msk); }
      if (i < ntl) {
        const int t = ATT_TILE(i);
        bool act, msk; ATT_FLAGS(t, act, msk);
        if (act) ATT_QK_READ1(bo_cur);
        if (i + 1 < ntl) ATT_STORE(bo_next);
        if (i + 2 < ntl) ATT_LOAD(ATT_TILE(i + 2));
        if (act) ATT_QK_REST(bo_cur);
      }
    }
    bo_prev = bo_cur; bo_cur = bo_next; bo_next = (bo_next == 2 * STG) ? 0 : bo_next + STG;
    __syncthreads();
  }
#undef ATT_LOAD
#undef ATT_STORE
#undef ATT_TILE
#undef ATT_FLAGS
#undef ATT_QK_READ1
#undef ATT_QK_REST
#undef ATT_VREAD
#undef ATT_VREAD_
#undef ATT_PVM_
#undef ATT_PVM
#undef ATT_SPV
  float ltot = lrun + __shfl_xor(lrun, 32);
  if (has_sink) ltot += __builtin_amdgcn_exp2f(sink_l2 + negmb);
  const float inv = 1.f / ltot;
  if (NS == 1) {
    unsigned char* op = Ob + (size_t)qrow * ldo + 4 * hi; const float is_ = inv * OSC;
#pragma unroll
    for (int db = 0; db < NDB; ++db)
#pragma unroll
      for (int r4 = 0; r4 < 4; ++r4)
        *(unsigned*)(op + db * 32 + 8 * r4) = pk4_fp8(o[db][4 * r4] * is_, o[db][4 * r4 + 1] * is_, o[db][4 * r4 + 2] * is_, o[db][4 * r4 + 3] * is_);
  } else {
    LAS float* ex = (LAS float*)lds + qsub * (DV * 32);
    if (stream == 1) {
#pragma unroll
      for (int db = 0; db < NDB; ++db)
#pragma unroll
        for (int r = 0; r < 16; ++r) ex[(db * 32 + crow(r, hi)) * 32 + l31] = o[db][r] * inv;
    }
    __syncthreads();
    if (stream == 0) {
      float ss = 0.f;
#pragma unroll
      for (int db = 0; db < NDB; ++db)
#pragma unroll
        for (int r = 0; r < 16; ++r) { const float v = o[db][r] * inv - lam * ex[(db * 32 + crow(r, hi)) * 32 + l31]; o[db][r] = v; ss += v * v; }
      ss += __shfl_xor(ss, 32);
      const float rs = rsqrtf(ss * (1.f / DV) + EPS) * (1.f - LAM_INIT);
      unsigned char* op = Ob + (size_t)qrow * ldo + 4 * hi; const float rs_ = rs * OSC;
#pragma unroll
      for (int db = 0; db < NDB; ++db)
#pragma unroll
        for (int r4 = 0; r4 < 4; ++r4) {
          const f32x4 g4 = *(const f32x4*)(gsub + db * 32 + 8 * r4 + 4 * hi);
          *(unsigned*)(op + db * 32 + 8 * r4) = pk4_fp8(o[db][4 * r4] * rs_ * g4.x, o[db][4 * r4 + 1] * rs_ * g4.y, o[db][4 * r4 + 2] * rs_ * g4.z, o[db][4 * r4 + 3] * rs_ * g4.w);
        }
    }
    __syncthreads();
  }
}

template <int DQK, int DV, bool WINDOW>
__device__ __forceinline__ void attn_unit_p(LAS unsigned char* lds, const bf16_t* __restrict__ Qb, int ldq, const bf16_t* __restrict__ Kb, int ldk, const bf16_t* __restrict__ Vb, int ldv,
                                            int q0, int ta0, int ta1, int tb0, int tb1, bool has_sink, float sink_l2, float kmax, unsigned char* __restrict__ Ob, int ldo, int wv) {
  static_assert(DV == 64 && !WINDOW, "pipelined form: DV = 64, no window");
  constexpr int KS = DQK * 2 + 16, KTB = 64 * KS, VS = 192, VOFF = KTB, VTB = 64 * VS, STG = VOFF + VTB;
  constexpr int KCR = DQK / 8, KCH = 64 * KCR, VCR = DV / 8, VCH = 64 * VCR, NCH = KCH + VCH, NI = (NCH + NTHREADS - 1) / NTHREADS;
  constexpr int NKS = DQK / 16, NQK = 2 * NKS, NPV = 8, EG = (NQK >= 12) ? 8 : NQK - 2;
  static_assert(3 * STG <= LDS_BYTES - 16, "LDS");
  const int tid = otid(wv), lane = tid & 63, wid = tid >> 6, l31 = lane & 31, hi = lane >> 5;
  const int qrow = q0 + wid * 32 + l31;
  bf16x8 qf[NKS];
  float qn2 = 0.f;
#pragma unroll
  for (int ks = 0; ks < NKS; ++ks) {
    const u32x4 w = *(const u32x4*)(Qb + (size_t)qrow * ldq + ks * 16 + hi * 8);
    qf[ks] = __builtin_bit_cast(bf16x8, w);
    const float a0 = bf_lo(w.x), a1 = bf_hi(w.x), a2 = bf_lo(w.y), a3 = bf_hi(w.y), a4 = bf_lo(w.z), a5 = bf_hi(w.z), a6 = bf_lo(w.w), a7 = bf_hi(w.w);
    qn2 += a0 * a0 + a1 * a1 + a2 * a2 + a3 * a3 + a4 * a4 + a5 * a5 + a6 * a6 + a7 * a7;
  }
  qn2 += __shfl_xor(qn2, 32);
  const float negmb = -(sqrtf(qn2) * kmax);
  f32x16 negmv;
#pragma unroll
  for (int r = 0; r < 16; ++r) negmv[r] = negmb;
  asm volatile("" : "+v"(negmv));
  f32x16 o[2];
#pragma unroll
  for (int db = 0; db < 2; ++db)
#pragma unroll
    for (int r = 0; r < 16; ++r) o[db][r] = 0.f;
  float lrun = 0.f;
  const int n1 = ta1 - ta0, ntl = n1 + (tb1 - tb0);
  u32x4 st[NI];
  f32x16 pA0, pA1, pB0, pB1;
  bf16x8 kw[3];
  v4i16_t vwl[3], vwh[3];
  u32x4 pw[2][2];
  const LAS unsigned char* klb = lds + l31 * KS + hi * 16;
  const LAS unsigned char* vlb = lds + VOFF + (4 * hi + ((lane & 15) >> 2)) * VS + (16 * ((lane >> 4) & 1) + 4 * (lane & 3)) * 2;
#define ATT_TILE(i_) (((i_) < n1) ? ta0 + (i_) : tb0 + ((i_) - n1))
  unsigned gof[NI], lof[NI];
#pragma unroll
  for (int ii = 0; ii < NI; ++ii) { const int cw = (wv + 8 * ii) * 64, c = cw + lane;
    if (cw < KCH) { const int row = c / KCR, kc = c - row * KCR; gof[ii] = (unsigned)(row * ldk + kc * 8) * 2u; lof[ii] = (unsigned)(row * KS + kc * 16); }
    else { const int cc = c - KCH, row = cc / VCR, vc = cc - row * VCR; gof[ii] = (unsigned)(row * ldv + vc * 8) * 2u; lof[ii] = (unsigned)(VOFF + row * VS + vc * 16); } }
#define ATT_LOAD(T_) do { const int t__ = (T_); _Pragma("unroll") for (int ii = 0; ii < NI; ++ii) { const int cw = (wv + 8 * ii) * 64; if (cw < NCH) { \
      const char* gb__ = (cw < KCH) ? (const char*)Kb + (size_t)t__ * 128 * ldk : (const char*)Vb + (size_t)t__ * 128 * ldv; st[ii] = *(const u32x4*)(gb__ + gof[ii]); } } } while (0)
#define ATT_STORE(BO_) do { _Pragma("unroll") for (int ii = 0; ii < NI; ++ii) { const int cw = (wv + 8 * ii) * 64; if (cw < NCH) *(LAS u32x4*)(lds + (BO_) + lof[ii]) = st[ii]; } } while (0)
#define SB_() __builtin_amdgcn_sched_barrier(0)
#define KRD1(BO_, G_) do { kw[(G_) % 3] = *(const LAS bf16x8*)(klb + (BO_) + ((G_) & 1) * 32 * KS + ((G_) >> 1) * 32); } while (0)
#define VRDG(BO_, G_) do { const LAS unsigned char* vp = vlb + (BO_) + ((((G_) >> 2) & 1) * 32 + 16 * (((G_) >> 1) & 1)) * VS + ((G_) & 1) * 64; \
      vwl[(G_) % 3] = __builtin_amdgcn_ds_read_tr16_b64_v4i16((LAS v4i16_t*)vp); vwh[(G_) % 3] = __builtin_amdgcn_ds_read_tr16_b64_v4i16((LAS v4i16_t*)(vp + 8 * VS)); } while (0)
#define QKM(R0_, R1_, G_) do { const int ks_ = (G_) >> 1; \
      if (((G_) & 1) == 0) R0_ = __builtin_amdgcn_mfma_f32_32x32x16_bf16(kw[(G_) % 3], qf[ks_], (ks_ == 0) ? negmv : R0_, 0, 0, 0); \
      else R1_ = __builtin_amdgcn_mfma_f32_32x32x16_bf16(kw[(G_) % 3], qf[ks_], (ks_ == 0) ? negmv : R1_, 0, 0, 0); } while (0)
#define PVM(G_) do { const int d2_ = (G_) & 1, kb_ = ((G_) >> 2) & 1, s_ = ((G_) >> 1) & 1; \
      const v4i16_t lo_ = vwl[(G_) % 3], hi_ = vwh[(G_) % 3]; const bf16x8 vf = (bf16x8){lo_[0], lo_[1], lo_[2], lo_[3], hi_[0], hi_[1], hi_[2], hi_[3]}; \
      o[d2_] = __builtin_amdgcn_mfma_f32_32x32x16_bf16(vf, __builtin_bit_cast(bf16x8, pw[kb_][s_]), o[d2_], 0, 0, 0); } while (0)
#define PACK1(P_, KB_, C_) do { const int s_ = (C_) >> 2, e_ = (C_) & 3; pw[KB_][s_][e_] = pk2(P_[8 * s_ + 2 * e_], P_[8 * s_ + 2 * e_ + 1]); } while (0)
#define EXPR(P_, LO_, HI_) do { _Pragma("unroll") for (int x_ = (LO_); x_ < (HI_); ++x_) { float e_ = __builtin_amdgcn_exp2f(P_[x_]); asm volatile("" : "+v"(e_)); P_[x_] = e_; } } while (0)
#define SUMR(P_, LO_, HI_) do { _Pragma("unroll") for (int x_ = (LO_); x_ < (HI_); ++x_) lrun += P_[x_]; asm volatile("" : "+v"(lrun)); } while (0)
#define FILL_A(E0_, E1_, G_) do { \
      if ((G_) < EG) EXPR(E1_, ((G_) * 16) / EG, (((G_) + 1) * 16) / EG); \
      if ((G_) >= 1 && (G_) <= EG) SUMR(E1_, (((G_) - 1) * 16) / EG, ((G_) * 16) / EG); \
      if ((G_) < EG) { _Pragma("unroll") for (int c = ((G_) * 8) / EG; c < (((G_) + 1) * 8) / EG; ++c) PACK1(E0_, 0, c); } \
      else { _Pragma("unroll") for (int c = (((G_) - EG) * 8) / (NQK - EG); c < (((G_) - EG + 1) * 8) / (NQK - EG); ++c) PACK1(E1_, 1, c); } } while (0)
#define FILL_B(R0_, G_) do { EXPR(R0_, 2 * (G_), 2 * (G_) + 2); if ((G_) >= 1) SUMR(R0_, 2 * (G_) - 2, 2 * (G_)); if ((G_) == NPV - 1) SUMR(R0_, 14, 16); } while (0)
#define STEP_MID(R0_, R1_, E0_, E1_, BOC_, BOP_) do { \
      _Pragma("unroll") for (int g = 0; g < NQK; ++g) { \
        QKM(R0_, R1_, g); \
        if (g + 2 < NQK) KRD1(BOC_, g + 2); \
        if (g >= NQK - 2) VRDG(BOP_, g - (NQK - 2)); \
        FILL_A(E0_, E1_, g); \
        SB_(); } \
      _Pragma("unroll") for (int g = 0; g < NPV; ++g) { \
        PVM(g); \
        if (g + 2 < NPV) VRDG(BOP_, g + 2); \
        FILL_B(R0_, g); \
        SB_(); } } while (0)
#define STEP_HEAD(R0_, R1_, BOC_) do { \
      _Pragma("unroll") for (int g = 0; g < NQK; ++g) { QKM(R0_, R1_, g); if (g + 2 < NQK) KRD1(BOC_, g + 2); SB_(); } \
      _Pragma("unroll") for (int g = 0; g < NPV; ++g) { FILL_B(R0_, g); } SB_(); } while (0)
#define STEP_TAIL(E0_, E1_, BOP_) do { \
      VRDG(BOP_, 0); VRDG(BOP_, 1); \
      _Pragma("unroll") for (int g = 0; g < NQK; ++g) FILL_A(E0_, E1_, g); SB_(); \
      _Pragma("unroll") for (int g = 0; g < NPV; ++g) { PVM(g); if (g + 2 < NPV) VRDG(BOP_, g + 2); SB_(); } } while (0)
#define STEP_PRE(I_, KR_) do { const int i__ = (I_); \
      if (KR_) { KRD1(bo_cur, 0); KRD1(bo_cur, 1); } \
      if (i__ + 1 < ntl) ATT_STORE(bo_next); \
      if (i__ + 2 < ntl) ATT_LOAD(ATT_TILE(i__ + 2)); \
      SB_(); } while (0)
#define STEP_POST() do { bo_prev = bo_cur; bo_cur = bo_next; bo_next = (bo_next == 2 * STG) ? 0 : bo_next + STG; __syncthreads(); } while (0)
  ATT_LOAD(ATT_TILE(0));
  ATT_STORE(0);
  if (ntl > 1) ATT_LOAD(ATT_TILE(1));
  __syncthreads();
  int bo_prev = 0, bo_cur = 0, bo_next = STG;
  STEP_PRE(0, true); STEP_HEAD(pA0, pA1, bo_cur); STEP_POST();
  int it = 1;
  for (; it + 1 < ntl; it += 2) {
    STEP_PRE(it, true); STEP_MID(pB0, pB1, pA0, pA1, bo_cur, bo_prev); STEP_POST();
    STEP_PRE(it + 1, true); STEP_MID(pA0, pA1, pB0, pB1, bo_cur, bo_prev); STEP_POST();
  }
  if (it < ntl) {
    STEP_PRE(it, true); STEP_MID(pB0, pB1, pA0, pA1, bo_cur, bo_prev); STEP_POST();
    STEP_TAIL(pB0, pB1, bo_prev);
  } else {
    STEP_TAIL(pA0, pA1, bo_prev);
  }
  __syncthreads();
#undef ATT_TILE
#undef ATT_LOAD
#undef ATT_STORE
#undef SB_
#undef KRD1
#undef VRDG
#undef QKM
#undef PVM
#undef PACK1
#undef EXPR
#undef SUMR
#undef FILL_A
#undef FILL_B
#undef STEP_MID
#undef STEP_HEAD
#undef STEP_TAIL
#undef STEP_PRE
#undef STEP_POST
  float ltot = lrun + __shfl_xor(lrun, 32);
  if (has_sink) ltot += __builtin_amdgcn_exp2f(sink_l2 + negmb);
  const float is_ = OSC / ltot;
  unsigned char* op = Ob + (size_t)qrow * ldo + 4 * hi;
#pragma unroll
  for (int db = 0; db < 2; ++db)
#pragma unroll
    for (int r4 = 0; r4 < 4; ++r4)
      *(unsigned*)(op + db * 32 + 8 * r4) = pk4_fp8(o[db][4 * r4] * is_, o[db][4 * r4 + 1] * is_, o[db][4 * r4 + 2] * is_, o[db][4 * r4 + 3] * is_);
}

#define TOPK_INSERT(ARR, KEY) do { unsigned k__ = (KEY); _Pragma("unroll") for (int t_ = 0; t_ < 16; ++t_) { const unsigned h__ = max(ARR[t_], k__); k__ = min(ARR[t_], k__); ARR[t_] = h__; } } while (0)
__device__ __forceinline__ void peer_phase(LAS unsigned char* lds, const bf16_t* __restrict__ S, const unsigned char* __restrict__ H, const unsigned char* __restrict__ U, const unsigned char* __restrict__ V, float uinv, float vinv,
                                           const float* __restrict__ modl, bf16_t* xl, bf16_t* xc, float* outf, bool last, bool live, unsigned char* Hn, const float* __restrict__ gn, const float* __restrict__ modn, int wv) {
  const int tid_ = otid(wv); const int lane = tid_ & 63, wid = tid_ >> 6;
  LAS unsigned* keysL = (LAS unsigned*)(lds + wid * 10240);
  LAS u32x2* resL = (LAS u32x2*)(lds + wid * 10240 + 6144);
  LAS float* wL = (LAS float*)(lds + wid * 10240 + 4096);
  const int ngroups = last ? (NB * SEQ / 4) : (M / 4);
  const int nwav = gridDim.x * NWAVES, nfull = (ngroups / nwav) * nwav, nitems = nfull + (ngroups - nfull) * 4;
  for (int q = blockIdx.x * NWAVES + wid; q < nitems; q += nwav) {
    const int g = (q < nfull) ? q : nfull + ((q - nfull) >> 2);
    const int tk0 = (q < nfull) ? 0 : ((q - nfull) & 3), tk1 = (q < nfull) ? 4 : tk0 + 1;
    const int r0 = last ? (g / (SEQ / 4)) * TPB + (g % (SEQ / 4)) * 4 : g * 4;
    const int tok = lane >> 4, hc = lane & 15;
    unsigned top[16];
    const bf16_t* sp = S + (size_t)(r0 + tok) * 2048 + hc * 128;
#define CE_DESC(A_, B_) do { const unsigned h__ = max(A_, B_), l__ = min(A_, B_); A_ = h__; B_ = l__; } while (0)
    u32x4 nx0 = *(const u32x4*)sp, nx1 = *(const u32x4*)(sp + 8);
#pragma unroll 1
    for (int j0 = 0; j0 < 128; j0 += 16) {
      unsigned blk[16];
      { const u32x4 v0 = nx0, v1 = nx1; { const int jn = (j0 + 16 < 128) ? j0 + 16 : j0; nx0 = *(const u32x4*)(sp + jn); nx1 = *(const u32x4*)(sp + jn + 8); }
        const unsigned base = (unsigned)(127 - j0);
        blk[0] = (f2ord(bf_lo(v0.x)) & ~127u) | (base - 0u);  blk[1] = (f2ord(bf_hi(v0.x)) & ~127u) | (base - 1u);
        blk[2] = (f2ord(bf_lo(v0.y)) & ~127u) | (base - 2u);  blk[3] = (f2ord(bf_hi(v0.y)) & ~127u) | (base - 3u);
        blk[4] = (f2ord(bf_lo(v0.z)) & ~127u) | (base - 4u);  blk[5] = (f2ord(bf_hi(v0.z)) & ~127u) | (base - 5u);
        blk[6] = (f2ord(bf_lo(v0.w)) & ~127u) | (base - 6u);  blk[7] = (f2ord(bf_hi(v0.w)) & ~127u) | (base - 7u);
        blk[8] = (f2ord(bf_lo(v1.x)) & ~127u) | (base - 8u);  blk[9] = (f2ord(bf_hi(v1.x)) & ~127u) | (base - 9u);
        blk[10] = (f2ord(bf_lo(v1.y)) & ~127u) | (base - 10u); blk[11] = (f2ord(bf_hi(v1.y)) & ~127u) | (base - 11u);
        blk[12] = (f2ord(bf_lo(v1.z)) & ~127u) | (base - 12u); blk[13] = (f2ord(bf_hi(v1.z)) & ~127u) | (base - 13u);
        blk[14] = (f2ord(bf_lo(v1.w)) & ~127u) | (base - 14u); blk[15] = (f2ord(bf_hi(v1.w)) & ~127u) | (base - 15u); }
#pragma unroll
      for (int k = 2; k <= 16; k <<= 1)
#pragma unroll
        for (int j = k >> 1; j > 0; j >>= 1)
#pragma unroll
          for (int i = 0; i < 16; ++i) { const int l = i ^ j; if (l > i) { if ((i & k) == 0) CE_DESC(blk[i], blk[l]); else CE_DESC(blk[l], blk[i]); } }
      if (j0 == 0) {
#pragma unroll
        for (int i = 0; i < 16; ++i) top[i] = blk[i];
      } else {
#pragma unroll
        for (int i = 0; i < 16; ++i) top[i] = max(top[i], blk[15 - i]);
#pragma unroll
        for (int j = 8; j > 0; j >>= 1)
#pragma unroll
          for (int i = 0; i < 16; ++i) { const int l = i ^ j; if (l > i) CE_DESC(top[i], top[l]); }
      }
    }
#undef CE_DESC
#pragma unroll
    for (int i = 0; i < 16; ++i) keysL[lane * 16 + i] = top[i];
    float v0[16], v1[16];
#pragma unroll
    for (int i = 0; i < 16; ++i) { const unsigned t1 = __shfl_down(top[i], 1); v0[i] = ord2f(top[i] & ~127u); v1[i] = ord2f(t1 & ~127u); }
    unsigned cd[16];
#define PEER_CK(a_, b_) ((f2ord(v0[a_] + v1[b_]) & ~255u) | (unsigned)(255 - ((a_) * 16 + (b_))))
#define PEER_MERGE(N_, A_, B_) do { unsigned L_[N_]; _Pragma("unroll") for (int i_ = 0; i_ < (N_); ++i_) L_[i_] = PEER_CK(A_, B_); \
      _Pragma("unroll") for (int i_ = 16 - (N_); i_ < 16; ++i_) cd[i_] = max(cd[i_], L_[15 - i_]); \
      _Pragma("unroll") for (int j_ = 8; j_ > 0; j_ >>= 1) _Pragma("unroll") for (int i_ = 0; i_ < 16; ++i_) { const int l_ = i_ ^ j_; if (l_ > i_) { const unsigned h__ = max(cd[i_], cd[l_]), m__ = min(cd[i_], cd[l_]); cd[i_] = h__; cd[l_] = m__; } } } while (0)
#pragma unroll
    for (int a = 0; a < 16; ++a) cd[a] = PEER_CK(a, 0);
    PEER_MERGE(15, 0, i_ + 1);
    PEER_MERGE(7, i_ + 1, 1);
    PEER_MERGE(6, 1, i_ + 2);
    PEER_MERGE(3, i_ + 2, 2);
    PEER_MERGE(2, 2, i_ + 3);
    TOPK_INSERT(cd, PEER_CK(3, 3));
#undef PEER_MERGE
#undef PEER_CK
    {
      float e[16]; float sum = 0.f; const float mx = ord2f(cd[0] & ~255u);
#pragma unroll
      for (int k = 0; k < 16; ++k) { e[k] = __expf(ord2f(cd[k] & ~255u) - mx); sum += e[k]; }
      const float inv = 1.f / sum;
      const int lp1 = (lane + 1) & 63;
#pragma unroll
      for (int k = 0; k < 16; ++k) {
        const int pos = 255 - (int)(cd[k] & 255u), a = pos >> 4, b = pos & 15;
        const unsigned i1 = 127u - (keysL[lane * 16 + a] & 127u), i2 = 127u - (keysL[lp1 * 16 + b] & 127u);
        if ((hc & 1) == 0) resL[tok * 128 + (hc >> 1) * 16 + k] = (u32x2){i1 * 128u + i2, __float_as_uint(e[k] * inv)};
      }
    }
    LAS unsigned char* parL = (LAS unsigned char*)keysL;
    if (live) {
      const int b_ = r0 / TPB, s_ = r0 - b_ * TPB; const int bi_ = (s_ >= SEQ) ? 8 : b_;
      const float* gt_ = modl + (size_t)(bi_ * 6 + 5) * D + lane * 16;
      f32x4 t4[4];
#pragma unroll
      for (int q = 0; q < 4; ++q) t4[q] = ((const f32x4*)gt_)[q];
      *(LAS u32x4*)(parL + lane * 32) = (u32x4){pk2(t4[0].x, t4[0].y), pk2(t4[0].z, t4[0].w), pk2(t4[1].x, t4[1].y), pk2(t4[1].z, t4[1].w)};
      *(LAS u32x4*)(parL + lane * 32 + 16) = (u32x4){pk2(t4[2].x, t4[2].y), pk2(t4[2].z, t4[2].w), pk2(t4[3].x, t4[3].y), pk2(t4[3].z, t4[3].w)};
      if (Hn != nullptr) {
        const float* sh_ = modn + (size_t)(bi_ * 6) * D + lane * 16; const float* sc_ = sh_ + D; const float* gg_ = gn + lane * 16;
#pragma unroll
        for (int q = 0; q < 4; ++q) { const f32x4 g4 = ((const f32x4*)gg_)[q], s4 = ((const f32x4*)sc_)[q]; t4[q] = g4 * (1.f + s4); }
        *(LAS u32x4*)(parL + 2048 + lane * 32) = (u32x4){pk2(t4[0].x, t4[0].y), pk2(t4[0].z, t4[0].w), pk2(t4[1].x, t4[1].y), pk2(t4[1].z, t4[1].w)};
        *(LAS u32x4*)(parL + 2048 + lane * 32 + 16) = (u32x4){pk2(t4[2].x, t4[2].y), pk2(t4[2].z, t4[2].w), pk2(t4[3].x, t4[3].y), pk2(t4[3].z, t4[3].w)};
#pragma unroll
        for (int q = 0; q < 4; ++q) t4[q] = ((const f32x4*)sh_)[q];
        *(LAS u32x4*)(parL + 4096 + lane * 32) = (u32x4){pk2(t4[0].x, t4[0].y), pk2(t4[0].z, t4[0].w), pk2(t4[1].x, t4[1].y), pk2(t4[1].z, t4[1].w)};
        *(LAS u32x4*)(parL + 4096 + lane * 32 + 16) = (u32x4){pk2(t4[2].x, t4[2].y), pk2(t4[2].z, t4[2].w), pk2(t4[3].x, t4[3].y), pk2(t4[3].z, t4[3].w)};
      }
    }
#define PAR_F4(V_, Q_) ([&]() { const u32x2 w_ = *(const LAS u32x2*)(parL + (V_) * 2048 + lane * 32 + (Q_) * 8); return (f32x4){bf_lo(w_.x), bf_hi(w_.x), bf_lo(w_.y), bf_hi(w_.y)}; }())
    for (int tk = tk0; tk < tk1; ++tk) {
      const int r = r0 + tk;
      u32x2 ua[16], va[16], ub[16], vb[16];
      const unsigned lane8 = (unsigned)lane * 8u;
#define PEER_LOAD(UU, VV, BT) do { _Pragma("unroll") for (int i = 0; i < 16; ++i) { const unsigned o_ = resL[tk * 128 + (BT) * 16 + i].x * 512u + lane8;     \
        UU[i] = *(const u32x2*)(U + o_); VV[i] = *(const u32x2*)(V + o_); } } while (0)
      PEER_LOAD(ua, va, 0);
      unsigned hq1a, hq1b, hq2a, hq2b; float hstep;
      { const u32x4 hp = *(const u32x4*)(H + (size_t)r * D + lane * 16); hq1a = hp.x; hq1b = hp.y; hq2a = hp.z; hq2b = hp.w;
        hstep = ((const float*)(H + (WS_CKVN - WS_H)))[M + r]; }
      const float uscale = uinv * hstep * (1.f / 16.f);
      f32x2_t o2[8];
#pragma unroll
      for (int j = 0; j < 8; ++j) o2[j] = (f32x2_t){0.f, 0.f};
      const bool b5 = (lane & 32) != 0, b4 = (lane & 16) != 0, b3 = (lane & 8) != 0, b2 = (lane & 4) != 0;
      const int ei = (lane >> 2) & 15;
#define PEER_PROC(UU, VV, BT) do { int d[16]; \
        _Pragma("unroll") for (int i = 0; i < 16; ++i) { const int w0 = (int)UU[i].x, w1 = (int)UU[i].y; \
          const int i1 = __builtin_amdgcn_sdot8(w1, (int)hq1b, __builtin_amdgcn_sdot8(w0, (int)hq1a, 0, false), false); \
          d[i] = __builtin_amdgcn_sdot8(w1, (int)hq2b, __builtin_amdgcn_sdot8(w0, (int)hq2a, i1 << 4, false), false); }     \
        int k8[8], k4[4], k2[2], k1; \
        _Pragma("unroll") for (int i = 0; i < 8; ++i) { const auto r_ = __builtin_amdgcn_permlane32_swap((unsigned)d[i], (unsigned)d[8 + i], false, false); k8[i] = (int)(r_[0] + r_[1]); } \
        _Pragma("unroll") for (int i = 0; i < 4; ++i) { const auto r_ = __builtin_amdgcn_permlane16_swap((unsigned)k8[i], (unsigned)k8[4 + i], false, false); k4[i] = (int)(r_[0] + r_[1]); } \
        _Pragma("unroll") for (int i = 0; i < 2; ++i) { \
          const int sa = k4[i] + __builtin_amdgcn_update_dpp(0, k4[i], 0x128, 0xf, 0xf, false); \
          const int sb = k4[2 + i] + __builtin_amdgcn_update_dpp(0, k4[2 + i], 0x128, 0xf, 0xf, false); \
          k2[i] = b3 ? sb : sa; } \
        { const int keep = b2 ? k2[1] : k2[0], send = b2 ? k2[0] : k2[1]; k1 = keep + __shfl_xor(send, 4); } \
        k1 += __shfl_xor(k1, 2); k1 += __shfl_xor(k1, 1); \
        const float tot = (float)k1 * uscale; \
        const float gate = __uint_as_float(resL[tk * 128 + (BT) * 16 + ei].y); \
        const float wact = 0.5f * tot * (1.f + erff(tot * 0.70710678118f)) * gate * vinv; \
        _Pragma("unroll") for (int i = 0; i < 16; ++i) { const float wi = __int_as_float(__builtin_amdgcn_readlane(__float_as_int(wact), 4 * i)); const f32x2_t w2 = {wi, wi}; const unsigned w0 = VV[i].x, w1 = VV[i].y; \
          o2[0] = __builtin_elementwise_fma(__builtin_amdgcn_cvt_scalef32_pk_f32_fp4(w0, 1.0f, 0), w2, o2[0]); o2[1] = __builtin_elementwise_fma(__builtin_amdgcn_cvt_scalef32_pk_f32_fp4(w0, 1.0f, 1), w2, o2[1]); \
          o2[2] = __builtin_elementwise_fma(__builtin_amdgcn_cvt_scalef32_pk_f32_fp4(w0, 1.0f, 2), w2, o2[2]); o2[3] = __builtin_elementwise_fma(__builtin_amdgcn_cvt_scalef32_pk_f32_fp4(w0, 1.0f, 3), w2, o2[3]); \
          o2[4] = __builtin_elementwise_fma(__builtin_amdgcn_cvt_scalef32_pk_f32_fp4(w1, 1.0f, 0), w2, o2[4]); o2[5] = __builtin_elementwise_fma(__builtin_amdgcn_cvt_scalef32_pk_f32_fp4(w1, 1.0f, 1), w2, o2[5]); \
          o2[6] = __builtin_elementwise_fma(__builtin_amdgcn_cvt_scalef32_pk_f32_fp4(w1, 1.0f, 2), w2, o2[6]); o2[7] = __builtin_elementwise_fma(__builtin_amdgcn_cvt_scalef32_pk_f32_fp4(w1, 1.0f, 3), w2, o2[7]); } } while (0)
      for (int bt = 0; bt < 8; bt += 2) {
        PEER_LOAD(ub, vb, bt + 1);
        PEER_PROC(ua, va, bt);
        if (bt + 2 < 8) PEER_LOAD(ua, va, bt + 2);
        PEER_PROC(ub, vb, bt + 1);
      }
#undef PEER_LOAD
#undef PEER_PROC
      if (live) {
        const int b = r / TPB, s = r - b * TPB; const int bi = (s >= SEQ) ? 8 : b;
        bf16_t* xp = xrow_ptr(xl, xc, r) + lane * 16;
        f32x4 xn[4]; float ss = 0.f;
        { const u32x4 xa = *(const u32x4*)xp, xb = *(const u32x4*)(xp + 8);
          xn[0] = (f32x4){bf_lo(xa.x), bf_hi(xa.x), bf_lo(xa.y), bf_hi(xa.y)}; xn[1] = (f32x4){bf_lo(xa.z), bf_hi(xa.z), bf_lo(xa.w), bf_hi(xa.w)};
          xn[2] = (f32x4){bf_lo(xb.x), bf_hi(xb.x), bf_lo(xb.y), bf_hi(xb.y)}; xn[3] = (f32x4){bf_lo(xb.z), bf_hi(xb.z), bf_lo(xb.w), bf_hi(xb.w)}; }
#pragma unroll
        for (int q = 0; q < 4; ++q) {
          const f32x4 gv = PAR_F4(0, q);
          xn[q] += gv * (f32x4){o2[2 * q].x, o2[2 * q].y, o2[2 * q + 1].x, o2[2 * q + 1].y};
          ss += xn[q].x * xn[q].x + xn[q].y * xn[q].y + xn[q].z * xn[q].z + xn[q].w * xn[q].w;
        }
        if (last) {
          float* op = outf + (size_t)(b * SEQ + s) * D + lane * 16;
#pragma unroll
          for (int q = 0; q < 4; ++q) ((f32x4*)op)[q] = xn[q];
        } else {
          *(u32x4*)xp = (u32x4){pk2(xn[0].x, xn[0].y), pk2(xn[0].z, xn[0].w), pk2(xn[1].x, xn[1].y), pk2(xn[1].z, xn[1].w)};
          *(u32x4*)(xp + 8) = (u32x4){pk2(xn[2].x, xn[2].y), pk2(xn[2].z, xn[2].w), pk2(xn[3].x, xn[3].y), pk2(xn[3].z, xn[3].w)};
        }
        if (Hn != nullptr) {
          ss = wave_sum(ss);
          const float rstd = rsqrtf(ss * (1.f / D) + EPS);
          u32x4 h0;
#pragma unroll
          for (int q = 0; q < 4; ++q) {
            const f32x4 y = (xn[q] * rstd * PAR_F4(1, q) + PAR_F4(2, q)) * ASC;
            h0[q] = pk4_fp8(y.x, y.y, y.z, y.w);
          }
          *(u32x4*)(Hn + (size_t)r * D + lane * 16) = h0;
        }
      }
    }
  }
}

#define XB_TMO      128
#define XB_XCNT(j)  (256  + 64 * (j))
#define XB_XSUB(j)  (1280 + 64 * (j))
#define XB_XGEN(j)  (2304 + 64 * (j))
#define XB_TOP      3328
#define XB_TOPGEN   3392
#define XCD_BAR_WORDS 3456
#define XB_SPIN_CAP (1u << 20)
__device__ __forceinline__ unsigned xb_ld(unsigned* p)              { return __hip_atomic_load(p, __ATOMIC_RELAXED, __HIP_MEMORY_SCOPE_AGENT); }
__device__ __forceinline__ unsigned xb_add(unsigned* p, unsigned v) { return __hip_atomic_fetch_add(p, v, __ATOMIC_RELAXED, __HIP_MEMORY_SCOPE_AGENT); }
__device__ __forceinline__ unsigned xb_xcc_id() { return (unsigned)__builtin_amdgcn_s_getreg((3 << 11) | 20) & 0xFu; }
#define XB_SPIN(cond, bar) do { unsigned _sp = 0; while (cond) { __builtin_amdgcn_s_sleep(1); \
    if ((++_sp & 255u) == 0u) { if (xb_ld(&(bar)[XB_TMO])) break; if (_sp > XB_SPIN_CAP) { atomicAdd(&(bar)[XB_TMO], 1u); break; } } } } while (0)
struct XcdBarrier { unsigned* bar; unsigned x; volatile LAS unsigned* st; };
__device__ __forceinline__ XcdBarrier xcd_barrier_post(unsigned* bar, volatile LAS unsigned* st) {
    XcdBarrier b; b.bar = bar; b.x = xb_xcc_id(); b.st = st;
    if (threadIdx.x == 0) (void)xb_add(&bar[XB_XCNT(b.x)], 1u);
    return b;
}
__device__ __forceinline__ void xcd_barrier_complete(unsigned* bar, unsigned x, unsigned& nloc, unsigned& nx) {
    const unsigned G = gridDim.x * gridDim.y * gridDim.z;
    unsigned sum, cnt, mine, sp = 0u;
    for (;;) {
        sum = 0u; cnt = 0u; mine = 0u;
#pragma unroll
        for (unsigned j = 0; j < 16; ++j) { const unsigned c = xb_ld(&bar[XB_XCNT(j)]); sum += c; cnt += (c > 0u) ? 1u : 0u; mine = (j == x) ? c : mine; }
        if (sum == G) break;
        __builtin_amdgcn_s_sleep(1);
        if ((++sp & 255u) == 0u) { if (xb_ld(&bar[XB_TMO])) break; if (sp > XB_SPIN_CAP) { atomicAdd(&bar[XB_TMO], 1u); break; } }
    }
    nloc = mine > 0u ? mine : 1u; nx = cnt > 0u ? cnt : 1u;
}
__device__ __forceinline__ void xcd_barrier(const XcdBarrier& b, int wv) {
    asm volatile("s_waitcnt vmcnt(0)" ::: "memory");
    __syncthreads();
    if (otid(wv) == 0) {
        unsigned* bar = b.bar;
        __builtin_amdgcn_s_waitcnt(0);
        unsigned nloc = b.st[0], nx = b.st[1];
        if (nloc == 0u) { xcd_barrier_complete(bar, b.x, nloc, nx); b.st[0] = nloc; b.st[1] = nx; }
        const unsigned old = xb_add(&bar[XB_XSUB(b.x)], 1u);
        const unsigned gen = old / nloc;
        asm volatile("buffer_inv sc1" ::: "memory");
        if (old + 1u == (gen + 1u) * nloc) {
            __builtin_amdgcn_fence(__ATOMIC_RELEASE, "agent");
            asm volatile("s_waitcnt vmcnt(0)" ::: "memory");
            (void)xb_add(&bar[XB_TOP], 1u);
            XB_SPIN(xb_ld(&bar[XB_TOP]) < (gen + 1u) * nx, bar);
            asm volatile("s_waitcnt vmcnt(0)" ::: "memory");
        } else {
            XB_SPIN(xb_ld(&bar[XB_TOP]) < (gen + 1u) * nx, bar);
            asm volatile("s_waitcnt vmcnt(0)" ::: "memory");
        }
    }
    __syncthreads();
}

enum { ST_NORM = 0, ST_GEMM_BF16, ST_GEMM_F32, ST_GEMM_RESID, ST_LATNORM, ST_HN_MLA, ST_HN_DS, ST_ATTN_MLA, ST_ATTN_D, ST_ATTN_S, ST_PEER };
#define SV(t, v) ((t) | ((v) << 4))
#define SR(t, v) ((t) | ((v) << 4) | 0x80)
__device__ const unsigned char STEPS[3][24] = {
  {SV(ST_NORM, 0), SV(ST_GEMM_BF16, 0), SV(ST_LATNORM, 0), SV(ST_GEMM_BF16, 1), SV(ST_GEMM_BF16, 2), SV(ST_HN_MLA, 0), SV(ST_ATTN_MLA, 0), SV(ST_GEMM_RESID, 0), SV(ST_NORM, 1), SV(ST_GEMM_F32, 0), SV(ST_PEER, 0), 0xFF},
  {SV(ST_NORM, 0), SV(ST_GEMM_BF16, 0), SV(ST_HN_DS, 0), SV(ST_ATTN_D, 0), SV(ST_GEMM_RESID, 0), SV(ST_NORM, 1), SV(ST_GEMM_F32, 0), SV(ST_PEER, 0), 0xFF},
  {SV(ST_NORM, 0), SV(ST_GEMM_BF16, 0), SV(ST_HN_DS, 0), SV(ST_ATTN_S, 0), SV(ST_GEMM_RESID, 0), SV(ST_NORM, 1), SV(ST_GEMM_F32, 0), SV(ST_PEER, 0), 0xFF}};
__global__ void __launch_bounds__(NTHREADS, 2) mega(Params p) {
  extern __shared__ __attribute__((aligned(16))) unsigned char lds_raw[];
  LAS unsigned char* lds = (LAS unsigned char*)lds_raw;
  cg::grid_group grid = cg::this_grid();
  const int tid = threadIdx.x;
  const int wv_s = __builtin_amdgcn_readfirstlane(tid >> 6);
  unsigned char* ws = p.ws;
  float* modp = (float*)(ws + WS_MODP); float* mod = (float*)(ws + WS_MOD);
  float* tab8 = (float*)(ws + WS_TAB); float* tab16 = tab8 + 64 * 8 * 2; float* lamp = tab16 + 64 * 16 * 2;
  bf16_t* xl = (bf16_t*)(ws + WS_XL); bf16_t* xc = (bf16_t*)(ws + WS_XC);
  bf16_t* wdown_t = (bf16_t*)(ws + WS_WDOWN); bf16_t* wuq_t = (bf16_t*)(ws + WS_WUQ); bf16_t* wukv_t = (bf16_t*)(ws + WS_WUKV); bf16_t* mwo_t = (bf16_t*)(ws + WS_MWO);
  bf16_t* dqkv_t = (bf16_t*)(ws + WS_DQKV); bf16_t* dwo_t = (bf16_t*)(ws + WS_DWO); bf16_t* sqkv_t = (bf16_t*)(ws + WS_SQKV); bf16_t* swo_t = (bf16_t*)(ws + WS_SWO);
  bf16_t* pwq = (bf16_t*)(ws + WS_PWQ); bf16_t* pkeys = (bf16_t*)(ws + WS_PKEYS); bf16_t* weff_t = (bf16_t*)(ws + WS_WEFF);
  unsigned char* pu = ws + WS_PU; unsigned char* pv = ws + WS_PV;
  bf16_t* Hb = (bf16_t*)(ws + WS_H); bf16_t* Ob = (bf16_t*)(ws + WS_O);
  bf16_t* B1 = (bf16_t*)(ws + WS_BUF1); bf16_t* B2 = (bf16_t*)(ws + WS_BUF2); bf16_t* B3 = (bf16_t*)(ws + WS_BUF3); bf16_t* B4 = (bf16_t*)(ws + WS_BUF4);
  bf16_t* CQN = (bf16_t*)(ws + WS_CQN); bf16_t* CKVN = (bf16_t*)(ws + WS_CKVN); float* SC = (float*)(ws + WS_SC);

  volatile LAS unsigned* xb_st = (volatile LAS unsigned*)(lds + LDS_BYTES - 16);
  if (tid < 4) xb_st[tid] = 0u;
  __syncthreads();
  int phc = 0;
#define PH_BEGIN {
#define PH_END } ++phc; if (phc == 1) { grid.sync(); if (threadIdx.x == 0) (void)xb_add(&((unsigned*)p.ws)[XB_XCNT(xb_xcc_id())], 1u); } else { XcdBarrier xb_; xb_.bar = (unsigned*)p.ws; xb_.x = xb_xcc_id(); xb_.st = (volatile LAS unsigned*)(lds + LDS_BYTES - 16); xcd_barrier(xb_, wv_s); }

  PH_BEGIN
    int rot = 0;
    for (int j = 0; j < 2; ++j) {
      tr_job<true>(lds, p.mla_w_down + (size_t)j * 1024 * 1056, (unsigned char*)wdown_t + (size_t)j * 1280 * 1024, 1024, 1056, 1280, rot);
      tr_job<true>(lds, p.mla_w_uq + (size_t)j * 768 * 1536, (unsigned char*)wuq_t + (size_t)j * 1536 * 768, 768, 1536, 1536, rot);
      tr_job<false>(lds, p.mla_w_ukv + (size_t)j * 256 * 2048, wukv_t + (size_t)j * 2048 * 256, 256, 2048, 2048, rot);
      tr_job<true>(lds, p.mla_w_o + (size_t)j * 1024 * 1024, (unsigned char*)mwo_t + (size_t)j * 1024 * 1024, 1024, 1024, 1024, rot);
    }
    tr_job<true>(lds, p.diff_w_qkv, dqkv_t, 1024, 3072, 3072, rot);
    tr_job<true>(lds, p.diff_w_o, dwo_t, 1024, 1024, 1024, rot);
    tr_job<true>(lds, p.swa_w_qkv, sqkv_t, 1024, 1536, 1536, rot);
    tr_job<true>(lds, p.swa_w_o, swo_t, 1024, 1024, 1024, rot);
    ada_job(lds, p, modp);
    cvt_job(p.peer_w_q, pwq, (size_t)4 * 1024 * 2048 / 8);
    cvt_job(p.peer_keys, pkeys, (size_t)4 * 16 * 128 * 128 / 8);
    {
      const int wv = tid >> 6, ln = tid & 63, l = wv >> 1; const float* t = ((wv & 1) ? p.peer_v : p.peer_u) + (size_t)l * 16384 * 1024;
      float ss = 0.f;
#pragma unroll
      for (int q = 0; q < 8; ++q) { const f32x4 v = ((const f32x4*)t)[ln + 64 * q]; ss += v.x * v.x + v.y * v.y + v.z * v.z + v.w * v.w; }
      ss = wave_sum(ss);
      const float rms = sqrtf(ss * (1.f / 2048.f));
      if (blockIdx.x == 0 && ln == 0) lamp[4 + wv] = (wv & 1) ? rms * 0.5f : rms * 0.34f;
    }
    if (blockIdx.x == 0) { for (int z = tid; z < 4096; z += NTHREADS) ((unsigned*)ws)[z] = 0u; }
    if (blockIdx.x == 0 && tid == 0) {
      const float** t = (const float**)(ws + WS_PTRS);
      t[0] = p.x; t[1] = p.c; t[2] = p.ctx; t[3] = p.c_ctx; t[4] = p.ada_w; t[5] = p.ada_b; t[6] = p.norm_mix; t[7] = p.norm_ffn;
      t[8] = p.mla_w_down; t[9] = p.mla_g_cq; t[10] = p.mla_g_ckv; t[11] = p.mla_w_uq; t[12] = p.mla_w_ukv; t[13] = p.mla_g_q; t[14] = p.mla_g_k; t[15] = p.mla_w_o;
      t[16] = p.diff_w_qkv; t[17] = p.diff_g_q; t[18] = p.diff_g_k; t[19] = p.diff_lambda; t[20] = p.diff_g_sub; t[21] = p.diff_w_o;
      t[22] = p.swa_w_qkv; t[23] = p.swa_g_q; t[24] = p.swa_g_k; t[25] = p.swa_sink; t[26] = p.swa_w_o; t[27] = p.peer_w_q; t[28] = p.peer_keys; t[29] = p.peer_u; t[30] = p.peer_v;
    }
    if (blockIdx.x == gridDim.x - 1) {
      for (int i = tid; i < 64 * 8; i += NTHREADS) { const int pos = i >> 3, j = i & 7; const float ang = (float)pos * powf(10000.f, -(float)j / 8.f); tab8[2 * i] = cosf(ang); tab8[2 * i + 1] = sinf(ang); }
      for (int i = tid; i < 64 * 16; i += NTHREADS) { const int pos = i >> 4, j = i & 15; const float ang = (float)pos * powf(10000.f, -(float)j / 16.f); tab16[2 * i] = cosf(ang); tab16[2 * i + 1] = sinf(ang); }
      if (tid >= 64 && tid < 68) {
        const int q = tid - 64; const float* g = (q < 2) ? p.mla_g_k + q * 96 : (q == 2) ? p.diff_g_k : p.swa_g_k; const int n = (q < 2) ? 96 : 64;
        float mx = 0.f; for (int i = 0; i < n; ++i) mx = fmaxf(mx, fabsf(g[i]));
        lamp[12 + q] = sqrtf((float)n) * mx * 1.002f;
      }
      if (tid == 0) { float s01 = 0.f, s23 = 0.f; for (int i = 0; i < 64; ++i) { s01 += p.diff_lambda[i] * p.diff_lambda[64 + i]; s23 += p.diff_lambda[128 + i] * p.diff_lambda[192 + i]; }
        lamp[0] = expf(s01) - expf(s23) + LAM_INIT; }
    }
  PH_END
  PH_BEGIN
    for (int i = blockIdx.x * NTHREADS + tid; i < 4 * 9 * 6144; i += gridDim.x * NTHREADS) {
      const int col = i % 6144, l = i / (9 * 6144); float a = p.ada_b[l * 6144 + col];
#pragma unroll
      for (int kc = 0; kc < 64; ++kc) a += modp[(size_t)kc * (4 * 9 * 6144) + i];
      mod[i] = a;
    }
    for (int U = blockIdx.x; U < 256; U += gridDim.x) {
      const int q = U >> 2, l = q >> 4, hc = q & 15;
      gemm_phase(lds, pwq + (size_t)l * 1024 * 2048 + hc * 128, 2048, pkeys + (size_t)q * 128 * 128, 128, 1024, 128, 128, false,
                 EpiBf16T{weff_t + (size_t)l * 2048 * 1024 + (size_t)hc * 128 * 1024, 1024}, U & 3, 4);
    }
  PH_END

  for (int l = 0; l < 4; ++l) {
    int kind = l % 3; asm volatile("" : "+s"(kind));
    const bool last = (l == 3);
    for (int ss = 0; STEPS[kind][ss] != 0xFF; ++ss) {
      unsigned long long w_ = (unsigned long long)p.ws; asm volatile("" : "+s"(w_));
      unsigned char* w = (unsigned char*)(GAS unsigned char*)w_;
      const unsigned long long* tab = (const unsigned long long*)(w + WS_PTRS);
#define IN_(i) ((const float*)(GAS const float*)tab[i])
      bf16_t* xl = (bf16_t*)(w + WS_XL); bf16_t* xc = (bf16_t*)(w + WS_XC);
      const float* modl = (const float*)(w + WS_MOD) + (size_t)l * 9 * 6144;
      const float* tab8 = (const float*)(w + WS_TAB); const float* tab16 = tab8 + 64 * 8 * 2; const float* lamp = tab16 + 64 * 16 * 2;
      unsigned char* Hb = w + WS_H; unsigned char* Ob = w + WS_O; float* SC = (float*)(w + WS_SC);
      unsigned char* H8 = w + WS_O + 18 * MiB;
      bf16_t* LAT = (bf16_t*)(w + WS_BUF1); bf16_t* QP = (bf16_t*)(w + WS_BUF2); bf16_t* KV = (bf16_t*)(w + WS_BUF3); bf16_t* KB = (bf16_t*)(w + WS_BUF4); bf16_t* QKV = LAT;
      unsigned char* CQN = w + WS_CQN; bf16_t* CKVN = (bf16_t*)(w + WS_CKVN);
      bf16_t* QN = (bf16_t*)(w + WS_SC);
      const int ent = STEPS[kind][ss]; const int ty = ent & 15, var = (ent >> 4) & 7; const bool live = (ent & 0x80) == 0 || (p.phase == 777);
      int lo_ = l; asm volatile("" : "+s"(lo_)); const int j = (lo_ >= 3) ? 1 : 0;
      bool sync = true;
      if (ty == ST_NORM) {
        const bool first = (var == 0);
        if (first && l > 0) sync = false;
        else norm_phase(IN_(0), IN_(2), xl, xc, first && l == 0, (first ? IN_(6) : IN_(7)) + l * D, modl, first ? 0 : 3, first ? H8 : Hb, first, last && !first, first ? nullptr : w + WS_CQN, (float*)(w + WS_CKVN), wv_s);
        if (first && l == 0) {
          const int t2 = otid(wv_s), ln = t2 & 63;
          for (int R = blockIdx.x * NWAVES + (t2 >> 6); R < 4 * 2048; R += gridDim.x * NWAVES) {
            const bf16_t* src = (const bf16_t*)(w + WS_WEFF) + (size_t)R * 1024 + ln * 16; const u32x4 a = *(const u32x4*)src, b2 = *(const u32x4*)(src + 8);
            float f[16] = {bf_lo(a.x), bf_hi(a.x), bf_lo(a.y), bf_hi(a.y), bf_lo(a.z), bf_hi(a.z), bf_lo(a.w), bf_hi(a.w), bf_lo(b2.x), bf_hi(b2.x), bf_lo(b2.y), bf_hi(b2.y), bf_lo(b2.z), bf_hi(b2.z), bf_lo(b2.w), bf_hi(b2.w)};
            float am = 0.f;
#pragma unroll
            for (int i = 0; i < 16; ++i) am = fmaxf(am, fabsf(f[i]));
#pragma unroll
            for (int o = 32; o >= 1; o >>= 1) am = fmaxf(am, __shfl_xor(am, o));
            am = fmaxf(am, 1e-20f); const float qs = 127.f / am;
            unsigned ow[4];
#pragma unroll
            for (int i = 0; i < 4; ++i) { const int q0 = (int)rintf(f[4 * i] * qs), q1 = (int)rintf(f[4 * i + 1] * qs), q2 = (int)rintf(f[4 * i + 2] * qs), q3 = (int)rintf(f[4 * i + 3] * qs);
              ow[i] = (unsigned)(q0 & 255) | ((unsigned)(q1 & 255) << 8) | ((unsigned)(q2 & 255) << 16) | ((unsigned)(q3 & 255) << 24); }
            *(u32x4*)(w + WS_WEFF + 16 * MiB + (size_t)R * 1024 + ln * 16) = (u32x4){ow[0], ow[1], ow[2], ow[3]};
            if (ln == 0) ((float*)(w + WS_WEFF + 24 * MiB))[R] = am * (1.f / 127.f);
          }
        }
      } else if (ty == ST_GEMM_BF16) {
        const void* A = H8; const void* Bt; bf16_t* O; int N, K = 1024;
        if (kind == 0) {
          if (var == 0) { Bt = w + WS_WDOWN + (size_t)j * 1280 * 1024; N = 1280; O = LAT; }
          else if (var == 1) { A = CQN; Bt = w + WS_WUQ + (size_t)j * 1536 * 768; N = 1536; K = 768; O = QP; sync = false; }
          else { A = CKVN; Bt = (const bf16_t*)(w + WS_WUKV) + (size_t)j * 2048 * 256; N = 2048; K = 256; O = KV; }
        } else if (kind == 1) { Bt = w + WS_DQKV; N = 3072; O = QKV; }
        else { Bt = w + WS_SQKV; N = 1536; O = QKV; }
        pg8::LatentOrder S; S.init(M, N, gridDim.x, blockIdx.x, last && kind == 0 && var == 1);
        if (kind == 0 && var == 2) pg8::gemm_phase<pg8::EpiBf16P, pg8::LatentOrder, true, true, false>(lds, pg8::Gemm{(const bf16_t*)A, (const bf16_t*)Bt, M, N, K}, S, pg8::EpiBf16P{O, N, 1.f}, wv_s);
        else pg8::gemm_phase<pg8::EpiBf16P, pg8::LatentOrder, true, true, true>(lds, pg8::Gemm{(const bf16_t*)A, (const bf16_t*)Bt, M, N, K / 2}, S, pg8::EpiBf16P{O, N, 1.f / (ASC * WSC)}, wv_s);

        {
          const int nwg_ = (false ? (M / 9) * 8 / 256 : M / 256) * (N / 256), rem_ = nwg_ % (int)gridDim.x;
          if ((rem_ == 0 || (int)blockIdx.x >= rem_) && ((var == 0) ? 0 : -1) >= 0) {
            const int E_ = (rem_ == 0) ? (int)gridDim.x : (int)gridDim.x - rem_, e_ = (rem_ == 0) ? (int)blockIdx.x : (int)blockIdx.x - rem_;
            const int s0_ = (((var == 0) ? 0 : -1) == 0) ? 0 : (((var == 0) ? 0 : -1) == 1) ? 16 : 21000, s1_ = (((var == 0) ? 0 : -1) == 0) ? 16 : (((var == 0) ? 0 : -1) == 1) ? 21000 : 32768;
            const int per_ = (s1_ - s0_ + E_ - 1) / E_, a_ = s0_ + e_ * per_, b_ = min(s1_, a_ + per_);
            const float su_ = 1.f / lamp[4 + 2 * l], sv_ = 1.f / lamp[5 + 2 * l];
            conv_rows(IN_(29) + (size_t)l * 16384 * 1024, IN_(30) + (size_t)l * 16384 * 1024, w + WS_PU + (size_t)l * 16384 * 512, w + WS_PV + (size_t)l * 16384 * 512, su_, sv_, a_, b_, otid(wv_s));
          }
        }
      } else if (ty == ST_GEMM_RESID) {
        const unsigned char* Bt = (kind == 0) ? w + WS_MWO + (size_t)j * 1024 * 1024 : (kind == 1) ? w + WS_DWO : w + WS_SWO;
        pg8::LatentOrder S; S.init(M, 1024, gridDim.x, blockIdx.x, last);
        pg8::gemm_phase<pg8::EpiResidN, pg8::LatentOrder, true, true, true>(lds, pg8::Gemm{(const bf16_t*)Ob, (const bf16_t*)Bt, M, 1024, 512}, S, pg8::EpiResidN{IN_(0), IN_(2), l == 0, xl, xc, modl, 2, live, 1.f / (OSC * WSC)}, wv_s);

        {
          const int nwg_ = (last ? (M / 9) * 8 / 256 : M / 256) * (1024 / 256), rem_ = nwg_ % (int)gridDim.x;
          if ((rem_ == 0 || (int)blockIdx.x >= rem_) && 1 >= 0) {
            const int E_ = (rem_ == 0) ? (int)gridDim.x : (int)gridDim.x - rem_, e_ = (rem_ == 0) ? (int)blockIdx.x : (int)blockIdx.x - rem_;
            const int s0_ = (1 == 0) ? 0 : (1 == 1) ? 16 : 21000, s1_ = (1 == 0) ? 16 : (1 == 1) ? 21000 : 32768;
            const int per_ = (s1_ - s0_ + E_ - 1) / E_, a_ = s0_ + e_ * per_, b_ = min(s1_, a_ + per_);
            const float su_ = 1.f / lamp[4 + 2 * l], sv_ = 1.f / lamp[5 + 2 * l];
            conv_rows(IN_(29) + (size_t)l * 16384 * 1024, IN_(30) + (size_t)l * 16384 * 1024, w + WS_PU + (size_t)l * 16384 * 512, w + WS_PV + (size_t)l * 16384 * 512, su_, sv_, a_, b_, otid(wv_s));
          }
        }
      } else if (ty == ST_GEMM_F32) {
        pg8::LatentOrder S; S.init(M, 2048, gridDim.x, blockIdx.x, last);
        pg8::gemm_phase<pg8::EpiI8, pg8::LatentOrder, true, true, false, true>(lds, pg8::Gemm{(const bf16_t*)(w + WS_CQN), (const bf16_t*)(w + WS_WEFF + 16 * MiB + (size_t)l * 2048 * 1024), M, 2048, 512}, S,
                                                                              pg8::EpiI8{(bf16_t*)SC, 2048, (const float*)(w + WS_CKVN), (const float*)(w + WS_WEFF + 24 * MiB) + l * 2048}, wv_s);

        {
          const int nwg_ = (last ? (M / 9) * 8 / 256 : M / 256) * (2048 / 256), rem_ = nwg_ % (int)gridDim.x;
          if ((rem_ == 0 || (int)blockIdx.x >= rem_) && 2 >= 0) {
            const int E_ = (rem_ == 0) ? (int)gridDim.x : (int)gridDim.x - rem_, e_ = (rem_ == 0) ? (int)blockIdx.x : (int)blockIdx.x - rem_;
            const int s0_ = (2 == 0) ? 0 : (2 == 1) ? 16 : 21000, s1_ = (2 == 0) ? 16 : (2 == 1) ? 21000 : 32768;
            const int per_ = (s1_ - s0_ + E_ - 1) / E_, a_ = s0_ + e_ * per_, b_ = min(s1_, a_ + per_);
            const float su_ = 1.f / lamp[4 + 2 * l], sv_ = 1.f / lamp[5 + 2 * l];
            conv_rows(IN_(29) + (size_t)l * 16384 * 1024, IN_(30) + (size_t)l * 16384 * 1024, w + WS_PU + (size_t)l * 16384 * 512, w + WS_PV + (size_t)l * 16384 * 512, su_, sv_, a_, b_, otid(wv_s));
          }
        }
      } else if (ty == ST_LATNORM) {
        latnorm_phase(LAT, IN_(9) + j * 768, IN_(10) + j * 256, CQN, CKVN, wv_s);
      } else if (ty == ST_HN_MLA) {
        const float qs = 0.10206207261596577f * LOG2E;
        for (int gi = blockIdx.x * NTHREADS + otid(wv_s); gi < M * 32 * 4; gi += gridDim.x * NTHREADS) {
          const int i = gi >> 2, jl = gi & 3, r = i >> 5, it = i & 31, h = it & 15; const int b = r / TPB, s = r - b * TPB; const bool lat = s < SEQ;
          if (it < 16) { const bf16_t* q = QP + (size_t)r * 1536 + h * 96; headnorm96(q, q + 64, QN + (size_t)r * 1536 + h * 96, IN_(13) + j * 96, qs, lat, s >> 6, s & 63, tab8, jl); }
          else headnorm96(KV + (size_t)r * 2048 + h * 128, LAT + (size_t)r * 1280 + 1024, KB + (size_t)r * 1536 + h * 96, IN_(14) + j * 96, 1.f, lat, s >> 6, s & 63, tab8, jl);
        }
      } else if (ty == ST_HN_DS) {
        const float qs = 0.125f * LOG2E;
        const int ipr = (kind == 1) ? 32 : 20, pitch = (kind == 1) ? 3072 : 1536, npitch = (kind == 1) ? 2048 : 1280;
        const float* gq = (kind == 1) ? IN_(17) : IN_(23); const float* gk = (kind == 1) ? IN_(18) : IN_(24);
        for (int gi = blockIdx.x * NTHREADS + otid(wv_s); gi < M * ipr * 4; gi += gridDim.x * NTHREADS) {
          const int i = gi >> 2, jl = gi & 3; int r, it; if (kind == 1) { r = i >> 5; it = i & 31; } else { r = i / 20; it = i - r * 20; }
          const int b = r / TPB, s = r - b * TPB; const bool lat = s < SEQ;
          const bf16_t* q = QKV + (size_t)r * pitch + it * 64;
          headnorm64(q, QN + (size_t)r * npitch + it * 64, (it < 16) ? gq : gk, (it < 16) ? qs : 1.f, lat, s >> 6, s & 63, tab16, jl);
        }
      } else if (ty == ST_ATTN_MLA) {
        const int nu = last ? 1024 : 1152;
        for (int u = blockIdx.x; u < nu; u += gridDim.x) {
          int bh, q0, ta0; if (u < 1024) { const int x = u & 7, y = u >> 3; bh = ((y >> 3) << 3) + x; q0 = (y & 7) * 256; ta0 = 0; } else { bh = u - 1024; q0 = SEQ; ta0 = 32; }
          const int b = bh >> 4, h = bh & 15; const size_t rb = (size_t)b * TPB;
          attn_unit_p<96, 64, false>(lds, QN + rb * 1536 + h * 96, 1536, KB + rb * 1536 + h * 96, 1536, KV + rb * 2048 + h * 128 + 64, 2048,
                                     q0, ta0, 36, 0, 0, false, 0.f, lamp[12 + j], Ob + rb * D + h * 64, D, wv_s);
        }
      } else if (ty == ST_ATTN_D) {
        const float lam = lamp[0];
        for (int u = blockIdx.x; u < 1152; u += gridDim.x) {
          int bh, q0, ta0; if (u < 1024) { const int x = u & 7, y = u >> 3; bh = ((y >> 4) << 3) + x; q0 = (y & 15) * 128; ta0 = 0; } else { bh = (u - 1024) >> 1; q0 = SEQ + ((u - 1024) & 1) * 128; ta0 = 32; }
          const int b = bh >> 3, h = bh & 7; const size_t rb = (size_t)b * TPB;
          attn_unit<64, 128, 2, false>(lds, QN + rb * 2048 + h * 128, 64, 2048, QN + rb * 2048 + 1024 + h * 128, 64, 2048, QKV + rb * 3072 + 2048 + h * 128, 3072,
                                       q0, ta0, 36, 0, 0, false, 0.f, lamp[14], Ob + rb * D + h * 128, D, lam, IN_(20), wv_s);
        }
      } else if (ty == ST_ATTN_S) {
        for (int u = blockIdx.x; u < 1152; u += gridDim.x) {
          int bh, q0, ta0, ta1; if (u < 1024) { const int x = u & 7, y = u >> 3; bh = ((y >> 3) << 3) + x; q0 = (y & 7) * 256; ta0 = max(0, q0 / 64 - 2); ta1 = min(32, q0 / 64 + 6); } else { bh = u - 1024; q0 = SEQ; ta0 = 0; ta1 = 0; }
          const int b = bh >> 4, h = bh & 15, kvh = h >> 2; const size_t rb = (size_t)b * TPB;
          attn_unit<64, 64, 1, true>(lds, QN + rb * 1280 + h * 64, 0, 1280, QN + rb * 1280 + 1024 + kvh * 64, 0, 1280, QKV + rb * 1536 + 1280 + kvh * 64, 1536,
                                     q0, ta0, ta1, 32, 36, true, IN_(25)[h] * LOG2E, lamp[15], Ob + rb * D + h * 64, D, 0.f, nullptr, wv_s);
        }
      } else {
        peer_phase(lds, (const bf16_t*)SC, Hb, w + WS_PU + (size_t)l * 16384 * 512, w + WS_PV + (size_t)l * 16384 * 512, lamp[4 + 2 * l], lamp[5 + 2 * l], modl, xl, xc, p.out, last, live, last ? nullptr : H8, IN_(6) + (l + 1) * D, modl + 9 * 6144, wv_s);
      }
#undef IN_
      if (sync) { XcdBarrier xb_; xb_.bar = (unsigned*)p.ws; xb_.x = xb_xcc_id(); xb_.st = (volatile LAS unsigned*)(lds + LDS_BYTES - 16); xcd_barrier(xb_, wv_s); }
    }
  }
#undef PH_BEGIN
#undef PH_END
}

extern "C" void kernel_launch(void* const* d_in, const int* in_sizes, int n_in, void* d_out, int out_size, void* d_ws, size_t ws_size, hipStream_t stream) {
  static int grid_blocks = 0;
  if (grid_blocks == 0) {
    int dev = 0, cus = 0, per_cu = 0;
    if (n_in != 31 || out_size != NB * SEQ * D || ws_size < WS_TOTAL) { fprintf(stderr, "kernel_launch: unexpected shapes (n_in %d out %d ws %zu)\n", n_in, out_size, ws_size); grid_blocks = -1; return; }
    (void)hipGetDevice(&dev);
    (void)hipDeviceGetAttribute(&cus, hipDeviceAttributeMultiprocessorCount, dev);
    (void)hipFuncSetAttribute((const void*)mega, hipFuncAttributeMaxDynamicSharedMemorySize, LDS_BYTES);
    (void)hipOccupancyMaxActiveBlocksPerMultiprocessor(&per_cu, (const void*)mega, NTHREADS, LDS_BYTES);
    if (per_cu < 1) { fprintf(stderr, "kernel_launch: occupancy query says %d blocks/CU\n", per_cu); per_cu = 1; }
    grid_blocks = cus;
  }
  if (grid_blocks < 0) return;
  Params p{};
  const float** f = (const float**)&p;
  for (int i = 0; i < 31; ++i) f[i] = (const float*)d_in[i];
  p.out = (float*)d_out; p.ws = (unsigned char*)d_ws;
  p.single = 1; p.phase = 0;
  void* args[] = {&p};
  hipError_t e = hipLaunchCooperativeKernel((const void*)mega, dim3(grid_blocks), dim3(NTHREADS), args, LDS_BYTES, stream);
  if (e != hipSuccess) fprintf(stderr, "cooperative launch failed: %s (grid %d)\n", hipGetErrorString(e), grid_blocks);
}
```
